# Optimizing an MI355X kernel written in HIP

```python
import math
import jax
import jax.numpy as jnp
from jax import lax
import numpy as np

D_MODEL = 1024
BATCH = 2
SEQ = 16384
DEPTH = 4

N_NSA_HEADS = 8
N_KV_HEADS = 2
GQA_GROUP = N_NSA_HEADS // N_KV_HEADS
HEAD_DIM = 64
NSA_WIDTH = N_NSA_HEADS * HEAD_DIM
KV_WIDTH = N_KV_HEADS * HEAD_DIM
N_BRANCHES = 3
N_GATES = N_BRANCHES * N_NSA_HEADS
CMP_BLOCK = 32
CMP_STRIDE = 16
CMP_HIDDEN = 4 * HEAD_DIM
SLC_BLOCK = 64
SLC_TOPK = 16
N_LOCAL_BLOCKS = 2
WINDOW = 512
Q_BLOCK = 128
GMLP_WIDTH = D_MODEL - NSA_WIDTH
N_GMLP_GROUPS = 8
GMLP_GROUP_DIM = GMLP_WIDTH // N_GMLP_GROUPS
GMLP_CHUNK = 128
IN_WIDTH = NSA_WIDTH + 6 * KV_WIDTH + N_GATES + 2 * GMLP_WIDTH
D_FF = ((8 * D_MODEL + 3 * 256 - 1) // (3 * 256)) * 256
N_BUCKETS = 32
REL_MAX_DISTANCE = 128
RMS_EPS = 1e-6
LN_EPS = 1e-5

kernel_name = "nsa_gmlp_parallel_hybrid"


def rms_norm(x, g):
    xf = x.astype(jnp.float32)
    y = xf * lax.rsqrt(jnp.mean(xf * xf, axis=-1, keepdims=True) + RMS_EPS)
    return (y * g.astype(jnp.float32)).astype(x.dtype)


def layer_norm(x, g, b):
    xf = x.astype(jnp.float32)
    mu = jnp.mean(xf, axis=-1, keepdims=True)
    var = jnp.mean(jnp.square(xf - mu), axis=-1, keepdims=True)
    y = (xf - mu) * lax.rsqrt(var + LN_EPS)
    return (y * g.astype(jnp.float32) + b.astype(jnp.float32)).astype(x.dtype)


def t5_bucket(dist):
    n = jnp.maximum(dist, 0)
    max_exact = N_BUCKETS // 2
    nf = jnp.maximum(n, max_exact).astype(jnp.float32)
    large = max_exact + (jnp.log(nf / max_exact) / math.log(REL_MAX_DISTANCE / max_exact)
                         * (N_BUCKETS - max_exact)).astype(jnp.int32)
    return jnp.where(n < max_exact, n, jnp.minimum(large, N_BUCKETS - 1))


def bias_shared(table, dist):
    b = table.astype(jnp.float32)[t5_bucket(dist)]
    return b.transpose(2, 0, 1).reshape(N_KV_HEADS, GQA_GROUP, *dist.shape)


def bias_grouped(table, dist):
    tab = table.astype(jnp.float32).reshape(N_BUCKETS, N_KV_HEADS, GQA_GROUP)
    b = jax.vmap(lambda t, d: t[d], in_axes=(1, 1), out_axes=1)(tab, t5_bucket(dist))
    return b.transpose(0, 1, 4, 2, 3)


def masked_softmax(logits, mask):
    lg = jnp.where(mask, logits.astype(jnp.float32), -jnp.inf)
    m = jnp.max(lg, axis=-1, keepdims=True)
    m = jnp.where(jnp.isfinite(m), m, 0.0)
    e = jnp.where(mask, jnp.exp(lg - m), 0.0)
    return e / jnp.maximum(jnp.sum(e, axis=-1, keepdims=True), 1e-30)


def compress_tokens(t, pos_emb, w1, w2):
    B, G, S, dh = t.shape
    r = CMP_BLOCK // CMP_STRIDE
    n_chunks = S // CMP_STRIDE
    n_cmp = n_chunks - r + 1
    chunks = t.reshape(B, G, n_chunks, CMP_STRIDE, dh)
    blocks = jnp.concatenate([chunks[:, :, i:i + n_cmp] for i in range(r)], axis=3)
    blocks = (blocks + pos_emb).reshape(B, G, n_cmp, CMP_BLOCK * dh)
    return jax.nn.gelu(blocks @ w1) @ w2


gather_blocks = jax.vmap(jax.vmap(lambda blocks, ix: blocks[ix]))


def nsa_gmlp_mixer(h, w_in, cmp_pos_k, cmp_w1_k, cmp_w2_k, cmp_pos_v, cmp_w1_v, cmp_w2_v,
                   gmlp_ln_g, gmlp_ln_b, gmlp_w_s, gmlp_b_s, w_out, rel_bias):
    B, S, _ = h.shape
    G, R, dh = N_KV_HEADS, GQA_GROUP, HEAD_DIM
    proj = jnp.einsum("bsd,de->bse", h, w_in)
    sizes = [NSA_WIDTH] + [KV_WIDTH] * 6 + [N_GATES, GMLP_WIDTH]
    points = [sum(sizes[:i + 1]) for i in range(len(sizes))]
    q, k_c, v_c, k_s, v_s, k_w, v_w, gate_logits, u, v = jnp.split(proj, points, axis=-1)

    def heads_kv(t):
        return t.reshape(B, S, G, dh).transpose(0, 2, 1, 3)

    q = q.reshape(B, S, G, R, dh).transpose(0, 2, 3, 1, 4) * (HEAD_DIM ** -0.5)
    gates = jax.nn.sigmoid(gate_logits.astype(jnp.float32)).reshape(B, S, G, R, N_BRANCHES)
    gates = gates.transpose(0, 2, 3, 1, 4)

    kc = compress_tokens(heads_kv(k_c), cmp_pos_k, cmp_w1_k, cmp_w2_k)
    vc = compress_tokens(heads_kv(v_c), cmp_pos_v, cmp_w1_v, cmp_w2_v)
    n_cmp = kc.shape[2]
    cmp_start = jnp.arange(n_cmp, dtype=jnp.int32) * CMP_STRIDE
    cmp_end = cmp_start + (CMP_BLOCK - 1)

    n_slc = S // SLC_BLOCK
    ks_blocks = heads_kv(k_s).reshape(B, G, n_slc, SLC_BLOCK, dh)
    vs_blocks = heads_kv(v_s).reshape(B, G, n_slc, SLC_BLOCK, dh)
    slc_start = jnp.arange(n_slc, dtype=jnp.int32) * SLC_BLOCK
    ov = (jnp.minimum(cmp_start[:, None] + CMP_BLOCK, slc_start[None, :] + SLC_BLOCK)
          - jnp.maximum(cmp_start[:, None], slc_start[None, :]))
    overlap = jnp.maximum(ov, 0).astype(jnp.float32) / CMP_BLOCK
    k_sel = min(SLC_TOPK, n_slc)

    pad = ((0, 0), (0, 0), (WINDOW, 0), (0, 0))
    kw_pad = jnp.pad(heads_kv(k_w), pad)
    vw_pad = jnp.pad(heads_kv(v_w), pad)

    def query_block(qi):
        s0 = qi * Q_BLOCK
        tq = s0 + jnp.arange(Q_BLOCK, dtype=jnp.int32)
        qb = lax.dynamic_slice_in_dim(q, s0, Q_BLOCK, axis=3)
        gb = lax.dynamic_slice_in_dim(gates, s0, Q_BLOCK, axis=3)

        d_c = tq[:, None] - cmp_end[None, :]
        lg_c = jnp.einsum("bgrqd,bgkd->bgrqk", qb, kc).astype(jnp.float32) + bias_shared(rel_bias, d_c)
        p_c = masked_softmax(lg_c, d_c >= 0)
        o_c = jnp.einsum("bgrqk,bgkd->bgrqd", p_c.astype(vc.dtype), vc)

        imp = jnp.einsum("bgrqk,kn->bgqn", p_c, overlap)
        jq = (tq // SLC_BLOCK)[:, None]
        blk = jnp.arange(n_slc, dtype=jnp.int32)[None, :]
        forced = (blk == 0) | ((blk <= jq) & (blk > jq - N_LOCAL_BLOCKS))
        score = jnp.where(forced, jnp.inf, jnp.where(blk <= jq, imp, -jnp.inf))
        _, idx = lax.top_k(score, k_sel)
        kb = gather_blocks(ks_blocks, idx).reshape(B, G, Q_BLOCK, k_sel * SLC_BLOCK, dh)
        vb = gather_blocks(vs_blocks, idx).reshape(B, G, Q_BLOCK, k_sel * SLC_BLOCK, dh)
        key_pos = (idx[..., None] * SLC_BLOCK + jnp.arange(SLC_BLOCK, dtype=jnp.int32)
                   ).reshape(B, G, Q_BLOCK, k_sel * SLC_BLOCK)
        d_s = tq[None, None, :, None] - key_pos
        lg_s = jnp.einsum("bgrqd,bgqkd->bgrqk", qb, kb).astype(jnp.float32) + bias_grouped(rel_bias, d_s)
        p_s = masked_softmax(lg_s, (d_s >= 0)[:, :, None])
        o_s = jnp.einsum("bgrqk,bgqkd->bgrqd", p_s.astype(vb.dtype), vb)

        kwb = lax.dynamic_slice_in_dim(kw_pad, s0, WINDOW + Q_BLOCK, axis=2)
        vwb = lax.dynamic_slice_in_dim(vw_pad, s0, WINDOW + Q_BLOCK, axis=2)
        kpos = s0 - WINDOW + jnp.arange(WINDOW + Q_BLOCK, dtype=jnp.int32)
        d_w = tq[:, None] - kpos[None, :]
        mask_w = (d_w >= 0) & (d_w < WINDOW) & (kpos[None, :] >= 0)
        lg_w = jnp.einsum("bgrqd,bgkd->bgrqk", qb, kwb).astype(jnp.float32) + bias_shared(rel_bias, d_w)
        p_w = masked_softmax(lg_w, mask_w)
        o_w = jnp.einsum("bgrqk,bgkd->bgrqd", p_w.astype(vwb.dtype), vwb)

        o = gb[..., 0:1] * o_c + gb[..., 1:2] * o_s + gb[..., 2:3] * o_w
        return o.astype(h.dtype)

    o = lax.map(query_block, jnp.arange(S // Q_BLOCK, dtype=jnp.int32))
    nsa_out = o.transpose(1, 0, 4, 2, 3, 5).reshape(B, S, NSA_WIDTH)

    z_u = jax.nn.gelu(u)
    z_v = layer_norm(jax.nn.gelu(v), gmlp_ln_g, gmlp_ln_b)
    n_chunks = S // GMLP_CHUNK
    zv = z_v.reshape(B, n_chunks, GMLP_CHUNK, N_GMLP_GROUPS, GMLP_GROUP_DIM)
    causal = jnp.tril(jnp.ones((GMLP_CHUNK, GMLP_CHUNK), dtype=bool))
    w_s = jnp.where(causal, gmlp_w_s, 0.0).astype(zv.dtype)
    sv = jnp.einsum("gts,bnsgd->bntgd", w_s, zv) + gmlp_b_s.T[None, None, :, :, None]
    gm = (z_u.reshape(B, n_chunks, GMLP_CHUNK, N_GMLP_GROUPS, GMLP_GROUP_DIM) * sv).reshape(B, S, GMLP_WIDTH)

    mixed = jnp.concatenate([nsa_out, gm.astype(h.dtype)], axis=-1)
    return jnp.einsum("bse,ed->bsd", mixed, w_out)


def swiglu_ffn(h, w_gate_up, w_down):
    gate, up = jnp.split(jnp.einsum("bsd,df->bsf", h, w_gate_up), 2, axis=-1)
    return jnp.einsum("bsf,fd->bsd", jax.nn.silu(gate) * up, w_down)


def setup_inputs(seed: int = 0) -> dict:
    key = jax.random.key(seed)
    ks = jax.random.split(key, 20)
    f32 = jnp.float32
    L = DEPTH

    def nrm(k, shape, scale):
        return jax.random.normal(k, shape, f32) * scale

    def gain(k, shape):
        return 1.0 + 0.05 * jax.random.normal(k, shape, f32)

    return {
        "x": nrm(ks[0], (BATCH, SEQ, D_MODEL), 1.0),
        "rel_bias": nrm(ks[1], (N_BUCKETS, N_NSA_HEADS), 0.5),
        "norm_mix_pre": gain(ks[2], (L, D_MODEL)),
        "norm_mix_post": gain(ks[3], (L, D_MODEL)),
        "norm_ffn_pre": gain(ks[4], (L, D_MODEL)),
        "norm_ffn_post": gain(ks[5], (L, D_MODEL)),
        "w_in": nrm(ks[6], (L, D_MODEL, IN_WIDTH), D_MODEL ** -0.5),
        "cmp_pos_k": nrm(ks[7], (L, CMP_BLOCK, HEAD_DIM), 0.1),
        "cmp_w1_k": nrm(ks[8], (L, CMP_BLOCK * HEAD_DIM, CMP_HIDDEN), (CMP_BLOCK * HEAD_DIM) ** -0.5),
        "cmp_w2_k": nrm(ks[9], (L, CMP_HIDDEN, HEAD_DIM), CMP_HIDDEN ** -0.5),
        "cmp_pos_v": nrm(ks[10], (L, CMP_BLOCK, HEAD_DIM), 0.1),
        "cmp_w1_v": nrm(ks[11], (L, CMP_BLOCK * HEAD_DIM, CMP_HIDDEN), (CMP_BLOCK * HEAD_DIM) ** -0.5),
        "cmp_w2_v": nrm(ks[12], (L, CMP_HIDDEN, HEAD_DIM), CMP_HIDDEN ** -0.5),
        "gmlp_ln_g": gain(ks[13], (L, GMLP_WIDTH)),
        "gmlp_ln_b": nrm(ks[14], (L, GMLP_WIDTH), 0.02),
        "gmlp_w_s": nrm(ks[15], (L, N_GMLP_GROUPS, GMLP_CHUNK, GMLP_CHUNK), GMLP_CHUNK ** -0.5),
        "gmlp_b_s": gain(ks[16], (L, N_GMLP_GROUPS, GMLP_CHUNK)),
        "w_out": nrm(ks[17], (L, D_MODEL, D_MODEL), D_MODEL ** -0.5),
        "w_gate_up": nrm(ks[18], (L, D_MODEL, 2 * D_FF), D_MODEL ** -0.5),
        "w_down": nrm(ks[19], (L, D_FF, D_MODEL), D_FF ** -0.5),
    }


def reference(x, rel_bias, norm_mix_pre, norm_mix_post, norm_ffn_pre, norm_ffn_post, w_in,
              cmp_pos_k, cmp_w1_k, cmp_w2_k, cmp_pos_v, cmp_w1_v, cmp_w2_v,
              gmlp_ln_g, gmlp_ln_b, gmlp_w_s, gmlp_b_s, w_out, w_gate_up, w_down):
    h = x
    for l in range(DEPTH):
        mix = nsa_gmlp_mixer(rms_norm(h, norm_mix_pre[l]), w_in[l],
                             cmp_pos_k[l], cmp_w1_k[l], cmp_w2_k[l],
                             cmp_pos_v[l], cmp_w1_v[l], cmp_w2_v[l],
                             gmlp_ln_g[l], gmlp_ln_b[l], gmlp_w_s[l], gmlp_b_s[l],
                             w_out[l], rel_bias)
        h = h + rms_norm(mix, norm_mix_post[l])
        ffn = swiglu_ffn(rms_norm(h, norm_ffn_pre[l]), w_gate_up[l], w_down[l])
        h = h + rms_norm(ffn, norm_ffn_post[l])
    return h
```

```cpp
#include <hip/hip_runtime.h>
#include <hip/hip_cooperative_groups.h>
#include <cstdio>
#include <cstdint>
namespace cg = cooperative_groups;

#define LAS __attribute__((address_space(3)))
typedef unsigned short bf16_t;
typedef short bf16x8 __attribute__((ext_vector_type(8)));
typedef short s16x4 __attribute__((ext_vector_type(4)));
typedef float f32x2 __attribute__((ext_vector_type(2)));
typedef float f32x4 __attribute__((ext_vector_type(4)));
typedef float f32x16 __attribute__((ext_vector_type(16)));
typedef unsigned u32x2 __attribute__((ext_vector_type(2)));
typedef unsigned u32x4 __attribute__((ext_vector_type(4)));
typedef long l64x2 __attribute__((ext_vector_type(2)));

#ifndef REP_PA
#define REP_PA 1
#endif
#ifndef REP_PB
#define REP_PB 1
#endif
#ifndef REP_PC
#define REP_PC 1
#endif
#ifndef REP_PD
#define REP_PD 1
#endif
#ifndef REP_PF
#define REP_PF 1
#endif
#ifndef REP_PG
#define REP_PG 1
#endif
#ifndef SYNC_REP
#define SYNC_REP 1
#endif
#define GSYNC() do { for (int _r = 0; _r < SYNC_REP; ++_r) xcd_barrier((unsigned*)P_ws(p), (volatile LAS unsigned*)(lds + LDS_BYTES - 64)); } while (0)
#ifndef NSA_ENABLE
#define NSA_ENABLE 1
#endif

constexpr int NB = 2, S = 16384, DM = 1024, DEPTH = 4, MT = NB * S;
constexpr int INW = 2328, NINP = 2560, DFF = 2816, NGU = 2 * DFF;
constexpr int NCMP = 1024;
constexpr float RMS_EPS = 1e-6f, LN_EPS = 1e-5f;
constexpr float LOG2E = 1.4426950408889634f;
constexpr float QSCALE = 0.125f * LOG2E;
constexpr int NWAVES = 8, NTHREADS = 512;
constexpr int LDS_BYTES = 147456;

constexpr size_t MiB = 1u << 20;
constexpr size_t WS_W = 1 * MiB, W_LAYER = 26 * MiB;
constexpr size_t W_IN = 0, W_OUT = 5 * MiB, W_GU = 7 * MiB, W_DN = 18 * MiB, W_C1K = 23 * MiB + 512 * 1024, W_C1V = 24 * MiB + 512 * 1024,
                 W_C2K = 25 * MiB + 512 * 1024, W_C2V = W_C2K + 64 * 1024, W_CBK = W_C2V + 64 * 1024, W_CBV = W_CBK + 4096;
constexpr size_t WS_AN = 105 * MiB;
constexpr size_t WS_R1 = 169 * MiB;
constexpr size_t R_Q = 0, R_ZU = 32 * MiB, R_ZV = 64 * MiB, R_KC = 96 * MiB, R_VC = 105 * MiB, R_KS = 114 * MiB, R_VST = 122 * MiB, R_KW = 130 * MiB,
                 R_VWT = 138 * MiB, R_GATES = 146 * MiB, R_HID = 150 * MiB, R_KCMP = 154 * MiB, R_VCMPT = 155 * MiB;
constexpr size_t WS_MIX = 345 * MiB;
constexpr size_t WS_HB = WS_MIX + 64 * MiB;
constexpr size_t WS_RS = 256 * 1024;
constexpr size_t WS_END = 473 * MiB;

struct Params {
    const float* in[20];
    float* out;
    unsigned char* ws;
};

typedef const __attribute__((address_space(4))) unsigned char* kargp_t;
__device__ __forceinline__ void* karg_ld(int byte_off) {
    kargp_t k = (kargp_t)__builtin_amdgcn_kernarg_segment_ptr();
    int off = byte_off; asm volatile("" : "+s"(off));
    return *(void* const __attribute__((address_space(4)))*)(k + off);
}
__device__ __forceinline__ const float* P_in(const Params&, int i) { return (const float*)karg_ld(8 * i); }
__device__ __forceinline__ float* P_out(const Params&) { return (float*)karg_ld(160); }
__device__ __forceinline__ unsigned char* P_ws(const Params&) { return (unsigned char*)karg_ld(168); }
__device__ __forceinline__ unsigned cvt_pk_bf16(float lo, float hi) { unsigned r; asm volatile("v_cvt_pk_bf16_f32 %0, %1, %2" : "=v"(r) : "v"(lo), "v"(hi)); return r; }
__device__ __forceinline__ float fast_exp2(float x) { return __builtin_amdgcn_exp2f(x); }
__device__ __forceinline__ float fast_rcp(float x) { return __builtin_amdgcn_rcpf(x); }
__device__ __forceinline__ float gelu_tanh(float x) { const float u = x + 0.044715f * x * x * x; return x * fast_rcp(1.0f + fast_exp2(-2.3022081982f * u)); }
__device__ __forceinline__ float silu_f(float x) { return x * fast_rcp(1.0f + fast_exp2(-LOG2E * x)); }
__device__ __forceinline__ float sigmoid_f(float x) { return fast_rcp(1.0f + fast_exp2(-LOG2E * x)); }
__device__ __forceinline__ float wave_sum(float v) {
#pragma unroll
    for (int o = 1; o < 64; o <<= 1) v += __shfl_xor(v, o);
    return v;
}
__device__ __forceinline__ float wave_max(float v) {
#pragma unroll
    for (int o = 1; o < 64; o <<= 1) v = fmaxf(v, __shfl_xor(v, o));
    return v;
}
template <int CTRL> __device__ __forceinline__ float dpp_f(float x) { return __builtin_bit_cast(float, __builtin_amdgcn_mov_dpp(__builtin_bit_cast(int, x), CTRL, 0xf, 0xf, true)); }
__device__ __forceinline__ float xhalf_max(float x) { auto t = __builtin_amdgcn_permlane32_swap(__float_as_uint(x), __float_as_uint(x), false, false); return fmaxf(__uint_as_float(t[0]), __uint_as_float(t[1])); }
__device__ __forceinline__ float xhalf_sum(float x) { auto t = __builtin_amdgcn_permlane32_swap(__float_as_uint(x), __float_as_uint(x), false, false); return __uint_as_float(t[0]) + __uint_as_float(t[1]); }
__device__ __forceinline__ float quad_sum(float x) { x += dpp_f<0xB1>(x); x += dpp_f<0x4E>(x); return x; }
__device__ __forceinline__ float wave_max_fast(float x) {
    x = fmaxf(x, dpp_f<0xB1>(x)); x = fmaxf(x, dpp_f<0x4E>(x)); x = fmaxf(x, dpp_f<0x141>(x)); x = fmaxf(x, dpp_f<0x128>(x));
    auto s = __builtin_amdgcn_permlane16_swap(__float_as_uint(x), __float_as_uint(x), false, false); x = fmaxf(__uint_as_float(s[0]), __uint_as_float(s[1]));
    return xhalf_max(x);
}
__device__ __forceinline__ float wave_sum_fast(float x) {
    x += dpp_f<0xB1>(x); x += dpp_f<0x4E>(x); x += dpp_f<0x141>(x); x += dpp_f<0x128>(x);
    auto s = __builtin_amdgcn_permlane16_swap(__float_as_uint(x), __float_as_uint(x), false, false); x = __uint_as_float(s[0]) + __uint_as_float(s[1]);
    return xhalf_sum(x);
}
__device__ __forceinline__ float bf2f(bf16_t b) { return __uint_as_float(((unsigned)b) << 16); }
#define LAUNDER(x) asm volatile("" : "+v"(x))
#define MFMA32(a, b, c) __builtin_amdgcn_mfma_f32_32x32x16_bf16((a), (b), (c), 0, 0, 0)

namespace pg8 {
constexpr int BM = 256, BK = 64, HALF = 128, HTB = HALF * BK * 2, STAGE_BYTES = 8 * HTB, NXCD = 8, WGM = 8;
__host__ __device__ __forceinline__ int lds_byte(int r, int c) { const int st = (r >> 4) * 2 + (c >> 5), rr = r & 15, cc = c & 31, ob = rr * 64 + cc * 2; return st * 1024 + (ob ^ (((ob >> 9) & 1) << 5)); }
__host__ __device__ __forceinline__ void stage_rc(int b, int& R, int& C) { const int st = b / 1024, sb = b % 1024, swz = sb ^ (((sb >> 9) & 1) << 5); R = (st >> 1) * 16 + swz / 64; C = (st & 1) * 32 + (swz % 64) / 2; }
__host__ __device__ __forceinline__ int perm32(int rho) { const int n = rho >> 4, i = rho & 15; return 8 * (i >> 2) + 4 * n + (i & 3); }

struct Unit { int pm, pn; };
struct Gemm { const bf16_t* A; const bf16_t* Bt; int M, N, K, lda; };

struct StaticOrder {
    int nM, nN, nwg, G, c, lim;
    __device__ __forceinline__ void init(int M, int N, int G_, int c_, int reps = 1) { nM = M / BM; nN = N / BM; nwg = nM * nN; G = G_; c = c_; const int per = (c < nwg) ? (nwg - c + G - 1) / G : 0; lim = per * reps; }
    __device__ __forceinline__ bool next(int i, Unit& u) const {
        if (i >= lim) return false;
        const int per = (nwg - c + G - 1) / G; const long L = (long)(i % per) * G + c;
        int wgid = (int)L; { const int q = nwg / NXCD, r = nwg % NXCD, xcd = wgid % NXCD, off = wgid / NXCD; wgid = (xcd < r ? xcd * (q + 1) : r * (q + 1) + (xcd - r) * q) + off; }
        const int nig = WGM * nN, gid = wgid / nig, fm = gid * WGM, gsz = (nM - fm) < WGM ? (nM - fm) : WGM;
        u.pm = fm + ((wgid % nig) % gsz); u.pn = (wgid % nig) / gsz; return true;
    }
};

struct EpiF32 {
    static constexpr bool PERM = false;
    float* C; int ldc;
    __device__ __forceinline__ void operator()(const f32x4 (&acc)[2][2][4][2], const Unit& u, int wr, int wc, int fr, int fq) const {
        const int row0 = u.pm * BM + wr * 64 + fr, col0 = u.pn * BM + wc * 32 + 4 * fq;
#pragma unroll
        for (int ai = 0; ai < 2; ++ai)
#pragma unroll
            for (int m = 0; m < 4; ++m) { float* rowp = C + (size_t)(row0 + ai * HALF + m * 16) * ldc + col0;
#pragma unroll
                for (int bj = 0; bj < 2; ++bj)
#pragma unroll
                    for (int n = 0; n < 2; ++n) *(f32x4*)(rowp + bj * HALF + n * 16) = acc[ai][bj][m][n]; }
    }
};

struct EpiBf16 {
    static constexpr bool PERM = true;
    bf16_t* C; int ldc;
    __device__ __forceinline__ void operator()(const f32x4 (&acc)[2][2][4][2], const Unit& u, int wr, int wc, int fr, int fq) const {
        const int row0 = u.pm * BM + wr * 64 + fr, col0 = u.pn * BM + wc * 32 + 8 * fq;
#pragma unroll
        for (int ai = 0; ai < 2; ++ai)
#pragma unroll
            for (int m = 0; m < 4; ++m) { bf16_t* rowp = C + (size_t)(row0 + ai * HALF + m * 16) * ldc + col0;
#pragma unroll
                for (int bj = 0; bj < 2; ++bj) { const f32x4 v0 = acc[ai][bj][m][0], v1 = acc[ai][bj][m][1];
                    u32x4 w; w.x = cvt_pk_bf16(v0[0], v0[1]); w.y = cvt_pk_bf16(v0[2], v0[3]); w.z = cvt_pk_bf16(v1[0], v1[1]); w.w = cvt_pk_bf16(v1[2], v1[3]);
                    *(u32x4*)(rowp + bj * HALF) = w; } }
    }
};

struct EpiGU {
    static constexpr bool PERM = true;
    bf16_t* act; const float* rs;
    __device__ __forceinline__ void operator()(const f32x4 (&acc)[2][2][4][2], const Unit& u, int wr, int wc, int fr, int fq) const {
        const int row0 = u.pm * BM + wr * 64 + fr, col0 = u.pn * HALF + wc * 32 + 8 * fq;
        float rrv[2][4];
#pragma unroll
        for (int ai = 0; ai < 2; ++ai)
#pragma unroll
            for (int m = 0; m < 4; ++m) rrv[ai][m] = rs[row0 + ai * HALF + m * 16];
#pragma unroll
        for (int ai = 0; ai < 2; ++ai)
#pragma unroll
            for (int m = 0; m < 4; ++m) {
                const float rr = rrv[ai][m];
                const f32x4 g0 = acc[ai][0][m][0] * rr, g1 = acc[ai][0][m][1] * rr, u0 = acc[ai][1][m][0] * rr, u1 = acc[ai][1][m][1] * rr;
                u32x4 w;
                w.x = cvt_pk_bf16(silu_f(g0[0]) * u0[0], silu_f(g0[1]) * u0[1]); w.y = cvt_pk_bf16(silu_f(g0[2]) * u0[2], silu_f(g0[3]) * u0[3]);
                w.z = cvt_pk_bf16(silu_f(g1[0]) * u1[0], silu_f(g1[1]) * u1[1]); w.w = cvt_pk_bf16(silu_f(g1[2]) * u1[2], silu_f(g1[3]) * u1[3]);
                *(u32x4*)(act + (size_t)(row0 + ai * HALF + m * 16) * DFF + col0) = w;
            }
    }
};

struct EpiCmp1 {
    static constexpr bool PERM = true;
    bf16_t* hid; const float* cbias;
    __device__ __forceinline__ void operator()(const f32x4 (&acc)[2][2][4][2], const Unit& u, int wr, int wc, int fr, int fq) const {
        const int row0 = u.pm * BM + wr * 64 + fr;
#pragma unroll
        for (int bj = 0; bj < 2; ++bj) {
            const int col0 = bj * HALF + wc * 32 + 8 * fq;
            const f32x4 b0 = *(const f32x4*)(cbias + col0), b1 = *(const f32x4*)(cbias + col0 + 4);
#pragma unroll
            for (int ai = 0; ai < 2; ++ai)
#pragma unroll
                for (int m = 0; m < 4; ++m) {
                    const f32x4 v0 = acc[ai][bj][m][0] + b0, v1 = acc[ai][bj][m][1] + b1;
                    u32x4 w;
                    w.x = cvt_pk_bf16(gelu_tanh(v0[0]), gelu_tanh(v0[1])); w.y = cvt_pk_bf16(gelu_tanh(v0[2]), gelu_tanh(v0[3]));
                    w.z = cvt_pk_bf16(gelu_tanh(v1[0]), gelu_tanh(v1[1])); w.w = cvt_pk_bf16(gelu_tanh(v1[2]), gelu_tanh(v1[3]));
                    *(u32x4*)(hid + (size_t)(row0 + ai * HALF + m * 16) * 256 + col0) = w;
                }
        }
    }
};

struct EpiIn {
    static constexpr bool PERM = true;
    unsigned char* r1;
    const float* rs;
    __device__ __forceinline__ void operator()(const f32x4 (&acc)[2][2][4][2], const Unit& u, int wr, int wc, int fr, int fq) const {
        const int pn = u.pn;
        float rrv[2][4];
#pragma unroll
        for (int ai = 0; ai < 2; ++ai)
#pragma unroll
            for (int m = 0; m < 4; ++m) rrv[ai][m] = rs[u.pm * BM + ai * HALF + wr * 64 + m * 16 + fr];
#pragma unroll
        for (int ai = 0; ai < 2; ++ai)
#pragma unroll
            for (int m = 0; m < 4; ++m) {
                const int row = u.pm * BM + ai * HALF + wr * 64 + m * 16 + fr;
                const int b = row >> 14, s = row & (S - 1);
                const float rr = rrv[ai][m];
#pragma unroll
                for (int bj = 0; bj < 2; ++bj) {
                    f32x4 v0 = acc[ai][bj][m][0] * rr, v1 = acc[ai][bj][m][1] * rr;
                    const int cw = bj * HALF + wc * 32 + 8 * fq;
                    if (pn < 2) {
                        v0 = v0 * QSCALE; v1 = v1 * QSCALE;
                        u32x4 w; w.x = cvt_pk_bf16(v0[0], v0[1]); w.y = cvt_pk_bf16(v0[2], v0[3]); w.z = cvt_pk_bf16(v1[0], v1[1]); w.w = cvt_pk_bf16(v1[2], v1[3]);
                        *(u32x4*)((bf16_t*)(r1 + R_Q) + (size_t)row * 512 + pn * 256 + cw) = w;
                    } else if (pn < 5) {
                        const int g = wc >> 1, d = (wc & 1) * 32 + 8 * fq, bg = b * 2 + g;
                        if (pn == 2) {
                            bf16_t* base = (bf16_t*)(r1 + (bj == 0 ? R_KC : R_VC));
                            u32x4 w; w.x = cvt_pk_bf16(v0[0], v0[1]); w.y = cvt_pk_bf16(v0[2], v0[3]); w.z = cvt_pk_bf16(v1[0], v1[1]); w.w = cvt_pk_bf16(v1[2], v1[3]);
                            *(u32x4*)(base + ((size_t)bg * S + s) * 64 + d) = w;
                        } else if (pn == 3) {
                            if (bj == 0) {
                                int w0 = __builtin_amdgcn_cvt_pk_fp8_f32(v0[0], v0[1], 0, false); w0 = __builtin_amdgcn_cvt_pk_fp8_f32(v0[2], v0[3], w0, true);
                                int w1 = __builtin_amdgcn_cvt_pk_fp8_f32(v1[0], v1[1], 0, false); w1 = __builtin_amdgcn_cvt_pk_fp8_f32(v1[2], v1[3], w1, true);
                                u32x2 w; w.x = (unsigned)w0; w.y = (unsigned)w1;
                                *(u32x2*)(r1 + R_KS + (size_t)bg * S * 64 + (size_t)(s >> 6) * 4096 + ((s >> 4) & 3) * 1024 + (((d >> 3) & 3) * 16 + (s & 15)) * 16 + (d >> 5) * 8) = w;
                            } else {
                                const int kb = s & 63, kp = kb >> 5, k32 = kb & 31, fqv = (k32 >> 2) & 3, jj = ((k32 >> 4) << 2) | (k32 & 3);
                                unsigned char* dst = r1 + R_VST + (size_t)bg * S * 64 + (size_t)(s >> 6) * 4096 + (d >> 4) * 1024 + (fqv * 16 + (d & 15)) * 16 + kp * 8 + jj;
                                const int w0 = __builtin_amdgcn_cvt_pk_fp8_f32(v0[0], v0[1], 0, false), w1 = __builtin_amdgcn_cvt_pk_fp8_f32(v0[2], v0[3], 0, false);
                                const int w2 = __builtin_amdgcn_cvt_pk_fp8_f32(v1[0], v1[1], 0, false), w3 = __builtin_amdgcn_cvt_pk_fp8_f32(v1[2], v1[3], 0, false);
                                dst[0] = (unsigned char)(w0 & 0xff); dst[16] = (unsigned char)((w0 >> 8) & 0xff); dst[32] = (unsigned char)(w1 & 0xff); dst[48] = (unsigned char)((w1 >> 8) & 0xff);
                                dst[64] = (unsigned char)(w2 & 0xff); dst[80] = (unsigned char)((w2 >> 8) & 0xff); dst[96] = (unsigned char)(w3 & 0xff); dst[112] = (unsigned char)((w3 >> 8) & 0xff);
                            }
                        } else if (bj == 0) {
                            bf16_t* base = (bf16_t*)(r1 + R_KW);
                            u32x4 w; w.x = cvt_pk_bf16(v0[0], v0[1]); w.y = cvt_pk_bf16(v0[2], v0[3]); w.z = cvt_pk_bf16(v1[0], v1[1]); w.w = cvt_pk_bf16(v1[2], v1[3]);
                            *(u32x4*)(base + (size_t)bg * S * 64 + (size_t)(s >> 5) * 2048 + (d >> 4) * 512 + ((d >> 3) & 1) * 256 + (s & 31) * 8) = w;
                        } else {
                            const int kk = s & 31;
                            bf16_t* dst = (bf16_t*)(r1 + R_VWT) + (size_t)bg * S * 64 + (size_t)(s >> 5) * 2048 + (d >> 5) * 1024 + (kk >> 4) * 512 + ((kk >> 2) & 1) * 256 + (d & 31) * 8 + ((kk >> 3) & 1) * 4 + (kk & 3);
                            const unsigned w0 = cvt_pk_bf16(v0[0], v0[1]), w1 = cvt_pk_bf16(v0[2], v0[3]), w2 = cvt_pk_bf16(v1[0], v1[1]), w3 = cvt_pk_bf16(v1[2], v1[3]);
                            dst[0] = (bf16_t)(w0 & 0xffff); dst[8] = (bf16_t)(w0 >> 16); dst[16] = (bf16_t)(w1 & 0xffff); dst[24] = (bf16_t)(w1 >> 16);
                            dst[32] = (bf16_t)(w2 & 0xffff); dst[40] = (bf16_t)(w2 >> 16); dst[48] = (bf16_t)(w3 & 0xffff); dst[56] = (bf16_t)(w3 >> 16);
                        }
                    } else if (pn < 9) {
                        bf16_t* base = (bf16_t*)(r1 + ((pn < 7) ? R_ZU : R_ZV)); const int ct = (pn < 7) ? (pn - 5) : (pn - 7);
                        u32x4 w;
                        w.x = cvt_pk_bf16(gelu_tanh(v0[0]), gelu_tanh(v0[1])); w.y = cvt_pk_bf16(gelu_tanh(v0[2]), gelu_tanh(v0[3]));
                        w.z = cvt_pk_bf16(gelu_tanh(v1[0]), gelu_tanh(v1[1])); w.w = cvt_pk_bf16(gelu_tanh(v1[2]), gelu_tanh(v1[3]));
                        *(u32x4*)(base + (size_t)row * 512 + ct * 256 + cw) = w;
                    } else {
                        if (bj == 0 && wc == 0 && fq < 3) {
                            float* gp = (float*)(r1 + R_GATES) + (size_t)row * 24 + 8 * fq;
                            *(f32x4*)gp = (f32x4){sigmoid_f(v0[0]), sigmoid_f(v0[1]), sigmoid_f(v0[2]), sigmoid_f(v0[3])};
                            *(f32x4*)(gp + 4) = (f32x4){sigmoid_f(v1[0]), sigmoid_f(v1[1]), sigmoid_f(v1[2]), sigmoid_f(v1[3])};
                        }
                    }
                }
            }
    }
};

template <class Epi>
__device__ __forceinline__ void gemm_phase(LAS unsigned char* lds, const Gemm g, const StaticOrder& S, const Epi& E) {
    int tid = threadIdx.x; LAUNDER(tid);
    const int wid = __builtin_amdgcn_readfirstlane(tid >> 6), lane = tid & 63, wr = wid >> 2, wc = wid & 3, fr = lane & 15, fq = lane >> 4;
    const int K = g.K, nt = K / BK, lda = g.lda;
    unsigned voffA[2], voffB[2];
#pragma unroll
    for (int i = 0; i < 2; ++i) { int R, C; stage_rc(tid * 16 + i * 8192, R, C); const int Rb = Epi::PERM ? ((R & ~31) + perm32(R & 31)) : R;
        voffA[i] = (unsigned)(R * lda + C) * 2u; voffB[i] = (unsigned)(Rb * K + C) * 2u; }
    const size_t kstep = (size_t)(BK * 2);
    const size_t hA = (size_t)HALF * lda * 2, hB = (size_t)HALF * K * 2;
    const size_t tA = 2 * hA, tB = 2 * hB;
    const unsigned ldsw = (unsigned)wid * 1024u;
    const int aoff = lds_byte(wr * 64 + fr, fq * 8), boff = lds_byte(wc * 32 + fr, fq * 8);
#define PG8_SA(b, h) (((b) * 2 + (h)) * HTB)
#define PG8_SB(b, h) ((4 + (b) * 2 + (h)) * HTB)
#define PG8_STAGE(bufoff, gbase, voff) do { _Pragma("unroll") for (int _i = 0; _i < 2; ++_i) \
        __builtin_amdgcn_global_load_lds((const unsigned*)((const char*)(gbase) + (voff)[_i]), (LAS unsigned*)(lds + (bufoff) + ldsw + _i * 8192), 16, 0, 0); } while (0)
#define PG8_LDA(dst, b, h) do { _Pragma("unroll") for (int m = 0; m < 4; ++m) _Pragma("unroll") for (int k = 0; k < 2; ++k) dst[m][k] = *(const LAS bf16x8*)(lds + PG8_SA(b, h) + aoff + m * 2048 + k * 1024); } while (0)
#define PG8_LDB(dst, b, h) do { _Pragma("unroll") for (int n = 0; n < 2; ++n) _Pragma("unroll") for (int k = 0; k < 2; ++k) dst[n][k] = *(const LAS bf16x8*)(lds + PG8_SB(b, h) + boff + n * 2048 + k * 1024); } while (0)
#define PG8_MMA(ai, bj, At, Bt) do { __builtin_amdgcn_s_setprio(1); _Pragma("unroll") for (int m = 0; m < 4; ++m) _Pragma("unroll") for (int n = 0; n < 2; ++n) _Pragma("unroll") for (int k = 0; k < 2; ++k) \
        acc[ai][bj][m][n] = __builtin_amdgcn_mfma_f32_16x16x32_bf16(Bt[n][k], At[m][k], acc[ai][bj][m][n], 0, 0, 0); __builtin_amdgcn_s_setprio(0); } while (0)
#define PG8_WAIT_V(n) asm volatile("s_waitcnt vmcnt(" #n ")" ::: "memory")
#define PG8_WAIT_L(n) asm volatile("s_waitcnt lgkmcnt(" #n ")" ::: "memory")
#define PG8_BAR __builtin_amdgcn_s_barrier()
#define PG8_SCHED __builtin_amdgcn_sched_barrier(0)
    Unit cur, nxt; int ui = 0;
    if (!S.next(0, cur)) return;
    f32x4 acc[2][2][4][2];
#pragma unroll
    for (int a = 0; a < 2; ++a)
#pragma unroll
        for (int b = 0; b < 2; ++b)
#pragma unroll
            for (int m = 0; m < 4; ++m)
#pragma unroll
                for (int n = 0; n < 2; ++n) acc[a][b][m][n] = (f32x4){0.f, 0.f, 0.f, 0.f};
    bf16x8 At[4][2], B0[2][2], B1[2][2];
    const char* cA = (const char*)g.A + (size_t)cur.pm * tA; const char* cB = (const char*)g.Bt + (size_t)cur.pn * tB;
    PG8_STAGE(PG8_SB(0, 0), cB, voffB); PG8_STAGE(PG8_SB(0, 1), cB + hB, voffB); PG8_STAGE(PG8_SA(0, 0), cA, voffA); PG8_STAGE(PG8_SA(0, 1), cA + hA, voffA);
    if (wr == 1) PG8_BAR;
    PG8_WAIT_V(2); PG8_BAR;
    PG8_STAGE(PG8_SB(1, 0), cB + kstep, voffB); PG8_STAGE(PG8_SA(1, 0), cA + kstep, voffA); PG8_STAGE(PG8_SB(1, 1), cB + hB + kstep, voffB);
    PG8_WAIT_V(6); PG8_BAR;
    for (;;) {
        const bool has_next = S.next(ui + 1, nxt);
        const char* nA = has_next ? (const char*)g.A + (size_t)nxt.pm * tA : cA; const char* nB = has_next ? (const char*)g.Bt + (size_t)nxt.pn * tB : cB;
        for (int t = 0; t < nt; t += 2) {
            const bool last = (t == nt - 2);
            const char* a1 = cA + (size_t)(t + 1) * kstep;
            const char* a2 = last ? nA : cA + (size_t)(t + 2) * kstep; const char* b2 = last ? nB : cB + (size_t)(t + 2) * kstep;
            const char* a3 = a2 + kstep; const char* b3 = b2 + kstep;
            PG8_LDB(B0, 0, 0); PG8_LDB(B1, 0, 1); PG8_SCHED; PG8_LDA(At, 0, 0); PG8_STAGE(PG8_SA(1, 1), a1 + hA, voffA);
            PG8_WAIT_V(8); PG8_WAIT_L(0); PG8_BAR; PG8_MMA(0, 0, At, B0); PG8_MMA(0, 1, At, B1); PG8_BAR; PG8_SCHED;
            PG8_LDA(At, 0, 1); PG8_STAGE(PG8_SB(0, 0), b2, voffB); PG8_STAGE(PG8_SB(0, 1), b2 + hB, voffB); PG8_STAGE(PG8_SA(0, 0), a2, voffA);
            PG8_WAIT_V(8); PG8_WAIT_L(0); PG8_BAR; PG8_MMA(1, 0, At, B0); PG8_MMA(1, 1, At, B1); PG8_BAR; PG8_SCHED;
            PG8_LDB(B0, 1, 0); PG8_LDB(B1, 1, 1); PG8_SCHED; PG8_LDA(At, 1, 0); PG8_STAGE(PG8_SA(0, 1), a2 + hA, voffA);
            PG8_WAIT_V(8); PG8_WAIT_L(0); PG8_BAR; PG8_MMA(0, 0, At, B0); PG8_MMA(0, 1, At, B1); PG8_BAR; PG8_SCHED;
            PG8_LDA(At, 1, 1); PG8_STAGE(PG8_SB(1, 0), b3, voffB); PG8_STAGE(PG8_SB(1, 1), b3 + hB, voffB); PG8_STAGE(PG8_SA(1, 0), a3, voffA);
            PG8_WAIT_V(8); PG8_WAIT_L(0); PG8_BAR; PG8_MMA(1, 0, At, B0); PG8_MMA(1, 1, At, B1); PG8_BAR; PG8_SCHED;
        }
        if (wr == 0) PG8_BAR;
        E(acc, cur, wr, wc, fr, fq);
        if (!has_next) break;
#pragma unroll
        for (int a = 0; a < 2; ++a)
#pragma unroll
            for (int b = 0; b < 2; ++b)
#pragma unroll
                for (int m = 0; m < 4; ++m)
#pragma unroll
                    for (int n = 0; n < 2; ++n) acc[a][b][m][n] = (f32x4){0.f, 0.f, 0.f, 0.f};
        cur = nxt; cA = nA; cB = nB; ++ui;
        if (wr == 1) PG8_BAR;
    }
    PG8_WAIT_V(0);
    PG8_BAR;
#undef PG8_SA
#undef PG8_SB
#undef PG8_STAGE
#undef PG8_LDA
#undef PG8_LDB
#undef PG8_MMA
#undef PG8_WAIT_V
#undef PG8_WAIT_L
#undef PG8_BAR
#undef PG8_SCHED
}
}

template <int MAP> __device__ __forceinline__ int src_col(int n) {
    if (MAP == 0) return n;
    if (MAP == 1) { if (n < 1280) return n; if (n < 2304) return n + 24; if (n < 2328) return n - 1024; return -1; }
    const int t = n >> 8, w = n & 255; return (w < 128) ? (128 * t + w) : (DFF + 128 * t + (w - 128));
}
constexpr int TP = 65;
template <int MAP> __device__ __forceinline__ void transpose_item(const float* W, int K, int Nsrc, bf16_t* WT, int nblk, int item, LAS float* scr, int lane, const float* gain = nullptr) {
    const int kb = item / nblk, nb = item % nblk, k0 = 64 * kb, n0 = 64 * nb;
    const int nl = 4 * (lane & 15), kr = lane >> 4;
    const int ns = src_col<MAP>(n0 + nl);
    f32x4 v[16];
#pragma unroll
    for (int i = 0; i < 16; ++i) v[i] = (ns >= 0) ? *(const f32x4*)(W + (size_t)(k0 + kr + 4 * i) * Nsrc + ns) : (f32x4){0.f, 0.f, 0.f, 0.f};
    if (gain) {
#pragma unroll
        for (int i = 0; i < 16; ++i) v[i] = v[i] * gain[k0 + kr + 4 * i];
    }
#pragma unroll
    for (int i = 0; i < 16; ++i) { LAS float* d = scr + (kr + 4 * i) * TP + nl; d[0] = v[i][0]; d[1] = v[i][1]; d[2] = v[i][2]; d[3] = v[i][3]; }
    asm volatile("s_waitcnt lgkmcnt(0)" ::: "memory");
    __builtin_amdgcn_wave_barrier();
    const int c = lane & 7;
#pragma unroll
    for (int j = 0; j < 8; ++j) { const int n = (lane >> 3) + 8 * j; const LAS float* s = scr + (8 * c) * TP + n;
        u32x4 o; o.x = cvt_pk_bf16(s[0 * TP], s[1 * TP]); o.y = cvt_pk_bf16(s[2 * TP], s[3 * TP]); o.z = cvt_pk_bf16(s[4 * TP], s[5 * TP]); o.w = cvt_pk_bf16(s[6 * TP], s[7 * TP]);
        *(u32x4*)(WT + (size_t)(n0 + n) * K + k0 + 8 * c) = o; }
    asm volatile("s_waitcnt lgkmcnt(0)" ::: "memory");
    __builtin_amdgcn_wave_barrier();
}

__device__ __forceinline__ void row_pass(const float* x0, bf16_t* hb, const bf16_t* mix, const float* gpost, float* rs, float* fout, int gw, int NGW, int lane) {
    LAUNDER(lane);
    if (x0) {
        for (int m = gw; m < MT; m += NGW) {
            const f32x4* hr = (const f32x4*)(x0 + (size_t)m * DM) + lane;
            f32x4 h[4]; float s2 = 0.f;
#pragma unroll
            for (int j = 0; j < 4; ++j) { h[j] = hr[64 * j]; s2 += (h[j][0] * h[j][0] + h[j][1] * h[j][1]) + (h[j][2] * h[j][2] + h[j][3] * h[j][3]); }
            const float r2 = 1.0f / sqrtf(wave_sum_fast(s2) * (1.0f / DM) + RMS_EPS);
            u32x2* ao = (u32x2*)(hb + (size_t)m * DM) + lane;
#pragma unroll
            for (int j = 0; j < 4; ++j) { u32x2 w; w.x = cvt_pk_bf16(h[j][0], h[j][1]); w.y = cvt_pk_bf16(h[j][2], h[j][3]); ao[64 * j] = w; }
            if (lane == 0) rs[m] = r2;
        }
        return;
    }
    u32x2 hn[4], mn[4];
    if (gw < MT) {
        const u32x2* hr = (const u32x2*)(hb + (size_t)gw * DM) + lane; const u32x2* mr = (const u32x2*)(mix + (size_t)gw * DM) + lane;
#pragma unroll
        for (int j = 0; j < 4; ++j) { hn[j] = hr[64 * j]; mn[j] = mr[64 * j]; }
    }
    for (int m = gw; m < MT; m += NGW) {
        u32x2 hv[4], mv[4];
#pragma unroll
        for (int j = 0; j < 4; ++j) { hv[j] = hn[j]; mv[j] = mn[j]; }
        const int m2 = m + NGW;
        if (m2 < MT) {
            const u32x2* hr = (const u32x2*)(hb + (size_t)m2 * DM) + lane; const u32x2* mr = (const u32x2*)(mix + (size_t)m2 * DM) + lane;
#pragma unroll
            for (int j = 0; j < 4; ++j) { hn[j] = hr[64 * j]; mn[j] = mr[64 * j]; }
        }
        f32x4 h[4], x[4]; float ss = 0.f;
#pragma unroll
        for (int j = 0; j < 4; ++j) {
            h[j] = (f32x4){__uint_as_float(hv[j].x << 16), __uint_as_float(hv[j].x & 0xffff0000u), __uint_as_float(hv[j].y << 16), __uint_as_float(hv[j].y & 0xffff0000u)};
            x[j] = (f32x4){__uint_as_float(mv[j].x << 16), __uint_as_float(mv[j].x & 0xffff0000u), __uint_as_float(mv[j].y << 16), __uint_as_float(mv[j].y & 0xffff0000u)};
            ss += (x[j][0] * x[j][0] + x[j][1] * x[j][1]) + (x[j][2] * x[j][2] + x[j][3] * x[j][3]);
        }
        const float r1 = 1.0f / sqrtf(wave_sum_fast(ss) * (1.0f / DM) + RMS_EPS);
        float s2 = 0.f;
#pragma unroll
        for (int j = 0; j < 4; ++j) { const f32x4 gp = *((const f32x4*)gpost + lane + 64 * j); h[j] = h[j] + x[j] * r1 * gp; s2 += (h[j][0] * h[j][0] + h[j][1] * h[j][1]) + (h[j][2] * h[j][2] + h[j][3] * h[j][3]); }
        if (fout) {
            f32x4* ho = (f32x4*)(fout + (size_t)m * DM) + lane;
#pragma unroll
            for (int j = 0; j < 4; ++j) ho[64 * j] = h[j];
        } else {
            const float r2 = 1.0f / sqrtf(wave_sum_fast(s2) * (1.0f / DM) + RMS_EPS);
            u32x2* ao = (u32x2*)(hb + (size_t)m * DM) + lane;
#pragma unroll
            for (int j = 0; j < 4; ++j) { u32x2 w; w.x = cvt_pk_bf16(h[j][0], h[j][1]); w.y = cvt_pk_bf16(h[j][2], h[j][3]); ao[64 * j] = w; }
            if (lane == 0) rs[m] = r2;
        }
    }
}

constexpr int ZPITCH = 136;
__device__ __forceinline__ void gmlp_unit(const Params& p, int layer, int chunk, LAS unsigned char* lds, int wave, int lane) {
    LAUNDER(lane);
    const unsigned char* ws = P_ws(p);
    const bf16_t* zu = (const bf16_t*)(ws + WS_R1 + R_ZU); const bf16_t* zv = (const bf16_t*)(ws + WS_R1 + R_ZV);
    bf16_t* mixed = (bf16_t*)(ws + WS_AN);
    const float* ln_g = P_in(p, 13) + layer * 512; const float* ln_b = P_in(p, 14) + layer * 512;
    const float* w_s = P_in(p, 15) + (size_t)layer * 8 * 128 * 128 + (size_t)wave * 128 * 128;
    const float* b_s = P_in(p, 16) + layer * 8 * 128 + wave * 128;
    LAS float* stats = (LAS float*)(lds + 8 * 64 * ZPITCH * 2);
    LAS bf16_t* zt = (LAS bf16_t*)(lds + wave * 64 * ZPITCH * 2);
    const int tok0 = chunk * 128;
    __syncthreads();
#pragma unroll
    for (int i = 0; i < 16; ++i) {
        const int t = wave * 16 + i;
        const bf16x8 v = *(const bf16x8*)(zv + (size_t)(tok0 + t) * 512 + lane * 8);
        float s = 0.f, s2 = 0.f;
#pragma unroll
        for (int e = 0; e < 8; ++e) { const float x = bf2f((bf16_t)v[e]); s += x; s2 += x * x; }
        s = wave_sum_fast(s); s2 = wave_sum_fast(s2);
        const float mean = s * (1.0f / 512.0f); const float var = fmaxf(s2 * (1.0f / 512.0f) - mean * mean, 0.f);
        if (lane == 0) { stats[2 * t] = mean; stats[2 * t + 1] = 1.0f / sqrtf(var + LN_EPS); }
    }
    __syncthreads();
    {
        const int dc = lane & 7, d0 = dc * 8;
        const f32x4 g0 = *(const f32x4*)(ln_g + wave * 64 + d0), g1 = *(const f32x4*)(ln_g + wave * 64 + d0 + 4);
        const f32x4 b0 = *(const f32x4*)(ln_b + wave * 64 + d0), b1 = *(const f32x4*)(ln_b + wave * 64 + d0 + 4);
#pragma unroll 8
        for (int i = 0; i < 16; ++i) {
            const int s = (lane >> 3) + 8 * i;
            const bf16x8 v = *(const bf16x8*)(zv + (size_t)(tok0 + s) * 512 + wave * 64 + d0);
            const float mean = stats[2 * s], rstd = stats[2 * s + 1];
#pragma unroll
            for (int e = 0; e < 8; ++e) {
                const float gg = (e < 4) ? g0[e & 3] : g1[e & 3], bb = (e < 4) ? b0[e & 3] : b1[e & 3];
                const float y = (bf2f((bf16_t)v[e]) - mean) * rstd * gg + bb;
                zt[(d0 + e) * ZPITCH + s] = (bf16_t)(cvt_pk_bf16(y, 0.f) & 0xffff);
            }
        }
    }
    asm volatile("s_waitcnt lgkmcnt(0)" ::: "memory");
    __builtin_amdgcn_wave_barrier();
    const int r = lane & 31, h = lane >> 5;
#pragma unroll
    for (int mt = 0; mt < 4; ++mt) {
        f32x16 acc0, acc1;
#pragma unroll
        for (int i = 0; i < 16; ++i) { acc0[i] = 0.f; acc1[i] = 0.f; }
        const int t = 32 * mt + r;
#pragma unroll
        for (int ks = 0; ks < 2 * (mt + 1); ++ks) {
            const int s0 = 16 * ks + 8 * h;
            const f32x4 w0 = *(const f32x4*)(w_s + (size_t)t * 128 + s0), w1 = *(const f32x4*)(w_s + (size_t)t * 128 + s0 + 4);
            float wv[8] = {w0[0], w0[1], w0[2], w0[3], w1[0], w1[1], w1[2], w1[3]};
#pragma unroll
            for (int e = 0; e < 8; ++e) wv[e] = (s0 + e <= t) ? wv[e] : 0.f;
            u32x4 wb; wb.x = cvt_pk_bf16(wv[0], wv[1]); wb.y = cvt_pk_bf16(wv[2], wv[3]); wb.z = cvt_pk_bf16(wv[4], wv[5]); wb.w = cvt_pk_bf16(wv[6], wv[7]);
            const bf16x8 bfrag = __builtin_bit_cast(bf16x8, wb);
            const bf16x8 a0 = *(const LAS bf16x8*)(zt + (r) * ZPITCH + s0);
            const bf16x8 a1 = *(const LAS bf16x8*)(zt + (32 + r) * ZPITCH + s0);
            acc0 = MFMA32(a0, bfrag, acc0);
            acc1 = MFMA32(a1, bfrag, acc1);
        }
        const float bs = b_s[t];
        const size_t rowoff = (size_t)(tok0 + t) * 512 + wave * 64;
        bf16_t* mrow = mixed + (size_t)(tok0 + t) * 1024 + 512 + wave * 64;
#pragma unroll
        for (int dt = 0; dt < 2; ++dt)
#pragma unroll
            for (int i4 = 0; i4 < 4; ++i4) {
                const int d = 32 * dt + 8 * i4 + 4 * h;
                const u32x2 zz = *(const u32x2*)(zu + rowoff + d);
                const float z0 = __uint_as_float(zz.x << 16), z1 = __uint_as_float(zz.x & 0xffff0000u), z2 = __uint_as_float(zz.y << 16), z3 = __uint_as_float(zz.y & 0xffff0000u);
                const f32x16& a = dt ? acc1 : acc0;
                u32x2 o; o.x = cvt_pk_bf16(z0 * (a[4 * i4] + bs), z1 * (a[4 * i4 + 1] + bs)); o.y = cvt_pk_bf16(z2 * (a[4 * i4 + 2] + bs), z3 * (a[4 * i4 + 3] + bs));
                *(u32x2*)(mrow + d) = o;
            }
    }
}

__device__ __forceinline__ void cmp_gemm2(const bf16_t* hidden, const bf16_t* w2t, bf16_t* kcmp, bf16_t* vcmpT, int kv, int row0, int lane) {
    LAUNDER(lane);
    const int r = lane & 31, h = lane >> 5;
    f32x16 acc[2];
#pragma unroll
    for (int i = 0; i < 16; ++i) { acc[0][i] = 0.f; acc[1][i] = 0.f; }
#pragma unroll
    for (int ks = 0; ks < 16; ++ks) {
        const bf16x8 hf = *(const bf16x8*)(hidden + (size_t)(row0 + r) * 256 + ks * 16 + h * 8);
#pragma unroll
        for (int dt = 0; dt < 2; ++dt) {
            const bf16x8 wf = *(const bf16x8*)(w2t + (size_t)(dt * 32 + r) * 256 + ks * 16 + h * 8);
            if (kv == 0) acc[dt] = MFMA32(wf, hf, acc[dt]);
            else         acc[dt] = MFMA32(hf, wf, acc[dt]);
        }
    }
#pragma unroll
    for (int dt = 0; dt < 2; ++dt)
#pragma unroll
        for (int i4 = 0; i4 < 4; ++i4) {
            u32x2 o; o.x = cvt_pk_bf16(acc[dt][4 * i4], acc[dt][4 * i4 + 1]); o.y = cvt_pk_bf16(acc[dt][4 * i4 + 2], acc[dt][4 * i4 + 3]);
            if (kv == 0) *(u32x2*)(kcmp + (size_t)(row0 >> 5) * 2048 + (dt * 2 + (i4 >> 1)) * 512 + (i4 & 1) * 256 + r * 8 + 4 * h) = o;
            else         *(u32x2*)(vcmpT + (size_t)(row0 >> 5) * 2048 + dt * 1024 + (i4 >> 1) * 512 + h * 256 + r * 8 + (i4 & 1) * 4) = o;
        }
}

constexpr int NSA_WAVE_LDS = 11264;
constexpr float NEG_INF = -__builtin_inff();

__device__ __forceinline__ void load_k(bf16x8 (&kf)[4], const bf16_t* Kt, int lane) {
    const int r = lane & 31, h = lane >> 5;
#pragma unroll
    for (int ks = 0; ks < 4; ++ks) kf[ks] = *(const bf16x8*)(Kt + ks * 512 + lane * 8);
}
__device__ __forceinline__ void load_v(bf16x8 (&vf)[2][2], const bf16_t* vT, int lane) {
    const int r = lane & 31, h = lane >> 5;
#pragma unroll
    for (int dt = 0; dt < 2; ++dt)
#pragma unroll
        for (int s = 0; s < 2; ++s) vf[dt][s] = *(const bf16x8*)(vT + dt * 1024 + s * 512 + lane * 8);
}
__device__ __forceinline__ f32x16 qk_tile(const bf16x8 (&kf)[4], const bf16x8 (&qf)[4]) {
    f32x16 s;
#pragma unroll
    for (int i = 0; i < 16; ++i) s[i] = 0.f;
#pragma unroll
    for (int ks = 0; ks < 4; ++ks) s = MFMA32(kf[ks], qf[ks], s);
    return s;
}
template <int STRIDE> __device__ __forceinline__ void score_tile(f32x16& s, int dl, int dmax, bool lane_ok, bool fast, float lutfar, const LAS float* lutr) {
    if (fast) {
#pragma unroll
        for (int i = 0; i < 16; ++i) s[i] = lane_ok ? (s[i] + lutfar) : NEG_INF;
    } else {
#pragma unroll
        for (int i = 0; i < 16; ++i) {
            const int d = dl - STRIDE * ((i & 3) + 8 * (i >> 2));
            const bool ok = lane_ok && d >= 0 && d < dmax;
            const int di = min(max(d, 0), 128);
            s[i] = ok ? (s[i] + lutr[di]) : NEG_INF;
        }
    }
}
__device__ __forceinline__ void pv_tile(f32x16& o0, f32x16& o1, const f32x16& pr, const bf16x8 (&vf)[2][2]) {
#pragma unroll
    for (int s = 0; s < 2; ++s) {
        u32x4 pk; pk.x = cvt_pk_bf16(pr[8 * s], pr[8 * s + 1]); pk.y = cvt_pk_bf16(pr[8 * s + 2], pr[8 * s + 3]); pk.z = cvt_pk_bf16(pr[8 * s + 4], pr[8 * s + 5]); pk.w = cvt_pk_bf16(pr[8 * s + 6], pr[8 * s + 7]);
        const bf16x8 pb = __builtin_bit_cast(bf16x8, pk);
        o0 = MFMA32(vf[0][s], pb, o0);
        o1 = MFMA32(vf[1][s], pb, o1);
    }
}
template <bool FAST> __device__ __forceinline__ void online_step(f32x16& s, float bias, bool lane_ok, float& m, float& l, f32x16& o0, f32x16& o1, const bf16x8 (&vf)[2][2]) {
    float mx = fmaxf(fmaxf(fmaxf(s[0], s[1]), fmaxf(s[2], s[3])), fmaxf(fmaxf(s[4], s[5]), fmaxf(s[6], s[7])));
    mx = fmaxf(mx, fmaxf(fmaxf(fmaxf(s[8], s[9]), fmaxf(s[10], s[11])), fmaxf(fmaxf(s[12], s[13]), fmaxf(s[14], s[15]))));
    if (FAST) { mx += bias; mx = lane_ok ? mx : NEG_INF; }
    mx = xhalf_max(mx);
    if (__any(mx > m + 8.0f)) {
        const float mnew = (mx > m + 8.0f) ? mx : m;
        const float alpha = fast_exp2(m - mnew);
        l *= alpha; m = mnew;
#pragma unroll
        for (int i = 0; i < 16; ++i) { o0[i] *= alpha; o1[i] *= alpha; }
    }
    const float c = FAST ? (lane_ok ? (m - bias) : __builtin_inff()) : m;
    float ps = 0.f;
#pragma unroll
    for (int i = 0; i < 16; ++i) { s[i] = fast_exp2(s[i] - c); ps += s[i]; }
    ps = xhalf_sum(ps);
    l += ps;
    pv_tile(o0, o1, s, vf);
}

#define MFMA8(a, b, c) __builtin_amdgcn_mfma_f32_32x32x16_fp8_fp8((a), (b), (c), 0, 0, 0)
__device__ __forceinline__ void load_k8(long (&kf)[4], const unsigned char* Kt, int lane) {
#pragma unroll
    for (int ks = 0; ks < 4; ++ks) kf[ks] = *(const long*)(Kt + ks * 512 + lane * 8);
}
__device__ __forceinline__ void load_v8(long (&vf)[2][2], const unsigned char* vT, int lane) {
#pragma unroll
    for (int dt = 0; dt < 2; ++dt)
#pragma unroll
        for (int s = 0; s < 2; ++s) vf[dt][s] = *(const long*)(vT + dt * 1024 + s * 512 + lane * 8);
}
__device__ __forceinline__ long pack_fp8x8(float a0, float a1, float a2, float a3, float a4, float a5, float a6, float a7) {
    int w0 = __builtin_amdgcn_cvt_pk_fp8_f32(a0, a1, 0, false); w0 = __builtin_amdgcn_cvt_pk_fp8_f32(a2, a3, w0, true);
    int w1 = __builtin_amdgcn_cvt_pk_fp8_f32(a4, a5, 0, false); w1 = __builtin_amdgcn_cvt_pk_fp8_f32(a6, a7, w1, true);
    return (long)(((unsigned long long)(unsigned)w1 << 32) | (unsigned long long)(unsigned)w0);
}
template <bool FAST> __device__ __forceinline__ void online_step8(f32x16& s, float bias, bool lane_ok, float& m, float& l, f32x16& o0, f32x16& o1, const long (&vf)[2][2]) {
    float mx = fmaxf(fmaxf(fmaxf(s[0], s[1]), fmaxf(s[2], s[3])), fmaxf(fmaxf(s[4], s[5]), fmaxf(s[6], s[7])));
    mx = fmaxf(mx, fmaxf(fmaxf(fmaxf(s[8], s[9]), fmaxf(s[10], s[11])), fmaxf(fmaxf(s[12], s[13]), fmaxf(s[14], s[15]))));
    if (FAST) { mx = mx * QSCALE + bias; mx = lane_ok ? mx : NEG_INF; }
    mx = xhalf_max(mx);
    if (__any(mx > m + 2.0f)) {
        const float mnew = (mx > m + 2.0f) ? mx : m;
        const float alpha = fast_exp2(m - mnew);
        l *= alpha; m = mnew;
#pragma unroll
        for (int i = 0; i < 16; ++i) { o0[i] *= alpha; o1[i] *= alpha; }
    }
    float ps = 0.f;
    if (FAST) {
        const float c = lane_ok ? (m - bias - 6.0f) : __builtin_inff();
#pragma unroll
        for (int i = 0; i < 16; ++i) { s[i] = fast_exp2(__builtin_fmaf(s[i], QSCALE, -c)); ps += s[i]; }
    } else {
        const float c = m - 6.0f;
#pragma unroll
        for (int i = 0; i < 16; ++i) { s[i] = fast_exp2(s[i] - c); ps += s[i]; }
    }
    ps = xhalf_sum(ps);
    l += ps;
#pragma unroll
    for (int t = 0; t < 2; ++t) {
        const long pb = pack_fp8x8(s[8 * t], s[8 * t + 1], s[8 * t + 2], s[8 * t + 3], s[8 * t + 4], s[8 * t + 5], s[8 * t + 6], s[8 * t + 7]);
        o0 = MFMA8(vf[0][t], pb, o0);
        o1 = MFMA8(vf[1][t], pb, o1);
    }
}

__device__ __forceinline__ float max16(const f32x16& s) {
    const float a = fmaxf(fmaxf(fmaxf(s[0], s[1]), fmaxf(s[2], s[3])), fmaxf(fmaxf(s[4], s[5]), fmaxf(s[6], s[7])));
    const float b = fmaxf(fmaxf(fmaxf(s[8], s[9]), fmaxf(s[10], s[11])), fmaxf(fmaxf(s[12], s[13]), fmaxf(s[14], s[15])));
    return fmaxf(a, b);
}
template <bool FAST> __device__ __forceinline__ void online_step8x2(f32x16& sa, f32x16& sb, float bias, bool lane_ok, float& m, float& l, f32x16& o0, f32x16& o1, const long (&va)[2][2], const long (&vb)[2][2]) {
    float mx = fmaxf(max16(sa), max16(sb));
    if (FAST) { mx = mx * QSCALE + bias; mx = lane_ok ? mx : NEG_INF; }
    mx = xhalf_max(mx);
    if (__any(mx > m + 2.0f)) {
        const float mnew = (mx > m + 2.0f) ? mx : m;
        const float alpha = fast_exp2(m - mnew);
        l *= alpha; m = mnew;
#pragma unroll
        for (int i = 0; i < 16; ++i) { o0[i] *= alpha; o1[i] *= alpha; }
    }
    float ps = 0.f, ps2 = 0.f;
    if (FAST) {
        const float c = lane_ok ? (m - bias - 6.0f) : __builtin_inff();
#pragma unroll
        for (int i = 0; i < 16; ++i) { sa[i] = fast_exp2(__builtin_fmaf(sa[i], QSCALE, -c)); ps += sa[i]; sb[i] = fast_exp2(__builtin_fmaf(sb[i], QSCALE, -c)); ps2 += sb[i]; }
    } else {
        const float c = m - 6.0f;
#pragma unroll
        for (int i = 0; i < 16; ++i) { sa[i] = fast_exp2(sa[i] - c); ps += sa[i]; sb[i] = fast_exp2(sb[i] - c); ps2 += sb[i]; }
    }
    ps += ps2;
    ps = xhalf_sum(ps);
    l += ps;
    const long pa0 = pack_fp8x8(sa[0], sa[1], sa[2], sa[3], sa[4], sa[5], sa[6], sa[7]);
    const long pb0 = pack_fp8x8(sb[0], sb[1], sb[2], sb[3], sb[4], sb[5], sb[6], sb[7]);
    o0 = MFMA8(va[0][0], pa0, o0); o1 = MFMA8(va[1][0], pa0, o1);
    const long pa1 = pack_fp8x8(sa[8], sa[9], sa[10], sa[11], sa[12], sa[13], sa[14], sa[15]);
    o0 = MFMA8(vb[0][0], pb0, o0); o1 = MFMA8(vb[1][0], pb0, o1);
    const long pb1 = pack_fp8x8(sb[8], sb[9], sb[10], sb[11], sb[12], sb[13], sb[14], sb[15]);
    o0 = MFMA8(va[0][1], pa1, o0); o1 = MFMA8(va[1][1], pa1, o1);
    o0 = MFMA8(vb[0][1], pb1, o0); o1 = MFMA8(vb[1][1], pb1, o1);
}

__device__ __forceinline__ void nsa_unit(const Params& p, int bg, int jq, LAS unsigned char* lds, int wave, int lane, bool build_lut) {
    LAUNDER(lane);
    const unsigned char* ws = P_ws(p);
    const bf16_t* qb = (const bf16_t*)(ws + WS_R1 + R_Q);
    const bf16_t* kcmp = (const bf16_t*)(ws + WS_R1 + R_KCMP) + (size_t)bg * NCMP * 64;
    const bf16_t* vcmpT = (const bf16_t*)(ws + WS_R1 + R_VCMPT) + (size_t)bg * NCMP * 64;
    const unsigned char* ks8 = ws + WS_R1 + R_KS + (size_t)bg * S * 64;
    const unsigned char* vs8 = ws + WS_R1 + R_VST + (size_t)bg * S * 64;
    const bf16_t* kwb = (const bf16_t*)(ws + WS_R1 + R_KW) + (size_t)bg * S * 64;
    const bf16_t* vwT = (const bf16_t*)(ws + WS_R1 + R_VWT) + (size_t)bg * S * 64;
    const float* gates = (const float*)(ws + WS_R1 + R_GATES);
    bf16_t* mixed = (bf16_t*)(ws + WS_AN);
    const float* relb = P_in(p, 1);
    const int b = bg >> 1, g = bg & 1;
    LAS float* imp = (LAS float*)(lds + wave * NSA_WAVE_LDS);
    LAS unsigned* selw = (LAS unsigned*)(lds + wave * NSA_WAVE_LDS + 8192);
    LAS float* lut = (LAS float*)(lds + wave * NSA_WAVE_LDS + 8192 + 256);
    LAS int* list = (LAS int*)(lds + wave * NSA_WAVE_LDS + 8192 + 256 + 2112);
    const int c = lane & 31, h = lane >> 5, ql = c >> 2, r = c & 3;
    const int tq0 = 64 * jq + 8 * wave, tq = tq0 + ql;
    const size_t tok = (size_t)b * S + tq;

    if (build_lut) {
        for (int e = lane; e < 4 * 129; e += 64) {
            const int rr = e / 129, n = e % 129;
            int bk = n;
            if (n >= 16) bk = 16 + (n >= 19) + (n >= 21) + (n >= 24) + (n >= 27) + (n >= 31) + (n >= 35) + (n >= 40) + (n >= 46) + (n >= 52) + (n >= 59) + (n >= 67) + (n >= 77) + (n >= 87) + (n >= 99) + (n >= 113);
            lut[rr * 132 + n] = relb[bk * 8 + g * 4 + rr] * LOG2E;
        }
    }
    for (int e = lane; e < 2048; e += 64) imp[e] = 0.f;
    {
        const int k = lane & 7; unsigned w = 0u;
        if (k == 0) w |= 1u;
        if ((jq >> 5) == k) w |= 1u << (jq & 31);
        if (jq >= 1 && ((jq - 1) >> 5) == k) w |= 1u << ((jq - 1) & 31);
        selw[lane] = w;
    }
    asm volatile("s_waitcnt lgkmcnt(0)" ::: "memory");
    __builtin_amdgcn_wave_barrier();
    const LAS float* lutr = lut + r * 132;
    const float lutfar = lutr[128];

    bf16x8 qf[4];
#pragma unroll
    for (int ks = 0; ks < 4; ++ks) qf[ks] = *(const bf16x8*)(qb + tok * 512 + (g * 4 + r) * 64 + ks * 16 + h * 8);
    const float g0 = gates[tok * 24 + (g * 4 + r) * 3 + 0], g1 = gates[tok * 24 + (g * 4 + r) * 3 + 1], g2 = gates[tok * 24 + (g * 4 + r) * 3 + 2];

    f32x16 oa0, oa1;
    bf16x8 kf[4], kn[4], vf[2][2];
    {
        const int jmaxw = (tq0 + 7 - 31) >> 4;
        const int ntile = (jmaxw >= 0) ? (jmaxw >> 5) + 1 : 0;
        float m = -1e30f, l = 0.f;
        if (ntile > 0) load_k(kn, kcmp, lane);
        for (int T = 0; T < ntile; ++T) {
#pragma unroll
            for (int ks = 0; ks < 4; ++ks) kf[ks] = kn[ks];
            if (T + 1 < ntile) load_k(kn, kcmp + (size_t)(T + 1) * 2048, lane);
            f32x16 s = qk_tile(kf, qf);
            const int base = 512 * T + 31;
            const bool fast = (tq0 - base - 16 * 31) >= 128;
            score_tile<16>(s, tq - base - 64 * h, 1 << 30, true, fast, lutfar, lutr);
            float mx = s[0];
#pragma unroll
            for (int i = 1; i < 16; ++i) mx = fmaxf(mx, s[i]);
            mx = xhalf_max(mx);
            const float mnew = fmaxf(m, mx);
            float ps = 0.f;
#pragma unroll
            for (int i = 0; i < 16; ++i) ps += fast_exp2(s[i] - mnew);
            ps = xhalf_sum(ps);
            l = l * fast_exp2(m - mnew) + ps; m = mnew;
        }
        const float c2 = (l > 0.f) ? (m + __builtin_amdgcn_logf(l)) : __builtin_inff();
        const float c2f = c2 - lutfar;
        f32x16 o0, o1;
#pragma unroll
        for (int i = 0; i < 16; ++i) { o0[i] = 0.f; o1[i] = 0.f; }
        if (ntile > 0) load_k(kn, kcmp, lane);
        for (int T = 0; T < ntile; ++T) {
#pragma unroll
            for (int ks = 0; ks < 4; ++ks) kf[ks] = kn[ks];
            load_v(vf, vcmpT + (size_t)T * 2048, lane);
            if (T + 1 < ntile) load_k(kn, kcmp + (size_t)(T + 1) * 2048, lane);
            f32x16 s = qk_tile(kf, qf);
            const int base = 512 * T + 31;
            const bool fast = (tq0 - base - 16 * 31) >= 128;
            if (fast) {
#pragma unroll
                for (int i = 0; i < 16; ++i) s[i] = fast_exp2(s[i] - c2f);
            } else {
                score_tile<16>(s, tq - base - 64 * h, 1 << 30, true, false, lutfar, lutr);
#pragma unroll
                for (int i = 0; i < 16; ++i) s[i] = fast_exp2(s[i] - c2);
            }
#pragma unroll
            for (int i4 = 0; i4 < 4; ++i4) {
                float a = (s[4 * i4] + s[4 * i4 + 1]) + (s[4 * i4 + 2] + 0.5f * s[4 * i4 + 3]);
                float bb = 0.5f * s[4 * i4 + 3];
                a = quad_sum(a); bb = quad_sum(bb);
                if (r == i4) {
                    const int n = 8 * T + 2 * i4 + h;
                    atomicAdd((float*)(imp + ql * 256 + n), a);
                    if (n + 1 < 256) atomicAdd((float*)(imp + ql * 256 + n + 1), bb);
                }
            }
            pv_tile(o0, o1, s, vf);
        }
#pragma unroll
        for (int i = 0; i < 16; ++i) { oa0[i] = g0 * o0[i]; oa1[i] = g0 * o1[i]; }
    }
    asm volatile("s_waitcnt lgkmcnt(0)" ::: "memory");
    __builtin_amdgcn_wave_barrier();
    if (jq >= 3) {
        float val[8][4];
#pragma unroll
        for (int qq = 0; qq < 8; ++qq) {
            const f32x4 iv = *(const LAS f32x4*)(imp + qq * 256 + 4 * lane);
#pragma unroll
            for (int e = 0; e < 4; ++e) { const int n = 4 * lane + e; val[qq][e] = (n >= 1 && n <= jq - 2) ? iv[e] : -1.0f; }
        }
        unsigned mybits[8];
#pragma unroll
        for (int qq = 0; qq < 8; ++qq) mybits[qq] = 0u;
        for (int round = 0; round < 13; ++round) {
#pragma unroll
            for (int qq = 0; qq < 8; ++qq) {
                const float lb = fmaxf(fmaxf(val[qq][0], val[qq][1]), fmaxf(val[qq][2], val[qq][3]));
                const float wm = wave_max_fast(lb);
                const unsigned long long bal = __ballot(lb == wm);
                const int wl = __builtin_ctzll(bal | (1ull << 63));
                const bool win = (lane == wl) && (wm >= 0.f);
                const int e = (val[qq][0] == wm) ? 0 : ((val[qq][1] == wm) ? 1 : ((val[qq][2] == wm) ? 2 : 3));
                mybits[qq] |= win ? (1u << e) : 0u;
                val[qq][0] = (win && e == 0) ? -2.0f : val[qq][0]; val[qq][1] = (win && e == 1) ? -2.0f : val[qq][1];
                val[qq][2] = (win && e == 2) ? -2.0f : val[qq][2]; val[qq][3] = (win && e == 3) ? -2.0f : val[qq][3];
            }
        }
#pragma unroll
        for (int qq = 0; qq < 8; ++qq)
            if (mybits[qq]) atomicOr((unsigned*)(selw + qq * 8 + (lane >> 3)), mybits[qq] << ((lane & 7) * 4));
    }
    asm volatile("s_waitcnt lgkmcnt(0)" ::: "memory");
    __builtin_amdgcn_wave_barrier();
    {
        unsigned uwA = 0u, uwB = 0u;
        if (lane < 8) {
#pragma unroll
            for (int qq = 0; qq < 4; ++qq) { uwA |= selw[qq * 8 + lane]; uwB |= selw[(qq + 4) * 8 + lane]; }
        }
        int cntA = 0, cntB = 0;
        for (int k = 0; k < 8; ++k) {
            unsigned bits = (unsigned)__builtin_amdgcn_readlane((int)uwA, k);
            while (bits) { const int bit = __builtin_ctz(bits); bits &= bits - 1u; if (lane == 0) list[cntA] = 32 * k + bit; ++cntA; }
            bits = (unsigned)__builtin_amdgcn_readlane((int)uwB, k);
            while (bits) { const int bit = __builtin_ctz(bits); bits &= bits - 1u; if (lane == 0) list[64 + cntB] = 32 * k + bit; ++cntB; }
        }
        asm volatile("s_waitcnt lgkmcnt(0)" ::: "memory");
        __builtin_amdgcn_wave_barrier();
        LAS float* ostage = imp;
        const int c16 = lane & 15, fq = lane >> 4, q4 = c16 >> 2, r16 = c16 & 3;
        const LAS float* lutr16 = lut + r16 * 132;
        const float lutfar16 = lutr16[128];
        for (int grp = 0; grp < 2; ++grp) {
            const int cnt = grp ? cntB : cntA, lbase = grp * 64;
            const int tqg = tq0 + 4 * grp + q4, tq0g = tq0 + 4 * grp;
            long q8[2];
            {
                const bf16_t* qp = qb + ((size_t)b * S + tqg) * 512 + (g * 4 + r16) * 64 + 8 * fq;
#pragma unroll
                for (int ks = 0; ks < 2; ++ks) {
                    const bf16x8 qv = *(const bf16x8*)(qp + 32 * ks);
                    float f[8];
#pragma unroll
                    for (int e = 0; e < 8; ++e) f[e] = bf2f((bf16_t)qv[e]) * (1.0f / QSCALE);
                    q8[ks] = pack_fp8x8(f[0], f[1], f[2], f[3], f[4], f[5], f[6], f[7]);
                }
            }
            float m = -1e30f, l = 0.f;
            f32x4 o[4];
#pragma unroll
            for (int dt = 0; dt < 4; ++dt) o[dt] = (f32x4){0.f, 0.f, 0.f, 0.f};
            const int npair = (cnt + 1) >> 1;
            if (lane == 0 && (cnt & 1)) list[lbase + cnt] = 0;
            asm volatile("s_waitcnt lgkmcnt(0)" ::: "memory");
            __builtin_amdgcn_wave_barrier();
            long k8[2][8], v8[2][8];
            int n0 = __builtin_amdgcn_readfirstlane(list[lbase]), n1 = __builtin_amdgcn_readfirstlane(list[lbase + 1]);
#pragma unroll
            for (int i = 0; i < 4; ++i) { const l64x2 t0 = *(const l64x2*)(ks8 + (size_t)n0 * 4096 + i * 1024 + lane * 16), t1 = *(const l64x2*)(ks8 + (size_t)n1 * 4096 + i * 1024 + lane * 16);
                k8[0][2 * i] = t0[0]; k8[0][2 * i + 1] = t0[1]; k8[1][2 * i] = t1[0]; k8[1][2 * i + 1] = t1[1]; }
            for (int it = 0; it < npair; ++it) {
                const int nb[2] = {n0, n1};
                const bool real1 = (2 * it + 1) < cnt;
#pragma unroll
                for (int u = 0; u < 2; ++u)
#pragma unroll
                    for (int i = 0; i < 4; ++i) { const l64x2 t = *(const l64x2*)(vs8 + (size_t)nb[u] * 4096 + i * 1024 + lane * 16); v8[u][2 * i] = t[0]; v8[u][2 * i + 1] = t[1]; }
                f32x4 sc[2][4];
#pragma unroll
                for (int u = 0; u < 2; ++u)
#pragma unroll
                    for (int kt = 0; kt < 4; ++kt) {
                        sc[u][kt] = __builtin_amdgcn_mfma_f32_16x16x32_fp8_fp8(k8[u][2 * kt], q8[0], (f32x4){0.f, 0.f, 0.f, 0.f}, 0, 0, 0);
                        sc[u][kt] = __builtin_amdgcn_mfma_f32_16x16x32_fp8_fp8(k8[u][2 * kt + 1], q8[1], sc[u][kt], 0, 0, 0);
                    }
                if (it + 1 < npair) {
                    n0 = __builtin_amdgcn_readfirstlane(list[lbase + 2 * it + 2]); n1 = __builtin_amdgcn_readfirstlane(list[lbase + 2 * it + 3]);
#pragma unroll
                    for (int i = 0; i < 4; ++i) { const l64x2 t0 = *(const l64x2*)(ks8 + (size_t)n0 * 4096 + i * 1024 + lane * 16), t1 = *(const l64x2*)(ks8 + (size_t)n1 * 4096 + i * 1024 + lane * 16);
                        k8[0][2 * i] = t0[0]; k8[0][2 * i + 1] = t0[1]; k8[1][2 * i] = t1[0]; k8[1][2 * i + 1] = t1[1]; }
                }
                bool ok[2];
                ok[0] = (selw[(grp * 4 + q4) * 8 + (nb[0] >> 5)] >> (nb[0] & 31)) & 1u;
                ok[1] = real1 && ((selw[(grp * 4 + q4) * 8 + (nb[1] >> 5)] >> (nb[1] & 31)) & 1u);
                const int bmax = real1 ? max(nb[0], nb[1]) : nb[0];
                const bool fast = (tq0g - 64 * bmax - 63) >= 128;
                float mx = NEG_INF;
                if (fast) {
#pragma unroll
                    for (int u = 0; u < 2; ++u) {
                        float t = fmaxf(fmaxf(fmaxf(sc[u][0][0], sc[u][0][1]), fmaxf(sc[u][0][2], sc[u][0][3])), fmaxf(fmaxf(sc[u][1][0], sc[u][1][1]), fmaxf(sc[u][1][2], sc[u][1][3])));
                        t = fmaxf(t, fmaxf(fmaxf(fmaxf(sc[u][2][0], sc[u][2][1]), fmaxf(sc[u][2][2], sc[u][2][3])), fmaxf(fmaxf(sc[u][3][0], sc[u][3][1]), fmaxf(sc[u][3][2], sc[u][3][3]))));
                        mx = fmaxf(mx, ok[u] ? (t * QSCALE + lutfar16) : NEG_INF);
                    }
                } else {
#pragma unroll
                    for (int u = 0; u < 2; ++u)
#pragma unroll
                        for (int kt = 0; kt < 4; ++kt)
#pragma unroll
                            for (int e = 0; e < 4; ++e) {
                                const int d = tqg - 64 * nb[u] - 16 * kt - 4 * fq - e;
                                const bool okk = ok[u] && d >= 0;
                                const float v = okk ? (sc[u][kt][e] * QSCALE + lutr16[min(max(d, 0), 128)]) : NEG_INF;
                                sc[u][kt][e] = v; mx = fmaxf(mx, v);
                            }
                }
                {
                    auto t1 = __builtin_amdgcn_permlane16_swap(__float_as_uint(mx), __float_as_uint(mx), false, false); mx = fmaxf(__uint_as_float(t1[0]), __uint_as_float(t1[1]));
                    mx = xhalf_max(mx);
                }
                if (__any(mx > m + 2.0f)) {
                    const float mnew = (mx > m + 2.0f) ? mx : m;
                    const float alpha = fast_exp2(m - mnew);
                    l *= alpha; m = mnew;
#pragma unroll
                    for (int dt = 0; dt < 4; ++dt) o[dt] = o[dt] * alpha;
                }
                float ps = 0.f;
                if (fast) {
#pragma unroll
                    for (int u = 0; u < 2; ++u) {
                        const float cexp = ok[u] ? (m - lutfar16 - 6.0f) : __builtin_inff();
#pragma unroll
                        for (int kt = 0; kt < 4; ++kt)
#pragma unroll
                            for (int e = 0; e < 4; ++e) { sc[u][kt][e] = fast_exp2(__builtin_fmaf(sc[u][kt][e], QSCALE, -cexp)); ps += sc[u][kt][e]; }
                    }
                } else {
                    const float cexp = m - 6.0f;
#pragma unroll
                    for (int u = 0; u < 2; ++u)
#pragma unroll
                        for (int kt = 0; kt < 4; ++kt)
#pragma unroll
                            for (int e = 0; e < 4; ++e) { sc[u][kt][e] = fast_exp2(sc[u][kt][e] - cexp); ps += sc[u][kt][e]; }
                }
                {
                    auto t1 = __builtin_amdgcn_permlane16_swap(__float_as_uint(ps), __float_as_uint(ps), false, false); ps = __uint_as_float(t1[0]) + __uint_as_float(t1[1]);
                    ps = xhalf_sum(ps);
                }
                l += ps;
#pragma unroll
                for (int u = 0; u < 2; ++u) {
                    const long pb0 = pack_fp8x8(sc[u][0][0], sc[u][0][1], sc[u][0][2], sc[u][0][3], sc[u][1][0], sc[u][1][1], sc[u][1][2], sc[u][1][3]);
                    const long pb1 = pack_fp8x8(sc[u][2][0], sc[u][2][1], sc[u][2][2], sc[u][2][3], sc[u][3][0], sc[u][3][1], sc[u][3][2], sc[u][3][3]);
#pragma unroll
                    for (int dt = 0; dt < 4; ++dt) {
                        o[dt] = __builtin_amdgcn_mfma_f32_16x16x32_fp8_fp8(v8[u][2 * dt], pb0, o[dt], 0, 0, 0);
                        o[dt] = __builtin_amdgcn_mfma_f32_16x16x32_fp8_fp8(v8[u][2 * dt + 1], pb1, o[dt], 0, 0, 0);
                    }
                }
            }
            const float invl = (l > 0.f) ? 1.0f / l : 0.f;
#pragma unroll
            for (int dt = 0; dt < 4; ++dt) *(LAS f32x4*)(ostage + ((grp * 4 + q4) * 4 + r16) * 64 + 16 * dt + 4 * fq) = o[dt] * invl;
        }
        asm volatile("s_waitcnt lgkmcnt(0)" ::: "memory");
        __builtin_amdgcn_wave_barrier();
#pragma unroll
        for (int dt = 0; dt < 2; ++dt)
#pragma unroll
            for (int i4 = 0; i4 < 4; ++i4) {
                const f32x4 v = *(const LAS f32x4*)(ostage + (ql * 4 + r) * 64 + 32 * dt + 8 * i4 + 4 * h);
                if (dt == 0) { oa0[4 * i4] += g1 * v[0]; oa0[4 * i4 + 1] += g1 * v[1]; oa0[4 * i4 + 2] += g1 * v[2]; oa0[4 * i4 + 3] += g1 * v[3]; }
                else         { oa1[4 * i4] += g1 * v[0]; oa1[4 * i4 + 1] += g1 * v[1]; oa1[4 * i4 + 2] += g1 * v[2]; oa1[4 * i4 + 3] += g1 * v[3]; }
            }
        asm volatile("s_waitcnt lgkmcnt(0)" ::: "memory");
        __builtin_amdgcn_wave_barrier();
    }
    {
        {
            const bf16_t* qp = qb + tok * 512 + (g * 4 + r) * 64 + h * 8;
            asm volatile("" : "+v"(qp));
#pragma unroll
            for (int ks = 0; ks < 4; ++ks) qf[ks] = *(const bf16x8*)(qp + ks * 16);
        }
        const int T0 = max(0, (tq0 - 511) >> 5), T1 = (tq0 + 7) >> 5;
        float m = -1e30f, l = 0.f;
        f32x16 o0, o1;
#pragma unroll
        for (int i = 0; i < 16; ++i) { o0[i] = 0.f; o1[i] = 0.f; }
        load_k(kn, kwb + (size_t)(32 * T0) * 64, lane);
        for (int T = T0; T <= T1; ++T) {
#pragma unroll
            for (int ks = 0; ks < 4; ++ks) kf[ks] = kn[ks];
            load_v(vf, vwT + (size_t)T * 2048, lane);
            if (T < T1) load_k(kn, kwb + (size_t)(32 * (T + 1)) * 64, lane);
            const int base = 32 * T;
            f32x16 s = qk_tile(kf, qf);
            if (((tq0 - base - 31) >= 128) && ((tq0 + 7 - base) < 512)) online_step<true>(s, lutfar, true, m, l, o0, o1, vf);
            else { score_tile<1>(s, tq - base - 4 * h, 512, true, false, lutfar, lutr); online_step<false>(s, 0.f, true, m, l, o0, o1, vf); }
        }
        const float sc = (l > 0.f) ? g2 / l : 0.f;
#pragma unroll
        for (int i = 0; i < 16; ++i) { oa0[i] += sc * o0[i]; oa1[i] += sc * o1[i]; }
    }
    bf16_t* orow = mixed + tok * 1024 + (g * 4 + r) * 64;
#pragma unroll
    for (int dt = 0; dt < 2; ++dt)
#pragma unroll
        for (int i4 = 0; i4 < 4; ++i4) {
            const f32x16& a = dt ? oa1 : oa0;
            u32x2 o; o.x = cvt_pk_bf16(a[4 * i4], a[4 * i4 + 1]); o.y = cvt_pk_bf16(a[4 * i4 + 2], a[4 * i4 + 3]);
            *(u32x2*)(orow + 32 * dt + 8 * i4 + 4 * h) = o;
        }
}


#define XB_TMO      128
#define XB_XCNT(j)  (256  + 64 * (j))
#define XB_XSUB(j)  (1280 + 64 * (j))
#define XB_XGEN(j)  (2304 + 64 * (j))
#define XB_TOP      3328
#define XB_TOPGEN   3392
#define XCD_BAR_WORDS 3456
#define XB_SPIN_CAP (1u << 22)
__device__ __forceinline__ unsigned xb_ld(unsigned* p)              { return __hip_atomic_load(p, __ATOMIC_RELAXED, __HIP_MEMORY_SCOPE_AGENT); }
__device__ __forceinline__ unsigned xb_add(unsigned* p, unsigned v) { return __hip_atomic_fetch_add(p, v, __ATOMIC_RELAXED, __HIP_MEMORY_SCOPE_AGENT); }
__device__ __forceinline__ unsigned xb_xcc_id() { return (unsigned)__builtin_amdgcn_s_getreg((3 << 11) | 20) & 0xFu; }
#define XB_SPIN(cond, bar) do { unsigned _sp = 0; while (cond) { __builtin_amdgcn_s_sleep(1); \
    if ((++_sp & 255u) == 0u) { if (xb_ld(&(bar)[XB_TMO])) break; if (_sp > XB_SPIN_CAP) { atomicAdd(&(bar)[XB_TMO], 1u); break; } } } } while (0)
__device__ __forceinline__ void xcd_barrier_complete(unsigned* bar, unsigned x, unsigned& nloc, unsigned& nx) {
    const unsigned G = gridDim.x * gridDim.y * gridDim.z;
    unsigned sum, cnt, mine, sp = 0u;
    for (;;) {
        sum = 0u; cnt = 0u; mine = 0u;
#pragma unroll
        for (unsigned j = 0; j < 16; ++j) { const unsigned c = xb_ld(&bar[XB_XCNT(j)]); sum += c; cnt += (c > 0u) ? 1u : 0u; mine = (j == x) ? c : mine; }
        if (sum == G) break;
        __builtin_amdgcn_s_sleep(1);
        if ((++sp & 255u) == 0u) { if (xb_ld(&bar[XB_TMO])) break; if (sp > XB_SPIN_CAP) { atomicAdd(&bar[XB_TMO], 1u); break; } }
    }
    nloc = mine > 0u ? mine : 1u; nx = cnt > 0u ? cnt : 1u;
}
__device__ __forceinline__ void xcd_barrier(unsigned* bar, volatile LAS unsigned* st) {
    asm volatile("s_waitcnt vmcnt(0)" ::: "memory");
    __syncthreads();
    if (threadIdx.x == 0) {
        const unsigned x = xb_xcc_id();
        __builtin_amdgcn_s_waitcnt(0);
        unsigned nloc = st[0], nx = st[1];
        if (nloc == 0u) { xcd_barrier_complete(bar, x, nloc, nx); st[0] = nloc; st[1] = nx; }
        const unsigned old = xb_add(&bar[XB_XSUB(x)], 1u);
        const unsigned gen = old / nloc;
        if (old + 1u == (gen + 1u) * nloc) {
            __builtin_amdgcn_fence(__ATOMIC_RELEASE, "agent");
            asm volatile("s_waitcnt vmcnt(0)" ::: "memory");
            const unsigned og = xb_add(&bar[XB_TOP], 1u);
            const unsigned tg = og / nx;
            if (og + 1u == (tg + 1u) * nx) xb_add(&bar[XB_TOPGEN], 1u);
            else XB_SPIN(xb_ld(&bar[XB_TOPGEN]) == tg, bar);
            __builtin_amdgcn_fence(__ATOMIC_ACQUIRE, "agent");
            xb_add(&bar[XB_XGEN(x)], 1u);
            asm volatile("s_waitcnt vmcnt(0)" ::: "memory");
        } else {
            XB_SPIN(xb_ld(&bar[XB_XGEN(x)]) == gen, bar);
            __builtin_amdgcn_fence(__ATOMIC_ACQUIRE, "agent");
            asm volatile("s_waitcnt vmcnt(0)" ::: "memory");
        }
    }
    __syncthreads();
}

__global__ void __launch_bounds__(NTHREADS, 2) fwd_megakernel(Params p) {
    extern __shared__ __attribute__((aligned(16))) unsigned char lds_raw[];
    LAS unsigned char* lds = (LAS unsigned char*)lds_raw;
    cg::grid_group grid = cg::this_grid();
#define TID_F ({ int _t = threadIdx.x; LAUNDER(_t); _t; })
#define LANE_F (TID_F & 63)
#define WAVE_F (__builtin_amdgcn_readfirstlane(TID_F >> 6))
    const int G = gridDim.x, bx = blockIdx.x;
    const int NGW = G * NWAVES;
#define GW_F (bx * NWAVES + WAVE_F)
#define FRESH_WS unsigned char* ws = P_ws(p); bf16_t* AN = (bf16_t*)(ws + WS_AN); float* MIX = (float*)(ws + WS_MIX); (void)AN; (void)MIX

    { const int tid = TID_F; if (tid < 16) ((LAS unsigned*)(lds + LDS_BYTES - 64))[tid] = 0u; }
    if (bx == 0) { unsigned* barw = (unsigned*)P_ws(p); for (int i = TID_F; i < XCD_BAR_WORDS; i += NTHREADS) barw[i] = 0u; }
    __syncthreads();
    {
        FRESH_WS;
        const int tid = TID_F, lane = tid & 63, wave = __builtin_amdgcn_readfirstlane(tid >> 6), gw = bx * NWAVES + wave;
        LAS float* scr = (LAS float*)(lds + wave * 17408);
        for (int layer = 0; layer < DEPTH; ++layer) {
            unsigned char* wl = ws + WS_W + (size_t)layer * W_LAYER;
            const int I_IN = 16 * (NINP / 64), I_OUT = 16 * 16, I_GU = 16 * (NGU / 64), I_DN = 44 * 16, I_C1 = 32 * 4, I_C2 = 4 * 1;
            const int NIT = I_IN + I_OUT + I_GU + I_DN + 2 * I_C1 + 2 * I_C2;
            for (int it = gw; it < NIT; it += NGW) {
                int r = it;
                if (r < I_IN) { transpose_item<1>(P_in(p, 6) + (size_t)layer * DM * INW, DM, INW, (bf16_t*)(wl + W_IN), NINP / 64, r, scr, lane, P_in(p, 2) + layer * DM); continue; } r -= I_IN;
                if (r < I_OUT) { transpose_item<0>(P_in(p, 17) + (size_t)layer * DM * DM, DM, DM, (bf16_t*)(wl + W_OUT), 16, r, scr, lane); continue; } r -= I_OUT;
                if (r < I_GU) { transpose_item<2>(P_in(p, 18) + (size_t)layer * DM * NGU, DM, NGU, (bf16_t*)(wl + W_GU), NGU / 64, r, scr, lane, P_in(p, 4) + layer * DM); continue; } r -= I_GU;
                if (r < I_DN) { transpose_item<0>(P_in(p, 19) + (size_t)layer * DFF * DM, DFF, DM, (bf16_t*)(wl + W_DN), 16, r, scr, lane); continue; } r -= I_DN;
                if (r < I_C1) { transpose_item<0>(P_in(p, 8) + (size_t)layer * 2048 * 256, 2048, 256, (bf16_t*)(wl + W_C1K), 4, r, scr, lane); continue; } r -= I_C1;
                if (r < I_C1) { transpose_item<0>(P_in(p, 11) + (size_t)layer * 2048 * 256, 2048, 256, (bf16_t*)(wl + W_C1V), 4, r, scr, lane); continue; } r -= I_C1;
                if (r < I_C2) { transpose_item<0>(P_in(p, 9) + (size_t)layer * 256 * 64, 256, 64, (bf16_t*)(wl + W_C2K), 1, r, scr, lane); continue; } r -= I_C2;
                transpose_item<0>(P_in(p, 12) + (size_t)layer * 256 * 64, 256, 64, (bf16_t*)(wl + W_C2V), 1, r, scr, lane);
            }
        }
        __syncthreads();
        if (bx >= G - 2 * DEPTH) {
            const int id = G - 1 - bx, layer = id >> 1, kv = id & 1;
            const float* pos = P_in(p, kv ? 10 : 7) + (size_t)layer * 2048;
            const float* w1 = P_in(p, kv ? 11 : 8) + (size_t)layer * 2048 * 256;
            LAS float* red = (LAS float*)lds;
            f32x4 acc4 = (f32x4){0.f, 0.f, 0.f, 0.f};
#pragma unroll 8
            for (int i = wave * 256; i < wave * 256 + 256; ++i) { const f32x4 w = *(const f32x4*)(w1 + (size_t)i * 256 + 4 * lane); acc4 = acc4 + w * pos[i]; }
            red[wave * 256 + 4 * lane + 0] = acc4[0]; red[wave * 256 + 4 * lane + 1] = acc4[1]; red[wave * 256 + 4 * lane + 2] = acc4[2]; red[wave * 256 + 4 * lane + 3] = acc4[3];
            __syncthreads();
            if (tid < 256) { float sum = 0.f;
#pragma unroll
                for (int w = 0; w < 8; ++w) sum += red[w * 256 + tid];
                ((float*)(ws + WS_W + (size_t)layer * W_LAYER + (kv ? W_CBV : W_CBK)))[tid] = sum; }
            __syncthreads();
        }
        row_pass(P_in(p, 0), (bf16_t*)(ws + WS_HB), nullptr, nullptr, (float*)(ws + WS_RS), nullptr, gw, NGW, lane);
    }
    grid.sync();
    if (TID_F == 0) (void)xb_add(&((unsigned*)P_ws(p))[XB_XCNT(xb_xcc_id())], 1u);

#pragma unroll 1
    for (int layer = 0; layer < DEPTH; ++layer) {
        const size_t wloff = WS_W + (size_t)layer * W_LAYER;
#ifndef SKIP_PA
        {
            FRESH_WS; unsigned char* wl = ws + wloff;
            pg8::Gemm g{(const bf16_t*)(ws + WS_HB), (const bf16_t*)(wl + W_IN), MT, NINP, DM, DM};
            pg8::StaticOrder so; so.init(MT, NINP, G, bx, REP_PA);
            pg8::EpiIn E{ws + WS_R1, (const float*)(ws + WS_RS)};
            pg8::gemm_phase<pg8::EpiIn>(lds, g, so, E);
        }
#endif
        GSYNC();
#ifndef SKIP_PB
        for (int rep = 0; rep < REP_PB; ++rep) {
            FRESH_WS; unsigned char* wl = ws + wloff;
            for (int kv = 0; kv < 2; ++kv) {
                const int c = kv ? ((bx + (G >> 1)) % G) : bx;
                if (c < 16) {
                    bf16_t* hid = (bf16_t*)(ws + WS_R1 + R_HID) + (size_t)kv * 4096 * 256;
                    pg8::Gemm g{(const bf16_t*)(ws + WS_R1 + (kv ? R_VC : R_KC)), (const bf16_t*)(wl + (kv ? W_C1V : W_C1K)), 4096, 256, 2048, 1024};
                    pg8::StaticOrder so; so.init(4096, 256, G, c);
                    pg8::EpiCmp1 E{hid, (const float*)(wl + (kv ? W_CBV : W_CBK))};
                    pg8::gemm_phase<pg8::EpiCmp1>(lds, g, so, E);
                    pg8::Unit u; so.next(0, u);
                    asm volatile("s_waitcnt vmcnt(0)" ::: "memory");
                    __builtin_amdgcn_fence(__ATOMIC_RELEASE, "agent");
                    __syncthreads();
                    __builtin_amdgcn_fence(__ATOMIC_ACQUIRE, "agent");
                    cmp_gemm2(hid, (const bf16_t*)(wl + (kv ? W_C2V : W_C2K)), (bf16_t*)(ws + WS_R1 + R_KCMP), (bf16_t*)(ws + WS_R1 + R_VCMPT), kv, u.pm * 256 + WAVE_F * 32, LANE_F);
                    __syncthreads();
                }
            }
            if (G == 256) {
                const bool is_cmp = (bx < 16) || (bx >= 128 && bx < 144);
                if (!is_cmp) {
                    const int idx = (bx < 128) ? (bx - 16) : (bx - 32);
                    gmlp_unit(p, layer, idx, lds, WAVE_F, LANE_F);
                    if (idx + 224 < MT / 128) gmlp_unit(p, layer, idx + 224, lds, WAVE_F, LANE_F);
                }
            } else {
                for (int ch = bx; ch < MT / 128; ch += G) gmlp_unit(p, layer, ch, lds, WAVE_F, LANE_F);
            }
        }
#endif
        GSYNC();
        {
#if NSA_ENABLE
            __syncthreads();
            for (int rep = 0; rep < REP_PC; ++rep) {
                if (G == 256) {
                    const int x = bx & 7, y = bx >> 3, bg = x >> 1, j = (x & 1) * 32 + y;
                    for (int i = 0; i < 4; ++i) {
                        const int jq = (i >> 1) * 128 + ((i & 1) ? (127 - j) : j);
                        nsa_unit(p, bg, jq, lds, WAVE_F, LANE_F, i == 0);
                    }
                } else {
                    for (int i = 0; bx + i * G < 1024; ++i) {
                        const int u = bx + i * G;
                        const int bg = u >> 8, x = u & 255;
                        const int jq = (bg & 1) ? (255 - x) : x;
                        nsa_unit(p, bg, jq, lds, WAVE_F, LANE_F, true);
                    }
                }
            }
#else
            FRESH_WS;
            bf16_t* mixed = (bf16_t*)(ws + WS_AN);
            for (int m = GW_F; m < MT; m += NGW) { u32x4* o = (u32x4*)(mixed + (size_t)m * 1024); o[LANE_F] = (u32x4){0u, 0u, 0u, 0u}; }
#endif
        }
        GSYNC();
#ifndef SKIP_PD
        {
            FRESH_WS; unsigned char* wl = ws + wloff;
            pg8::Gemm g{AN, (const bf16_t*)(wl + W_OUT), MT, DM, DM, DM};
            pg8::StaticOrder so; so.init(MT, DM, G, bx, REP_PD);
            pg8::EpiBf16 E{(bf16_t*)MIX, DM};
            pg8::gemm_phase<pg8::EpiBf16>(lds, g, so, E);
        }
#endif
        GSYNC();
        { FRESH_WS; row_pass(nullptr, (bf16_t*)(ws + WS_HB), (const bf16_t*)MIX, P_in(p, 3) + layer * DM, (float*)(ws + WS_RS), nullptr, GW_F, NGW, LANE_F); }
        GSYNC();
#ifndef SKIP_PF
        {
            FRESH_WS; unsigned char* wl = ws + wloff;
            pg8::Gemm g{(const bf16_t*)(ws + WS_HB), (const bf16_t*)(wl + W_GU), MT, NGU, DM, DM};
            pg8::StaticOrder so; so.init(MT, NGU, G, bx, REP_PF);
            pg8::EpiGU E{(bf16_t*)(ws + WS_R1), (const float*)(ws + WS_RS)};
            pg8::gemm_phase<pg8::EpiGU>(lds, g, so, E);
        }
#endif
        GSYNC();
#ifndef SKIP_PG
        {
            FRESH_WS; unsigned char* wl = ws + wloff;
            pg8::Gemm g{(const bf16_t*)(ws + WS_R1), (const bf16_t*)(wl + W_DN), MT, DM, DFF, DFF};
            pg8::StaticOrder so; so.init(MT, DM, G, bx, REP_PG);
            pg8::EpiBf16 E{(bf16_t*)MIX, DM};
            pg8::gemm_phase<pg8::EpiBf16>(lds, g, so, E);
        }
#endif
        GSYNC();
        { FRESH_WS; row_pass(nullptr, (bf16_t*)(ws + WS_HB), (const bf16_t*)MIX, P_in(p, 5) + layer * DM, (float*)(ws + WS_RS), (layer + 1 < DEPTH) ? nullptr : P_out(p), GW_F, NGW, LANE_F); }
        if (layer + 1 < DEPTH) GSYNC();
    }
}

extern "C" void kernel_launch(void* const* d_in, const int* in_sizes, int n_in, void* d_out, int out_size, void* d_ws, size_t ws_size, hipStream_t stream) {
    static int grid = 0;
    if (grid == 0) {
        if (n_in != 20 || out_size != MT * DM || ws_size < WS_END) { fprintf(stderr, "kernel_launch: unexpected shapes (n_in %d out %d ws %zu need %zu)\n", n_in, out_size, ws_size, (size_t)WS_END); grid = -1; return; }
        int dev = 0, cus = 0, per_cu = 0;
        hipGetDevice(&dev);
        hipDeviceGetAttribute(&cus, hipDeviceAttributeMultiprocessorCount, dev);
        if (hipFuncSetAttribute((const void*)fwd_megakernel, hipFuncAttributeMaxDynamicSharedMemorySize, LDS_BYTES) != hipSuccess) { fprintf(stderr, "kernel_launch: hipFuncSetAttribute failed\n"); grid = -1; return; }
        if (hipOccupancyMaxActiveBlocksPerMultiprocessor(&per_cu, (const void*)fwd_megakernel, NTHREADS, LDS_BYTES) != hipSuccess || per_cu < 1) { fprintf(stderr, "kernel_launch: occupancy query says %d\n", per_cu); per_cu = 1; }
        (void)hipGetLastError();
        grid = cus;
        if (grid > 256) grid = 256;
    }
    if (grid < 0) return;
    Params p{};
    for (int i = 0; i < 20; ++i) p.in[i] = (const float*)d_in[i];
    p.out = (float*)d_out; p.ws = (unsigned char*)d_ws;
    void* args[] = {&p};
    hipError_t e = hipLaunchCooperativeKernel((const void*)fwd_megakernel, dim3(grid), dim3(NTHREADS), args, LDS_BYTES, stream);
    if (e != hipSuccess) fprintf(stderr, "cooperative launch failed: %s (grid %d)\n", hipGetErrorString(e), grid);
}
```

```cpp
#include <hip/hip_runtime.h>
#include <hip/hip_cooperative_groups.h>
#include <cstdio>
#include <cstdint>
namespace cg = cooperative_groups;

#define LAS __attribute__((address_space(3)))
typedef unsigned short bf16_t;
typedef short bf16x8 __attribute__((ext_vector_type(8)));
typedef short s16x4 __attribute__((ext_vector_type(4)));
typedef float f32x2 __attribute__((ext_vector_type(2)));
typedef float f32x4 __attribute__((ext_vector_type(4)));
typedef float f32x16 __attribute__((ext_vector_type(16)));
typedef unsigned u32x2 __attribute__((ext_vector_type(2)));
typedef unsigned u32x4 __attribute__((ext_vector_type(4)));
typedef long l64x2 __attribute__((ext_vector_type(2)));

#ifndef REP_PA
#define REP_PA 1
#endif
#ifndef REP_PB
#define REP_PB 1
#endif
#ifndef REP_PC
#define REP_PC 1
#endif
#ifndef REP_PD
#define REP_PD 1
#endif
#ifndef REP_PF
#define REP_PF 1
#endif
#ifndef REP_PG
#define REP_PG 1
#endif
#ifndef SYNC_REP
#define SYNC_REP 1
#endif
#define GSYNC() do { for (int _r = 0; _r < SYNC_REP; ++_r) xcd_barrier((unsigned*)P_ws(p), (volatile LAS unsigned*)(lds + LDS_BYTES - 64)); } while (0)
#ifndef NSA_ENABLE
#define NSA_ENABLE 1
#endif

constexpr int NB = 2, S = 16384, DM = 1024, DEPTH = 4, MT = NB * S;
constexpr int INW = 2328, NINP = 2560, DFF = 2816, NGU = 2 * DFF;
constexpr int NCMP = 1024;
constexpr float RMS_EPS = 1e-6f, LN_EPS = 1e-5f;
constexpr float LOG2E = 1.4426950408889634f;
constexpr float QSCALE = 0.125f * LOG2E;
constexpr int NWAVES = 8, NTHREADS = 512;
constexpr int LDS_BYTES = 147456;

constexpr size_t MiB = 1u << 20;
constexpr size_t WS_W = 1 * MiB, W_LAYER = 26 * MiB;
constexpr size_t W_IN = 0, W_OUT = 5 * MiB, W_GU = 7 * MiB, W_DN = 18 * MiB, W_C1K = 23 * MiB + 512 * 1024, W_C1V = 24 * MiB + 512 * 1024,
                 W_C2K = 25 * MiB + 512 * 1024, W_C2V = W_C2K + 64 * 1024, W_CBK = W_C2V + 64 * 1024, W_CBV = W_CBK + 4096;
constexpr size_t WS_AN = 105 * MiB;
constexpr size_t WS_R1 = 169 * MiB;
constexpr size_t R_Q = 0, R_ZU = 32 * MiB, R_ZV = 64 * MiB, R_KC = 96 * MiB, R_VC = 105 * MiB, R_KS = 114 * MiB, R_VST = 122 * MiB, R_KW = 130 * MiB,
                 R_VWT = 138 * MiB, R_GATES = 146 * MiB, R_HID = 150 * MiB, R_KCMP = 154 * MiB, R_VCMPT = 155 * MiB;
constexpr size_t WS_MIX = 345 * MiB;
constexpr size_t WS_HB = WS_MIX + 64 * MiB;
constexpr size_t WS_RS = 256 * 1024;
constexpr size_t WS_END = 473 * MiB;

struct Params {
    const float* in[20];
    float* out;
    unsigned char* ws;
};

typedef const __attribute__((address_space(4))) unsigned char* kargp_t;
__device__ __forceinline__ void* karg_ld(int byte_off) {
    kargp_t k = (kargp_t)__builtin_amdgcn_kernarg_segment_ptr();
    int off = byte_off; asm volatile("" : "+s"(off));
    return *(void* const __attribute__((address_space(4)))*)(k + off);
}
__device__ __forceinline__ const float* P_in(const Params&, int i) { return (const float*)karg_ld(8 * i); }
__device__ __forceinline__ float* P_out(const Params&) { return (float*)karg_ld(160); }
__device__ __forceinline__ unsigned char* P_ws(const Params&) { return (unsigned char*)karg_ld(168); }
__device__ __forceinline__ unsigned cvt_pk_bf16(float lo, float hi) { unsigned r; asm volatile("v_cvt_pk_bf16_f32 %0, %1, %2" : "=v"(r) : "v"(lo), "v"(hi)); return r; }
__device__ __forceinline__ float fast_exp2(float x) { return __builtin_amdgcn_exp2f(x); }
__device__ __forceinline__ float fast_rcp(float x) { return __builtin_amdgcn_rcpf(x); }
__device__ __forceinline__ float gelu_tanh(float x) { const float u = x + 0.044715f * x * x * x; return x * fast_rcp(1.0f + fast_exp2(-2.3022081982f * u)); }
__device__ __forceinline__ float silu_f(float x) { return x * fast_rcp(1.0f + fast_exp2(-LOG2E * x)); }
__device__ __forceinline__ float sigmoid_f(float x) { return fast_rcp(1.0f + fast_exp2(-LOG2E * x)); }
__device__ __forceinline__ float wave_sum(float v) {
#pragma unroll
    for (int o = 1; o < 64; o <<= 1) v += __shfl_xor(v, o);
    return v;
}
__device__ __forceinline__ float wave_max(float v) {
#pragma unroll
    for (int o = 1; o < 64; o <<= 1) v = fmaxf(v, __shfl_xor(v, o));
    return v;
}
template <int CTRL> __device__ __forceinline__ float dpp_f(float x) { return __builtin_bit_cast(float, __builtin_amdgcn_mov_dpp(__builtin_bit_cast(int, x), CTRL, 0xf, 0xf, true)); }
__device__ __forceinline__ float xhalf_max(float x) { auto t = __builtin_amdgcn_permlane32_swap(__float_as_uint(x), __float_as_uint(x), false, false); return fmaxf(__uint_as_float(t[0]), __uint_as_float(t[1])); }
__device__ __forceinline__ float xhalf_sum(float x) { auto t = __builtin_amdgcn_permlane32_swap(__float_as_uint(x), __float_as_uint(x), false, false); return __uint_as_float(t[0]) + __uint_as_float(t[1]); }
__device__ __forceinline__ float quad_sum(float x) { x += dpp_f<0xB1>(x); x += dpp_f<0x4E>(x); return x; }
__device__ __forceinline__ float wave_max_fast(float x) {
    x = fmaxf(x, dpp_f<0xB1>(x)); x = fmaxf(x, dpp_f<0x4E>(x)); x = fmaxf(x, dpp_f<0x141>(x)); x = fmaxf(x, dpp_f<0x128>(x));
    auto s = __builtin_amdgcn_permlane16_swap(__float_as_uint(x), __float_as_uint(x), false, false); x = fmaxf(__uint_as_float(s[0]), __uint_as_float(s[1]));
    return xhalf_max(x);
}
__device__ __forceinline__ float wave_sum_fast(float x) {
    x += dpp_f<0xB1>(x); x += dpp_f<0x4E>(x); x += dpp_f<0x141>(x); x += dpp_f<0x128>(x);
    auto s = __builtin_amdgcn_permlane16_swap(__float_as_uint(x), __float_as_uint(x), false, false); x = __uint_as_float(s[0]) + __uint_as_float(s[1]);
    return xhalf_sum(x);
}
__device__ __forceinline__ float bf2f(bf16_t b) { return __uint_as_float(((unsigned)b) << 16); }
#define LAUNDER(x) asm volatile("" : "+v"(x))
#define MFMA32(a, b, c) __builtin_amdgcn_mfma_f32_32x32x16_bf16((a), (b), (c), 0, 0, 0)

namespace pg8 {
constexpr int BM = 256, BK = 64, HALF = 128, HTB = HALF * BK * 2, STAGE_BYTES = 8 * HTB, NXCD = 8, WGM = 8;
__host__ __device__ __forceinline__ int lds_byte(int r, int c) { const int st = (r >> 4) * 2 + (c >> 5), rr = r & 15, cc = c & 31, ob = rr * 64 + cc * 2; return st * 1024 + (ob ^ (((ob >> 9) & 1) << 5)); }
__host__ __device__ __forceinline__ void stage_rc(int b, int& R, int& C) { const int st = b / 1024, sb = b % 1024, swz = sb ^ (((sb >> 9) & 1) << 5); R = (st >> 1) * 16 + swz / 64; C = (st & 1) * 32 + (swz % 64) / 2; }
__host__ __device__ __forceinline__ int perm32(int rho) { const int n = rho >> 4, i = rho & 15; return 8 * (i >> 2) + 4 * n + (i & 3); }

struct Unit { int pm, pn; };
struct Gemm { const bf16_t* A; const bf16_t* Bt; int M, N, K, lda; };

struct StaticOrder {
    int nM, nN, nwg, G, c, lim;
    __device__ __forceinline__ void init(int M, int N, int G_, int c_, int reps = 1) { nM = M / BM; nN = N / BM; nwg = nM * nN; G = G_; c = c_; const int per = (c < nwg) ? (nwg - c + G - 1) / G : 0; lim = per * reps; }
    __device__ __forceinline__ bool next(int i, Unit& u) const {
        if (i >= lim) return false;
        const int per = (nwg - c + G - 1) / G; const long L = (long)(i % per) * G + c;
        int wgid = (int)L; { const int q = nwg / NXCD, r = nwg % NXCD, xcd = wgid % NXCD, off = wgid / NXCD; wgid = (xcd < r ? xcd * (q + 1) : r * (q + 1) + (xcd - r) * q) + off; }
        const int nig = WGM * nN, gid = wgid / nig, fm = gid * WGM, gsz = (nM - fm) < WGM ? (nM - fm) : WGM;
        u.pm = fm + ((wgid % nig) % gsz); u.pn = (wgid % nig) / gsz; return true;
    }
};

struct EpiF32 {
    static constexpr bool PERM = false;
    float* C; int ldc;
    __device__ __forceinline__ void operator()(const f32x4 (&acc)[2][2][4][2], const Unit& u, int wr, int wc, int fr, int fq) const {
        const int row0 = u.pm * BM + wr * 64 + fr, col0 = u.pn * BM + wc * 32 + 4 * fq;
#pragma unroll
        for (int ai = 0; ai < 2; ++ai)
#pragma unroll
            for (int m = 0; m < 4; ++m) { float* rowp = C + (size_t)(row0 + ai * HALF + m * 16) * ldc + col0;
#pragma unroll
                for (int bj = 0; bj < 2; ++bj)
#pragma unroll
                    for (int n = 0; n < 2; ++n) *(f32x4*)(rowp + bj * HALF + n * 16) = acc[ai][bj][m][n]; }
    }
};

struct EpiBf16 {
    static constexpr bool PERM = true;
    bf16_t* C; int ldc;
    __device__ __forceinline__ void operator()(const f32x4 (&acc)[2][2][4][2], const Unit& u, int wr, int wc, int fr, int fq) const {
        const int row0 = u.pm * BM + wr * 64 + fr, col0 = u.pn * BM + wc * 32 + 8 * fq;
#pragma unroll
        for (int ai = 0; ai < 2; ++ai)
#pragma unroll
            for (int m = 0; m < 4; ++m) { bf16_t* rowp = C + (size_t)(row0 + ai * HALF + m * 16) * ldc + col0;
#pragma unroll
                for (int bj = 0; bj < 2; ++bj) { const f32x4 v0 = acc[ai][bj][m][0], v1 = acc[ai][bj][m][1];
                    u32x4 w; w.x = cvt_pk_bf16(v0[0], v0[1]); w.y = cvt_pk_bf16(v0[2], v0[3]); w.z = cvt_pk_bf16(v1[0], v1[1]); w.w = cvt_pk_bf16(v1[2], v1[3]);
                    *(u32x4*)(rowp + bj * HALF) = w; } }
    }
};

struct EpiGU {
    static constexpr bool PERM = true;
    bf16_t* act; const float* rs;
    __device__ __forceinline__ void operator()(const f32x4 (&acc)[2][2][4][2], const Unit& u, int wr, int wc, int fr, int fq) const {
        const int row0 = u.pm * BM + wr * 64 + fr, col0 = u.pn * HALF + wc * 32 + 8 * fq;
        float rrv[2][4];
#pragma unroll
        for (int ai = 0; ai < 2; ++ai)
#pragma unroll
            for (int m = 0; m < 4; ++m) rrv[ai][m] = rs[row0 + ai * HALF + m * 16];
#pragma unroll
        for (int ai = 0; ai < 2; ++ai)
#pragma unroll
            for (int m = 0; m < 4; ++m) {
                const float rr = rrv[ai][m];
                const f32x4 g0 = acc[ai][0][m][0] * rr, g1 = acc[ai][0][m][1] * rr, u0 = acc[ai][1][m][0] * rr, u1 = acc[ai][1][m][1] * rr;
                u32x4 w;
                w.x = cvt_pk_bf16(silu_f(g0[0]) * u0[0], silu_f(g0[1]) * u0[1]); w.y = cvt_pk_bf16(silu_f(g0[2]) * u0[2], silu_f(g0[3]) * u0[3]);
                w.z = cvt_pk_bf16(silu_f(g1[0]) * u1[0], silu_f(g1[1]) * u1[1]); w.w = cvt_pk_bf16(silu_f(g1[2]) * u1[2], silu_f(g1[3]) * u1[3]);
                *(u32x4*)(act + (size_t)(row0 + ai * HALF + m * 16) * DFF + col0) = w;
            }
    }
};

struct EpiCmp1 {
    static constexpr bool PERM = true;
    bf16_t* hid; const float* cbias;
    __device__ __forceinline__ void operator()(const f32x4 (&acc)[2][2][4][2], const Unit& u, int wr, int wc, int fr, int fq) const {
        const int row0 = u.pm * BM + wr * 64 + fr;
#pragma unroll
        for (int bj = 0; bj < 2; ++bj) {
            const int col0 = bj * HALF + wc * 32 + 8 * fq;
            const f32x4 b0 = *(const f32x4*)(cbias + col0), b1 = *(const f32x4*)(cbias + col0 + 4);
#pragma unroll
            for (int ai = 0; ai < 2; ++ai)
#pragma unroll
                for (int m = 0; m < 4; ++m) {
                    const f32x4 v0 = acc[ai][bj][m][0] + b0, v1 = acc[ai][bj][m][1] + b1;
                    u32x4 w;
                    w.x = cvt_pk_bf16(gelu_tanh(v0[0]), gelu_tanh(v0[1])); w.y = cvt_pk_bf16(gelu_tanh(v0[2]), gelu_tanh(v0[3]));
                    w.z = cvt_pk_bf16(gelu_tanh(v1[0]), gelu_tanh(v1[1])); w.w = cvt_pk_bf16(gelu_tanh(v1[2]), gelu_tanh(v1[3]));
                    *(u32x4*)(hid + (size_t)(row0 + ai * HALF + m * 16) * 256 + col0) = w;
                }
        }
    }
};

struct EpiIn {
    static constexpr bool PERM = true;
    unsigned char* r1;
    const float* rs;
    __device__ __forceinline__ void operator()(const f32x4 (&acc)[2][2][4][2], const Unit& u, int wr, int wc, int fr, int fq) const {
        const int pn = u.pn;
        float rrv[2][4];
#pragma unroll
        for (int ai = 0; ai < 2; ++ai)
#pragma unroll
            for (int m = 0; m < 4; ++m) rrv[ai][m] = rs[u.pm * BM + ai * HALF + wr * 64 + m * 16 + fr];
#pragma unroll
        for (int ai = 0; ai < 2; ++ai)
#pragma unroll
            for (int m = 0; m < 4; ++m) {
                const int row = u.pm * BM + ai * HALF + wr * 64 + m * 16 + fr;
                const int b = row >> 14, s = row & (S - 1);
                const float rr = rrv[ai][m];
#pragma unroll
                for (int bj = 0; bj < 2; ++bj) {
                    f32x4 v0 = acc[ai][bj][m][0] * rr, v1 = acc[ai][bj][m][1] * rr;
                    const int cw = bj * HALF + wc * 32 + 8 * fq;
                    if (pn < 2) {
                        v0 = v0 * QSCALE; v1 = v1 * QSCALE;
                        u32x4 w; w.x = cvt_pk_bf16(v0[0], v0[1]); w.y = cvt_pk_bf16(v0[2], v0[3]); w.z = cvt_pk_bf16(v1[0], v1[1]); w.w = cvt_pk_bf16(v1[2], v1[3]);
                        *(u32x4*)((bf16_t*)(r1 + R_Q) + (size_t)row * 512 + pn * 256 + cw) = w;
                    } else if (pn < 5) {
                        const int g = wc >> 1, d = (wc & 1) * 32 + 8 * fq, bg = b * 2 + g;
                        if (pn == 2) {
                            bf16_t* base = (bf16_t*)(r1 + (bj == 0 ? R_KC : R_VC));
                            u32x4 w; w.x = cvt_pk_bf16(v0[0], v0[1]); w.y = cvt_pk_bf16(v0[2], v0[3]); w.z = cvt_pk_bf16(v1[0], v1[1]); w.w = cvt_pk_bf16(v1[2], v1[3]);
                            *(u32x4*)(base + ((size_t)bg * S + s) * 64 + d) = w;
                        } else if (pn == 3) {
                            if (bj == 0) {
                                int w0 = __builtin_amdgcn_cvt_pk_fp8_f32(v0[0], v0[1], 0, false); w0 = __builtin_amdgcn_cvt_pk_fp8_f32(v0[2], v0[3], w0, true);
                                int w1 = __builtin_amdgcn_cvt_pk_fp8_f32(v1[0], v1[1], 0, false); w1 = __builtin_amdgcn_cvt_pk_fp8_f32(v1[2], v1[3], w1, true);
                                u32x2 w; w.x = (unsigned)w0; w.y = (unsigned)w1;
                                *(u32x2*)(r1 + R_KS + (size_t)bg * S * 64 + (size_t)(s >> 6) * 4096 + ((s >> 4) & 3) * 1024 + (((d >> 3) & 3) * 16 + (s & 15)) * 16 + (d >> 5) * 8) = w;
                            } else {
                                const int kb = s & 63, kp = kb >> 5, k32 = kb & 31, fqv = (k32 >> 2) & 3, jj = ((k32 >> 4) << 2) | (k32 & 3);
                                unsigned char* dst = r1 + R_VST + (size_t)bg * S * 64 + (size_t)(s >> 6) * 4096 + (d >> 4) * 1024 + (fqv * 16 + (d & 15)) * 16 + kp * 8 + jj;
                                const int w0 = __builtin_amdgcn_cvt_pk_fp8_f32(v0[0], v0[1], 0, false), w1 = __builtin_amdgcn_cvt_pk_fp8_f32(v0[2], v0[3], 0, false);
                                const int w2 = __builtin_amdgcn_cvt_pk_fp8_f32(v1[0], v1[1], 0, false), w3 = __builtin_amdgcn_cvt_pk_fp8_f32(v1[2], v1[3], 0, false);
                                dst[0] = (unsigned char)(w0 & 0xff); dst[16] = (unsigned char)((w0 >> 8) & 0xff); dst[32] = (unsigned char)(w1 & 0xff); dst[48] = (unsigned char)((w1 >> 8) & 0xff);
                                dst[64] = (unsigned char)(w2 & 0xff); dst[80] = (unsigned char)((w2 >> 8) & 0xff); dst[96] = (unsigned char)(w3 & 0xff); dst[112] = (unsigned char)((w3 >> 8) & 0xff);
                            }
                        } else if (bj == 0) {
                            bf16_t* base = (bf16_t*)(r1 + R_KW);
                            u32x4 w; w.x = cvt_pk_bf16(v0[0], v0[1]); w.y = cvt_pk_bf16(v0[2], v0[3]); w.z = cvt_pk_bf16(v1[0], v1[1]); w.w = cvt_pk_bf16(v1[2], v1[3]);
                            *(u32x4*)(base + (size_t)bg * S * 64 + (size_t)(s >> 5) * 2048 + (d >> 4) * 512 + ((d >> 3) & 1) * 256 + (s & 31) * 8) = w;
                        } else {
                            const int kk = s & 31;
                            bf16_t* dst = (bf16_t*)(r1 + R_VWT) + (size_t)bg * S * 64 + (size_t)(s >> 5) * 2048 + (d >> 5) * 1024 + (kk >> 4) * 512 + ((kk >> 2) & 1) * 256 + (d & 31) * 8 + ((kk >> 3) & 1) * 4 + (kk & 3);
                            const unsigned w0 = cvt_pk_bf16(v0[0], v0[1]), w1 = cvt_pk_bf16(v0[2], v0[3]), w2 = cvt_pk_bf16(v1[0], v1[1]), w3 = cvt_pk_bf16(v1[2], v1[3]);
                            dst[0] = (bf16_t)(w0 & 0xffff); dst[8] = (bf16_t)(w0 >> 16); dst[16] = (bf16_t)(w1 & 0xffff); dst[24] = (bf16_t)(w1 >> 16);
                            dst[32] = (bf16_t)(w2 & 0xffff); dst[40] = (bf16_t)(w2 >> 16); dst[48] = (bf16_t)(w3 & 0xffff); dst[56] = (bf16_t)(w3 >> 16);
                        }
                    } else if (pn < 9) {
                        bf16_t* base = (bf16_t*)(r1 + ((pn < 7) ? R_ZU : R_ZV)); const int ct = (pn < 7) ? (pn - 5) : (pn - 7);
                        u32x4 w;
                        w.x = cvt_pk_bf16(gelu_tanh(v0[0]), gelu_tanh(v0[1])); w.y = cvt_pk_bf16(gelu_tanh(v0[2]), gelu_tanh(v0[3]));
                        w.z = cvt_pk_bf16(gelu_tanh(v1[0]), gelu_tanh(v1[1])); w.w = cvt_pk_bf16(gelu_tanh(v1[2]), gelu_tanh(v1[3]));
                        *(u32x4*)(base + (size_t)row * 512 + ct * 256 + cw) = w;
                    } else {
                        if (bj == 0 && wc == 0 && fq < 3) {
                            float* gp = (float*)(r1 + R_GATES) + (size_t)row * 24 + 8 * fq;
                            *(f32x4*)gp = (f32x4){sigmoid_f(v0[0]), sigmoid_f(v0[1]), sigmoid_f(v0[2]), sigmoid_f(v0[3])};
                            *(f32x4*)(gp + 4) = (f32x4){sigmoid_f(v1[0]), sigmoid_f(v1[1]), sigmoid_f(v1[2]), sigmoid_f(v1[3])};
                        }
                    }
                }
            }
    }
};

template <class Epi>
__device__ __forceinline__ void gemm_phase(LAS unsigned char* lds, const Gemm g, const StaticOrder& S, const Epi& E) {
    int tid = threadIdx.x; LAUNDER(tid);
    const int wid = __builtin_amdgcn_readfirstlane(tid >> 6), lane = tid & 63, wr = wid >> 2, wc = wid & 3, fr = lane & 15, fq = lane >> 4;
    const int K = g.K, nt = K / BK, lda = g.lda;
    unsigned voffA[2], voffB[2];
#pragma unroll
    for (int i = 0; i < 2; ++i) { int R, C; stage_rc(tid * 16 + i * 8192, R, C); const int Rb = Epi::PERM ? ((R & ~31) + perm32(R & 31)) : R;
        voffA[i] = (unsigned)(R * lda + C) * 2u; voffB[i] = (unsigned)(Rb * K + C) * 2u; }
    const size_t kstep = (size_t)(BK * 2);
    const size_t hA = (size_t)HALF * lda * 2, hB = (size_t)HALF * K * 2;
    const size_t tA = 2 * hA, tB = 2 * hB;
    const unsigned ldsw = (unsigned)wid * 1024u;
    const int aoff = lds_byte(wr * 64 + fr, fq * 8), boff = lds_byte(wc * 32 + fr, fq * 8);
#define PG8_SA(b, h) (((b) * 2 + (h)) * HTB)
#define PG8_SB(b, h) ((4 + (b) * 2 + (h)) * HTB)
#define PG8_STAGE(bufoff, gbase, voff) do { _Pragma("unroll") for (int _i = 0; _i < 2; ++_i) \
        __builtin_amdgcn_global_load_lds((const unsigned*)((const char*)(gbase) + (voff)[_i]), (LAS unsigned*)(lds + (bufoff) + ldsw + _i * 8192), 16, 0, 0); } while (0)
#define PG8_LDA(dst, b, h) do { _Pragma("unroll") for (int m = 0; m < 4; ++m) _Pragma("unroll") for (int k = 0; k < 2; ++k) dst[m][k] = *(const LAS bf16x8*)(lds + PG8_SA(b, h) + aoff + m * 2048 + k * 1024); } while (0)
#define PG8_LDB(dst, b, h) do { _Pragma("unroll") for (int n = 0; n < 2; ++n) _Pragma("unroll") for (int k = 0; k < 2; ++k) dst[n][k] = *(const LAS bf16x8*)(lds + PG8_SB(b, h) + boff + n * 2048 + k * 1024); } while (0)
#define PG8_MMA(ai, bj, At, Bt) do { __builtin_amdgcn_s_setprio(1); _Pragma("unroll") for (int m = 0; m < 4; ++m) _Pragma("unroll") for (int n = 0; n < 2; ++n) _Pragma("unroll") for (int k = 0; k < 2; ++k) \
        acc[ai][bj][m][n] = __builtin_amdgcn_mfma_f32_16x16x32_bf16(Bt[n][k], At[m][k], acc[ai][bj][m][n], 0, 0, 0); __builtin_amdgcn_s_setprio(0); } while (0)
#define PG8_WAIT_V(n) asm volatile("s_waitcnt vmcnt(" #n ")" ::: "memory")
#define PG8_WAIT_L(n) asm volatile("s_waitcnt lgkmcnt(" #n ")" ::: "memory")
#define PG8_BAR __builtin_amdgcn_s_barrier()
#define PG8_SCHED __builtin_amdgcn_sched_barrier(0)
    Unit cur, nxt; int ui = 0;
    if (!S.next(0, cur)) return;
    f32x4 acc[2][2][4][2];
#pragma unroll
    for (int a = 0; a < 2; ++a)
#pragma unroll
        for (int b = 0; b < 2; ++b)
#pragma unroll
            for (int m = 0; m < 4; ++m)
#pragma unroll
                for (int n = 0; n < 2; ++n) acc[a][b][m][n] = (f32x4){0.f, 0.f, 0.f, 0.f};
    bf16x8 At[4][2], B0[2][2], B1[2][2];
    const char* cA = (const char*)g.A + (size_t)cur.pm * tA; const char* cB = (const char*)g.Bt + (size_t)cur.pn * tB;
    PG8_STAGE(PG8_SB(0, 0), cB, voffB); PG8_STAGE(PG8_SB(0, 1), cB + hB, voffB); PG8_STAGE(PG8_SA(0, 0), cA, voffA); PG8_STAGE(PG8_SA(0, 1), cA + hA, voffA);
    if (wr == 1) PG8_BAR;
    PG8_WAIT_V(2); PG8_BAR;
    PG8_STAGE(PG8_SB(1, 0), cB + kstep, voffB); PG8_STAGE(PG8_SA(1, 0), cA + kstep, voffA); PG8_STAGE(PG8_SB(1, 1), cB + hB + kstep, voffB);
    PG8_WAIT_V(6); PG8_BAR;
    for (;;) {
        const bool has_next = S.next(ui + 1, nxt);
        const char* nA = has_next ? (const char*)g.A + (size_t)nxt.pm * tA : cA; const char* nB = has_next ? (const char*)g.Bt + (size_t)nxt.pn * tB : cB;
        for (int t = 0; t < nt; t += 2) {
            const bool last = (t == nt - 2);
            const char* a1 = cA + (size_t)(t + 1) * kstep;
            const char* a2 = last ? nA : cA + (size_t)(t + 2) * kstep; const char* b2 = last ? nB : cB + (size_t)(t + 2) * kstep;
            const char* a3 = a2 + kstep; const char* b3 = b2 + kstep;
            PG8_LDB(B0, 0, 0); PG8_LDB(B1, 0, 1); PG8_SCHED; PG8_LDA(At, 0, 0); PG8_STAGE(PG8_SA(1, 1), a1 + hA, voffA);
            PG8_WAIT_V(8); PG8_WAIT_L(0); PG8_BAR; PG8_MMA(0, 0, At, B0); PG8_MMA(0, 1, At, B1); PG8_BAR; PG8_SCHED;
            PG8_LDA(At, 0, 1); PG8_STAGE(PG8_SB(0, 0), b2, voffB); PG8_STAGE(PG8_SB(0, 1), b2 + hB, voffB); PG8_STAGE(PG8_SA(0, 0), a2, voffA);
            PG8_WAIT_V(8); PG8_WAIT_L(0); PG8_BAR; PG8_MMA(1, 0, At, B0); PG8_MMA(1, 1, At, B1); PG8_BAR; PG8_SCHED;
            PG8_LDB(B0, 1, 0); PG8_LDB(B1, 1, 1); PG8_SCHED; PG8_LDA(At, 1, 0); PG8_STAGE(PG8_SA(0, 1), a2 + hA, voffA);
            PG8_WAIT_V(8); PG8_WAIT_L(0); PG8_BAR; PG8_MMA(0, 0, At, B0); PG8_MMA(0, 1, At, B1); PG8_BAR; PG8_SCHED;
            PG8_LDA(At, 1, 1); PG8_STAGE(PG8_SB(1, 0), b3, voffB); PG8_STAGE(PG8_SB(1, 1), b3 + hB, voffB); PG8_STAGE(PG8_SA(1, 0), a3, voffA);
            PG8_WAIT_V(8); PG8_WAIT_L(0); PG8_BAR; PG8_MMA(1, 0, At, B0); PG8_MMA(1, 1, At, B1); PG8_BAR; PG8_SCHED;
        }
        if (wr == 0) PG8_BAR;
        E(acc, cur, wr, wc, fr, fq);
        if (!has_next) break;
#pragma unroll
        for (int a = 0; a < 2; ++a)
#pragma unroll
            for (int b = 0; b < 2; ++b)
#pragma unroll
                for (int m = 0; m < 4; ++m)
#pragma unroll
                    for (int n = 0; n < 2; ++n) acc[a][b][m][n] = (f32x4){0.f, 0.f, 0.f, 0.f};
        cur = nxt; cA = nA; cB = nB; ++ui;
        if (wr == 1) PG8_BAR;
    }
    PG8_WAIT_V(0);
    PG8_BAR;
#undef PG8_SA
#undef PG8_SB
#undef PG8_STAGE
#undef PG8_LDA
#undef PG8_LDB
#undef PG8_MMA
#undef PG8_WAIT_V
#undef PG8_WAIT_L
#undef PG8_BAR
#undef PG8_SCHED
}
}

template <int MAP> __device__ __forceinline__ int src_col(int n) {
    if (MAP == 0) return n;
    if (MAP == 1) { if (n < 1280) return n; if (n < 2304) return n + 24; if (n < 2328) return n - 1024; return -1; }
    const int t = n >> 8, w = n & 255; return (w < 128) ? (128 * t + w) : (DFF + 128 * t + (w - 128));
}
constexpr int TP = 65;
template <int MAP> __device__ __forceinline__ void transpose_item(const float* W, int K, int Nsrc, bf16_t* WT, int nblk, int item, LAS float* scr, int lane, const float* gain = nullptr) {
    const int kb = item / nblk, nb = item % nblk, k0 = 64 * kb, n0 = 64 * nb;
    const int nl = 4 * (lane & 15), kr = lane >> 4;
    const int ns = src_col<MAP>(n0 + nl);
    f32x4 v[16];
#pragma unroll
    for (int i = 0; i < 16; ++i) v[i] = (ns >= 0) ? *(const f32x4*)(W + (size_t)(k0 + kr + 4 * i) * Nsrc + ns) : (f32x4){0.f, 0.f, 0.f, 0.f};
    if (gain) {
#pragma unroll
        for (int i = 0; i < 16; ++i) v[i] = v[i] * gain[k0 + kr + 4 * i];
    }
#pragma unroll
    for (int i = 0; i < 16; ++i) { LAS float* d = scr + (kr + 4 * i) * TP + nl; d[0] = v[i][0]; d[1] = v[i][1]; d[2] = v[i][2]; d[3] = v[i][3]; }
    asm volatile("s_waitcnt lgkmcnt(0)" ::: "memory");
    __builtin_amdgcn_wave_barrier();
    const int c = lane & 7;
#pragma unroll
    for (int j = 0; j < 8; ++j) { const int n = (lane >> 3) + 8 * j; const LAS float* s = scr + (8 * c) * TP + n;
        u32x4 o; o.x = cvt_pk_bf16(s[0 * TP], s[1 * TP]); o.y = cvt_pk_bf16(s[2 * TP], s[3 * TP]); o.z = cvt_pk_bf16(s[4 * TP], s[5 * TP]); o.w = cvt_pk_bf16(s[6 * TP], s[7 * TP]);
        *(u32x4*)(WT + (size_t)(n0 + n) * K + k0 + 8 * c) = o; }
    asm volatile("s_waitcnt lgkmcnt(0)" ::: "memory");
    __builtin_amdgcn_wave_barrier();
}

__device__ __forceinline__ void row_pass(const float* x0, bf16_t* hb, const bf16_t* mix, const float* gpost, float* rs, float* fout, int gw, int NGW, int lane) {
    LAUNDER(lane);
    if (x0) {
        for (int m = gw; m < MT; m += NGW) {
            const f32x4* hr = (const f32x4*)(x0 + (size_t)m * DM) + lane;
            f32x4 h[4]; float s2 = 0.f;
#pragma unroll
            for (int j = 0; j < 4; ++j) { h[j] = hr[64 * j]; s2 += (h[j][0] * h[j][0] + h[j][1] * h[j][1]) + (h[j][2] * h[j][2] + h[j][3] * h[j][3]); }
            const float r2 = 1.0f / sqrtf(wave_sum_fast(s2) * (1.0f / DM) + RMS_EPS);
            u32x2* ao = (u32x2*)(hb + (size_t)m * DM) + lane;
#pragma unroll
            for (int j = 0; j < 4; ++j) { u32x2 w; w.x = cvt_pk_bf16(h[j][0], h[j][1]); w.y = cvt_pk_bf16(h[j][2], h[j][3]); ao[64 * j] = w; }
            if (lane == 0) rs[m] = r2;
        }
        return;
    }
    u32x2 hn[4], mn[4];
    if (gw < MT) {
        const u32x2* hr = (const u32x2*)(hb + (size_t)gw * DM) + lane; const u32x2* mr = (const u32x2*)(mix + (size_t)gw * DM) + lane;
#pragma unroll
        for (int j = 0; j < 4; ++j) { hn[j] = hr[64 * j]; mn[j] = mr[64 * j]; }
    }
    for (int m = gw; m < MT; m += NGW) {
        u32x2 hv[4], mv[4];
#pragma unroll
        for (int j = 0; j < 4; ++j) { hv[j] = hn[j]; mv[j] = mn[j]; }
        const int m2 = m + NGW;
        if (m2 < MT) {
            const u32x2* hr = (const u32x2*)(hb + (size_t)m2 * DM) + lane; const u32x2* mr = (const u32x2*)(mix + (size_t)m2 * DM) + lane;
#pragma unroll
            for (int j = 0; j < 4; ++j) { hn[j] = hr[64 * j]; mn[j] = mr[64 * j]; }
        }
        f32x4 h[4], x[4]; float ss = 0.f;
#pragma unroll
        for (int j = 0; j < 4; ++j) {
            h[j] = (f32x4){__uint_as_float(hv[j].x << 16), __uint_as_float(hv[j].x & 0xffff0000u), __uint_as_float(hv[j].y << 16), __uint_as_float(hv[j].y & 0xffff0000u)};
            x[j] = (f32x4){__uint_as_float(mv[j].x << 16), __uint_as_float(mv[j].x & 0xffff0000u), __uint_as_float(mv[j].y << 16), __uint_as_float(mv[j].y & 0xffff0000u)};
            ss += (x[j][0] * x[j][0] + x[j][1] * x[j][1]) + (x[j][2] * x[j][2] + x[j][3] * x[j][3]);
        }
        const float r1 = 1.0f / sqrtf(wave_sum_fast(ss) * (1.0f / DM) + RMS_EPS);
        float s2 = 0.f;
#pragma unroll
        for (int j = 0; j < 4; ++j) { const f32x4 gp = *((const f32x4*)gpost + lane + 64 * j); h[j] = h[j] + x[j] * r1 * gp; s2 += (h[j][0] * h[j][0] + h[j][1] * h[j][1]) + (h[j][2] * h[j][2] + h[j][3] * h[j][3]); }
        if (fout) {
            f32x4* ho = (f32x4*)(fout + (size_t)m * DM) + lane;
#pragma unroll
            for (int j = 0; j < 4; ++j) ho[64 * j] = h[j];
        } else {
            const float r2 = 1.0f / sqrtf(wave_sum_fast(s2) * (1.0f / DM) + RMS_EPS);
            u32x2* ao = (u32x2*)(hb + (size_t)m * DM) + lane;
#pragma unroll
            for (int j = 0; j < 4; ++j) { u32x2 w; w.x = cvt_pk_bf16(h[j][0], h[j][1]); w.y = cvt_pk_bf16(h[j][2], h[j][3]); ao[64 * j] = w; }
            if (lane == 0) rs[m] = r2;
        }
    }
}

constexpr int ZPITCH = 136;
__device__ __forceinline__ void gmlp_unit(const Params& p, int layer, int chunk, LAS unsigned char* lds, int wave, int lane) {
    LAUNDER(lane);
    const unsigned char* ws = P_ws(p);
    const bf16_t* zu = (const bf16_t*)(ws + WS_R1 + R_ZU); const bf16_t* zv = (const bf16_t*)(ws + WS_R1 + R_ZV);
    bf16_t* mixed = (bf16_t*)(ws + WS_AN);
    const float* ln_g = P_in(p, 13) + layer * 512; const float* ln_b = P_in(p, 14) + layer * 512;
    const float* w_s = P_in(p, 15) + (size_t)layer * 8 * 128 * 128 + (size_t)wave * 128 * 128;
    const float* b_s = P_in(p, 16) + layer * 8 * 128 + wave * 128;
    LAS float* stats = (LAS float*)(lds + 8 * 64 * ZPITCH * 2);
    LAS bf16_t* zt = (LAS bf16_t*)(lds + wave * 64 * ZPITCH * 2);
    const int tok0 = chunk * 128;
    __syncthreads();
#pragma unroll
    for (int i = 0; i < 16; ++i) {
        const int t = wave * 16 + i;
        const bf16x8 v = *(const bf16x8*)(zv + (size_t)(tok0 + t) * 512 + lane * 8);
        float s = 0.f, s2 = 0.f;
#pragma unroll
        for (int e = 0; e < 8; ++e) { const float x = bf2f((bf16_t)v[e]); s += x; s2 += x * x; }
        s = wave_sum_fast(s); s2 = wave_sum_fast(s2);
        const float mean = s * (1.0f / 512.0f); const float var = fmaxf(s2 * (1.0f / 512.0f) - mean * mean, 0.f);
        if (lane == 0) { stats[2 * t] = mean; stats[2 * t + 1] = 1.0f / sqrtf(var + LN_EPS); }
    }
    __syncthreads();
    {
        const int dc = lane & 7, d0 = dc * 8;
        const f32x4 g0 = *(const f32x4*)(ln_g + wave * 64 + d0), g1 = *(const f32x4*)(ln_g + wave * 64 + d0 + 4);
        const f32x4 b0 = *(const f32x4*)(ln_b + wave * 64 + d0), b1 = *(const f32x4*)(ln_b + wave * 64 + d0 + 4);
#pragma unroll 8
        for (int i = 0; i < 16; ++i) {
            const int s = (lane >> 3) + 8 * i;
            const bf16x8 v = *(const bf16x8*)(zv + (size_t)(tok0 + s) * 512 + wave * 64 + d0);
            const float mean = stats[2 * s], rstd = stats[2 * s + 1];
#pragma unroll
            for (int e = 0; e < 8; ++e) {
                const float gg = (e < 4) ? g0[e & 3] : g1[e & 3], bb = (e < 4) ? b0[e & 3] : b1[e & 3];
                const float y = (bf2f((bf16_t)v[e]) - mean) * rstd * gg + bb;
                zt[(d0 + e) * ZPITCH + s] = (bf16_t)(cvt_pk_bf16(y, 0.f) & 0xffff);
            }
        }
    }
    asm volatile("s_waitcnt lgkmcnt(0)" ::: "memory");
    __builtin_amdgcn_wave_barrier();
    const int r = lane & 31, h = lane >> 5;
#pragma unroll
    for (int mt = 0; mt < 4; ++mt) {
        f32x16 acc0, acc1;
#pragma unroll
        for (int i = 0; i < 16; ++i) { acc0[i] = 0.f; acc1[i] = 0.f; }
        const int t = 32 * mt + r;
#pragma unroll
        for (int ks = 0; ks < 2 * (mt + 1); ++ks) {
            const int s0 = 16 * ks + 8 * h;
            const f32x4 w0 = *(const f32x4*)(w_s + (size_t)t * 128 + s0), w1 = *(const f32x4*)(w_s + (size_t)t * 128 + s0 + 4);
            float wv[8] = {w0[0], w0[1], w0[2], w0[3], w1[0], w1[1], w1[2], w1[3]};
#pragma unroll
            for (int e = 0; e < 8; ++e) wv[e] = (s0 + e <= t) ? wv[e] : 0.f;
            u32x4 wb; wb.x = cvt_pk_bf16(wv[0], wv[1]); wb.y = cvt_pk_bf16(wv[2], wv[3]); wb.z = cvt_pk_bf16(wv[4], wv[5]); wb.w = cvt_pk_bf16(wv[6], wv[7]);
            const bf16x8 bfrag = __builtin_bit_cast(bf16x8, wb);
            const bf16x8 a0 = *(const LAS bf16x8*)(zt + (r) * ZPITCH + s0);
            const bf16x8 a1 = *(const LAS bf16x8*)(zt + (32 + r) * ZPITCH + s0);
            acc0 = MFMA32(a0, bfrag, acc0);
            acc1 = MFMA32(a1, bfrag, acc1);
        }
        const float bs = b_s[t];
        const size_t rowoff = (size_t)(tok0 + t) * 512 + wave * 64;
        bf16_t* mrow = mixed + (size_t)(tok0 + t) * 1024 + 512 + wave * 64;
#pragma unroll
        for (int dt = 0; dt < 2; ++dt)
#pragma unroll
            for (int i4 = 0; i4 < 4; ++i4) {
                const int d = 32 * dt + 8 * i4 + 4 * h;
                const u32x2 zz = *(const u32x2*)(zu + rowoff + d);
                const float z0 = __uint_as_float(zz.x << 16), z1 = __uint_as_float(zz.x & 0xffff0000u), z2 = __uint_as_float(zz.y << 16), z3 = __uint_as_float(zz.y & 0xffff0000u);
                const f32x16& a = dt ? acc1 : acc0;
                u32x2 o; o.x = cvt_pk_bf16(z0 * (a[4 * i4] + bs), z1 * (a[4 * i4 + 1] + bs)); o.y = cvt_pk_bf16(z2 * (a[4 * i4 + 2] + bs), z3 * (a[4 * i4 + 3] + bs));
                *(u32x2*)(mrow + d) = o;
            }
    }
}

__device__ __forceinline__ void cmp_gemm2(const bf16_t* hidden, const bf16_t* w2t, bf16_t* kcmp, bf16_t* vcmpT, int kv, int row0, int lane) {
    LAUNDER(lane);
    const int r = lane & 31, h = lane >> 5;
    f32x16 acc[2];
#pragma unroll
    for (int i = 0; i < 16; ++i) { acc[0][i] = 0.f; acc[1][i] = 0.f; }
#pragma unroll
    for (int ks = 0; ks < 16; ++ks) {
        const bf16x8 hf = *(const bf16x8*)(hidden + (size_t)(row0 + r) * 256 + ks * 16 + h * 8);
#pragma unroll
        for (int dt = 0; dt < 2; ++dt) {
            const bf16x8 wf = *(const bf16x8*)(w2t + (size_t)(dt * 32 + r) * 256 + ks * 16 + h * 8);
            if (kv == 0) acc[dt] = MFMA32(wf, hf, acc[dt]);
            else         acc[dt] = MFMA32(hf, wf, acc[dt]);
        }
    }
#pragma unroll
    for (int dt = 0; dt < 2; ++dt)
#pragma unroll
        for (int i4 = 0; i4 < 4; ++i4) {
            u32x2 o; o.x = cvt_pk_bf16(acc[dt][4 * i4], acc[dt][4 * i4 + 1]); o.y = cvt_pk_bf16(acc[dt][4 * i4 + 2], acc[dt][4 * i4 + 3]);
            if (kv == 0) *(u32x2*)(kcmp + (size_t)(row0 >> 5) * 2048 + (dt * 2 + (i4 >> 1)) * 512 + (i4 & 1) * 256 + r * 8 + 4 * h) = o;
            else         *(u32x2*)(vcmpT + (size_t)(row0 >> 5) * 2048 + dt * 1024 + (i4 >> 1) * 512 + h * 256 + r * 8 + (i4 & 1) * 4) = o;
        }
}

constexpr int NSA_WAVE_LDS = 11264;
constexpr float NEG_INF = -__builtin_inff();

__device__ __forceinline__ void load_k(bf16x8 (&kf)[4], const bf16_t* Kt, int lane) {
    const int r = lane & 31, h = lane >> 5;
#pragma unroll
    for (int ks = 0; ks < 4; ++ks) kf[ks] = *(const bf16x8*)(Kt + ks * 512 + lane * 8);
}
__device__ __forceinline__ void load_v(bf16x8 (&vf)[2][2], const bf16_t* vT, int lane) {
    const int r = lane & 31, h = lane >> 5;
#pragma unroll
    for (int dt = 0; dt < 2; ++dt)
#pragma unroll
        for (int s = 0; s < 2; ++s) vf[dt][s] = *(const bf16x8*)(vT + dt * 1024 + s * 512 + lane * 8);
}
__device__ __forceinline__ f32x16 qk_tile(const bf16x8 (&kf)[4], const bf16x8 (&qf)[4]) {
    f32x16 s;
#pragma unroll
    for (int i = 0; i < 16; ++i) s[i] = 0.f;
#pragma unroll
    for (int ks = 0; ks < 4; ++ks) s = MFMA32(kf[ks], qf[ks], s);
    return s;
}
template <int STRIDE> __device__ __forceinline__ void score_tile(f32x16& s, int dl, int dmax, bool lane_ok, bool fast, float lutfar, const LAS float* lutr) {
    if (fast) {
#pragma unroll
        for (int i = 0; i < 16; ++i) s[i] = lane_ok ? (s[i] + lutfar) : NEG_INF;
    } else {
#pragma unroll
        for (int i = 0; i < 16; ++i) {
            const int d = dl - STRIDE * ((i & 3) + 8 * (i >> 2));
            const bool ok = lane_ok && d >= 0 && d < dmax;
            const int di = min(max(d, 0), 128);
            s[i] = ok ? (s[i] + lutr[di]) : NEG_INF;
        }
    }
}
__device__ __forceinline__ void pv_tile(f32x16& o0, f32x16& o1, const f32x16& pr, const bf16x8 (&vf)[2][2]) {
#pragma unroll
    for (int s = 0; s < 2; ++s) {
        u32x4 pk; pk.x = cvt_pk_bf16(pr[8 * s], pr[8 * s + 1]); pk.y = cvt_pk_bf16(pr[8 * s + 2], pr[8 * s + 3]); pk.z = cvt_pk_bf16(pr[8 * s + 4], pr[8 * s + 5]); pk.w = cvt_pk_bf16(pr[8 * s + 6], pr[8 * s + 7]);
        const bf16x8 pb = __builtin_bit_cast(bf16x8, pk);
        o0 = MFMA32(vf[0][s], pb, o0);
        o1 = MFMA32(vf[1][s], pb, o1);
    }
}
template <bool FAST> __device__ __forceinline__ void online_step(f32x16& s, float bias, bool lane_ok, float& m, float& l, f32x16& o0, f32x16& o1, const bf16x8 (&vf)[2][2]) {
    float mx = fmaxf(fmaxf(fmaxf(s[0], s[1]), fmaxf(s[2], s[3])), fmaxf(fmaxf(s[4], s[5]), fmaxf(s[6], s[7])));
    mx = fmaxf(mx, fmaxf(fmaxf(fmaxf(s[8], s[9]), fmaxf(s[10], s[11])), fmaxf(fmaxf(s[12], s[13]), fmaxf(s[14], s[15]))));
    if (FAST) { mx += bias; mx = lane_ok ? mx : NEG_INF; }
    mx = xhalf_max(mx);
    if (__any(mx > m + 8.0f)) {
        const float mnew = (mx > m + 8.0f) ? mx : m;
        const float alpha = fast_exp2(m - mnew);
        l *= alpha; m = mnew;
#pragma unroll
        for (int i = 0; i < 16; ++i) { o0[i] *= alpha; o1[i] *= alpha; }
    }
    const float c = FAST ? (lane_ok ? (m - bias) : __builtin_inff()) : m;
    float ps = 0.f;
#pragma unroll
    for (int i = 0; i < 16; ++i) { s[i] = fast_exp2(s[i] - c); ps += s[i]; }
    ps = xhalf_sum(ps);
    l += ps;
    pv_tile(o0, o1, s, vf);
}

#define MFMA8(a, b, c) __builtin_amdgcn_mfma_f32_32x32x16_fp8_fp8((a), (b), (c), 0, 0, 0)
__device__ __forceinline__ void load_k8(long (&kf)[4], const unsigned char* Kt, int lane) {
#pragma unroll
    for (int ks = 0; ks < 4; ++ks) kf[ks] = *(const long*)(Kt + ks * 512 + lane * 8);
}
__device__ __forceinline__ void load_v8(long (&vf)[2][2], const unsigned char* vT, int lane) {
#pragma unroll
    for (int dt = 0; dt < 2; ++dt)
#pragma unroll
        for (int s = 0; s < 2; ++s) vf[dt][s] = *(const long*)(vT + dt * 1024 + s * 512 + lane * 8);
}
__device__ __forceinline__ long pack_fp8x8(float a0, float a1, float a2, float a3, float a4, float a5, float a6, float a7) {
    int w0 = __builtin_amdgcn_cvt_pk_fp8_f32(a0, a1, 0, false); w0 = __builtin_amdgcn_cvt_pk_fp8_f32(a2, a3, w0, true);
    int w1 = __builtin_amdgcn_cvt_pk_fp8_f32(a4, a5, 0, false); w1 = __builtin_amdgcn_cvt_pk_fp8_f32(a6, a7, w1, true);
    return (long)(((unsigned long long)(unsigned)w1 << 32) | (unsigned long long)(unsigned)w0);
}
template <bool FAST> __device__ __forceinline__ void online_step8(f32x16& s, float bias, bool lane_ok, float& m, float& l, f32x16& o0, f32x16& o1, const long (&vf)[2][2]) {
    float mx = fmaxf(fmaxf(fmaxf(s[0], s[1]), fmaxf(s[2], s[3])), fmaxf(fmaxf(s[4], s[5]), fmaxf(s[6], s[7])));
    mx = fmaxf(mx, fmaxf(fmaxf(fmaxf(s[8], s[9]), fmaxf(s[10], s[11])), fmaxf(fmaxf(s[12], s[13]), fmaxf(s[14], s[15]))));
    if (FAST) { mx = mx * QSCALE + bias; mx = lane_ok ? mx : NEG_INF; }
    mx = xhalf_max(mx);
    if (__any(mx > m + 2.0f)) {
        const float mnew = (mx > m + 2.0f) ? mx : m;
        const float alpha = fast_exp2(m - mnew);
        l *= alpha; m = mnew;
#pragma unroll
        for (int i = 0; i < 16; ++i) { o0[i] *= alpha; o1[i] *= alpha; }
    }
    float ps = 0.f;
    if (FAST) {
        const float c = lane_ok ? (m - bias - 6.0f) : __builtin_inff();
#pragma unroll
        for (int i = 0; i < 16; ++i) { s[i] = fast_exp2(__builtin_fmaf(s[i], QSCALE, -c)); ps += s[i]; }
    } else {
        const float c = m - 6.0f;
#pragma unroll
        for (int i = 0; i < 16; ++i) { s[i] = fast_exp2(s[i] - c); ps += s[i]; }
    }
    ps = xhalf_sum(ps);
    l += ps;
#pragma unroll
    for (int t = 0; t < 2; ++t) {
        const long pb = pack_fp8x8(s[8 * t], s[8 * t + 1], s[8 * t + 2], s[8 * t + 3], s[8 * t + 4], s[8 * t + 5], s[8 * t + 6], s[8 * t + 7]);
        o0 = MFMA8(vf[0][t], pb, o0);
        o1 = MFMA8(vf[1][t], pb, o1);
    }
}

__device__ __forceinline__ float max16(const f32x16& s) {
    const float a = fmaxf(fmaxf(fmaxf(s[0], s[1]), fmaxf(s[2], s[3])), fmaxf(fmaxf(s[4], s[5]), fmaxf(s[6], s[7])));
    const float b = fmaxf(fmaxf(fmaxf(s[8], s[9]), fmaxf(s[10], s[11])), fmaxf(fmaxf(s[12], s[13]), fmaxf(s[14], s[15])));
    return fmaxf(a, b);
}
template <bool FAST> __device__ __forceinline__ void online_step8x2(f32x16& sa, f32x16& sb, float bias, bool lane_ok, float& m, float& l, f32x16& o0, f32x16& o1, const long (&va)[2][2], const long (&vb)[2][2]) {
    float mx = fmaxf(max16(sa), max16(sb));
    if (FAST) { mx = mx * QSCALE + bias; mx = lane_ok ? mx : NEG_INF; }
    mx = xhalf_max(mx);
    if (__any(mx > m + 2.0f)) {
        const float mnew = (mx > m + 2.0f) ? mx : m;
        const float alpha = fast_exp2(m - mnew);
        l *= alpha; m = mnew;
#pragma unroll
        for (int i = 0; i < 16; ++i) { o0[i] *= alpha; o1[i] *= alpha; }
    }
    float ps = 0.f, ps2 = 0.f;
    if (FAST) {
        const float c = lane_ok ? (m - bias - 6.0f) : __builtin_inff();
#pragma unroll
        for (int i = 0; i < 16; ++i) { sa[i] = fast_exp2(__builtin_fmaf(sa[i], QSCALE, -c)); ps += sa[i]; sb[i] = fast_exp2(__builtin_fmaf(sb[i], QSCALE, -c)); ps2 += sb[i]; }
    } else {
        const float c = m - 6.0f;
#pragma unroll
        for (int i = 0; i < 16; ++i) { sa[i] = fast_exp2(sa[i] - c); ps += sa[i]; sb[i] = fast_exp2(sb[i] - c); ps2 += sb[i]; }
    }
    ps += ps2;
    ps = xhalf_sum(ps);
    l += ps;
    const long pa0 = pack_fp8x8(sa[0], sa[1], sa[2], sa[3], sa[4], sa[5], sa[6], sa[7]);
    const long pb0 = pack_fp8x8(sb[0], sb[1], sb[2], sb[3], sb[4], sb[5], sb[6], sb[7]);
    o0 = MFMA8(va[0][0], pa0, o0); o1 = MFMA8(va[1][0], pa0, o1);
    const long pa1 = pack_fp8x8(sa[8], sa[9], sa[10], sa[11], sa[12], sa[13], sa[14], sa[15]);
    o0 = MFMA8(vb[0][0], pb0, o0); o1 = MFMA8(vb[1][0], pb0, o1);
    const long pb1 = pack_fp8x8(sb[8], sb[9], sb[10], sb[11], sb[12], sb[13], sb[14], sb[15]);
    o0 = MFMA8(va[0][1], pa1, o0); o1 = MFMA8(va[1][1], pa1, o1);
    o0 = MFMA8(vb[0][1], pb1, o0); o1 = MFMA8(vb[1][1], pb1, o1);
}

__device__ __forceinline__ void nsa_unit(const Params& p, int bg, int jq, LAS unsigned char* lds, int wave, int lane, bool build_lut) {
    LAUNDER(lane);
    const unsigned char* ws = P_ws(p);
    const bf16_t* qb = (const bf16_t*)(ws + WS_R1 + R_Q);
    const bf16_t* kcmp = (const bf16_t*)(ws + WS_R1 + R_KCMP) + (size_t)bg * NCMP * 64;
    const bf16_t* vcmpT = (const bf16_t*)(ws + WS_R1 + R_VCMPT) + (size_t)bg * NCMP * 64;
    const unsigned char* ks8 = ws + WS_R1 + R_KS + (size_t)bg * S * 64;
    const unsigned char* vs8 = ws + WS_R1 + R_VST + (size_t)bg * S * 64;
    const bf16_t* kwb = (const bf16_t*)(ws + WS_R1 + R_KW) + (size_t)bg * S * 64;
    const bf16_t* vwT = (const bf16_t*)(ws + WS_R1 + R_VWT) + (size_t)bg * S * 64;
    const float* gates = (const float*)(ws + WS_R1 + R_GATES);
    bf16_t* mixed = (bf16_t*)(ws + WS_AN);
    const float* relb = P_in(p, 1);
    const int b = bg >> 1, g = bg & 1;
    LAS float* imp = (LAS float*)(lds + wave * NSA_WAVE_LDS);
    LAS unsigned* selw = (LAS unsigned*)(lds + wave * NSA_WAVE_LDS + 8192);
    LAS float* lut = (LAS float*)(lds + wave * NSA_WAVE_LDS + 8192 + 256);
    LAS int* list = (LAS int*)(lds + wave * NSA_WAVE_LDS + 8192 + 256 + 2112);
    const int c = lane & 31, h = lane >> 5, ql = c >> 2, r = c & 3;
    const int tq0 = 64 * jq + 8 * wave, tq = tq0 + ql;
    const size_t tok = (size_t)b * S + tq;

    if (build_lut) {
        for (int e = lane; e < 4 * 129; e += 64) {
            const int rr = e / 129, n = e % 129;
            int bk = n;
            if (n >= 16) bk = 16 + (n >= 19) + (n >= 21) + (n >= 24) + (n >= 27) + (n >= 31) + (n >= 35) + (n >= 40) + (n >= 46) + (n >= 52) + (n >= 59) + (n >= 67) + (n >= 77) + (n >= 87) + (n >= 99) + (n >= 113);
            lut[rr * 132 + n] = relb[bk * 8 + g * 4 + rr] * LOG2E;
        }
    }
    for (int e = lane; e < 2048; e += 64) imp[e] = 0.f;
    {
        const int k = lane & 7; unsigned w = 0u;
        if (k == 0) w |= 1u;
        if ((jq >> 5) == k) w |= 1u << (jq & 31);
        if (jq >= 1 && ((jq - 1) >> 5) == k) w |= 1u << ((jq - 1) & 31);
        selw[lane] = w;
    }
    asm volatile("s_waitcnt lgkmcnt(0)" ::: "memory");
    __builtin_amdgcn_wave_barrier();
    const LAS float* lutr = lut + r * 132;
    const float lutfar = lutr[128];

    bf16x8 qf[4];
#pragma unroll
    for (int ks = 0; ks < 4; ++ks) qf[ks] = *(const bf16x8*)(qb + tok * 512 + (g * 4 + r) * 64 + ks * 16 + h * 8);
    const float g0 = gates[tok * 24 + (g * 4 + r) * 3 + 0], g1 = gates[tok * 24 + (g * 4 + r) * 3 + 1], g2 = gates[tok * 24 + (g * 4 + r) * 3 + 2];

    f32x16 oa0, oa1;
    bf16x8 kf[4], kn[4], vf[2][2];
    {
        const int jmaxw = (tq0 + 7 - 31) >> 4;
        const int ntile = (jmaxw >= 0) ? (jmaxw >> 5) + 1 : 0;
        float m = -1e30f, l = 0.f;
        if (ntile > 0) load_k(kn, kcmp, lane);
        for (int T = 0; T < ntile; ++T) {
#pragma unroll
            for (int ks = 0; ks < 4; ++ks) kf[ks] = kn[ks];
            if (T + 1 < ntile) load_k(kn, kcmp + (size_t)(T + 1) * 2048, lane);
            f32x16 s = qk_tile(kf, qf);
            const int base = 512 * T + 31;
            const bool fast = (tq0 - base - 16 * 31) >= 128;
            score_tile<16>(s, tq - base - 64 * h, 1 << 30, true, fast, lutfar, lutr);
            float mx = s[0];
#pragma unroll
            for (int i = 1; i < 16; ++i) mx = fmaxf(mx, s[i]);
            mx = xhalf_max(mx);
            const float mnew = fmaxf(m, mx);
            float ps = 0.f;
#pragma unroll
            for (int i = 0; i < 16; ++i) ps += fast_exp2(s[i] - mnew);
            ps = xhalf_sum(ps);
            l = l * fast_exp2(m - mnew) + ps; m = mnew;
        }
        const float c2 = (l > 0.f) ? (m + __builtin_amdgcn_logf(l)) : __builtin_inff();
        const float c2f = c2 - lutfar;
        f32x16 o0, o1;
#pragma unroll
        for (int i = 0; i < 16; ++i) { o0[i] = 0.f; o1[i] = 0.f; }
        if (ntile > 0) load_k(kn, kcmp, lane);
        for (int T = 0; T < ntile; ++T) {
#pragma unroll
            for (int ks = 0; ks < 4; ++ks) kf[ks] = kn[ks];
            load_v(vf, vcmpT + (size_t)T * 2048, lane);
            if (T + 1 < ntile) load_k(kn, kcmp + (size_t)(T + 1) * 2048, lane);
            f32x16 s = qk_tile(kf, qf);
            const int base = 512 * T + 31;
            const bool fast = (tq0 - base - 16 * 31) >= 128;
            if (fast) {
#pragma unroll
                for (int i = 0; i < 16; ++i) s[i] = fast_exp2(s[i] - c2f);
            } else {
                score_tile<16>(s, tq - base - 64 * h, 1 << 30, true, false, lutfar, lutr);
#pragma unroll
                for (int i = 0; i < 16; ++i) s[i] = fast_exp2(s[i] - c2);
            }
#pragma unroll
            for (int i4 = 0; i4 < 4; ++i4) {
                float a = (s[4 * i4] + s[4 * i4 + 1]) + (s[4 * i4 + 2] + 0.5f * s[4 * i4 + 3]);
                float bb = 0.5f * s[4 * i4 + 3];
                a = quad_sum(a); bb = quad_sum(bb);
                if (r == i4) {
                    const int n = 8 * T + 2 * i4 + h;
                    atomicAdd((float*)(imp + ql * 256 + n), a);
                    if (n + 1 < 256) atomicAdd((float*)(imp + ql * 256 + n + 1), bb);
                }
            }
            pv_tile(o0, o1, s, vf);
        }
#pragma unroll
        for (int i = 0; i < 16; ++i) { oa0[i] = g0 * o0[i]; oa1[i] = g0 * o1[i]; }
    }
    asm volatile("s_waitcnt lgkmcnt(0)" ::: "memory");
    __builtin_amdgcn_wave_barrier();
    if (jq >= 3) {
        float val[8][4];
#pragma unroll
        for (int qq = 0; qq < 8; ++qq) {
            const f32x4 iv = *(const LAS f32x4*)(imp + qq * 256 + 4 * lane);
#pragma unroll
            for (int e = 0; e < 4; ++e) { const int n = 4 * lane + e; val[qq][e] = (n >= 1 && n <= jq - 2) ? iv[e] : -1.0f; }
        }
        unsigned mybits[8];
#pragma unroll
        for (int qq = 0; qq < 8; ++qq) mybits[qq] = 0u;
        for (int round = 0; round < 13; ++round) {
#pragma unroll
            for (int qq = 0; qq < 8; ++qq) {
                const float lb = fmaxf(fmaxf(val[qq][0], val[qq][1]), fmaxf(val[qq][2], val[qq][3]));
                const float wm = wave_max_fast(lb);
                const unsigned long long bal = __ballot(lb == wm);
                const int wl = __builtin_ctzll(bal | (1ull << 63));
                const bool win = (lane == wl) && (wm >= 0.f);
                const int e = (val[qq][0] == wm) ? 0 : ((val[qq][1] == wm) ? 1 : ((val[qq][2] == wm) ? 2 : 3));
                mybits[qq] |= win ? (1u << e) : 0u;
                val[qq][0] = (win && e == 0) ? -2.0f : val[qq][0]; val[qq][1] = (win && e == 1) ? -2.0f : val[qq][1];
                val[qq][2] = (win && e == 2) ? -2.0f : val[qq][2]; val[qq][3] = (win && e == 3) ? -2.0f : val[qq][3];
            }
        }
#pragma unroll
        for (int qq = 0; qq < 8; ++qq)
            if (mybits[qq]) atomicOr((unsigned*)(selw + qq * 8 + (lane >> 3)), mybits[qq] << ((lane & 7) * 4));
    }
    asm volatile("s_waitcnt lgkmcnt(0)" ::: "memory");
    __builtin_amdgcn_wave_barrier();
    {
        unsigned uwA = 0u, uwB = 0u;
        if (lane < 8) {
#pragma unroll
            for (int qq = 0; qq < 4; ++qq) { uwA |= selw[qq * 8 + lane]; uwB |= selw[(qq + 4) * 8 + lane]; }
        }
        int cntA = 0, cntB = 0;
        for (int k = 0; k < 8; ++k) {
            unsigned bits = (unsigned)__builtin_amdgcn_readlane((int)uwA, k);
            while (bits) { const int bit = __builtin_ctz(bits); bits &= bits - 1u; if (lane == 0) list[cntA] = 32 * k + bit; ++cntA; }
            bits = (unsigned)__builtin_amdgcn_readlane((int)uwB, k);
            while (bits) { const int bit = __builtin_ctz(bits); bits &= bits - 1u; if (lane == 0) list[64 + cntB] = 32 * k + bit; ++cntB; }
        }
        asm volatile("s_waitcnt lgkmcnt(0)" ::: "memory");
        __builtin_amdgcn_wave_barrier();
        LAS float* ostage = imp;
        const int c16 = lane & 15, fq = lane >> 4, q4 = c16 >> 2, r16 = c16 & 3;
        const LAS float* lutr16 = lut + r16 * 132;
        const float lutfar16 = lutr16[128];
        for (int grp = 0; grp < 2; ++grp) {
            const int cnt = grp ? cntB : cntA, lbase = grp * 64;
            const int tqg = tq0 + 4 * grp + q4, tq0g = tq0 + 4 * grp;
            long q8[2];
            {
                const bf16_t* qp = qb + ((size_t)b * S + tqg) * 512 + (g * 4 + r16) * 64 + 8 * fq;
#pragma unroll
                for (int ks = 0; ks < 2; ++ks) {
                    const bf16x8 qv = *(const bf16x8*)(qp + 32 * ks);
                    float f[8];
#pragma unroll
                    for (int e = 0; e < 8; ++e) f[e] = bf2f((bf16_t)qv[e]) * (1.0f / QSCALE);
                    q8[ks] = pack_fp8x8(f[0], f[1], f[2], f[3], f[4], f[5], f[6], f[7]);
                }
            }
            float m = -1e30f;
            f32x4 lacc = (f32x4){0.f, 0.f, 0.f, 0.f};
            const long ones8 = 0x3838383838383838L;
            f32x4 o[4];
#pragma unroll
            for (int dt = 0; dt < 4; ++dt) o[dt] = (f32x4){0.f, 0.f, 0.f, 0.f};
            const int npair = (cnt + 1) >> 1;
            if (lane == 0 && (cnt & 1)) list[lbase + cnt] = 0;
            asm volatile("s_waitcnt lgkmcnt(0)" ::: "memory");
            __builtin_amdgcn_wave_barrier();
            long k8[2][8], v8[2][8];
            int n0 = __builtin_amdgcn_readfirstlane(list[lbase]), n1 = __builtin_amdgcn_readfirstlane(list[lbase + 1]);
#pragma unroll
            for (int i = 0; i < 4; ++i) { const l64x2 t0 = *(const l64x2*)(ks8 + (size_t)n0 * 4096 + i * 1024 + lane * 16), t1 = *(const l64x2*)(ks8 + (size_t)n1 * 4096 + i * 1024 + lane * 16);
                k8[0][2 * i] = t0[0]; k8[0][2 * i + 1] = t0[1]; k8[1][2 * i] = t1[0]; k8[1][2 * i + 1] = t1[1]; }
            for (int it = 0; it < npair; ++it) {
                const int nb[2] = {n0, n1};
                const bool real1 = (2 * it + 1) < cnt;
#pragma unroll
                for (int u = 0; u < 2; ++u)
#pragma unroll
                    for (int i = 0; i < 4; ++i) { const l64x2 t = *(const l64x2*)(vs8 + (size_t)nb[u] * 4096 + i * 1024 + lane * 16); v8[u][2 * i] = t[0]; v8[u][2 * i + 1] = t[1]; }
                f32x4 sc[2][4];
#pragma unroll
                for (int u = 0; u < 2; ++u)
#pragma unroll
                    for (int kt = 0; kt < 4; ++kt) {
                        sc[u][kt] = __builtin_amdgcn_mfma_f32_16x16x32_fp8_fp8(k8[u][2 * kt], q8[0], (f32x4){0.f, 0.f, 0.f, 0.f}, 0, 0, 0);
                        sc[u][kt] = __builtin_amdgcn_mfma_f32_16x16x32_fp8_fp8(k8[u][2 * kt + 1], q8[1], sc[u][kt], 0, 0, 0);
                    }
                if (it + 1 < npair) {
                    n0 = __builtin_amdgcn_readfirstlane(list[lbase + 2 * it + 2]); n1 = __builtin_amdgcn_readfirstlane(list[lbase + 2 * it + 3]);
#pragma unroll
                    for (int i = 0; i < 4; ++i) { const l64x2 t0 = *(const l64x2*)(ks8 + (size_t)n0 * 4096 + i * 1024 + lane * 16), t1 = *(const l64x2*)(ks8 + (size_t)n1 * 4096 + i * 1024 + lane * 16);
                        k8[0][2 * i] = t0[0]; k8[0][2 * i + 1] = t0[1]; k8[1][2 * i] = t1[0]; k8[1][2 * i + 1] = t1[1]; }
                }
                bool ok[2];
                ok[0] = (selw[(grp * 4 + q4) * 8 + (nb[0] >> 5)] >> (nb[0] & 31)) & 1u;
                ok[1] = real1 && ((selw[(grp * 4 + q4) * 8 + (nb[1] >> 5)] >> (nb[1] & 31)) & 1u);
                const int bmax = real1 ? max(nb[0], nb[1]) : nb[0];
                const bool fast = (tq0g - 64 * bmax - 63) >= 128;
                float mx = NEG_INF;
                if (fast) {
#pragma unroll
                    for (int u = 0; u < 2; ++u) {
                        float t = fmaxf(fmaxf(fmaxf(sc[u][0][0], sc[u][0][1]), fmaxf(sc[u][0][2], sc[u][0][3])), fmaxf(fmaxf(sc[u][1][0], sc[u][1][1]), fmaxf(sc[u][1][2], sc[u][1][3])));
                        t = fmaxf(t, fmaxf(fmaxf(fmaxf(sc[u][2][0], sc[u][2][1]), fmaxf(sc[u][2][2], sc[u][2][3])), fmaxf(fmaxf(sc[u][3][0], sc[u][3][1]), fmaxf(sc[u][3][2], sc[u][3][3]))));
                        mx = fmaxf(mx, ok[u] ? (t * QSCALE + lutfar16) : NEG_INF);
                    }
                } else {
#pragma unroll
                    for (int u = 0; u < 2; ++u)
#pragma unroll
                        for (int kt = 0; kt < 4; ++kt)
#pragma unroll
                            for (int e = 0; e < 4; ++e) {
                                const int d = tqg - 64 * nb[u] - 16 * kt - 4 * fq - e;
                                const bool okk = ok[u] && d >= 0;
                                const float v = okk ? (sc[u][kt][e] * QSCALE + lutr16[min(max(d, 0), 128)]) : NEG_INF;
                                sc[u][kt][e] = v; mx = fmaxf(mx, v);
                            }
                }
                {
                    auto t1 = __builtin_amdgcn_permlane16_swap(__float_as_uint(mx), __float_as_uint(mx), false, false); mx = fmaxf(__uint_as_float(t1[0]), __uint_as_float(t1[1]));
                    mx = xhalf_max(mx);
                }
                if (__any(mx > m + 2.0f)) {
                    const float mnew = (mx > m + 2.0f) ? mx : m;
                    const float alpha = fast_exp2(m - mnew);
                    lacc = lacc * alpha; m = mnew;
#pragma unroll
                    for (int dt = 0; dt < 4; ++dt) o[dt] = o[dt] * alpha;
                }
                if (fast) {
#pragma unroll
                    for (int u = 0; u < 2; ++u) {
                        const float cexp = ok[u] ? (m - lutfar16 - 6.0f) : __builtin_inff();
#pragma unroll
                        for (int kt = 0; kt < 4; ++kt)
#pragma unroll
                            for (int e = 0; e < 4; ++e) sc[u][kt][e] = fast_exp2(__builtin_fmaf(sc[u][kt][e], QSCALE, -cexp));
                    }
                } else {
                    const float cexp = m - 6.0f;
#pragma unroll
                    for (int u = 0; u < 2; ++u)
#pragma unroll
                        for (int kt = 0; kt < 4; ++kt)
#pragma unroll
                            for (int e = 0; e < 4; ++e) sc[u][kt][e] = fast_exp2(sc[u][kt][e] - cexp);
                }
#pragma unroll
                for (int u = 0; u < 2; ++u) {
                    const long pb0 = pack_fp8x8(sc[u][0][0], sc[u][0][1], sc[u][0][2], sc[u][0][3], sc[u][1][0], sc[u][1][1], sc[u][1][2], sc[u][1][3]);
                    const long pb1 = pack_fp8x8(sc[u][2][0], sc[u][2][1], sc[u][2][2], sc[u][2][3], sc[u][3][0], sc[u][3][1], sc[u][3][2], sc[u][3][3]);
#pragma unroll
                    for (int dt = 0; dt < 4; ++dt) {
                        o[dt] = __builtin_amdgcn_mfma_f32_16x16x32_fp8_fp8(v8[u][2 * dt], pb0, o[dt], 0, 0, 0);
                        o[dt] = __builtin_amdgcn_mfma_f32_16x16x32_fp8_fp8(v8[u][2 * dt + 1], pb1, o[dt], 0, 0, 0);
                    }
                    lacc = __builtin_amdgcn_mfma_f32_16x16x32_fp8_fp8(ones8, pb0, lacc, 0, 0, 0);
                    lacc = __builtin_amdgcn_mfma_f32_16x16x32_fp8_fp8(ones8, pb1, lacc, 0, 0, 0);
                }
            }
            const float l = lacc[0];
            const float invl = (l > 0.f) ? 1.0f / l : 0.f;
#pragma unroll
            for (int dt = 0; dt < 4; ++dt) *(LAS f32x4*)(ostage + ((grp * 4 + q4) * 4 + r16) * 64 + 16 * dt + 4 * fq) = o[dt] * invl;
        }
        asm volatile("s_waitcnt lgkmcnt(0)" ::: "memory");
        __builtin_amdgcn_wave_barrier();
#pragma unroll
        for (int dt = 0; dt < 2; ++dt)
#pragma unroll
            for (int i4 = 0; i4 < 4; ++i4) {
                const f32x4 v = *(const LAS f32x4*)(ostage + (ql * 4 + r) * 64 + 32 * dt + 8 * i4 + 4 * h);
                if (dt == 0) { oa0[4 * i4] += g1 * v[0]; oa0[4 * i4 + 1] += g1 * v[1]; oa0[4 * i4 + 2] += g1 * v[2]; oa0[4 * i4 + 3] += g1 * v[3]; }
                else         { oa1[4 * i4] += g1 * v[0]; oa1[4 * i4 + 1] += g1 * v[1]; oa1[4 * i4 + 2] += g1 * v[2]; oa1[4 * i4 + 3] += g1 * v[3]; }
            }
        asm volatile("s_waitcnt lgkmcnt(0)" ::: "memory");
        __builtin_amdgcn_wave_barrier();
    }
    {
        {
            const bf16_t* qp = qb + tok * 512 + (g * 4 + r) * 64 + h * 8;
            asm volatile("" : "+v"(qp));
#pragma unroll
            for (int ks = 0; ks < 4; ++ks) qf[ks] = *(const bf16x8*)(qp + ks * 16);
        }
        const int T0 = max(0, (tq0 - 511) >> 5), T1 = (tq0 + 7) >> 5;
        float m = -1e30f, l = 0.f;
        f32x16 o0, o1;
#pragma unroll
        for (int i = 0; i < 16; ++i) { o0[i] = 0.f; o1[i] = 0.f; }
        load_k(kn, kwb + (size_t)(32 * T0) * 64, lane);
        for (int T = T0; T <= T1; ++T) {
#pragma unroll
            for (int ks = 0; ks < 4; ++ks) kf[ks] = kn[ks];
            load_v(vf, vwT + (size_t)T * 2048, lane);
            if (T < T1) load_k(kn, kwb + (size_t)(32 * (T + 1)) * 64, lane);
            const int base = 32 * T;
            f32x16 s = qk_tile(kf, qf);
            if (((tq0 - base - 31) >= 128) && ((tq0 + 7 - base) < 512)) online_step<true>(s, lutfar, true, m, l, o0, o1, vf);
            else { score_tile<1>(s, tq - base - 4 * h, 512, true, false, lutfar, lutr); online_step<false>(s, 0.f, true, m, l, o0, o1, vf); }
        }
        const float sc = (l > 0.f) ? g2 / l : 0.f;
#pragma unroll
        for (int i = 0; i < 16; ++i) { oa0[i] += sc * o0[i]; oa1[i] += sc * o1[i]; }
    }
    bf16_t* orow = mixed + tok * 1024 + (g * 4 + r) * 64;
#pragma unroll
    for (int dt = 0; dt < 2; ++dt)
#pragma unroll
        for (int i4 = 0; i4 < 4; ++i4) {
            const f32x16& a = dt ? oa1 : oa0;
            u32x2 o; o.x = cvt_pk_bf16(a[4 * i4], a[4 * i4 + 1]); o.y = cvt_pk_bf16(a[4 * i4 + 2], a[4 * i4 + 3]);
            *(u32x2*)(orow + 32 * dt + 8 * i4 + 4 * h) = o;
        }
}


#define XB_TMO      128
#define XB_XCNT(j)  (256  + 64 * (j))
#define XB_XSUB(j)  (1280 + 64 * (j))
#define XB_XGEN(j)  (2304 + 64 * (j))
#define XB_TOP      3328
#define XB_TOPGEN   3392
#define XCD_BAR_WORDS 3456
#define XB_SPIN_CAP (1u << 22)
__device__ __forceinline__ unsigned xb_ld(unsigned* p)              { return __hip_atomic_load(p, __ATOMIC_RELAXED, __HIP_MEMORY_SCOPE_AGENT); }
__device__ __forceinline__ unsigned xb_add(unsigned* p, unsigned v) { return __hip_atomic_fetch_add(p, v, __ATOMIC_RELAXED, __HIP_MEMORY_SCOPE_AGENT); }
__device__ __forceinline__ unsigned xb_xcc_id() { return (unsigned)__builtin_amdgcn_s_getreg((3 << 11) | 20) & 0xFu; }
#define XB_SPIN(cond, bar) do { unsigned _sp = 0; while (cond) { __builtin_amdgcn_s_sleep(1); \
    if ((++_sp & 255u) == 0u) { if (xb_ld(&(bar)[XB_TMO])) break; if (_sp > XB_SPIN_CAP) { atomicAdd(&(bar)[XB_TMO], 1u); break; } } } } while (0)
__device__ __forceinline__ void xcd_barrier_complete(unsigned* bar, unsigned x, unsigned& nloc, unsigned& nx) {
    const unsigned G = gridDim.x * gridDim.y * gridDim.z;
    unsigned sum, cnt, mine, sp = 0u;
    for (;;) {
        sum = 0u; cnt = 0u; mine = 0u;
#pragma unroll
        for (unsigned j = 0; j < 16; ++j) { const unsigned c = xb_ld(&bar[XB_XCNT(j)]); sum += c; cnt += (c > 0u) ? 1u : 0u; mine = (j == x) ? c : mine; }
        if (sum == G) break;
        __builtin_amdgcn_s_sleep(1);
        if ((++sp & 255u) == 0u) { if (xb_ld(&bar[XB_TMO])) break; if (sp > XB_SPIN_CAP) { atomicAdd(&bar[XB_TMO], 1u); break; } }
    }
    nloc = mine > 0u ? mine : 1u; nx = cnt > 0u ? cnt : 1u;
}
__device__ __forceinline__ void xcd_barrier(unsigned* bar, volatile LAS unsigned* st) {
    asm volatile("s_waitcnt vmcnt(0)" ::: "memory");
    __syncthreads();
    if (threadIdx.x == 0) {
        const unsigned x = xb_xcc_id();
        __builtin_amdgcn_s_waitcnt(0);
        unsigned nloc = st[0], nx = st[1];
        if (nloc == 0u) { xcd_barrier_complete(bar, x, nloc, nx); st[0] = nloc; st[1] = nx; }
        const unsigned old = xb_add(&bar[XB_XSUB(x)], 1u);
        const unsigned gen = old / nloc;
        if (old + 1u == (gen + 1u) * nloc) {
            __builtin_amdgcn_fence(__ATOMIC_RELEASE, "agent");
            asm volatile("s_waitcnt vmcnt(0)" ::: "memory");
            const unsigned og = xb_add(&bar[XB_TOP], 1u);
            const unsigned tg = og / nx;
            if (og + 1u == (tg + 1u) * nx) xb_add(&bar[XB_TOPGEN], 1u);
            else XB_SPIN(xb_ld(&bar[XB_TOPGEN]) == tg, bar);
            __builtin_amdgcn_fence(__ATOMIC_ACQUIRE, "agent");
            xb_add(&bar[XB_XGEN(x)], 1u);
            asm volatile("s_waitcnt vmcnt(0)" ::: "memory");
        } else {
            XB_SPIN(xb_ld(&bar[XB_XGEN(x)]) == gen, bar);
            __builtin_amdgcn_fence(__ATOMIC_ACQUIRE, "agent");
            asm volatile("s_waitcnt vmcnt(0)" ::: "memory");
        }
    }
    __syncthreads();
}

__global__ void __launch_bounds__(NTHREADS, 2) fwd_megakernel(Params p) {
    extern __shared__ __attribute__((aligned(16))) unsigned char lds_raw[];
    LAS unsigned char* lds = (LAS unsigned char*)lds_raw;
    cg::grid_group grid = cg::this_grid();
#define TID_F ({ int _t = threadIdx.x; LAUNDER(_t); _t; })
#define LANE_F (TID_F & 63)
#define WAVE_F (__builtin_amdgcn_readfirstlane(TID_F >> 6))
    const int G = gridDim.x, bx = blockIdx.x;
    const int NGW = G * NWAVES;
#define GW_F (bx * NWAVES + WAVE_F)
#define FRESH_WS unsigned char* ws = P_ws(p); bf16_t* AN = (bf16_t*)(ws + WS_AN); float* MIX = (float*)(ws + WS_MIX); (void)AN; (void)MIX

    { const int tid = TID_F; if (tid < 16) ((LAS unsigned*)(lds + LDS_BYTES - 64))[tid] = 0u; }
    if (bx == 0) { unsigned* barw = (unsigned*)P_ws(p); for (int i = TID_F; i < XCD_BAR_WORDS; i += NTHREADS) barw[i] = 0u; }
    __syncthreads();
    {
        FRESH_WS;
        const int tid = TID_F, lane = tid & 63, wave = __builtin_amdgcn_readfirstlane(tid >> 6), gw = bx * NWAVES + wave;
        LAS float* scr = (LAS float*)(lds + wave * 17408);
        for (int layer = 0; layer < DEPTH; ++layer) {
            unsigned char* wl = ws + WS_W + (size_t)layer * W_LAYER;
            const int I_IN = 16 * (NINP / 64), I_OUT = 16 * 16, I_GU = 16 * (NGU / 64), I_DN = 44 * 16, I_C1 = 32 * 4, I_C2 = 4 * 1;
            const int NIT = I_IN + I_OUT + I_GU + I_DN + 2 * I_C1 + 2 * I_C2;
            for (int it = gw; it < NIT; it += NGW) {
                int r = it;
                if (r < I_IN) { transpose_item<1>(P_in(p, 6) + (size_t)layer * DM * INW, DM, INW, (bf16_t*)(wl + W_IN), NINP / 64, r, scr, lane, P_in(p, 2) + layer * DM); continue; } r -= I_IN;
                if (r < I_OUT) { transpose_item<0>(P_in(p, 17) + (size_t)layer * DM * DM, DM, DM, (bf16_t*)(wl + W_OUT), 16, r, scr, lane); continue; } r -= I_OUT;
                if (r < I_GU) { transpose_item<2>(P_in(p, 18) + (size_t)layer * DM * NGU, DM, NGU, (bf16_t*)(wl + W_GU), NGU / 64, r, scr, lane, P_in(p, 4) + layer * DM); continue; } r -= I_GU;
                if (r < I_DN) { transpose_item<0>(P_in(p, 19) + (size_t)layer * DFF * DM, DFF, DM, (bf16_t*)(wl + W_DN), 16, r, scr, lane); continue; } r -= I_DN;
                if (r < I_C1) { transpose_item<0>(P_in(p, 8) + (size_t)layer * 2048 * 256, 2048, 256, (bf16_t*)(wl + W_C1K), 4, r, scr, lane); continue; } r -= I_C1;
                if (r < I_C1) { transpose_item<0>(P_in(p, 11) + (size_t)layer * 2048 * 256, 2048, 256, (bf16_t*)(wl + W_C1V), 4, r, scr, lane); continue; } r -= I_C1;
                if (r < I_C2) { transpose_item<0>(P_in(p, 9) + (size_t)layer * 256 * 64, 256, 64, (bf16_t*)(wl + W_C2K), 1, r, scr, lane); continue; } r -= I_C2;
                transpose_item<0>(P_in(p, 12) + (size_t)layer * 256 * 64, 256, 64, (bf16_t*)(wl + W_C2V), 1, r, scr, lane);
            }
        }
        __syncthreads();
        if (bx >= G - 2 * DEPTH) {
            const int id = G - 1 - bx, layer = id >> 1, kv = id & 1;
            const float* pos = P_in(p, kv ? 10 : 7) + (size_t)layer * 2048;
            const float* w1 = P_in(p, kv ? 11 : 8) + (size_t)layer * 2048 * 256;
            LAS float* red = (LAS float*)lds;
            f32x4 acc4 = (f32x4){0.f, 0.f, 0.f, 0.f};
#pragma unroll 8
            for (int i = wave * 256; i < wave * 256 + 256; ++i) { const f32x4 w = *(const f32x4*)(w1 + (size_t)i * 256 + 4 * lane); acc4 = acc4 + w * pos[i]; }
            red[wave * 256 + 4 * lane + 0] = acc4[0]; red[wave * 256 + 4 * lane + 1] = acc4[1]; red[wave * 256 + 4 * lane + 2] = acc4[2]; red[wave * 256 + 4 * lane + 3] = acc4[3];
            __syncthreads();
            if (tid < 256) { float sum = 0.f;
#pragma unroll
                for (int w = 0; w < 8; ++w) sum += red[w * 256 + tid];
                ((float*)(ws + WS_W + (size_t)layer * W_LAYER + (kv ? W_CBV : W_CBK)))[tid] = sum; }
            __syncthreads();
        }
        row_pass(P_in(p, 0), (bf16_t*)(ws + WS_HB), nullptr, nullptr, (float*)(ws + WS_RS), nullptr, gw, NGW, lane);
    }
    grid.sync();
    if (TID_F == 0) (void)xb_add(&((unsigned*)P_ws(p))[XB_XCNT(xb_xcc_id())], 1u);

#pragma unroll 1
    for (int layer = 0; layer < DEPTH; ++layer) {
        const size_t wloff = WS_W + (size_t)layer * W_LAYER;
#ifndef SKIP_PA
        {
            FRESH_WS; unsigned char* wl = ws + wloff;
            pg8::Gemm g{(const bf16_t*)(ws + WS_HB), (const bf16_t*)(wl + W_IN), MT, NINP, DM, DM};
            pg8::StaticOrder so; so.init(MT, NINP, G, bx, REP_PA);
            pg8::EpiIn E{ws + WS_R1, (const float*)(ws + WS_RS)};
            pg8::gemm_phase<pg8::EpiIn>(lds, g, so, E);
        }
#endif
        GSYNC();
#ifndef SKIP_PB
        for (int rep = 0; rep < REP_PB; ++rep) {
            FRESH_WS; unsigned char* wl = ws + wloff;
            for (int kv = 0; kv < 2; ++kv) {
                const int c = kv ? ((bx + (G >> 1)) % G) : bx;
                if (c < 16) {
                    bf16_t* hid = (bf16_t*)(ws + WS_R1 + R_HID) + (size_t)kv * 4096 * 256;
                    pg8::Gemm g{(const bf16_t*)(ws + WS_R1 + (kv ? R_VC : R_KC)), (const bf16_t*)(wl + (kv ? W_C1V : W_C1K)), 4096, 256, 2048, 1024};
                    pg8::StaticOrder so; so.init(4096, 256, G, c);
                    pg8::EpiCmp1 E{hid, (const float*)(wl + (kv ? W_CBV : W_CBK))};
                    pg8::gemm_phase<pg8::EpiCmp1>(lds, g, so, E);
                    pg8::Unit u; so.next(0, u);
                    asm volatile("s_waitcnt vmcnt(0)" ::: "memory");
                    __builtin_amdgcn_fence(__ATOMIC_RELEASE, "agent");
                    __syncthreads();
                    __builtin_amdgcn_fence(__ATOMIC_ACQUIRE, "agent");
                    cmp_gemm2(hid, (const bf16_t*)(wl + (kv ? W_C2V : W_C2K)), (bf16_t*)(ws + WS_R1 + R_KCMP), (bf16_t*)(ws + WS_R1 + R_VCMPT), kv, u.pm * 256 + WAVE_F * 32, LANE_F);
                    __syncthreads();
                }
            }
            if (G == 256) {
                const bool is_cmp = (bx < 16) || (bx >= 128 && bx < 144);
                if (!is_cmp) {
                    const int idx = (bx < 128) ? (bx - 16) : (bx - 32);
                    gmlp_unit(p, layer, idx, lds, WAVE_F, LANE_F);
                    if (idx + 224 < MT / 128) gmlp_unit(p, layer, idx + 224, lds, WAVE_F, LANE_F);
                }
            } else {
                for (int ch = bx; ch < MT / 128; ch += G) gmlp_unit(p, layer, ch, lds, WAVE_F, LANE_F);
            }
        }
#endif
        GSYNC();
        {
#if NSA_ENABLE
            __syncthreads();
            for (int rep = 0; rep < REP_PC; ++rep) {
                if (G == 256) {
                    const int x = bx & 7, y = bx >> 3, bg = x >> 1, j = (x & 1) * 32 + y;
                    for (int i = 0; i < 4; ++i) {
                        const int jq = (i >> 1) * 128 + ((i & 1) ? (127 - j) : j);
                        nsa_unit(p, bg, jq, lds, WAVE_F, LANE_F, i == 0);
                    }
                } else {
                    for (int i = 0; bx + i * G < 1024; ++i) {
                        const int u = bx + i * G;
                        const int bg = u >> 8, x = u & 255;
                        const int jq = (bg & 1) ? (255 - x) : x;
                        nsa_unit(p, bg, jq, lds, WAVE_F, LANE_F, true);
                    }
                }
            }
#else
            FRESH_WS;
            bf16_t* mixed = (bf16_t*)(ws + WS_AN);
            for (int m = GW_F; m < MT; m += NGW) { u32x4* o = (u32x4*)(mixed + (size_t)m * 1024); o[LANE_F] = (u32x4){0u, 0u, 0u, 0u}; }
#endif
        }
        GSYNC();
#ifndef SKIP_PD
        {
            FRESH_WS; unsigned char* wl = ws + wloff;
            pg8::Gemm g{AN, (const bf16_t*)(wl + W_OUT), MT, DM, DM, DM};
            pg8::StaticOrder so; so.init(MT, DM, G, bx, REP_PD);
            pg8::EpiBf16 E{(bf16_t*)MIX, DM};
            pg8::gemm_phase<pg8::EpiBf16>(lds, g, so, E);
        }
#endif
        GSYNC();
        { FRESH_WS; row_pass(nullptr, (bf16_t*)(ws + WS_HB), (const bf16_t*)MIX, P_in(p, 3) + layer * DM, (float*)(ws + WS_RS), nullptr, GW_F, NGW, LANE_F); }
        GSYNC();
#ifndef SKIP_PF
        {
            FRESH_WS; unsigned char* wl = ws + wloff;
            pg8::Gemm g{(const bf16_t*)(ws + WS_HB), (const bf16_t*)(wl + W_GU), MT, NGU, DM, DM};
            pg8::StaticOrder so; so.init(MT, NGU, G, bx, REP_PF);
            pg8::EpiGU E{(bf16_t*)(ws + WS_R1), (const float*)(ws + WS_RS)};
            pg8::gemm_phase<pg8::EpiGU>(lds, g, so, E);
        }
#endif
        GSYNC();
#ifndef SKIP_PG
        {
            FRESH_WS; unsigned char* wl = ws + wloff;
            pg8::Gemm g{(const bf16_t*)(ws + WS_R1), (const bf16_t*)(wl + W_DN), MT, DM, DFF, DFF};
            pg8::StaticOrder so; so.init(MT, DM, G, bx, REP_PG);
            pg8::EpiBf16 E{(bf16_t*)MIX, DM};
            pg8::gemm_phase<pg8::EpiBf16>(lds, g, so, E);
        }
#endif
        GSYNC();
        { FRESH_WS; row_pass(nullptr, (bf16_t*)(ws + WS_HB), (const bf16_t*)MIX, P_in(p, 5) + layer * DM, (float*)(ws + WS_RS), (layer + 1 < DEPTH) ? nullptr : P_out(p), GW_F, NGW, LANE_F); }
        if (layer + 1 < DEPTH) GSYNC();
    }
}

extern "C" void kernel_launch(void* const* d_in, const int* in_sizes, int n_in, void* d_out, int out_size, void* d_ws, size_t ws_size, hipStream_t stream) {
    static int grid = 0;
    if (grid == 0) {
        if (n_in != 20 || out_size != MT * DM || ws_size < WS_END) { fprintf(stderr, "kernel_launch: unexpected shapes (n_in %d out %d ws %zu need %zu)\n", n_in, out_size, ws_size, (size_t)WS_END); grid = -1; return; }
        int dev = 0, cus = 0, per_cu = 0;
        hipGetDevice(&dev);
        hipDeviceGetAttribute(&cus, hipDeviceAttributeMultiprocessorCount, dev);
        if (hipFuncSetAttribute((const void*)fwd_megakernel, hipFuncAttributeMaxDynamicSharedMemorySize, LDS_BYTES) != hipSuccess) { fprintf(stderr, "kernel_launch: hipFuncSetAttribute failed\n"); grid = -1; return; }
        if (hipOccupancyMaxActiveBlocksPerMultiprocessor(&per_cu, (const void*)fwd_megakernel, NTHREADS, LDS_BYTES) != hipSuccess || per_cu < 1) { fprintf(stderr, "kernel_launch: occupancy query says %d\n", per_cu); per_cu = 1; }
        (void)hipGetLastError();
        grid = cus;
        if (grid > 256) grid = 256;
    }
    if (grid < 0) return;
    Params p{};
    for (int i = 0; i < 20; ++i) p.in[i] = (const float*)d_in[i];
    p.out = (float*)d_out; p.ws = (unsigned char*)d_ws;
    void* args[] = {&p};
    hipError_t e = hipLaunchCooperativeKernel((const void*)fwd_megakernel, dim3(grid), dim3(NTHREADS), args, LDS_BYTES, stream);
    if (e != hipSuccess) fprintf(stderr, "cooperative launch failed: %s (grid %d)\n", hipGetErrorString(e), grid);
}
```

```cpp
#include <hip/hip_runtime.h>
#include <hip/hip_cooperative_groups.h>
#include <cstdio>
#include <cstdint>
namespace cg = cooperative_groups;

#define LAS __attribute__((address_space(3)))
typedef unsigned short bf16_t;
typedef short bf16x8 __attribute__((ext_vector_type(8)));
typedef short s16x4 __attribute__((ext_vector_type(4)));
typedef float f32x2 __attribute__((ext_vector_type(2)));
typedef float f32x4 __attribute__((ext_vector_type(4)));
typedef float f32x16 __attribute__((ext_vector_type(16)));
typedef unsigned u32x2 __attribute__((ext_vector_type(2)));
typedef unsigned u32x4 __attribute__((ext_vector_type(4)));
typedef long l64x2 __attribute__((ext_vector_type(2)));

#ifndef REP_PA
#define REP_PA 1
#endif
#ifndef REP_PB
#define REP_PB 1
#endif
#ifndef REP_PC
#define REP_PC 1
#endif
#ifndef REP_PD
#define REP_PD 1
#endif
#ifndef REP_PF
#define REP_PF 1
#endif
#ifndef REP_PG
#define REP_PG 1
#endif
#ifndef SYNC_REP
#define SYNC_REP 1
#endif
#define GSYNC() do { for (int _r = 0; _r < SYNC_REP; ++_r) xcd_barrier((unsigned*)P_ws(p), (volatile LAS unsigned*)(lds + LDS_BYTES - 64)); } while (0)
#ifndef NSA_ENABLE
#define NSA_ENABLE 1
#endif

constexpr int NB = 2, S = 16384, DM = 1024, DEPTH = 4, MT = NB * S;
constexpr int INW = 2328, NINP = 2560, DFF = 2816, NGU = 2 * DFF;
constexpr int NCMP = 1024;
constexpr float RMS_EPS = 1e-6f, LN_EPS = 1e-5f;
constexpr float LOG2E = 1.4426950408889634f;
constexpr float QSCALE = 0.125f * LOG2E;
constexpr int NWAVES = 8, NTHREADS = 512;
constexpr int LDS_BYTES = 156672;

constexpr size_t MiB = 1u << 20;
constexpr size_t WS_W = 1 * MiB, W_LAYER = 26 * MiB;
constexpr size_t W_IN = 0, W_OUT = 5 * MiB, W_GU = 7 * MiB, W_DN = 18 * MiB, W_C1K = 23 * MiB + 512 * 1024, W_C1V = 24 * MiB + 512 * 1024,
                 W_C2K = 25 * MiB + 512 * 1024, W_C2V = W_C2K + 64 * 1024, W_CBK = W_C2V + 64 * 1024, W_CBV = W_CBK + 4096;
constexpr size_t WS_AN = 105 * MiB;
constexpr size_t WS_R1 = 169 * MiB;
constexpr size_t R_Q = 0, R_ZU = 32 * MiB, R_ZV = 64 * MiB, R_KC = 96 * MiB, R_VC = 105 * MiB, R_KS = 114 * MiB, R_VST = 122 * MiB, R_KW = 130 * MiB,
                 R_VWT = 138 * MiB, R_GATES = 146 * MiB, R_HID = 150 * MiB, R_KCMP = 154 * MiB, R_VCMPT = 155 * MiB;
constexpr size_t WS_MIX = 345 * MiB;
constexpr size_t WS_HB = WS_MIX + 64 * MiB;
constexpr size_t WS_RS = 256 * 1024;
constexpr size_t WS_END = 473 * MiB;

struct Params {
    const float* in[20];
    float* out;
    unsigned char* ws;
};

typedef const __attribute__((address_space(4))) unsigned char* kargp_t;
__device__ __forceinline__ void* karg_ld(int byte_off) {
    kargp_t k = (kargp_t)__builtin_amdgcn_kernarg_segment_ptr();
    int off = byte_off; asm volatile("" : "+s"(off));
    return *(void* const __attribute__((address_space(4)))*)(k + off);
}
__device__ __forceinline__ const float* P_in(const Params&, int i) { return (const float*)karg_ld(8 * i); }
__device__ __forceinline__ float* P_out(const Params&) { return (float*)karg_ld(160); }
__device__ __forceinline__ unsigned char* P_ws(const Params&) { return (unsigned char*)karg_ld(168); }
__device__ __forceinline__ unsigned cvt_pk_bf16(float lo, float hi) { unsigned r; asm volatile("v_cvt_pk_bf16_f32 %0, %1, %2" : "=v"(r) : "v"(lo), "v"(hi)); return r; }
__device__ __forceinline__ float fast_exp2(float x) { return __builtin_amdgcn_exp2f(x); }
__device__ __forceinline__ float fast_rcp(float x) { return __builtin_amdgcn_rcpf(x); }
__device__ __forceinline__ float gelu_tanh(float x) { const float u = x + 0.044715f * x * x * x; return x * fast_rcp(1.0f + fast_exp2(-2.3022081982f * u)); }
__device__ __forceinline__ float silu_f(float x) { return x * fast_rcp(1.0f + fast_exp2(-LOG2E * x)); }
__device__ __forceinline__ float sigmoid_f(float x) { return fast_rcp(1.0f + fast_exp2(-LOG2E * x)); }
__device__ __forceinline__ float wave_sum(float v) {
#pragma unroll
    for (int o = 1; o < 64; o <<= 1) v += __shfl_xor(v, o);
    return v;
}
__device__ __forceinline__ float wave_max(float v) {
#pragma unroll
    for (int o = 1; o < 64; o <<= 1) v = fmaxf(v, __shfl_xor(v, o));
    return v;
}
template <int CTRL> __device__ __forceinline__ float dpp_f(float x) { return __builtin_bit_cast(float, __builtin_amdgcn_mov_dpp(__builtin_bit_cast(int, x), CTRL, 0xf, 0xf, true)); }
__device__ __forceinline__ float xhalf_max(float x) { auto t = __builtin_amdgcn_permlane32_swap(__float_as_uint(x), __float_as_uint(x), false, false); return fmaxf(__uint_as_float(t[0]), __uint_as_float(t[1])); }
__device__ __forceinline__ float xhalf_sum(float x) { auto t = __builtin_amdgcn_permlane32_swap(__float_as_uint(x), __float_as_uint(x), false, false); return __uint_as_float(t[0]) + __uint_as_float(t[1]); }
__device__ __forceinline__ float quad_sum(float x) { x += dpp_f<0xB1>(x); x += dpp_f<0x4E>(x); return x; }
__device__ __forceinline__ float wave_max_fast(float x) {
    x = fmaxf(x, dpp_f<0xB1>(x)); x = fmaxf(x, dpp_f<0x4E>(x)); x = fmaxf(x, dpp_f<0x141>(x)); x = fmaxf(x, dpp_f<0x128>(x));
    auto s = __builtin_amdgcn_permlane16_swap(__float_as_uint(x), __float_as_uint(x), false, false); x = fmaxf(__uint_as_float(s[0]), __uint_as_float(s[1]));
    return xhalf_max(x);
}
__device__ __forceinline__ float wave_sum_fast(float x) {
    x += dpp_f<0xB1>(x); x += dpp_f<0x4E>(x); x += dpp_f<0x141>(x); x += dpp_f<0x128>(x);
    auto s = __builtin_amdgcn_permlane16_swap(__float_as_uint(x), __float_as_uint(x), false, false); x = __uint_as_float(s[0]) + __uint_as_float(s[1]);
    return xhalf_sum(x);
}
__device__ __forceinline__ float bf2f(bf16_t b) { return __uint_as_float(((unsigned)b) << 16); }
#define LAUNDER(x) asm volatile("" : "+v"(x))
#define MFMA32(a, b, c) __builtin_amdgcn_mfma_f32_32x32x16_bf16((a), (b), (c), 0, 0, 0)

namespace pg8 {
constexpr int BM = 256, BK = 64, HALF = 128, HTB = HALF * BK * 2, STAGE_BYTES = 8 * HTB, NXCD = 8, WGM = 8;
__host__ __device__ __forceinline__ int lds_byte(int r, int c) { const int st = (r >> 4) * 2 + (c >> 5), rr = r & 15, cc = c & 31, ob = rr * 64 + cc * 2; return st * 1024 + (ob ^ (((ob >> 9) & 1) << 5)); }
__host__ __device__ __forceinline__ void stage_rc(int b, int& R, int& C) { const int st = b / 1024, sb = b % 1024, swz = sb ^ (((sb >> 9) & 1) << 5); R = (st >> 1) * 16 + swz / 64; C = (st & 1) * 32 + (swz % 64) / 2; }
__host__ __device__ __forceinline__ int perm32(int rho) { const int n = rho >> 4, i = rho & 15; return 8 * (i >> 2) + 4 * n + (i & 3); }

struct Unit { int pm, pn; };
struct Gemm { const bf16_t* A; const bf16_t* Bt; int M, N, K, lda; };

struct StaticOrder {
    int nM, nN, nwg, G, c, lim;
    __device__ __forceinline__ void init(int M, int N, int G_, int c_, int reps = 1) { nM = M / BM; nN = N / BM; nwg = nM * nN; G = G_; c = c_; const int per = (c < nwg) ? (nwg - c + G - 1) / G : 0; lim = per * reps; }
    __device__ __forceinline__ bool next(int i, Unit& u) const {
        if (i >= lim) return false;
        const int per = (nwg - c + G - 1) / G; const long L = (long)(i % per) * G + c;
        int wgid = (int)L; { const int q = nwg / NXCD, r = nwg % NXCD, xcd = wgid % NXCD, off = wgid / NXCD; wgid = (xcd < r ? xcd * (q + 1) : r * (q + 1) + (xcd - r) * q) + off; }
        const int nig = WGM * nN, gid = wgid / nig, fm = gid * WGM, gsz = (nM - fm) < WGM ? (nM - fm) : WGM;
        u.pm = fm + ((wgid % nig) % gsz); u.pn = (wgid % nig) / gsz; return true;
    }
};

struct EpiF32 {
    static constexpr bool PERM = false;
    float* C; int ldc;
    __device__ __forceinline__ void operator()(const f32x4 (&acc)[2][2][4][2], const Unit& u, int wr, int wc, int fr, int fq) const {
        const int row0 = u.pm * BM + wr * 64 + fr, col0 = u.pn * BM + wc * 32 + 4 * fq;
#pragma unroll
        for (int ai = 0; ai < 2; ++ai)
#pragma unroll
            for (int m = 0; m < 4; ++m) { float* rowp = C + (size_t)(row0 + ai * HALF + m * 16) * ldc + col0;
#pragma unroll
                for (int bj = 0; bj < 2; ++bj)
#pragma unroll
                    for (int n = 0; n < 2; ++n) *(f32x4*)(rowp + bj * HALF + n * 16) = acc[ai][bj][m][n]; }
    }
};

struct EpiBf16 {
    static constexpr bool PERM = true;
    bf16_t* C; int ldc;
    __device__ __forceinline__ void operator()(const f32x4 (&acc)[2][2][4][2], const Unit& u, int wr, int wc, int fr, int fq) const {
        const int row0 = u.pm * BM + wr * 64 + fr, col0 = u.pn * BM + wc * 32 + 8 * fq;
#pragma unroll
        for (int ai = 0; ai < 2; ++ai)
#pragma unroll
            for (int m = 0; m < 4; ++m) { bf16_t* rowp = C + (size_t)(row0 + ai * HALF + m * 16) * ldc + col0;
#pragma unroll
                for (int bj = 0; bj < 2; ++bj) { const f32x4 v0 = acc[ai][bj][m][0], v1 = acc[ai][bj][m][1];
                    u32x4 w; w.x = cvt_pk_bf16(v0[0], v0[1]); w.y = cvt_pk_bf16(v0[2], v0[3]); w.z = cvt_pk_bf16(v1[0], v1[1]); w.w = cvt_pk_bf16(v1[2], v1[3]);
                    *(u32x4*)(rowp + bj * HALF) = w; } }
    }
};

struct EpiGU {
    static constexpr bool PERM = true;
    bf16_t* act; const float* rs;
    __device__ __forceinline__ void operator()(const f32x4 (&acc)[2][2][4][2], const Unit& u, int wr, int wc, int fr, int fq) const {
        const int row0 = u.pm * BM + wr * 64 + fr, col0 = u.pn * HALF + wc * 32 + 8 * fq;
        float rrv[2][4];
#pragma unroll
        for (int ai = 0; ai < 2; ++ai)
#pragma unroll
            for (int m = 0; m < 4; ++m) rrv[ai][m] = rs[row0 + ai * HALF + m * 16];
#pragma unroll
        for (int ai = 0; ai < 2; ++ai)
#pragma unroll
            for (int m = 0; m < 4; ++m) {
                const float rr = rrv[ai][m];
                const f32x4 g0 = acc[ai][0][m][0] * rr, g1 = acc[ai][0][m][1] * rr, u0 = acc[ai][1][m][0] * rr, u1 = acc[ai][1][m][1] * rr;
                u32x4 w;
                w.x = cvt_pk_bf16(silu_f(g0[0]) * u0[0], silu_f(g0[1]) * u0[1]); w.y = cvt_pk_bf16(silu_f(g0[2]) * u0[2], silu_f(g0[3]) * u0[3]);
                w.z = cvt_pk_bf16(silu_f(g1[0]) * u1[0], silu_f(g1[1]) * u1[1]); w.w = cvt_pk_bf16(silu_f(g1[2]) * u1[2], silu_f(g1[3]) * u1[3]);
                *(u32x4*)(act + (size_t)(row0 + ai * HALF + m * 16) * DFF + col0) = w;
            }
    }
};

struct EpiCmp1 {
    static constexpr bool PERM = true;
    bf16_t* hid; const float* cbias;
    __device__ __forceinline__ void operator()(const f32x4 (&acc)[2][2][4][2], const Unit& u, int wr, int wc, int fr, int fq) const {
        const int row0 = u.pm * BM + wr * 64 + fr;
#pragma unroll
        for (int bj = 0; bj < 2; ++bj) {
            const int col0 = bj * HALF + wc * 32 + 8 * fq;
            const f32x4 b0 = *(const f32x4*)(cbias + col0), b1 = *(const f32x4*)(cbias + col0 + 4);
#pragma unroll
            for (int ai = 0; ai < 2; ++ai)
#pragma unroll
                for (int m = 0; m < 4; ++m) {
                    const f32x4 v0 = acc[ai][bj][m][0] + b0, v1 = acc[ai][bj][m][1] + b1;
                    u32x4 w;
                    w.x = cvt_pk_bf16(gelu_tanh(v0[0]), gelu_tanh(v0[1])); w.y = cvt_pk_bf16(gelu_tanh(v0[2]), gelu_tanh(v0[3]));
                    w.z = cvt_pk_bf16(gelu_tanh(v1[0]), gelu_tanh(v1[1])); w.w = cvt_pk_bf16(gelu_tanh(v1[2]), gelu_tanh(v1[3]));
                    *(u32x4*)(hid + (size_t)(row0 + ai * HALF + m * 16) * 256 + col0) = w;
                }
        }
    }
};

struct EpiIn {
    static constexpr bool PERM = true;
    unsigned char* r1;
    const float* rs;
    __device__ __forceinline__ void operator()(const f32x4 (&acc)[2][2][4][2], const Unit& u, int wr, int wc, int fr, int fq) const {
        const int pn = u.pn;
        float rrv[2][4];
#pragma unroll
        for (int ai = 0; ai < 2; ++ai)
#pragma unroll
            for (int m = 0; m < 4; ++m) rrv[ai][m] = rs[u.pm * BM + ai * HALF + wr * 64 + m * 16 + fr];
#pragma unroll
        for (int ai = 0; ai < 2; ++ai)
#pragma unroll
            for (int m = 0; m < 4; ++m) {
                const int row = u.pm * BM + ai * HALF + wr * 64 + m * 16 + fr;
                const int b = row >> 14, s = row & (S - 1);
                const float rr = rrv[ai][m];
#pragma unroll
                for (int bj = 0; bj < 2; ++bj) {
                    f32x4 v0 = acc[ai][bj][m][0] * rr, v1 = acc[ai][bj][m][1] * rr;
                    const int cw = bj * HALF + wc * 32 + 8 * fq;
                    if (pn < 2) {
                        v0 = v0 * QSCALE; v1 = v1 * QSCALE;
                        u32x4 w; w.x = cvt_pk_bf16(v0[0], v0[1]); w.y = cvt_pk_bf16(v0[2], v0[3]); w.z = cvt_pk_bf16(v1[0], v1[1]); w.w = cvt_pk_bf16(v1[2], v1[3]);
                        *(u32x4*)((bf16_t*)(r1 + R_Q) + (size_t)row * 512 + pn * 256 + cw) = w;
                    } else if (pn < 5) {
                        const int g = wc >> 1, d = (wc & 1) * 32 + 8 * fq, bg = b * 2 + g;
                        if (pn == 2) {
                            bf16_t* base = (bf16_t*)(r1 + (bj == 0 ? R_KC : R_VC));
                            u32x4 w; w.x = cvt_pk_bf16(v0[0], v0[1]); w.y = cvt_pk_bf16(v0[2], v0[3]); w.z = cvt_pk_bf16(v1[0], v1[1]); w.w = cvt_pk_bf16(v1[2], v1[3]);
                            *(u32x4*)(base + ((size_t)bg * S + s) * 64 + d) = w;
                        } else if (pn == 3) {
                            if (bj == 0) {
                                v0 = v0 * 0.25f; v1 = v1 * 0.25f;
                                int w0 = __builtin_amdgcn_cvt_pk_fp8_f32(v0[0], v0[1], 0, false); w0 = __builtin_amdgcn_cvt_pk_fp8_f32(v0[2], v0[3], w0, true);
                                int w1 = __builtin_amdgcn_cvt_pk_fp8_f32(v1[0], v1[1], 0, false); w1 = __builtin_amdgcn_cvt_pk_fp8_f32(v1[2], v1[3], w1, true);
                                u32x2 w; w.x = (unsigned)w0; w.y = (unsigned)w1;
                                *(u32x2*)(r1 + R_KS + (size_t)bg * S * 64 + (size_t)(s >> 6) * 4096 + ((s >> 4) & 3) * 1024 + (((d >> 3) & 3) * 16 + (s & 15)) * 16 + (d >> 5) * 8) = w;
                            } else {
                                const int kb = s & 63, kp = kb >> 5, k32 = kb & 31, fqv = (k32 >> 2) & 3, jj = ((k32 >> 4) << 2) | (k32 & 3);
                                unsigned char* dst = r1 + R_VST + (size_t)bg * S * 64 + (size_t)(s >> 6) * 4096 + (d >> 4) * 1024 + (fqv * 16 + (d & 15)) * 16 + kp * 8 + jj;
                                const int w0 = __builtin_amdgcn_cvt_pk_fp8_f32(v0[0], v0[1], 0, false), w1 = __builtin_amdgcn_cvt_pk_fp8_f32(v0[2], v0[3], 0, false);
                                const int w2 = __builtin_amdgcn_cvt_pk_fp8_f32(v1[0], v1[1], 0, false), w3 = __builtin_amdgcn_cvt_pk_fp8_f32(v1[2], v1[3], 0, false);
                                dst[0] = (unsigned char)(w0 & 0xff); dst[16] = (unsigned char)((w0 >> 8) & 0xff); dst[32] = (unsigned char)(w1 & 0xff); dst[48] = (unsigned char)((w1 >> 8) & 0xff);
                                dst[64] = (unsigned char)(w2 & 0xff); dst[80] = (unsigned char)((w2 >> 8) & 0xff); dst[96] = (unsigned char)(w3 & 0xff); dst[112] = (unsigned char)((w3 >> 8) & 0xff);
                            }
                        } else if (bj == 0) {
                            bf16_t* base = (bf16_t*)(r1 + R_KW);
                            u32x4 w; w.x = cvt_pk_bf16(v0[0], v0[1]); w.y = cvt_pk_bf16(v0[2], v0[3]); w.z = cvt_pk_bf16(v1[0], v1[1]); w.w = cvt_pk_bf16(v1[2], v1[3]);
                            *(u32x4*)(base + (size_t)bg * S * 64 + (size_t)(s >> 5) * 2048 + (d >> 4) * 512 + ((d >> 3) & 1) * 256 + (s & 31) * 8) = w;
                        } else {
                            const int kk = s & 31;
                            bf16_t* dst = (bf16_t*)(r1 + R_VWT) + (size_t)bg * S * 64 + (size_t)(s >> 5) * 2048 + (d >> 5) * 1024 + (kk >> 4) * 512 + ((kk >> 2) & 1) * 256 + (d & 31) * 8 + ((kk >> 3) & 1) * 4 + (kk & 3);
                            const unsigned w0 = cvt_pk_bf16(v0[0], v0[1]), w1 = cvt_pk_bf16(v0[2], v0[3]), w2 = cvt_pk_bf16(v1[0], v1[1]), w3 = cvt_pk_bf16(v1[2], v1[3]);
                            dst[0] = (bf16_t)(w0 & 0xffff); dst[8] = (bf16_t)(w0 >> 16); dst[16] = (bf16_t)(w1 & 0xffff); dst[24] = (bf16_t)(w1 >> 16);
                            dst[32] = (bf16_t)(w2 & 0xffff); dst[40] = (bf16_t)(w2 >> 16); dst[48] = (bf16_t)(w3 & 0xffff); dst[56] = (bf16_t)(w3 >> 16);
                        }
                    } else if (pn < 9) {
                        bf16_t* base = (bf16_t*)(r1 + ((pn < 7) ? R_ZU : R_ZV)); const int ct = (pn < 7) ? (pn - 5) : (pn - 7);
                        u32x4 w;
                        w.x = cvt_pk_bf16(gelu_tanh(v0[0]), gelu_tanh(v0[1])); w.y = cvt_pk_bf16(gelu_tanh(v0[2]), gelu_tanh(v0[3]));
                        w.z = cvt_pk_bf16(gelu_tanh(v1[0]), gelu_tanh(v1[1])); w.w = cvt_pk_bf16(gelu_tanh(v1[2]), gelu_tanh(v1[3]));
                        *(u32x4*)(base + (size_t)row * 512 + ct * 256 + cw) = w;
                    } else {
                        if (bj == 0 && wc == 0 && fq < 3) {
                            float* gp = (float*)(r1 + R_GATES) + (size_t)row * 24 + 8 * fq;
                            *(f32x4*)gp = (f32x4){sigmoid_f(v0[0]), sigmoid_f(v0[1]), sigmoid_f(v0[2]), sigmoid_f(v0[3])};
                            *(f32x4*)(gp + 4) = (f32x4){sigmoid_f(v1[0]), sigmoid_f(v1[1]), sigmoid_f(v1[2]), sigmoid_f(v1[3])};
                        }
                    }
                }
            }
    }
};

template <class Epi>
__device__ __forceinline__ void gemm_phase(LAS unsigned char* lds, const Gemm g, const StaticOrder& S, const Epi& E) {
    int tid = threadIdx.x; LAUNDER(tid);
    const int wid = __builtin_amdgcn_readfirstlane(tid >> 6), lane = tid & 63, wr = wid >> 2, wc = wid & 3, fr = lane & 15, fq = lane >> 4;
    const int K = g.K, nt = K / BK, lda = g.lda;
    unsigned voffA[2], voffB[2];
#pragma unroll
    for (int i = 0; i < 2; ++i) { int R, C; stage_rc(tid * 16 + i * 8192, R, C); const int Rb = Epi::PERM ? ((R & ~31) + perm32(R & 31)) : R;
        voffA[i] = (unsigned)(R * lda + C) * 2u; voffB[i] = (unsigned)(Rb * K + C) * 2u; }
    const size_t kstep = (size_t)(BK * 2);
    const size_t hA = (size_t)HALF * lda * 2, hB = (size_t)HALF * K * 2;
    const size_t tA = 2 * hA, tB = 2 * hB;
    const unsigned ldsw = (unsigned)wid * 1024u;
    const int aoff = lds_byte(wr * 64 + fr, fq * 8), boff = lds_byte(wc * 32 + fr, fq * 8);
#define PG8_SA(b, h) (((b) * 2 + (h)) * HTB)
#define PG8_SB(b, h) ((4 + (b) * 2 + (h)) * HTB)
#define PG8_STAGE(bufoff, gbase, voff) do { _Pragma("unroll") for (int _i = 0; _i < 2; ++_i) \
        __builtin_amdgcn_global_load_lds((const unsigned*)((const char*)(gbase) + (voff)[_i]), (LAS unsigned*)(lds + (bufoff) + ldsw + _i * 8192), 16, 0, 0); } while (0)
#define PG8_LDA(dst, b, h) do { _Pragma("unroll") for (int m = 0; m < 4; ++m) _Pragma("unroll") for (int k = 0; k < 2; ++k) dst[m][k] = *(const LAS bf16x8*)(lds + PG8_SA(b, h) + aoff + m * 2048 + k * 1024); } while (0)
#define PG8_LDB(dst, b, h) do { _Pragma("unroll") for (int n = 0; n < 2; ++n) _Pragma("unroll") for (int k = 0; k < 2; ++k) dst[n][k] = *(const LAS bf16x8*)(lds + PG8_SB(b, h) + boff + n * 2048 + k * 1024); } while (0)
#define PG8_MMA(ai, bj, At, Bt) do { __builtin_amdgcn_s_setprio(1); _Pragma("unroll") for (int m = 0; m < 4; ++m) _Pragma("unroll") for (int n = 0; n < 2; ++n) _Pragma("unroll") for (int k = 0; k < 2; ++k) \
        acc[ai][bj][m][n] = __builtin_amdgcn_mfma_f32_16x16x32_bf16(Bt[n][k], At[m][k], acc[ai][bj][m][n], 0, 0, 0); __builtin_amdgcn_s_setprio(0); } while (0)
#define PG8_WAIT_V(n) asm volatile("s_waitcnt vmcnt(" #n ")" ::: "memory")
#define PG8_WAIT_L(n) asm volatile("s_waitcnt lgkmcnt(" #n ")" ::: "memory")
#define PG8_BAR __builtin_amdgcn_s_barrier()
#define PG8_SCHED __builtin_amdgcn_sched_barrier(0)
    Unit cur, nxt; int ui = 0;
    if (!S.next(0, cur)) return;
    f32x4 acc[2][2][4][2];
#pragma unroll
    for (int a = 0; a < 2; ++a)
#pragma unroll
        for (int b = 0; b < 2; ++b)
#pragma unroll
            for (int m = 0; m < 4; ++m)
#pragma unroll
                for (int n = 0; n < 2; ++n) acc[a][b][m][n] = (f32x4){0.f, 0.f, 0.f, 0.f};
    bf16x8 At[4][2], B0[2][2], B1[2][2];
    const char* cA = (const char*)g.A + (size_t)cur.pm * tA; const char* cB = (const char*)g.Bt + (size_t)cur.pn * tB;
    PG8_STAGE(PG8_SB(0, 0), cB, voffB); PG8_STAGE(PG8_SB(0, 1), cB + hB, voffB); PG8_STAGE(PG8_SA(0, 0), cA, voffA); PG8_STAGE(PG8_SA(0, 1), cA + hA, voffA);
    if (wr == 1) PG8_BAR;
    PG8_WAIT_V(2); PG8_BAR;
    PG8_STAGE(PG8_SB(1, 0), cB + kstep, voffB); PG8_STAGE(PG8_SA(1, 0), cA + kstep, voffA); PG8_STAGE(PG8_SB(1, 1), cB + hB + kstep, voffB);
    PG8_WAIT_V(6); PG8_BAR;
    for (;;) {
        const bool has_next = S.next(ui + 1, nxt);
        const char* nA = has_next ? (const char*)g.A + (size_t)nxt.pm * tA : cA; const char* nB = has_next ? (const char*)g.Bt + (size_t)nxt.pn * tB : cB;
        for (int t = 0; t < nt; t += 2) {
            const bool last = (t == nt - 2);
            const char* a1 = cA + (size_t)(t + 1) * kstep;
            const char* a2 = last ? nA : cA + (size_t)(t + 2) * kstep; const char* b2 = last ? nB : cB + (size_t)(t + 2) * kstep;
            const char* a3 = a2 + kstep; const char* b3 = b2 + kstep;
            PG8_LDB(B0, 0, 0); PG8_LDB(B1, 0, 1); PG8_SCHED; PG8_LDA(At, 0, 0); PG8_STAGE(PG8_SA(1, 1), a1 + hA, voffA);
            PG8_WAIT_V(8); PG8_WAIT_L(0); PG8_BAR; PG8_MMA(0, 0, At, B0); PG8_MMA(0, 1, At, B1); PG8_BAR; PG8_SCHED;
            PG8_LDA(At, 0, 1); PG8_STAGE(PG8_SB(0, 0), b2, voffB); PG8_STAGE(PG8_SB(0, 1), b2 + hB, voffB); PG8_STAGE(PG8_SA(0, 0), a2, voffA);
            PG8_WAIT_V(8); PG8_WAIT_L(0); PG8_BAR; PG8_MMA(1, 0, At, B0); PG8_MMA(1, 1, At, B1); PG8_BAR; PG8_SCHED;
            PG8_LDB(B0, 1, 0); PG8_LDB(B1, 1, 1); PG8_SCHED; PG8_LDA(At, 1, 0); PG8_STAGE(PG8_SA(0, 1), a2 + hA, voffA);
            PG8_WAIT_V(8); PG8_WAIT_L(0); PG8_BAR; PG8_MMA(0, 0, At, B0); PG8_MMA(0, 1, At, B1); PG8_BAR; PG8_SCHED;
            PG8_LDA(At, 1, 1); PG8_STAGE(PG8_SB(1, 0), b3, voffB); PG8_STAGE(PG8_SB(1, 1), b3 + hB, voffB); PG8_STAGE(PG8_SA(1, 0), a3, voffA);
            PG8_WAIT_V(8); PG8_WAIT_L(0); PG8_BAR; PG8_MMA(1, 0, At, B0); PG8_MMA(1, 1, At, B1); PG8_BAR; PG8_SCHED;
        }
        if (wr == 0) PG8_BAR;
        E(acc, cur, wr, wc, fr, fq);
        if (!has_next) break;
#pragma unroll
        for (int a = 0; a < 2; ++a)
#pragma unroll
            for (int b = 0; b < 2; ++b)
#pragma unroll
                for (int m = 0; m < 4; ++m)
#pragma unroll
                    for (int n = 0; n < 2; ++n) acc[a][b][m][n] = (f32x4){0.f, 0.f, 0.f, 0.f};
        cur = nxt; cA = nA; cB = nB; ++ui;
        if (wr == 1) PG8_BAR;
    }
    PG8_WAIT_V(0);
    PG8_BAR;
#undef PG8_SA
#undef PG8_SB
#undef PG8_STAGE
#undef PG8_LDA
#undef PG8_LDB
#undef PG8_MMA
#undef PG8_WAIT_V
#undef PG8_WAIT_L
#undef PG8_BAR
#undef PG8_SCHED
}
}

template <int MAP> __device__ __forceinline__ int src_col(int n) {
    if (MAP == 0) return n;
    if (MAP == 1) { if (n < 1280) return n; if (n < 2304) return n + 24; if (n < 2328) return n - 1024; return -1; }
    const int t = n >> 8, w = n & 255; return (w < 128) ? (128 * t + w) : (DFF + 128 * t + (w - 128));
}
constexpr int TP = 65;
template <int MAP> __device__ __forceinline__ void transpose_item(const float* W, int K, int Nsrc, bf16_t* WT, int nblk, int item, LAS float* scr, int lane, const float* gain = nullptr) {
    const int kb = item / nblk, nb = item % nblk, k0 = 64 * kb, n0 = 64 * nb;
    const int nl = 4 * (lane & 15), kr = lane >> 4;
    const int ns = src_col<MAP>(n0 + nl);
    f32x4 v[16];
#pragma unroll
    for (int i = 0; i < 16; ++i) v[i] = (ns >= 0) ? *(const f32x4*)(W + (size_t)(k0 + kr + 4 * i) * Nsrc + ns) : (f32x4){0.f, 0.f, 0.f, 0.f};
    if (gain) {
#pragma unroll
        for (int i = 0; i < 16; ++i) v[i] = v[i] * gain[k0 + kr + 4 * i];
    }
#pragma unroll
    for (int i = 0; i < 16; ++i) { LAS float* d = scr + (kr + 4 * i) * TP + nl; d[0] = v[i][0]; d[1] = v[i][1]; d[2] = v[i][2]; d[3] = v[i][3]; }
    asm volatile("s_waitcnt lgkmcnt(0)" ::: "memory");
    __builtin_amdgcn_wave_barrier();
    const int c = lane & 7;
#pragma unroll
    for (int j = 0; j < 8; ++j) { const int n = (lane >> 3) + 8 * j; const LAS float* s = scr + (8 * c) * TP + n;
        u32x4 o; o.x = cvt_pk_bf16(s[0 * TP], s[1 * TP]); o.y = cvt_pk_bf16(s[2 * TP], s[3 * TP]); o.z = cvt_pk_bf16(s[4 * TP], s[5 * TP]); o.w = cvt_pk_bf16(s[6 * TP], s[7 * TP]);
        *(u32x4*)(WT + (size_t)(n0 + n) * K + k0 + 8 * c) = o; }
    asm volatile("s_waitcnt lgkmcnt(0)" ::: "memory");
    __builtin_amdgcn_wave_barrier();
}

__device__ __forceinline__ void row_pass(const float* x0, bf16_t* hb, const bf16_t* mix, const float* gpost, float* rs, float* fout, int gw, int NGW, int lane) {
    LAUNDER(lane);
    if (x0) {
        for (int m = gw; m < MT; m += NGW) {
            const f32x4* hr = (const f32x4*)(x0 + (size_t)m * DM) + lane;
            f32x4 h[4]; float s2 = 0.f;
#pragma unroll
            for (int j = 0; j < 4; ++j) { h[j] = hr[64 * j]; s2 += (h[j][0] * h[j][0] + h[j][1] * h[j][1]) + (h[j][2] * h[j][2] + h[j][3] * h[j][3]); }
            const float r2 = 1.0f / sqrtf(wave_sum_fast(s2) * (1.0f / DM) + RMS_EPS);
            u32x2* ao = (u32x2*)(hb + (size_t)m * DM) + lane;
#pragma unroll
            for (int j = 0; j < 4; ++j) { u32x2 w; w.x = cvt_pk_bf16(h[j][0], h[j][1]); w.y = cvt_pk_bf16(h[j][2], h[j][3]); ao[64 * j] = w; }
            if (lane == 0) rs[m] = r2;
        }
        return;
    }
    u32x2 hn[4], mn[4];
    if (gw < MT) {
        const u32x2* hr = (const u32x2*)(hb + (size_t)gw * DM) + lane; const u32x2* mr = (const u32x2*)(mix + (size_t)gw * DM) + lane;
#pragma unroll
        for (int j = 0; j < 4; ++j) { hn[j] = hr[64 * j]; mn[j] = mr[64 * j]; }
    }
    for (int m = gw; m < MT; m += NGW) {
        u32x2 hv[4], mv[4];
#pragma unroll
        for (int j = 0; j < 4; ++j) { hv[j] = hn[j]; mv[j] = mn[j]; }
        const int m2 = m + NGW;
        if (m2 < MT) {
            const u32x2* hr = (const u32x2*)(hb + (size_t)m2 * DM) + lane; const u32x2* mr = (const u32x2*)(mix + (size_t)m2 * DM) + lane;
#pragma unroll
            for (int j = 0; j < 4; ++j) { hn[j] = hr[64 * j]; mn[j] = mr[64 * j]; }
        }
        f32x4 h[4], x[4]; float ss = 0.f;
#pragma unroll
        for (int j = 0; j < 4; ++j) {
            h[j] = (f32x4){__uint_as_float(hv[j].x << 16), __uint_as_float(hv[j].x & 0xffff0000u), __uint_as_float(hv[j].y << 16), __uint_as_float(hv[j].y & 0xffff0000u)};
            x[j] = (f32x4){__uint_as_float(mv[j].x << 16), __uint_as_float(mv[j].x & 0xffff0000u), __uint_as_float(mv[j].y << 16), __uint_as_float(mv[j].y & 0xffff0000u)};
            ss += (x[j][0] * x[j][0] + x[j][1] * x[j][1]) + (x[j][2] * x[j][2] + x[j][3] * x[j][3]);
        }
        const float r1 = 1.0f / sqrtf(wave_sum_fast(ss) * (1.0f / DM) + RMS_EPS);
        float s2 = 0.f;
#pragma unroll
        for (int j = 0; j < 4; ++j) { const f32x4 gp = *((const f32x4*)gpost + lane + 64 * j); h[j] = h[j] + x[j] * r1 * gp; s2 += (h[j][0] * h[j][0] + h[j][1] * h[j][1]) + (h[j][2] * h[j][2] + h[j][3] * h[j][3]); }
        if (fout) {
            f32x4* ho = (f32x4*)(fout + (size_t)m * DM) + lane;
#pragma unroll
            for (int j = 0; j < 4; ++j) ho[64 * j] = h[j];
        } else {
            const float r2 = 1.0f / sqrtf(wave_sum_fast(s2) * (1.0f / DM) + RMS_EPS);
            u32x2* ao = (u32x2*)(hb + (size_t)m * DM) + lane;
#pragma unroll
            for (int j = 0; j < 4; ++j) { u32x2 w; w.x = cvt_pk_bf16(h[j][0], h[j][1]); w.y = cvt_pk_bf16(h[j][2], h[j][3]); ao[64 * j] = w; }
            if (lane == 0) rs[m] = r2;
        }
    }
}

constexpr int ZPITCH = 136;
__device__ __forceinline__ void gmlp_unit(const Params& p, int layer, int chunk, LAS unsigned char* lds, int wave, int lane) {
    LAUNDER(lane);
    const unsigned char* ws = P_ws(p);
    const bf16_t* zu = (const bf16_t*)(ws + WS_R1 + R_ZU); const bf16_t* zv = (const bf16_t*)(ws + WS_R1 + R_ZV);
    bf16_t* mixed = (bf16_t*)(ws + WS_AN);
    const float* ln_g = P_in(p, 13) + layer * 512; const float* ln_b = P_in(p, 14) + layer * 512;
    const float* w_s = P_in(p, 15) + (size_t)layer * 8 * 128 * 128 + (size_t)wave * 128 * 128;
    const float* b_s = P_in(p, 16) + layer * 8 * 128 + wave * 128;
    LAS float* stats = (LAS float*)(lds + 8 * 64 * ZPITCH * 2);
    LAS bf16_t* zt = (LAS bf16_t*)(lds + wave * 64 * ZPITCH * 2);
    const int tok0 = chunk * 128;
    __syncthreads();
#pragma unroll
    for (int i = 0; i < 16; ++i) {
        const int t = wave * 16 + i;
        const bf16x8 v = *(const bf16x8*)(zv + (size_t)(tok0 + t) * 512 + lane * 8);
        float s = 0.f, s2 = 0.f;
#pragma unroll
        for (int e = 0; e < 8; ++e) { const float x = bf2f((bf16_t)v[e]); s += x; s2 += x * x; }
        s = wave_sum_fast(s); s2 = wave_sum_fast(s2);
        const float mean = s * (1.0f / 512.0f); const float var = fmaxf(s2 * (1.0f / 512.0f) - mean * mean, 0.f);
        if (lane == 0) { stats[2 * t] = mean; stats[2 * t + 1] = 1.0f / sqrtf(var + LN_EPS); }
    }
    __syncthreads();
    {
        const int dc = lane & 7, d0 = dc * 8;
        const f32x4 g0 = *(const f32x4*)(ln_g + wave * 64 + d0), g1 = *(const f32x4*)(ln_g + wave * 64 + d0 + 4);
        const f32x4 b0 = *(const f32x4*)(ln_b + wave * 64 + d0), b1 = *(const f32x4*)(ln_b + wave * 64 + d0 + 4);
#pragma unroll 8
        for (int i = 0; i < 16; ++i) {
            const int s = (lane >> 3) + 8 * i;
            const bf16x8 v = *(const bf16x8*)(zv + (size_t)(tok0 + s) * 512 + wave * 64 + d0);
            const float mean = stats[2 * s], rstd = stats[2 * s + 1];
#pragma unroll
            for (int e = 0; e < 8; ++e) {
                const float gg = (e < 4) ? g0[e & 3] : g1[e & 3], bb = (e < 4) ? b0[e & 3] : b1[e & 3];
                const float y = (bf2f((bf16_t)v[e]) - mean) * rstd * gg + bb;
                zt[(d0 + e) * ZPITCH + s] = (bf16_t)(cvt_pk_bf16(y, 0.f) & 0xffff);
            }
        }
    }
    asm volatile("s_waitcnt lgkmcnt(0)" ::: "memory");
    __builtin_amdgcn_wave_barrier();
    const int r = lane & 31, h = lane >> 5;
#pragma unroll
    for (int mt = 0; mt < 4; ++mt) {
        f32x16 acc0, acc1;
#pragma unroll
        for (int i = 0; i < 16; ++i) { acc0[i] = 0.f; acc1[i] = 0.f; }
        const int t = 32 * mt + r;
#pragma unroll
        for (int ks = 0; ks < 2 * (mt + 1); ++ks) {
            const int s0 = 16 * ks + 8 * h;
            const f32x4 w0 = *(const f32x4*)(w_s + (size_t)t * 128 + s0), w1 = *(const f32x4*)(w_s + (size_t)t * 128 + s0 + 4);
            float wv[8] = {w0[0], w0[1], w0[2], w0[3], w1[0], w1[1], w1[2], w1[3]};
#pragma unroll
            for (int e = 0; e < 8; ++e) wv[e] = (s0 + e <= t) ? wv[e] : 0.f;
            u32x4 wb; wb.x = cvt_pk_bf16(wv[0], wv[1]); wb.y = cvt_pk_bf16(wv[2], wv[3]); wb.z = cvt_pk_bf16(wv[4], wv[5]); wb.w = cvt_pk_bf16(wv[6], wv[7]);
            const bf16x8 bfrag = __builtin_bit_cast(bf16x8, wb);
            const bf16x8 a0 = *(const LAS bf16x8*)(zt + (r) * ZPITCH + s0);
            const bf16x8 a1 = *(const LAS bf16x8*)(zt + (32 + r) * ZPITCH + s0);
            acc0 = MFMA32(a0, bfrag, acc0);
            acc1 = MFMA32(a1, bfrag, acc1);
        }
        const float bs = b_s[t];
        const size_t rowoff = (size_t)(tok0 + t) * 512 + wave * 64;
        bf16_t* mrow = mixed + (size_t)(tok0 + t) * 1024 + 512 + wave * 64;
#pragma unroll
        for (int dt = 0; dt < 2; ++dt)
#pragma unroll
            for (int i4 = 0; i4 < 4; ++i4) {
                const int d = 32 * dt + 8 * i4 + 4 * h;
                const u32x2 zz = *(const u32x2*)(zu + rowoff + d);
                const float z0 = __uint_as_float(zz.x << 16), z1 = __uint_as_float(zz.x & 0xffff0000u), z2 = __uint_as_float(zz.y << 16), z3 = __uint_as_float(zz.y & 0xffff0000u);
                const f32x16& a = dt ? acc1 : acc0;
                u32x2 o; o.x = cvt_pk_bf16(z0 * (a[4 * i4] + bs), z1 * (a[4 * i4 + 1] + bs)); o.y = cvt_pk_bf16(z2 * (a[4 * i4 + 2] + bs), z3 * (a[4 * i4 + 3] + bs));
                *(u32x2*)(mrow + d) = o;
            }
    }
}

__device__ __forceinline__ void cmp_gemm2(const bf16_t* hidden, const bf16_t* w2t, bf16_t* kcmp, bf16_t* vcmpT, int kv, int row0, int lane) {
    LAUNDER(lane);
    const int r = lane & 31, h = lane >> 5;
    f32x16 acc[2];
#pragma unroll
    for (int i = 0; i < 16; ++i) { acc[0][i] = 0.f; acc[1][i] = 0.f; }
#pragma unroll
    for (int ks = 0; ks < 16; ++ks) {
        const bf16x8 hf = *(const bf16x8*)(hidden + (size_t)(row0 + r) * 256 + ks * 16 + h * 8);
#pragma unroll
        for (int dt = 0; dt < 2; ++dt) {
            const bf16x8 wf = *(const bf16x8*)(w2t + (size_t)(dt * 32 + r) * 256 + ks * 16 + h * 8);
            if (kv == 0) acc[dt] = MFMA32(wf, hf, acc[dt]);
            else         acc[dt] = MFMA32(hf, wf, acc[dt]);
        }
    }
#pragma unroll
    for (int dt = 0; dt < 2; ++dt)
#pragma unroll
        for (int i4 = 0; i4 < 4; ++i4) {
            u32x2 o; o.x = cvt_pk_bf16(acc[dt][4 * i4], acc[dt][4 * i4 + 1]); o.y = cvt_pk_bf16(acc[dt][4 * i4 + 2], acc[dt][4 * i4 + 3]);
            if (kv == 0) *(u32x2*)(kcmp + (size_t)(row0 >> 5) * 2048 + (dt * 2 + (i4 >> 1)) * 512 + (i4 & 1) * 256 + r * 8 + 4 * h) = o;
            else         *(u32x2*)(vcmpT + (size_t)(row0 >> 5) * 2048 + dt * 1024 + (i4 >> 1) * 512 + h * 256 + r * 8 + (i4 & 1) * 4) = o;
        }
}

constexpr int NSA_WAVE_LDS = 19456;
constexpr float NEG_INF = -__builtin_inff();

__device__ __forceinline__ void load_k(bf16x8 (&kf)[4], const bf16_t* Kt, int lane) {
    const int r = lane & 31, h = lane >> 5;
#pragma unroll
    for (int ks = 0; ks < 4; ++ks) kf[ks] = *(const bf16x8*)(Kt + ks * 512 + lane * 8);
}
__device__ __forceinline__ void load_v(bf16x8 (&vf)[2][2], const bf16_t* vT, int lane) {
    const int r = lane & 31, h = lane >> 5;
#pragma unroll
    for (int dt = 0; dt < 2; ++dt)
#pragma unroll
        for (int s = 0; s < 2; ++s) vf[dt][s] = *(const bf16x8*)(vT + dt * 1024 + s * 512 + lane * 8);
}
__device__ __forceinline__ f32x16 qk_tile(const bf16x8 (&kf)[4], const bf16x8 (&qf)[4]) {
    f32x16 s;
#pragma unroll
    for (int i = 0; i < 16; ++i) s[i] = 0.f;
#pragma unroll
    for (int ks = 0; ks < 4; ++ks) s = MFMA32(kf[ks], qf[ks], s);
    return s;
}
template <int STRIDE> __device__ __forceinline__ void score_tile(f32x16& s, int dl, int dmax, bool lane_ok, bool fast, float lutfar, const LAS float* lutr) {
    if (fast) {
#pragma unroll
        for (int i = 0; i < 16; ++i) s[i] = lane_ok ? (s[i] + lutfar) : NEG_INF;
    } else {
#pragma unroll
        for (int i = 0; i < 16; ++i) {
            const int d = dl - STRIDE * ((i & 3) + 8 * (i >> 2));
            const bool ok = lane_ok && d >= 0 && d < dmax;
            const int di = min(max(d, 0), 128);
            s[i] = ok ? (s[i] + lutr[di]) : NEG_INF;
        }
    }
}
__device__ __forceinline__ void pv_tile(f32x16& o0, f32x16& o1, const f32x16& pr, const bf16x8 (&vf)[2][2]) {
#pragma unroll
    for (int s = 0; s < 2; ++s) {
        u32x4 pk; pk.x = cvt_pk_bf16(pr[8 * s], pr[8 * s + 1]); pk.y = cvt_pk_bf16(pr[8 * s + 2], pr[8 * s + 3]); pk.z = cvt_pk_bf16(pr[8 * s + 4], pr[8 * s + 5]); pk.w = cvt_pk_bf16(pr[8 * s + 6], pr[8 * s + 7]);
        const bf16x8 pb = __builtin_bit_cast(bf16x8, pk);
        o0 = MFMA32(vf[0][s], pb, o0);
        o1 = MFMA32(vf[1][s], pb, o1);
    }
}
template <bool FAST> __device__ __forceinline__ void online_step(f32x16& s, float bias, bool lane_ok, float& m, float& l, f32x16& o0, f32x16& o1, const bf16x8 (&vf)[2][2]) {
    float mx = fmaxf(fmaxf(fmaxf(s[0], s[1]), fmaxf(s[2], s[3])), fmaxf(fmaxf(s[4], s[5]), fmaxf(s[6], s[7])));
    mx = fmaxf(mx, fmaxf(fmaxf(fmaxf(s[8], s[9]), fmaxf(s[10], s[11])), fmaxf(fmaxf(s[12], s[13]), fmaxf(s[14], s[15]))));
    if (FAST) { mx += bias; mx = lane_ok ? mx : NEG_INF; }
    mx = xhalf_max(mx);
    if (__any(mx > m + 8.0f)) {
        const float mnew = (mx > m + 8.0f) ? mx : m;
        const float alpha = fast_exp2(m - mnew);
        l *= alpha; m = mnew;
#pragma unroll
        for (int i = 0; i < 16; ++i) { o0[i] *= alpha; o1[i] *= alpha; }
    }
    const float c = FAST ? (lane_ok ? (m - bias) : __builtin_inff()) : m;
    float ps = 0.f;
#pragma unroll
    for (int i = 0; i < 16; ++i) { s[i] = fast_exp2(s[i] - c); ps += s[i]; }
    ps = xhalf_sum(ps);
    l += ps;
    pv_tile(o0, o1, s, vf);
}

#define MFMA8(a, b, c) __builtin_amdgcn_mfma_f32_32x32x16_fp8_fp8((a), (b), (c), 0, 0, 0)
__device__ __forceinline__ void load_k8(long (&kf)[4], const unsigned char* Kt, int lane) {
#pragma unroll
    for (int ks = 0; ks < 4; ++ks) kf[ks] = *(const long*)(Kt + ks * 512 + lane * 8);
}
__device__ __forceinline__ void load_v8(long (&vf)[2][2], const unsigned char* vT, int lane) {
#pragma unroll
    for (int dt = 0; dt < 2; ++dt)
#pragma unroll
        for (int s = 0; s < 2; ++s) vf[dt][s] = *(const long*)(vT + dt * 1024 + s * 512 + lane * 8);
}
__device__ __forceinline__ long pack_fp8x8(float a0, float a1, float a2, float a3, float a4, float a5, float a6, float a7) {
    int w0 = __builtin_amdgcn_cvt_pk_fp8_f32(a0, a1, 0, false); w0 = __builtin_amdgcn_cvt_pk_fp8_f32(a2, a3, w0, true);
    int w1 = __builtin_amdgcn_cvt_pk_fp8_f32(a4, a5, 0, false); w1 = __builtin_amdgcn_cvt_pk_fp8_f32(a6, a7, w1, true);
    return (long)(((unsigned long long)(unsigned)w1 << 32) | (unsigned long long)(unsigned)w0);
}
template <bool FAST> __device__ __forceinline__ void online_step8(f32x16& s, float bias, bool lane_ok, float& m, float& l, f32x16& o0, f32x16& o1, const long (&vf)[2][2]) {
    float mx = fmaxf(fmaxf(fmaxf(s[0], s[1]), fmaxf(s[2], s[3])), fmaxf(fmaxf(s[4], s[5]), fmaxf(s[6], s[7])));
    mx = fmaxf(mx, fmaxf(fmaxf(fmaxf(s[8], s[9]), fmaxf(s[10], s[11])), fmaxf(fmaxf(s[12], s[13]), fmaxf(s[14], s[15]))));
    if (FAST) { mx = mx * QSCALE + bias; mx = lane_ok ? mx : NEG_INF; }
    mx = xhalf_max(mx);
    if (__any(mx > m + 2.0f)) {
        const float mnew = (mx > m + 2.0f) ? mx : m;
        const float alpha = fast_exp2(m - mnew);
        l *= alpha; m = mnew;
#pragma unroll
        for (int i = 0; i < 16; ++i) { o0[i] *= alpha; o1[i] *= alpha; }
    }
    float ps = 0.f;
    if (FAST) {
        const float c = lane_ok ? (m - bias - 6.0f) : __builtin_inff();
#pragma unroll
        for (int i = 0; i < 16; ++i) { s[i] = fast_exp2(__builtin_fmaf(s[i], QSCALE, -c)); ps += s[i]; }
    } else {
        const float c = m - 6.0f;
#pragma unroll
        for (int i = 0; i < 16; ++i) { s[i] = fast_exp2(s[i] - c); ps += s[i]; }
    }
    ps = xhalf_sum(ps);
    l += ps;
#pragma unroll
    for (int t = 0; t < 2; ++t) {
        const long pb = pack_fp8x8(s[8 * t], s[8 * t + 1], s[8 * t + 2], s[8 * t + 3], s[8 * t + 4], s[8 * t + 5], s[8 * t + 6], s[8 * t + 7]);
        o0 = MFMA8(vf[0][t], pb, o0);
        o1 = MFMA8(vf[1][t], pb, o1);
    }
}

__device__ __forceinline__ float max16(const f32x16& s) {
    const float a = fmaxf(fmaxf(fmaxf(s[0], s[1]), fmaxf(s[2], s[3])), fmaxf(fmaxf(s[4], s[5]), fmaxf(s[6], s[7])));
    const float b = fmaxf(fmaxf(fmaxf(s[8], s[9]), fmaxf(s[10], s[11])), fmaxf(fmaxf(s[12], s[13]), fmaxf(s[14], s[15])));
    return fmaxf(a, b);
}
template <bool FAST> __device__ __forceinline__ void online_step8x2(f32x16& sa, f32x16& sb, float bias, bool lane_ok, float& m, float& l, f32x16& o0, f32x16& o1, const long (&va)[2][2], const long (&vb)[2][2]) {
    float mx = fmaxf(max16(sa), max16(sb));
    if (FAST) { mx = mx * QSCALE + bias; mx = lane_ok ? mx : NEG_INF; }
    mx = xhalf_max(mx);
    if (__any(mx > m + 2.0f)) {
        const float mnew = (mx > m + 2.0f) ? mx : m;
        const float alpha = fast_exp2(m - mnew);
        l *= alpha; m = mnew;
#pragma unroll
        for (int i = 0; i < 16; ++i) { o0[i] *= alpha; o1[i] *= alpha; }
    }
    float ps = 0.f, ps2 = 0.f;
    if (FAST) {
        const float c = lane_ok ? (m - bias - 6.0f) : __builtin_inff();
#pragma unroll
        for (int i = 0; i < 16; ++i) { sa[i] = fast_exp2(__builtin_fmaf(sa[i], QSCALE, -c)); ps += sa[i]; sb[i] = fast_exp2(__builtin_fmaf(sb[i], QSCALE, -c)); ps2 += sb[i]; }
    } else {
        const float c = m - 6.0f;
#pragma unroll
        for (int i = 0; i < 16; ++i) { sa[i] = fast_exp2(sa[i] - c); ps += sa[i]; sb[i] = fast_exp2(sb[i] - c); ps2 += sb[i]; }
    }
    ps += ps2;
    ps = xhalf_sum(ps);
    l += ps;
    const long pa0 = pack_fp8x8(sa[0], sa[1], sa[2], sa[3], sa[4], sa[5], sa[6], sa[7]);
    const long pb0 = pack_fp8x8(sb[0], sb[1], sb[2], sb[3], sb[4], sb[5], sb[6], sb[7]);
    o0 = MFMA8(va[0][0], pa0, o0); o1 = MFMA8(va[1][0], pa0, o1);
    const long pa1 = pack_fp8x8(sa[8], sa[9], sa[10], sa[11], sa[12], sa[13], sa[14], sa[15]);
    o0 = MFMA8(vb[0][0], pb0, o0); o1 = MFMA8(vb[1][0], pb0, o1);
    const long pb1 = pack_fp8x8(sb[8], sb[9], sb[10], sb[11], sb[12], sb[13], sb[14], sb[15]);
    o0 = MFMA8(va[0][1], pa1, o0); o1 = MFMA8(va[1][1], pa1, o1);
    o0 = MFMA8(vb[0][1], pb1, o0); o1 = MFMA8(vb[1][1], pb1, o1);
}

__device__ __forceinline__ void nsa_unit(const Params& p, int bg, int jq, LAS unsigned char* lds, int wave, int lane, bool build_lut) {
    LAUNDER(lane);
    const unsigned char* ws = P_ws(p);
    const bf16_t* qb = (const bf16_t*)(ws + WS_R1 + R_Q);
    const bf16_t* kcmp = (const bf16_t*)(ws + WS_R1 + R_KCMP) + (size_t)bg * NCMP * 64;
    const bf16_t* vcmpT = (const bf16_t*)(ws + WS_R1 + R_VCMPT) + (size_t)bg * NCMP * 64;
    const unsigned char* ks8 = ws + WS_R1 + R_KS + (size_t)bg * S * 64;
    const unsigned char* vs8 = ws + WS_R1 + R_VST + (size_t)bg * S * 64;
    const bf16_t* kwb = (const bf16_t*)(ws + WS_R1 + R_KW) + (size_t)bg * S * 64;
    const bf16_t* vwT = (const bf16_t*)(ws + WS_R1 + R_VWT) + (size_t)bg * S * 64;
    const float* gates = (const float*)(ws + WS_R1 + R_GATES);
    bf16_t* mixed = (bf16_t*)(ws + WS_AN);
    const float* relb = P_in(p, 1);
    const int b = bg >> 1, g = bg & 1;
    LAS float* imp = (LAS float*)(lds + wave * NSA_WAVE_LDS);
    LAS unsigned* selw = (LAS unsigned*)(lds + wave * NSA_WAVE_LDS + 8192);
    LAS float* lut = (LAS float*)(lds + wave * NSA_WAVE_LDS + 8192 + 256);
    LAS int* list = (LAS int*)(lds + wave * NSA_WAVE_LDS + 8192 + 256 + 2112);
    const int c = lane & 31, h = lane >> 5, ql = c >> 2, r = c & 3;
    const int tq0 = 64 * jq + 8 * wave, tq = tq0 + ql;
    const size_t tok = (size_t)b * S + tq;

    if (build_lut) {
        for (int e = lane; e < 4 * 129; e += 64) {
            const int rr = e / 129, n = e % 129;
            int bk = n;
            if (n >= 16) bk = 16 + (n >= 19) + (n >= 21) + (n >= 24) + (n >= 27) + (n >= 31) + (n >= 35) + (n >= 40) + (n >= 46) + (n >= 52) + (n >= 59) + (n >= 67) + (n >= 77) + (n >= 87) + (n >= 99) + (n >= 113);
            lut[rr * 132 + n] = relb[bk * 8 + g * 4 + rr] * LOG2E;
        }
    }
    for (int e = lane; e < 2048; e += 64) imp[e] = 0.f;
    {
        const int k = lane & 7; unsigned w = 0u;
        if (k == 0) w |= 1u;
        if ((jq >> 5) == k) w |= 1u << (jq & 31);
        if (jq >= 1 && ((jq - 1) >> 5) == k) w |= 1u << ((jq - 1) & 31);
        selw[lane] = w;
    }
    asm volatile("s_waitcnt lgkmcnt(0)" ::: "memory");
    __builtin_amdgcn_wave_barrier();
    const LAS float* lutr = lut + r * 132;
    const float lutfar = lutr[128];

    bf16x8 qf[4];
#pragma unroll
    for (int ks = 0; ks < 4; ++ks) qf[ks] = *(const bf16x8*)(qb + tok * 512 + (g * 4 + r) * 64 + ks * 16 + h * 8);
    const float g0 = gates[tok * 24 + (g * 4 + r) * 3 + 0], g1 = gates[tok * 24 + (g * 4 + r) * 3 + 1], g2 = gates[tok * 24 + (g * 4 + r) * 3 + 2];

    f32x16 oa0, oa1;
    bf16x8 kf[4], kn[4], vf[2][2];
    {
        const int jmaxw = (tq0 + 7 - 31) >> 4;
        const int ntile = (jmaxw >= 0) ? (jmaxw >> 5) + 1 : 0;
        float m = -1e30f, l = 0.f;
        if (ntile > 0) load_k(kn, kcmp, lane);
        for (int T = 0; T < ntile; ++T) {
#pragma unroll
            for (int ks = 0; ks < 4; ++ks) kf[ks] = kn[ks];
            if (T + 1 < ntile) load_k(kn, kcmp + (size_t)(T + 1) * 2048, lane);
            f32x16 s = qk_tile(kf, qf);
            const int base = 512 * T + 31;
            const bool fast = (tq0 - base - 16 * 31) >= 128;
            score_tile<16>(s, tq - base - 64 * h, 1 << 30, true, fast, lutfar, lutr);
            float mx = s[0];
#pragma unroll
            for (int i = 1; i < 16; ++i) mx = fmaxf(mx, s[i]);
            mx = xhalf_max(mx);
            const float mnew = fmaxf(m, mx);
            float ps = 0.f;
#pragma unroll
            for (int i = 0; i < 16; ++i) ps += fast_exp2(s[i] - mnew);
            ps = xhalf_sum(ps);
            l = l * fast_exp2(m - mnew) + ps; m = mnew;
        }
        const float c2 = (l > 0.f) ? (m + __builtin_amdgcn_logf(l)) : __builtin_inff();
        const float c2f = c2 - lutfar;
        f32x16 o0, o1;
#pragma unroll
        for (int i = 0; i < 16; ++i) { o0[i] = 0.f; o1[i] = 0.f; }
        if (ntile > 0) load_k(kn, kcmp, lane);
        for (int T = 0; T < ntile; ++T) {
#pragma unroll
            for (int ks = 0; ks < 4; ++ks) kf[ks] = kn[ks];
            load_v(vf, vcmpT + (size_t)T * 2048, lane);
            if (T + 1 < ntile) load_k(kn, kcmp + (size_t)(T + 1) * 2048, lane);
            f32x16 s = qk_tile(kf, qf);
            const int base = 512 * T + 31;
            const bool fast = (tq0 - base - 16 * 31) >= 128;
            if (fast) {
#pragma unroll
                for (int i = 0; i < 16; ++i) s[i] = fast_exp2(s[i] - c2f);
            } else {
                score_tile<16>(s, tq - base - 64 * h, 1 << 30, true, false, lutfar, lutr);
#pragma unroll
                for (int i = 0; i < 16; ++i) s[i] = fast_exp2(s[i] - c2);
            }
#pragma unroll
            for (int i4 = 0; i4 < 4; ++i4) {
                float a = (s[4 * i4] + s[4 * i4 + 1]) + (s[4 * i4 + 2] + 0.5f * s[4 * i4 + 3]);
                float bb = 0.5f * s[4 * i4 + 3];
                a = quad_sum(a); bb = quad_sum(bb);
                if (r == i4) {
                    const int n = 8 * T + 2 * i4 + h;
                    atomicAdd((float*)(imp + ql * 256 + n), a);
                    if (n + 1 < 256) atomicAdd((float*)(imp + ql * 256 + n + 1), bb);
                }
            }
            pv_tile(o0, o1, s, vf);
        }
        {
            LAS float* park = (LAS float*)(lds + wave * NSA_WAVE_LDS + 11264);
#pragma unroll
            for (int i = 0; i < 16; ++i) { park[i * 64 + lane] = g0 * o0[i]; park[(16 + i) * 64 + lane] = g0 * o1[i]; }
        }
    }
    asm volatile("s_waitcnt lgkmcnt(0)" ::: "memory");
    __builtin_amdgcn_wave_barrier();
    if (jq >= 3) {
        float val[8][4];
#pragma unroll
        for (int qq = 0; qq < 8; ++qq) {
            const f32x4 iv = *(const LAS f32x4*)(imp + qq * 256 + 4 * lane);
#pragma unroll
            for (int e = 0; e < 4; ++e) { const int n = 4 * lane + e; val[qq][e] = (n >= 1 && n <= jq - 2) ? iv[e] : -1.0f; }
        }
        unsigned mybits[8];
#pragma unroll
        for (int qq = 0; qq < 8; ++qq) mybits[qq] = 0u;
        for (int round = 0; round < 13; ++round) {
#pragma unroll
            for (int qq = 0; qq < 8; ++qq) {
                const float lb = fmaxf(fmaxf(val[qq][0], val[qq][1]), fmaxf(val[qq][2], val[qq][3]));
                const float wm = wave_max_fast(lb);
                const unsigned long long bal = __ballot(lb == wm);
                const int wl = __builtin_ctzll(bal | (1ull << 63));
                const bool win = (lane == wl) && (wm >= 0.f);
                const int e = (val[qq][0] == wm) ? 0 : ((val[qq][1] == wm) ? 1 : ((val[qq][2] == wm) ? 2 : 3));
                mybits[qq] |= win ? (1u << e) : 0u;
                val[qq][0] = (win && e == 0) ? -2.0f : val[qq][0]; val[qq][1] = (win && e == 1) ? -2.0f : val[qq][1];
                val[qq][2] = (win && e == 2) ? -2.0f : val[qq][2]; val[qq][3] = (win && e == 3) ? -2.0f : val[qq][3];
            }
        }
#pragma unroll
        for (int qq = 0; qq < 8; ++qq)
            if (mybits[qq]) atomicOr((unsigned*)(selw + qq * 8 + (lane >> 3)), mybits[qq] << ((lane & 7) * 4));
    }
    asm volatile("s_waitcnt lgkmcnt(0)" ::: "memory");
    __builtin_amdgcn_wave_barrier();
    {
        unsigned uwA = 0u, uwB = 0u;
        if (lane < 8) {
#pragma unroll
            for (int qq = 0; qq < 4; ++qq) { uwA |= selw[qq * 8 + lane]; uwB |= selw[(qq + 4) * 8 + lane]; }
        }
        int cntA = 0, cntB = 0;
        for (int k = 0; k < 8; ++k) {
            unsigned bits = (unsigned)__builtin_amdgcn_readlane((int)uwA, k);
            while (bits) { const int bit = __builtin_ctz(bits); bits &= bits - 1u; if (lane == 0) list[cntA] = 32 * k + bit; ++cntA; }
            bits = (unsigned)__builtin_amdgcn_readlane((int)uwB, k);
            while (bits) { const int bit = __builtin_ctz(bits); bits &= bits - 1u; if (lane == 0) list[64 + cntB] = 32 * k + bit; ++cntB; }
        }
        asm volatile("s_waitcnt lgkmcnt(0)" ::: "memory");
        __builtin_amdgcn_wave_barrier();
        LAS float* ostage = imp;
        const int c16 = lane & 15, fq = lane >> 4, q4 = c16 >> 2, r16 = c16 & 3;
        const LAS float* lutr16 = lut + r16 * 132;
        const float lutfar16 = lutr16[128];
        for (int grp = 0; grp < 2; ++grp) {
            const int cnt = grp ? cntB : cntA, lbase = grp * 64;
            const int tqg = tq0 + 4 * grp + q4, tq0g = tq0 + 4 * grp;
            long q8[2];
            {
                const bf16_t* qp = qb + ((size_t)b * S + tqg) * 512 + (g * 4 + r16) * 64 + 8 * fq;
#pragma unroll
                for (int ks = 0; ks < 2; ++ks) {
                    const bf16x8 qv = *(const bf16x8*)(qp + 32 * ks);
                    float f[8];
#pragma unroll
                    for (int e = 0; e < 8; ++e) f[e] = bf2f((bf16_t)qv[e]) * 4.0f;
                    q8[ks] = pack_fp8x8(f[0], f[1], f[2], f[3], f[4], f[5], f[6], f[7]);
                }
            }
            float m = -1e30f;
            f32x4 lacc = (f32x4){0.f, 0.f, 0.f, 0.f};
            const long ones8 = 0x3838383838383838L;
            f32x4 o[4];
#pragma unroll
            for (int dt = 0; dt < 4; ++dt) o[dt] = (f32x4){0.f, 0.f, 0.f, 0.f};
            const int npair = (cnt + 1) >> 1;
            if (lane == 0 && (cnt & 1)) list[lbase + cnt] = 0;
            asm volatile("s_waitcnt lgkmcnt(0)" ::: "memory");
            __builtin_amdgcn_wave_barrier();
            long k8[2][8], v8[2][8];
            int n0 = __builtin_amdgcn_readfirstlane(list[lbase]), n1 = __builtin_amdgcn_readfirstlane(list[lbase + 1]);
#pragma unroll
            for (int i = 0; i < 4; ++i) { const l64x2 t0 = *(const l64x2*)(ks8 + (size_t)n0 * 4096 + i * 1024 + lane * 16), t1 = *(const l64x2*)(ks8 + (size_t)n1 * 4096 + i * 1024 + lane * 16);
                k8[0][2 * i] = t0[0]; k8[0][2 * i + 1] = t0[1]; k8[1][2 * i] = t1[0]; k8[1][2 * i + 1] = t1[1]; }
            for (int it = 0; it < npair; ++it) {
                const int nb[2] = {n0, n1};
                const bool real1 = (2 * it + 1) < cnt;
#pragma unroll
                for (int u = 0; u < 2; ++u)
#pragma unroll
                    for (int i = 0; i < 4; ++i) { const l64x2 t = *(const l64x2*)(vs8 + (size_t)nb[u] * 4096 + i * 1024 + lane * 16); v8[u][2 * i] = t[0]; v8[u][2 * i + 1] = t[1]; }
                bool ok[2];
                ok[0] = (selw[(grp * 4 + q4) * 8 + (nb[0] >> 5)] >> (nb[0] & 31)) & 1u;
                ok[1] = real1 && ((selw[(grp * 4 + q4) * 8 + (nb[1] >> 5)] >> (nb[1] & 31)) & 1u);
                const int bmax = real1 ? max(nb[0], nb[1]) : nb[0];
                const bool fast = (tq0g - 64 * bmax - 63) >= 128;
                const bool fresh = m < -1e29f;
                const float mref = fresh ? 0.f : m;
                float ini[2];
                ini[0] = fast ? (ok[0] ? -(mref - lutfar16 - 6.0f) : NEG_INF) : 0.f;
                ini[1] = fast ? (ok[1] ? -(mref - lutfar16 - 6.0f) : NEG_INF) : 0.f;
                f32x4 sc[2][4];
#pragma unroll
                for (int u = 0; u < 2; ++u)
#pragma unroll
                    for (int kt = 0; kt < 4; ++kt) {
                        sc[u][kt] = __builtin_amdgcn_mfma_f32_16x16x32_fp8_fp8(k8[u][2 * kt], q8[0], (f32x4){ini[u], ini[u], ini[u], ini[u]}, 0, 0, 0);
                        sc[u][kt] = __builtin_amdgcn_mfma_f32_16x16x32_fp8_fp8(k8[u][2 * kt + 1], q8[1], sc[u][kt], 0, 0, 0);
                    }
                if (it + 1 < npair) {
                    n0 = __builtin_amdgcn_readfirstlane(list[lbase + 2 * it + 2]); n1 = __builtin_amdgcn_readfirstlane(list[lbase + 2 * it + 3]);
#pragma unroll
                    for (int i = 0; i < 4; ++i) { const l64x2 t0 = *(const l64x2*)(ks8 + (size_t)n0 * 4096 + i * 1024 + lane * 16), t1 = *(const l64x2*)(ks8 + (size_t)n1 * 4096 + i * 1024 + lane * 16);
                        k8[0][2 * i] = t0[0]; k8[0][2 * i + 1] = t0[1]; k8[1][2 * i] = t1[0]; k8[1][2 * i + 1] = t1[1]; }
                }
                if (fast) {
                    float t = NEG_INF;
#pragma unroll
                    for (int u = 0; u < 2; ++u) {
                        float tt = fmaxf(fmaxf(fmaxf(sc[u][0][0], sc[u][0][1]), fmaxf(sc[u][0][2], sc[u][0][3])), fmaxf(fmaxf(sc[u][1][0], sc[u][1][1]), fmaxf(sc[u][1][2], sc[u][1][3])));
                        tt = fmaxf(tt, fmaxf(fmaxf(fmaxf(sc[u][2][0], sc[u][2][1]), fmaxf(sc[u][2][2], sc[u][2][3])), fmaxf(fmaxf(sc[u][3][0], sc[u][3][1]), fmaxf(sc[u][3][2], sc[u][3][3]))));
                        t = fmaxf(t, tt);
                    }
                    { auto t1 = __builtin_amdgcn_permlane16_swap(__float_as_uint(t), __float_as_uint(t), false, false); t = fmaxf(__uint_as_float(t1[0]), __uint_as_float(t1[1])); t = xhalf_max(t); }
                    const float mxt = t - 6.0f + mref;
                    const bool need = fresh ? (t > NEG_INF) : (mxt > m + 2.0f);
                    if (__any(need)) {
                        const float mnew = need ? mxt : m;
                        const float delta = need ? (mnew - mref) : 0.f;
                        const float alpha = (need && !fresh) ? fast_exp2(m - mnew) : 1.0f;
                        lacc = lacc * alpha; m = mnew;
#pragma unroll
                        for (int dt = 0; dt < 4; ++dt) o[dt] = o[dt] * alpha;
#pragma unroll
                        for (int u = 0; u < 2; ++u)
#pragma unroll
                            for (int kt = 0; kt < 4; ++kt) sc[u][kt] = sc[u][kt] - delta;
                    }
#pragma unroll
                    for (int u = 0; u < 2; ++u)
#pragma unroll
                        for (int kt = 0; kt < 4; ++kt)
#pragma unroll
                            for (int e = 0; e < 4; ++e) sc[u][kt][e] = fast_exp2(sc[u][kt][e]);
                } else {
                    float mx = NEG_INF;
#pragma unroll
                    for (int u = 0; u < 2; ++u)
#pragma unroll
                        for (int kt = 0; kt < 4; ++kt)
#pragma unroll
                            for (int e = 0; e < 4; ++e) {
                                const int d = tqg - 64 * nb[u] - 16 * kt - 4 * fq - e;
                                const bool okk = ok[u] && d >= 0;
                                const float v = okk ? (sc[u][kt][e] + lutr16[min(max(d, 0), 128)]) : NEG_INF;
                                sc[u][kt][e] = v; mx = fmaxf(mx, v);
                            }
                    { auto t1 = __builtin_amdgcn_permlane16_swap(__float_as_uint(mx), __float_as_uint(mx), false, false); mx = fmaxf(__uint_as_float(t1[0]), __uint_as_float(t1[1])); mx = xhalf_max(mx); }
                    if (__any(mx > m + 2.0f)) {
                        const float mnew = (mx > m + 2.0f) ? mx : m;
                        const float alpha = fast_exp2(m - mnew);
                        lacc = lacc * alpha; m = mnew;
#pragma unroll
                        for (int dt = 0; dt < 4; ++dt) o[dt] = o[dt] * alpha;
                    }
                    const float cexp = m - 6.0f;
#pragma unroll
                    for (int u = 0; u < 2; ++u)
#pragma unroll
                        for (int kt = 0; kt < 4; ++kt)
#pragma unroll
                            for (int e = 0; e < 4; ++e) sc[u][kt][e] = fast_exp2(sc[u][kt][e] - cexp);
                }
#pragma unroll
                for (int u = 0; u < 2; ++u) {
                    const long pb0 = pack_fp8x8(sc[u][0][0], sc[u][0][1], sc[u][0][2], sc[u][0][3], sc[u][1][0], sc[u][1][1], sc[u][1][2], sc[u][1][3]);
                    const long pb1 = pack_fp8x8(sc[u][2][0], sc[u][2][1], sc[u][2][2], sc[u][2][3], sc[u][3][0], sc[u][3][1], sc[u][3][2], sc[u][3][3]);
#pragma unroll
                    for (int dt = 0; dt < 4; ++dt) {
                        o[dt] = __builtin_amdgcn_mfma_f32_16x16x32_fp8_fp8(v8[u][2 * dt], pb0, o[dt], 0, 0, 0);
                        o[dt] = __builtin_amdgcn_mfma_f32_16x16x32_fp8_fp8(v8[u][2 * dt + 1], pb1, o[dt], 0, 0, 0);
                    }
                    lacc = __builtin_amdgcn_mfma_f32_16x16x32_fp8_fp8(ones8, pb0, lacc, 0, 0, 0);
                    lacc = __builtin_amdgcn_mfma_f32_16x16x32_fp8_fp8(ones8, pb1, lacc, 0, 0, 0);
                }
            }
            const float l = lacc[0];
            const float invl = (l > 0.f) ? 1.0f / l : 0.f;
#pragma unroll
            for (int dt = 0; dt < 4; ++dt) *(LAS f32x4*)(ostage + ((grp * 4 + q4) * 4 + r16) * 64 + 16 * dt + 4 * fq) = o[dt] * invl;
        }
        asm volatile("s_waitcnt lgkmcnt(0)" ::: "memory");
        __builtin_amdgcn_wave_barrier();
        {
            const LAS float* park = (const LAS float*)(lds + wave * NSA_WAVE_LDS + 11264);
#pragma unroll
            for (int i = 0; i < 16; ++i) { oa0[i] = park[i * 64 + lane]; oa1[i] = park[(16 + i) * 64 + lane]; }
        }
#pragma unroll
        for (int dt = 0; dt < 2; ++dt)
#pragma unroll
            for (int i4 = 0; i4 < 4; ++i4) {
                const f32x4 v = *(const LAS f32x4*)(ostage + (ql * 4 + r) * 64 + 32 * dt + 8 * i4 + 4 * h);
                if (dt == 0) { oa0[4 * i4] += g1 * v[0]; oa0[4 * i4 + 1] += g1 * v[1]; oa0[4 * i4 + 2] += g1 * v[2]; oa0[4 * i4 + 3] += g1 * v[3]; }
                else         { oa1[4 * i4] += g1 * v[0]; oa1[4 * i4 + 1] += g1 * v[1]; oa1[4 * i4 + 2] += g1 * v[2]; oa1[4 * i4 + 3] += g1 * v[3]; }
            }
        asm volatile("s_waitcnt lgkmcnt(0)" ::: "memory");
        __builtin_amdgcn_wave_barrier();
    }
    {
        {
            const bf16_t* qp = qb + tok * 512 + (g * 4 + r) * 64 + h * 8;
            asm volatile("" : "+v"(qp));
#pragma unroll
            for (int ks = 0; ks < 4; ++ks) qf[ks] = *(const bf16x8*)(qp + ks * 16);
        }
        const int T0 = max(0, (tq0 - 511) >> 5), T1 = (tq0 + 7) >> 5;
        float m = -1e30f, l = 0.f;
        f32x16 o0, o1;
#pragma unroll
        for (int i = 0; i < 16; ++i) { o0[i] = 0.f; o1[i] = 0.f; }
        load_k(kn, kwb + (size_t)(32 * T0) * 64, lane);
        for (int T = T0; T <= T1; ++T) {
#pragma unroll
            for (int ks = 0; ks < 4; ++ks) kf[ks] = kn[ks];
            load_v(vf, vwT + (size_t)T * 2048, lane);
            if (T < T1) load_k(kn, kwb + (size_t)(32 * (T + 1)) * 64, lane);
            const int base = 32 * T;
            f32x16 s = qk_tile(kf, qf);
            if (((tq0 - base - 31) >= 128) && ((tq0 + 7 - base) < 512)) online_step<true>(s, lutfar, true, m, l, o0, o1, vf);
            else { score_tile<1>(s, tq - base - 4 * h, 512, true, false, lutfar, lutr); online_step<false>(s, 0.f, true, m, l, o0, o1, vf); }
        }
        const float sc = (l > 0.f) ? g2 / l : 0.f;
#pragma unroll
        for (int i = 0; i < 16; ++i) { oa0[i] += sc * o0[i]; oa1[i] += sc * o1[i]; }
    }
    bf16_t* orow = mixed + tok * 1024 + (g * 4 + r) * 64;
#pragma unroll
    for (int dt = 0; dt < 2; ++dt)
#pragma unroll
        for (int i4 = 0; i4 < 4; ++i4) {
            const f32x16& a = dt ? oa1 : oa0;
            u32x2 o; o.x = cvt_pk_bf16(a[4 * i4], a[4 * i4 + 1]); o.y = cvt_pk_bf16(a[4 * i4 + 2], a[4 * i4 + 3]);
            *(u32x2*)(orow + 32 * dt + 8 * i4 + 4 * h) = o;
        }
}


#define XB_TMO      128
#define XB_XCNT(j)  (256  + 64 * (j))
#define XB_XSUB(j)  (1280 + 64 * (j))
#define XB_XGEN(j)  (2304 + 64 * (j))
#define XB_TOP      3328
#define XB_TOPGEN   3392
#define XCD_BAR_WORDS 3456
#define XB_SPIN_CAP (1u << 22)
__device__ __forceinline__ unsigned xb_ld(unsigned* p)              { return __hip_atomic_load(p, __ATOMIC_RELAXED, __HIP_MEMORY_SCOPE_AGENT); }
__device__ __forceinline__ unsigned xb_add(unsigned* p, unsigned v) { return __hip_atomic_fetch_add(p, v, __ATOMIC_RELAXED, __HIP_MEMORY_SCOPE_AGENT); }
__device__ __forceinline__ unsigned xb_xcc_id() { return (unsigned)__builtin_amdgcn_s_getreg((3 << 11) | 20) & 0xFu; }
#define XB_SPIN(cond, bar) do { unsigned _sp = 0; while (cond) { __builtin_amdgcn_s_sleep(1); \
    if ((++_sp & 255u) == 0u) { if (xb_ld(&(bar)[XB_TMO])) break; if (_sp > XB_SPIN_CAP) { atomicAdd(&(bar)[XB_TMO], 1u); break; } } } } while (0)
__device__ __forceinline__ void xcd_barrier_complete(unsigned* bar, unsigned x, unsigned& nloc, unsigned& nx) {
    const unsigned G = gridDim.x * gridDim.y * gridDim.z;
    unsigned sum, cnt, mine, sp = 0u;
    for (;;) {
        sum = 0u; cnt = 0u; mine = 0u;
#pragma unroll
        for (unsigned j = 0; j < 16; ++j) { const unsigned c = xb_ld(&bar[XB_XCNT(j)]); sum += c; cnt += (c > 0u) ? 1u : 0u; mine = (j == x) ? c : mine; }
        if (sum == G) break;
        __builtin_amdgcn_s_sleep(1);
        if ((++sp & 255u) == 0u) { if (xb_ld(&bar[XB_TMO])) break; if (sp > XB_SPIN_CAP) { atomicAdd(&bar[XB_TMO], 1u); break; } }
    }
    nloc = mine > 0u ? mine : 1u; nx = cnt > 0u ? cnt : 1u;
}
__device__ __forceinline__ void xcd_barrier(unsigned* bar, volatile LAS unsigned* st) {
    asm volatile("s_waitcnt vmcnt(0)" ::: "memory");
    __syncthreads();
    if (threadIdx.x == 0) {
        const unsigned x = xb_xcc_id();
        __builtin_amdgcn_s_waitcnt(0);
        unsigned nloc = st[0], nx = st[1];
        if (nloc == 0u) { xcd_barrier_complete(bar, x, nloc, nx); st[0] = nloc; st[1] = nx; }
        const unsigned old = xb_add(&bar[XB_XSUB(x)], 1u);
        const unsigned gen = old / nloc;
        if (old + 1u == (gen + 1u) * nloc) {
            __builtin_amdgcn_fence(__ATOMIC_RELEASE, "agent");
            asm volatile("s_waitcnt vmcnt(0)" ::: "memory");
            const unsigned og = xb_add(&bar[XB_TOP], 1u);
            const unsigned tg = og / nx;
            if (og + 1u == (tg + 1u) * nx) xb_add(&bar[XB_TOPGEN], 1u);
            else XB_SPIN(xb_ld(&bar[XB_TOPGEN]) == tg, bar);
            __builtin_amdgcn_fence(__ATOMIC_ACQUIRE, "agent");
            xb_add(&bar[XB_XGEN(x)], 1u);
            asm volatile("s_waitcnt vmcnt(0)" ::: "memory");
        } else {
            XB_SPIN(xb_ld(&bar[XB_XGEN(x)]) == gen, bar);
            __builtin_amdgcn_fence(__ATOMIC_ACQUIRE, "agent");
            asm volatile("s_waitcnt vmcnt(0)" ::: "memory");
        }
    }
    __syncthreads();
}

__global__ void __launch_bounds__(NTHREADS, 2) fwd_megakernel(Params p) {
    extern __shared__ __attribute__((aligned(16))) unsigned char lds_raw[];
    LAS unsigned char* lds = (LAS unsigned char*)lds_raw;
    cg::grid_group grid = cg::this_grid();
#define TID_F ({ int _t = threadIdx.x; LAUNDER(_t); _t; })
#define LANE_F (TID_F & 63)
#define WAVE_F (__builtin_amdgcn_readfirstlane(TID_F >> 6))
    const int G = gridDim.x, bx = blockIdx.x;
    const int NGW = G * NWAVES;
#define GW_F (bx * NWAVES + WAVE_F)
#define FRESH_WS unsigned char* ws = P_ws(p); bf16_t* AN = (bf16_t*)(ws + WS_AN); float* MIX = (float*)(ws + WS_MIX); (void)AN; (void)MIX

    { const int tid = TID_F; if (tid < 16) ((LAS unsigned*)(lds + LDS_BYTES - 64))[tid] = 0u; }
    if (bx == 0) { unsigned* barw = (unsigned*)P_ws(p); for (int i = TID_F; i < XCD_BAR_WORDS; i += NTHREADS) barw[i] = 0u; }
    __syncthreads();
    {
        FRESH_WS;
        const int tid = TID_F, lane = tid & 63, wave = __builtin_amdgcn_readfirstlane(tid >> 6), gw = bx * NWAVES + wave;
        LAS float* scr = (LAS float*)(lds + wave * 17408);
        for (int layer = 0; layer < DEPTH; ++layer) {
            unsigned char* wl = ws + WS_W + (size_t)layer * W_LAYER;
            const int I_IN = 16 * (NINP / 64), I_OUT = 16 * 16, I_GU = 16 * (NGU / 64), I_DN = 44 * 16, I_C1 = 32 * 4, I_C2 = 4 * 1;
            const int NIT = I_IN + I_OUT + I_GU + I_DN + 2 * I_C1 + 2 * I_C2;
            for (int it = gw; it < NIT; it += NGW) {
                int r = it;
                if (r < I_IN) { transpose_item<1>(P_in(p, 6) + (size_t)layer * DM * INW, DM, INW, (bf16_t*)(wl + W_IN), NINP / 64, r, scr, lane, P_in(p, 2) + layer * DM); continue; } r -= I_IN;
                if (r < I_OUT) { transpose_item<0>(P_in(p, 17) + (size_t)layer * DM * DM, DM, DM, (bf16_t*)(wl + W_OUT), 16, r, scr, lane); continue; } r -= I_OUT;
                if (r < I_GU) { transpose_item<2>(P_in(p, 18) + (size_t)layer * DM * NGU, DM, NGU, (bf16_t*)(wl + W_GU), NGU / 64, r, scr, lane, P_in(p, 4) + layer * DM); continue; } r -= I_GU;
                if (r < I_DN) { transpose_item<0>(P_in(p, 19) + (size_t)layer * DFF * DM, DFF, DM, (bf16_t*)(wl + W_DN), 16, r, scr, lane); continue; } r -= I_DN;
                if (r < I_C1) { transpose_item<0>(P_in(p, 8) + (size_t)layer * 2048 * 256, 2048, 256, (bf16_t*)(wl + W_C1K), 4, r, scr, lane); continue; } r -= I_C1;
                if (r < I_C1) { transpose_item<0>(P_in(p, 11) + (size_t)layer * 2048 * 256, 2048, 256, (bf16_t*)(wl + W_C1V), 4, r, scr, lane); continue; } r -= I_C1;
                if (r < I_C2) { transpose_item<0>(P_in(p, 9) + (size_t)layer * 256 * 64, 256, 64, (bf16_t*)(wl + W_C2K), 1, r, scr, lane); continue; } r -= I_C2;
                transpose_item<0>(P_in(p, 12) + (size_t)layer * 256 * 64, 256, 64, (bf16_t*)(wl + W_C2V), 1, r, scr, lane);
            }
        }
        __syncthreads();
        if (bx >= G - 2 * DEPTH) {
            const int id = G - 1 - bx, layer = id >> 1, kv = id & 1;
            const float* pos = P_in(p, kv ? 10 : 7) + (size_t)layer * 2048;
            const float* w1 = P_in(p, kv ? 11 : 8) + (size_t)layer * 2048 * 256;
            LAS float* red = (LAS float*)lds;
            f32x4 acc4 = (f32x4){0.f, 0.f, 0.f, 0.f};
#pragma unroll 8
            for (int i = wave * 256; i < wave * 256 + 256; ++i) { const f32x4 w = *(const f32x4*)(w1 + (size_t)i * 256 + 4 * lane); acc4 = acc4 + w * pos[i]; }
            red[wave * 256 + 4 * lane + 0] = acc4[0]; red[wave * 256 + 4 * lane + 1] = acc4[1]; red[wave * 256 + 4 * lane + 2] = acc4[2]; red[wave * 256 + 4 * lane + 3] = acc4[3];
            __syncthreads();
            if (tid < 256) { float sum = 0.f;
#pragma unroll
                for (int w = 0; w < 8; ++w) sum += red[w * 256 + tid];
                ((float*)(ws + WS_W + (size_t)layer * W_LAYER + (kv ? W_CBV : W_CBK)))[tid] = sum; }
            __syncthreads();
        }
        row_pass(P_in(p, 0), (bf16_t*)(ws + WS_HB), nullptr, nullptr, (float*)(ws + WS_RS), nullptr, gw, NGW, lane);
    }
    grid.sync();
    if (TID_F == 0) (void)xb_add(&((unsigned*)P_ws(p))[XB_XCNT(xb_xcc_id())], 1u);

#pragma unroll 1
    for (int layer = 0; layer < DEPTH; ++layer) {
        const size_t wloff = WS_W + (size_t)layer * W_LAYER;
#ifndef SKIP_PA
        {
            FRESH_WS; unsigned char* wl = ws + wloff;
            pg8::Gemm g{(const bf16_t*)(ws + WS_HB), (const bf16_t*)(wl + W_IN), MT, NINP, DM, DM};
            pg8::StaticOrder so; so.init(MT, NINP, G, bx, REP_PA);
            pg8::EpiIn E{ws + WS_R1, (const float*)(ws + WS_RS)};
            pg8::gemm_phase<pg8::EpiIn>(lds, g, so, E);
        }
#endif
        GSYNC();
#ifndef SKIP_PB
        for (int rep = 0; rep < REP_PB; ++rep) {
            FRESH_WS; unsigned char* wl = ws + wloff;
            for (int kv = 0; kv < 2; ++kv) {
                const int c = kv ? ((bx + (G >> 1)) % G) : bx;
                if (c < 16) {
                    bf16_t* hid = (bf16_t*)(ws + WS_R1 + R_HID) + (size_t)kv * 4096 * 256;
                    pg8::Gemm g{(const bf16_t*)(ws + WS_R1 + (kv ? R_VC : R_KC)), (const bf16_t*)(wl + (kv ? W_C1V : W_C1K)), 4096, 256, 2048, 1024};
                    pg8::StaticOrder so; so.init(4096, 256, G, c);
                    pg8::EpiCmp1 E{hid, (const float*)(wl + (kv ? W_CBV : W_CBK))};
                    pg8::gemm_phase<pg8::EpiCmp1>(lds, g, so, E);
                    pg8::Unit u; so.next(0, u);
                    asm volatile("s_waitcnt vmcnt(0)" ::: "memory");
                    __builtin_amdgcn_fence(__ATOMIC_RELEASE, "agent");
                    __syncthreads();
                    __builtin_amdgcn_fence(__ATOMIC_ACQUIRE, "agent");
                    cmp_gemm2(hid, (const bf16_t*)(wl + (kv ? W_C2V : W_C2K)), (bf16_t*)(ws + WS_R1 + R_KCMP), (bf16_t*)(ws + WS_R1 + R_VCMPT), kv, u.pm * 256 + WAVE_F * 32, LANE_F);
                    __syncthreads();
                }
            }
            if (G == 256) {
                const bool is_cmp = (bx < 16) || (bx >= 128 && bx < 144);
                if (!is_cmp) {
                    const int idx = (bx < 128) ? (bx - 16) : (bx - 32);
                    gmlp_unit(p, layer, idx, lds, WAVE_F, LANE_F);
                    if (idx + 224 < MT / 128) gmlp_unit(p, layer, idx + 224, lds, WAVE_F, LANE_F);
                }
            } else {
                for (int ch = bx; ch < MT / 128; ch += G) gmlp_unit(p, layer, ch, lds, WAVE_F, LANE_F);
            }
        }
#endif
        GSYNC();
        {
#if NSA_ENABLE
            __syncthreads();
            for (int rep = 0; rep < REP_PC; ++rep) {
                if (G == 256) {
                    const int x = bx & 7, y = bx >> 3, bg = x >> 1, j = (x & 1) * 32 + y;
                    for (int i = 0; i < 4; ++i) {
                        const int jq = (i >> 1) * 128 + ((i & 1) ? (127 - j) : j);
                        nsa_unit(p, bg, jq, lds, WAVE_F, LANE_F, i == 0);
                    }
                } else {
                    for (int i = 0; bx + i * G < 1024; ++i) {
                        const int u = bx + i * G;
                        const int bg = u >> 8, x = u & 255;
                        const int jq = (bg & 1) ? (255 - x) : x;
                        nsa_unit(p, bg, jq, lds, WAVE_F, LANE_F, true);
                    }
                }
            }
#else
            FRESH_WS;
            bf16_t* mixed = (bf16_t*)(ws + WS_AN);
            for (int m = GW_F; m < MT; m += NGW) { u32x4* o = (u32x4*)(mixed + (size_t)m * 1024); o[LANE_F] = (u32x4){0u, 0u, 0u, 0u}; }
#endif
        }
        GSYNC();
#ifndef SKIP_PD
        {
            FRESH_WS; unsigned char* wl = ws + wloff;
            pg8::Gemm g{AN, (const bf16_t*)(wl + W_OUT), MT, DM, DM, DM};
            pg8::StaticOrder so; so.init(MT, DM, G, bx, REP_PD);
            pg8::EpiBf16 E{(bf16_t*)MIX, DM};
            pg8::gemm_phase<pg8::EpiBf16>(lds, g, so, E);
        }
#endif
        GSYNC();
        { FRESH_WS; row_pass(nullptr, (bf16_t*)(ws + WS_HB), (const bf16_t*)MIX, P_in(p, 3) + layer * DM, (float*)(ws + WS_RS), nullptr, GW_F, NGW, LANE_F); }
        GSYNC();
#ifndef SKIP_PF
        {
            FRESH_WS; unsigned char* wl = ws + wloff;
            pg8::Gemm g{(const bf16_t*)(ws + WS_HB), (const bf16_t*)(wl + W_GU), MT, NGU, DM, DM};
            pg8::StaticOrder so; so.init(MT, NGU, G, bx, REP_PF);
            pg8::EpiGU E{(bf16_t*)(ws + WS_R1), (const float*)(ws + WS_RS)};
            pg8::gemm_phase<pg8::EpiGU>(lds, g, so, E);
        }
#endif
        GSYNC();
#ifndef SKIP_PG
        {
            FRESH_WS; unsigned char* wl = ws + wloff;
            pg8::Gemm g{(const bf16_t*)(ws + WS_R1), (const bf16_t*)(wl + W_DN), MT, DM, DFF, DFF};
            pg8::StaticOrder so; so.init(MT, DM, G, bx, REP_PG);
            pg8::EpiBf16 E{(bf16_t*)MIX, DM};
            pg8::gemm_phase<pg8::EpiBf16>(lds, g, so, E);
        }
#endif
        GSYNC();
        { FRESH_WS; row_pass(nullptr, (bf16_t*)(ws + WS_HB), (const bf16_t*)MIX, P_in(p, 5) + layer * DM, (float*)(ws + WS_RS), (layer + 1 < DEPTH) ? nullptr : P_out(p), GW_F, NGW, LANE_F); }
        if (layer + 1 < DEPTH) GSYNC();
    }
}

extern "C" void kernel_launch(void* const* d_in, const int* in_sizes, int n_in, void* d_out, int out_size, void* d_ws, size_t ws_size, hipStream_t stream) {
    static int grid = 0;
    if (grid == 0) {
        if (n_in != 20 || out_size != MT * DM || ws_size < WS_END) { fprintf(stderr, "kernel_launch: unexpected shapes (n_in %d out %d ws %zu need %zu)\n", n_in, out_size, ws_size, (size_t)WS_END); grid = -1; return; }
        int dev = 0, cus = 0, per_cu = 0;
        hipGetDevice(&dev);
        hipDeviceGetAttribute(&cus, hipDeviceAttributeMultiprocessorCount, dev);
        if (hipFuncSetAttribute((const void*)fwd_megakernel, hipFuncAttributeMaxDynamicSharedMemorySize, LDS_BYTES) != hipSuccess) { fprintf(stderr, "kernel_launch: hipFuncSetAttribute failed\n"); grid = -1; return; }
        if (hipOccupancyMaxActiveBlocksPerMultiprocessor(&per_cu, (const void*)fwd_megakernel, NTHREADS, LDS_BYTES) != hipSuccess || per_cu < 1) { fprintf(stderr, "kernel_launch: occupancy query says %d\n", per_cu); per_cu = 1; }
        (void)hipGetLastError();
        grid = cus;
        if (grid > 256) grid = 256;
    }
    if (grid < 0) return;
    Params p{};
    for (int i = 0; i < 20; ++i) p.in[i] = (const float*)d_in[i];
    p.out = (float*)d_out; p.ws = (unsigned char*)d_ws;
    void* args[] = {&p};
    hipError_t e = hipLaunchCooperativeKernel((const void*)fwd_megakernel, dim3(grid), dim3(NTHREADS), args, LDS_BYTES, stream);
    if (e != hipSuccess) fprintf(stderr, "cooperative launch failed: %s (grid %d)\n", hipGetErrorString(e), grid);
}
```

```cpp
#include <hip/hip_runtime.h>
#include <hip/hip_cooperative_groups.h>
#include <cstdio>
#include <cstdint>
namespace cg = cooperative_groups;

#define LAS __attribute__((address_space(3)))
typedef unsigned short bf16_t;
typedef short bf16x8 __attribute__((ext_vector_type(8)));
typedef short s16x4 __attribute__((ext_vector_type(4)));
typedef float f32x2 __attribute__((ext_vector_type(2)));
typedef float f32x4 __attribute__((ext_vector_type(4)));
typedef float f32x16 __attribute__((ext_vector_type(16)));
typedef unsigned u32x2 __attribute__((ext_vector_type(2)));
typedef unsigned u32x4 __attribute__((ext_vector_type(4)));
typedef long l64x2 __attribute__((ext_vector_type(2)));

#ifndef REP_PA
#define REP_PA 1
#endif
#ifndef REP_PB
#define REP_PB 1
#endif
#ifndef REP_PC
#define REP_PC 1
#endif
#ifndef REP_PD
#define REP_PD 1
#endif
#ifndef REP_PF
#define REP_PF 1
#endif
#ifndef REP_PG
#define REP_PG 1
#endif
#ifndef SYNC_REP
#define SYNC_REP 1
#endif
#define GSYNC() do { for (int _r = 0; _r < SYNC_REP; ++_r) xcd_barrier((unsigned*)P_ws(p), (volatile LAS unsigned*)(lds + LDS_BYTES - 64)); } while (0)
#ifndef NSA_ENABLE
#define NSA_ENABLE 1
#endif

constexpr int NB = 2, S = 16384, DM = 1024, DEPTH = 4, MT = NB * S;
constexpr int INW = 2328, NINP = 2560, DFF = 2816, NGU = 2 * DFF;
constexpr int NCMP = 1024;
constexpr float RMS_EPS = 1e-6f, LN_EPS = 1e-5f;
constexpr float LOG2E = 1.4426950408889634f;
constexpr float QSCALE = 0.125f * LOG2E;
constexpr int NWAVES = 8, NTHREADS = 512;
constexpr int LDS_BYTES = 156672;

constexpr size_t MiB = 1u << 20;
constexpr size_t WS_W = 1 * MiB, W_LAYER = 26 * MiB;
constexpr size_t W_IN = 0, W_OUT = 5 * MiB, W_GU = 7 * MiB, W_DN = 18 * MiB, W_C1K = 23 * MiB + 512 * 1024, W_C1V = 24 * MiB + 512 * 1024,
                 W_C2K = 25 * MiB + 512 * 1024, W_C2V = W_C2K + 64 * 1024, W_CBK = W_C2V + 64 * 1024, W_CBV = W_CBK + 4096;
constexpr size_t WS_AN = 105 * MiB;
constexpr size_t WS_R1 = 169 * MiB;
constexpr size_t R_Q = 0, R_ZU = 32 * MiB, R_ZV = 64 * MiB, R_KC = 96 * MiB, R_VC = 105 * MiB, R_KS = 114 * MiB, R_VST = 122 * MiB, R_KW = 130 * MiB,
                 R_VWT = 138 * MiB, R_GATES = 146 * MiB, R_HID = 150 * MiB, R_KCMP = 154 * MiB, R_VCMPT = 155 * MiB;
constexpr size_t WS_MIX = 345 * MiB;
constexpr size_t WS_HB = WS_MIX + 64 * MiB;
constexpr size_t WS_RS = 256 * 1024;
constexpr size_t WS_XCNT = 512 * 1024;
constexpr size_t WS_XBUF = WS_MIX;
constexpr size_t WS_END = 473 * MiB;

struct Params {
    const float* in[20];
    float* out;
    unsigned char* ws;
};

typedef const __attribute__((address_space(4))) unsigned char* kargp_t;
__device__ __forceinline__ void* karg_ld(int byte_off) {
    kargp_t k = (kargp_t)__builtin_amdgcn_kernarg_segment_ptr();
    int off = byte_off; asm volatile("" : "+s"(off));
    return *(void* const __attribute__((address_space(4)))*)(k + off);
}
__device__ __forceinline__ const float* P_in(const Params&, int i) { return (const float*)karg_ld(8 * i); }
__device__ __forceinline__ float* P_out(const Params&) { return (float*)karg_ld(160); }
__device__ __forceinline__ unsigned char* P_ws(const Params&) { return (unsigned char*)karg_ld(168); }
__device__ __forceinline__ unsigned cvt_pk_bf16(float lo, float hi) { unsigned r; asm volatile("v_cvt_pk_bf16_f32 %0, %1, %2" : "=v"(r) : "v"(lo), "v"(hi)); return r; }
__device__ __forceinline__ float fast_exp2(float x) { return __builtin_amdgcn_exp2f(x); }
__device__ __forceinline__ float fast_rcp(float x) { return __builtin_amdgcn_rcpf(x); }
__device__ __forceinline__ float gelu_tanh(float x) { const float u = x + 0.044715f * x * x * x; return x * fast_rcp(1.0f + fast_exp2(-2.3022081982f * u)); }
__device__ __forceinline__ float silu_f(float x) { return x * fast_rcp(1.0f + fast_exp2(-LOG2E * x)); }
__device__ __forceinline__ float sigmoid_f(float x) { return fast_rcp(1.0f + fast_exp2(-LOG2E * x)); }
__device__ __forceinline__ float wave_sum(float v) {
#pragma unroll
    for (int o = 1; o < 64; o <<= 1) v += __shfl_xor(v, o);
    return v;
}
__device__ __forceinline__ float wave_max(float v) {
#pragma unroll
    for (int o = 1; o < 64; o <<= 1) v = fmaxf(v, __shfl_xor(v, o));
    return v;
}
template <int CTRL> __device__ __forceinline__ float dpp_f(float x) { return __builtin_bit_cast(float, __builtin_amdgcn_mov_dpp(__builtin_bit_cast(int, x), CTRL, 0xf, 0xf, true)); }
__device__ __forceinline__ float xhalf_max(float x) { auto t = __builtin_amdgcn_permlane32_swap(__float_as_uint(x), __float_as_uint(x), false, false); return fmaxf(__uint_as_float(t[0]), __uint_as_float(t[1])); }
__device__ __forceinline__ float xhalf_sum(float x) { auto t = __builtin_amdgcn_permlane32_swap(__float_as_uint(x), __float_as_uint(x), false, false); return __uint_as_float(t[0]) + __uint_as_float(t[1]); }
__device__ __forceinline__ float quad_sum(float x) { x += dpp_f<0xB1>(x); x += dpp_f<0x4E>(x); return x; }
__device__ __forceinline__ float wave_max_fast(float x) {
    x = fmaxf(x, dpp_f<0xB1>(x)); x = fmaxf(x, dpp_f<0x4E>(x)); x = fmaxf(x, dpp_f<0x141>(x)); x = fmaxf(x, dpp_f<0x128>(x));
    auto s = __builtin_amdgcn_permlane16_swap(__float_as_uint(x), __float_as_uint(x), false, false); x = fmaxf(__uint_as_float(s[0]), __uint_as_float(s[1]));
    return xhalf_max(x);
}
__device__ __forceinline__ float wave_sum_fast(float x) {
    x += dpp_f<0xB1>(x); x += dpp_f<0x4E>(x); x += dpp_f<0x141>(x); x += dpp_f<0x128>(x);
    auto s = __builtin_amdgcn_permlane16_swap(__float_as_uint(x), __float_as_uint(x), false, false); x = __uint_as_float(s[0]) + __uint_as_float(s[1]);
    return xhalf_sum(x);
}
__device__ __forceinline__ float bf2f(bf16_t b) { return __uint_as_float(((unsigned)b) << 16); }
#define LAUNDER(x) asm volatile("" : "+v"(x))
#define MFMA32(a, b, c) __builtin_amdgcn_mfma_f32_32x32x16_bf16((a), (b), (c), 0, 0, 0)

namespace pg8 {
constexpr int BM = 256, BK = 64, HALF = 128, HTB = HALF * BK * 2, STAGE_BYTES = 8 * HTB, NXCD = 8, WGM = 8;
__host__ __device__ __forceinline__ int lds_byte(int r, int c) { const int st = (r >> 4) * 2 + (c >> 5), rr = r & 15, cc = c & 31, ob = rr * 64 + cc * 2; return st * 1024 + (ob ^ (((ob >> 9) & 1) << 5)); }
__host__ __device__ __forceinline__ void stage_rc(int b, int& R, int& C) { const int st = b / 1024, sb = b % 1024, swz = sb ^ (((sb >> 9) & 1) << 5); R = (st >> 1) * 16 + swz / 64; C = (st & 1) * 32 + (swz % 64) / 2; }
__host__ __device__ __forceinline__ int perm32(int rho) { const int n = rho >> 4, i = rho & 15; return 8 * (i >> 2) + 4 * n + (i & 3); }

struct Unit { int pm, pn; };
struct Gemm { const bf16_t* A; const bf16_t* Bt; int M, N, K, lda; };

struct StaticOrder {
    int nM, nN, nwg, G, c, lim;
    __device__ __forceinline__ void init(int M, int N, int G_, int c_, int reps = 1) { nM = M / BM; nN = N / BM; nwg = nM * nN; G = G_; c = c_; const int per = (c < nwg) ? (nwg - c + G - 1) / G : 0; lim = per * reps; }
    __device__ __forceinline__ bool next(int i, Unit& u) const {
        if (i >= lim) return false;
        const int per = (nwg - c + G - 1) / G; const long L = (long)(i % per) * G + c;
        int wgid = (int)L; { const int q = nwg / NXCD, r = nwg % NXCD, xcd = wgid % NXCD, off = wgid / NXCD; wgid = (xcd < r ? xcd * (q + 1) : r * (q + 1) + (xcd - r) * q) + off; }
        const int nig = WGM * nN, gid = wgid / nig, fm = gid * WGM, gsz = (nM - fm) < WGM ? (nM - fm) : WGM;
        u.pm = fm + ((wgid % nig) % gsz); u.pn = (wgid % nig) / gsz; return true;
    }
};

struct EpiF32 {
    static constexpr bool PERM = false, FUSED = false;
    float* C; int ldc;
    __device__ __forceinline__ void operator()(const f32x4 (&acc)[2][2][4][2], const Unit& u, int wr, int wc, int fr, int fq) const {
        const int row0 = u.pm * BM + wr * 64 + fr, col0 = u.pn * BM + wc * 32 + 4 * fq;
#pragma unroll
        for (int ai = 0; ai < 2; ++ai)
#pragma unroll
            for (int m = 0; m < 4; ++m) { float* rowp = C + (size_t)(row0 + ai * HALF + m * 16) * ldc + col0;
#pragma unroll
                for (int bj = 0; bj < 2; ++bj)
#pragma unroll
                    for (int n = 0; n < 2; ++n) *(f32x4*)(rowp + bj * HALF + n * 16) = acc[ai][bj][m][n]; }
    }
};

struct EpiBf16 {
    static constexpr bool PERM = true, FUSED = false;
    bf16_t* C; int ldc;
    __device__ __forceinline__ void operator()(const f32x4 (&acc)[2][2][4][2], const Unit& u, int wr, int wc, int fr, int fq) const {
        const int row0 = u.pm * BM + wr * 64 + fr, col0 = u.pn * BM + wc * 32 + 8 * fq;
#pragma unroll
        for (int ai = 0; ai < 2; ++ai)
#pragma unroll
            for (int m = 0; m < 4; ++m) { bf16_t* rowp = C + (size_t)(row0 + ai * HALF + m * 16) * ldc + col0;
#pragma unroll
                for (int bj = 0; bj < 2; ++bj) { const f32x4 v0 = acc[ai][bj][m][0], v1 = acc[ai][bj][m][1];
                    u32x4 w; w.x = cvt_pk_bf16(v0[0], v0[1]); w.y = cvt_pk_bf16(v0[2], v0[3]); w.z = cvt_pk_bf16(v1[0], v1[1]); w.w = cvt_pk_bf16(v1[2], v1[3]);
                    *(u32x4*)(rowp + bj * HALF) = w; } }
    }
};

struct EpiGU {
    static constexpr bool PERM = true, FUSED = false;
    bf16_t* act; const float* rs;
    __device__ __forceinline__ void operator()(const f32x4 (&acc)[2][2][4][2], const Unit& u, int wr, int wc, int fr, int fq) const {
        const int row0 = u.pm * BM + wr * 64 + fr, col0 = u.pn * HALF + wc * 32 + 8 * fq;
        float rrv[2][4];
#pragma unroll
        for (int ai = 0; ai < 2; ++ai)
#pragma unroll
            for (int m = 0; m < 4; ++m) rrv[ai][m] = rs[row0 + ai * HALF + m * 16];
#pragma unroll
        for (int ai = 0; ai < 2; ++ai)
#pragma unroll
            for (int m = 0; m < 4; ++m) {
                const float rr = rrv[ai][m];
                const f32x4 g0 = acc[ai][0][m][0] * rr, g1 = acc[ai][0][m][1] * rr, u0 = acc[ai][1][m][0] * rr, u1 = acc[ai][1][m][1] * rr;
                u32x4 w;
                w.x = cvt_pk_bf16(silu_f(g0[0]) * u0[0], silu_f(g0[1]) * u0[1]); w.y = cvt_pk_bf16(silu_f(g0[2]) * u0[2], silu_f(g0[3]) * u0[3]);
                w.z = cvt_pk_bf16(silu_f(g1[0]) * u1[0], silu_f(g1[1]) * u1[1]); w.w = cvt_pk_bf16(silu_f(g1[2]) * u1[2], silu_f(g1[3]) * u1[3]);
                *(u32x4*)(act + (size_t)(row0 + ai * HALF + m * 16) * DFF + col0) = w;
            }
    }
};

struct EpiCmp1 {
    static constexpr bool PERM = true, FUSED = false;
    bf16_t* hid; const float* cbias;
    __device__ __forceinline__ void operator()(const f32x4 (&acc)[2][2][4][2], const Unit& u, int wr, int wc, int fr, int fq) const {
        const int row0 = u.pm * BM + wr * 64 + fr;
#pragma unroll
        for (int bj = 0; bj < 2; ++bj) {
            const int col0 = bj * HALF + wc * 32 + 8 * fq;
            const f32x4 b0 = *(const f32x4*)(cbias + col0), b1 = *(const f32x4*)(cbias + col0 + 4);
#pragma unroll
            for (int ai = 0; ai < 2; ++ai)
#pragma unroll
                for (int m = 0; m < 4; ++m) {
                    const f32x4 v0 = acc[ai][bj][m][0] + b0, v1 = acc[ai][bj][m][1] + b1;
                    u32x4 w;
                    w.x = cvt_pk_bf16(gelu_tanh(v0[0]), gelu_tanh(v0[1])); w.y = cvt_pk_bf16(gelu_tanh(v0[2]), gelu_tanh(v0[3]));
                    w.z = cvt_pk_bf16(gelu_tanh(v1[0]), gelu_tanh(v1[1])); w.w = cvt_pk_bf16(gelu_tanh(v1[2]), gelu_tanh(v1[3]));
                    *(u32x4*)(hid + (size_t)(row0 + ai * HALF + m * 16) * 256 + col0) = w;
                }
        }
    }
};

struct EpiIn {
    static constexpr bool PERM = true, FUSED = false;
    unsigned char* r1;
    const float* rs;
    __device__ __forceinline__ void operator()(const f32x4 (&acc)[2][2][4][2], const Unit& u, int wr, int wc, int fr, int fq) const {
        const int pn = u.pn;
        float rrv[2][4];
#pragma unroll
        for (int ai = 0; ai < 2; ++ai)
#pragma unroll
            for (int m = 0; m < 4; ++m) rrv[ai][m] = rs[u.pm * BM + ai * HALF + wr * 64 + m * 16 + fr];
#pragma unroll
        for (int ai = 0; ai < 2; ++ai)
#pragma unroll
            for (int m = 0; m < 4; ++m) {
                const int row = u.pm * BM + ai * HALF + wr * 64 + m * 16 + fr;
                const int b = row >> 14, s = row & (S - 1);
                const float rr = rrv[ai][m];
#pragma unroll
                for (int bj = 0; bj < 2; ++bj) {
                    f32x4 v0 = acc[ai][bj][m][0] * rr, v1 = acc[ai][bj][m][1] * rr;
                    const int cw = bj * HALF + wc * 32 + 8 * fq;
                    if (pn < 2) {
                        v0 = v0 * QSCALE; v1 = v1 * QSCALE;
                        u32x4 w; w.x = cvt_pk_bf16(v0[0], v0[1]); w.y = cvt_pk_bf16(v0[2], v0[3]); w.z = cvt_pk_bf16(v1[0], v1[1]); w.w = cvt_pk_bf16(v1[2], v1[3]);
                        *(u32x4*)((bf16_t*)(r1 + R_Q) + (size_t)row * 512 + pn * 256 + cw) = w;
                    } else if (pn < 5) {
                        const int g = wc >> 1, d = (wc & 1) * 32 + 8 * fq, bg = b * 2 + g;
                        if (pn == 2) {
                            bf16_t* base = (bf16_t*)(r1 + (bj == 0 ? R_KC : R_VC));
                            u32x4 w; w.x = cvt_pk_bf16(v0[0], v0[1]); w.y = cvt_pk_bf16(v0[2], v0[3]); w.z = cvt_pk_bf16(v1[0], v1[1]); w.w = cvt_pk_bf16(v1[2], v1[3]);
                            *(u32x4*)(base + ((size_t)bg * S + s) * 64 + d) = w;
                        } else if (pn == 3) {
                            if (bj == 0) {
                                v0 = v0 * 0.25f; v1 = v1 * 0.25f;
                                int w0 = __builtin_amdgcn_cvt_pk_fp8_f32(v0[0], v0[1], 0, false); w0 = __builtin_amdgcn_cvt_pk_fp8_f32(v0[2], v0[3], w0, true);
                                int w1 = __builtin_amdgcn_cvt_pk_fp8_f32(v1[0], v1[1], 0, false); w1 = __builtin_amdgcn_cvt_pk_fp8_f32(v1[2], v1[3], w1, true);
                                u32x2 w; w.x = (unsigned)w0; w.y = (unsigned)w1;
                                *(u32x2*)(r1 + R_KS + (size_t)bg * S * 64 + (size_t)(s >> 6) * 4096 + ((s >> 4) & 3) * 1024 + (((d >> 3) & 3) * 16 + (s & 15)) * 16 + (d >> 5) * 8) = w;
                            } else {
                                const int kb = s & 63, kp = kb >> 5, k32 = kb & 31, fqv = (k32 >> 2) & 3, jj = ((k32 >> 4) << 2) | (k32 & 3);
                                unsigned char* dst = r1 + R_VST + (size_t)bg * S * 64 + (size_t)(s >> 6) * 4096 + (d >> 4) * 1024 + (fqv * 16 + (d & 15)) * 16 + kp * 8 + jj;
                                const int w0 = __builtin_amdgcn_cvt_pk_fp8_f32(v0[0], v0[1], 0, false), w1 = __builtin_amdgcn_cvt_pk_fp8_f32(v0[2], v0[3], 0, false);
                                const int w2 = __builtin_amdgcn_cvt_pk_fp8_f32(v1[0], v1[1], 0, false), w3 = __builtin_amdgcn_cvt_pk_fp8_f32(v1[2], v1[3], 0, false);
                                dst[0] = (unsigned char)(w0 & 0xff); dst[16] = (unsigned char)((w0 >> 8) & 0xff); dst[32] = (unsigned char)(w1 & 0xff); dst[48] = (unsigned char)((w1 >> 8) & 0xff);
                                dst[64] = (unsigned char)(w2 & 0xff); dst[80] = (unsigned char)((w2 >> 8) & 0xff); dst[96] = (unsigned char)(w3 & 0xff); dst[112] = (unsigned char)((w3 >> 8) & 0xff);
                            }
                        } else if (bj == 0) {
                            bf16_t* base = (bf16_t*)(r1 + R_KW);
                            u32x4 w; w.x = cvt_pk_bf16(v0[0], v0[1]); w.y = cvt_pk_bf16(v0[2], v0[3]); w.z = cvt_pk_bf16(v1[0], v1[1]); w.w = cvt_pk_bf16(v1[2], v1[3]);
                            *(u32x4*)(base + (size_t)bg * S * 64 + (size_t)(s >> 5) * 2048 + (d >> 4) * 512 + ((d >> 3) & 1) * 256 + (s & 31) * 8) = w;
                        } else {
                            const int kk = s & 31;
                            bf16_t* dst = (bf16_t*)(r1 + R_VWT) + (size_t)bg * S * 64 + (size_t)(s >> 5) * 2048 + (d >> 5) * 1024 + (kk >> 4) * 512 + ((kk >> 2) & 1) * 256 + (d & 31) * 8 + ((kk >> 3) & 1) * 4 + (kk & 3);
                            const unsigned w0 = cvt_pk_bf16(v0[0], v0[1]), w1 = cvt_pk_bf16(v0[2], v0[3]), w2 = cvt_pk_bf16(v1[0], v1[1]), w3 = cvt_pk_bf16(v1[2], v1[3]);
                            dst[0] = (bf16_t)(w0 & 0xffff); dst[8] = (bf16_t)(w0 >> 16); dst[16] = (bf16_t)(w1 & 0xffff); dst[24] = (bf16_t)(w1 >> 16);
                            dst[32] = (bf16_t)(w2 & 0xffff); dst[40] = (bf16_t)(w2 >> 16); dst[48] = (bf16_t)(w3 & 0xffff); dst[56] = (bf16_t)(w3 >> 16);
                        }
                    } else if (pn < 9) {
                        bf16_t* base = (bf16_t*)(r1 + ((pn < 7) ? R_ZU : R_ZV)); const int ct = (pn < 7) ? (pn - 5) : (pn - 7);
                        u32x4 w;
                        w.x = cvt_pk_bf16(gelu_tanh(v0[0]), gelu_tanh(v0[1])); w.y = cvt_pk_bf16(gelu_tanh(v0[2]), gelu_tanh(v0[3]));
                        w.z = cvt_pk_bf16(gelu_tanh(v1[0]), gelu_tanh(v1[1])); w.w = cvt_pk_bf16(gelu_tanh(v1[2]), gelu_tanh(v1[3]));
                        *(u32x4*)(base + (size_t)row * 512 + ct * 256 + cw) = w;
                    } else {
                        if (bj == 0 && wc == 0 && fq < 3) {
                            float* gp = (float*)(r1 + R_GATES) + (size_t)row * 24 + 8 * fq;
                            *(f32x4*)gp = (f32x4){sigmoid_f(v0[0]), sigmoid_f(v0[1]), sigmoid_f(v0[2]), sigmoid_f(v0[3])};
                            *(f32x4*)(gp + 4) = (f32x4){sigmoid_f(v1[0]), sigmoid_f(v1[1]), sigmoid_f(v1[2]), sigmoid_f(v1[3])};
                        }
                    }
                }
            }
    }
};

struct EpiNormRes {
    static constexpr bool PERM = true, FUSED = true;
    unsigned char* ws; const float* gpost; float* fout; int inst;
    __device__ __forceinline__ void exchange(int e, float (&sv)[2][4], float (&rv)[2][4], const Unit& u, int wr, int wc, int fr, int fq, LAS unsigned char* lds, int wid, int lane) const {
        LAS float* P = (LAS float*)(lds + 131072);
        LAS float* Sx = P + 1024;
        float* xbuf = (float*)(ws + WS_XBUF) + (size_t)e * MT * 4;
        unsigned* cnt = (unsigned*)(ws + WS_XCNT) + ((size_t)(e * 8 + inst) * 128 + u.pm) * 16;
#pragma unroll
        for (int ai = 0; ai < 2; ++ai)
#pragma unroll
            for (int m = 0; m < 4; ++m) {
                float v = sv[ai][m];
                { auto t1 = __builtin_amdgcn_permlane16_swap(__float_as_uint(v), __float_as_uint(v), false, false); v = __uint_as_float(t1[0]) + __uint_as_float(t1[1]); }
                v = xhalf_sum(v);
                if (fq == 0) P[(ai * HALF + wr * 64 + m * 16 + fr) * 4 + wc] = v;
            }
        asm volatile("s_waitcnt lgkmcnt(0)" ::: "memory"); __builtin_amdgcn_s_barrier(); asm volatile("" ::: "memory");
        const int tid = wid * 64 + lane;
        if (tid < 256) {
            const f32x4 pp = *(const LAS f32x4*)(P + tid * 4);
            __hip_atomic_store(xbuf + ((size_t)u.pm * 256 + tid) * 4 + u.pn, (pp[0] + pp[1]) + (pp[2] + pp[3]), __ATOMIC_RELAXED, __HIP_MEMORY_SCOPE_AGENT);
        }
        asm volatile("s_waitcnt vmcnt(0)" ::: "memory");
        if (wid < 4 && lane == 0) __hip_atomic_fetch_add(cnt, 1u, __ATOMIC_RELAXED, __HIP_MEMORY_SCOPE_AGENT);
        if (wid == 0) {
            unsigned sp = 0;
            while ((unsigned)__builtin_amdgcn_readfirstlane(__hip_atomic_load(cnt, __ATOMIC_RELAXED, __HIP_MEMORY_SCOPE_AGENT)) < 16u) { __builtin_amdgcn_s_sleep(2); if (++sp > (1u << 22)) break; }
            __builtin_amdgcn_fence(__ATOMIC_ACQUIRE, "agent");
        }
        asm volatile("s_waitcnt vmcnt(0) lgkmcnt(0)" ::: "memory"); __builtin_amdgcn_s_barrier(); asm volatile("" ::: "memory");
        if (tid < 256) {
            const float* sl = xbuf + ((size_t)u.pm * 256 + tid) * 4;
            const float t0 = __hip_atomic_load(sl + 0, __ATOMIC_RELAXED, __HIP_MEMORY_SCOPE_AGENT), t1 = __hip_atomic_load(sl + 1, __ATOMIC_RELAXED, __HIP_MEMORY_SCOPE_AGENT);
            const float t2 = __hip_atomic_load(sl + 2, __ATOMIC_RELAXED, __HIP_MEMORY_SCOPE_AGENT), t3 = __hip_atomic_load(sl + 3, __ATOMIC_RELAXED, __HIP_MEMORY_SCOPE_AGENT);
            Sx[tid] = 1.0f / sqrtf(((t0 + t1) + (t2 + t3)) * (1.0f / 1024.0f) + RMS_EPS);
        }
        asm volatile("s_waitcnt vmcnt(0) lgkmcnt(0)" ::: "memory"); __builtin_amdgcn_s_barrier(); asm volatile("" ::: "memory");
#pragma unroll
        for (int ai = 0; ai < 2; ++ai)
#pragma unroll
            for (int m = 0; m < 4; ++m) rv[ai][m] = Sx[ai * HALF + wr * 64 + m * 16 + fr];
    }
    __device__ __forceinline__ void fused(f32x4 (&acc)[2][2][4][2], const Unit& u, int wr, int wc, int fr, int fq, LAS unsigned char* lds, int wid, int lane) const {
        bf16_t* hb = (bf16_t*)(ws + WS_HB);
        const int row0 = u.pm * BM + wr * 64 + fr, col0 = u.pn * BM + wc * 32 + 8 * fq;
        float sv[2][4], rv[2][4];
#pragma unroll
        for (int ai = 0; ai < 2; ++ai)
#pragma unroll
            for (int m = 0; m < 4; ++m) {
                float q = 0.f;
#pragma unroll
                for (int bj = 0; bj < 2; ++bj)
#pragma unroll
                    for (int n = 0; n < 2; ++n) { const f32x4 x = acc[ai][bj][m][n]; q += (x[0] * x[0] + x[1] * x[1]) + (x[2] * x[2] + x[3] * x[3]); }
                sv[ai][m] = q;
            }
        exchange(0, sv, rv, u, wr, wc, fr, fq, lds, wid, lane);
        float dep = 0.f;
#pragma unroll
        for (int ai = 0; ai < 2; ++ai)
#pragma unroll
            for (int m = 0; m < 4; ++m) {
                const bf16_t* hrow = hb + (size_t)(row0 + ai * HALF + m * 16) * DM + col0;
                asm volatile("" : "+v"(hrow) : "v"(dep));
                const float r1 = rv[ai][m];
                float q = 0.f;
#pragma unroll
                for (int bj = 0; bj < 2; ++bj) {
                    const u32x4 hv = *(const u32x4*)(hrow + bj * HALF);
                    const f32x4 h0 = (f32x4){__uint_as_float(hv.x << 16), __uint_as_float(hv.x & 0xffff0000u), __uint_as_float(hv.y << 16), __uint_as_float(hv.y & 0xffff0000u)};
                    const f32x4 h1 = (f32x4){__uint_as_float(hv.z << 16), __uint_as_float(hv.z & 0xffff0000u), __uint_as_float(hv.w << 16), __uint_as_float(hv.w & 0xffff0000u)};
                    const f32x4 gg0 = *(const f32x4*)(gpost + col0 + bj * HALF), gg1 = *(const f32x4*)(gpost + col0 + bj * HALF + 4);
                    f32x4 x0 = h0 + acc[ai][bj][m][0] * r1 * gg0, x1 = h1 + acc[ai][bj][m][1] * r1 * gg1;
                    acc[ai][bj][m][0] = x0; acc[ai][bj][m][1] = x1;
                    q += ((x0[0] * x0[0] + x0[1] * x0[1]) + (x0[2] * x0[2] + x0[3] * x0[3])) + ((x1[0] * x1[0] + x1[1] * x1[1]) + (x1[2] * x1[2] + x1[3] * x1[3]));
                }
                sv[ai][m] = q;
                dep = q;
            }
        if (fout) {
#pragma unroll
            for (int ai = 0; ai < 2; ++ai)
#pragma unroll
                for (int m = 0; m < 4; ++m) { float* orow = fout + (size_t)(row0 + ai * HALF + m * 16) * DM + col0;
#pragma unroll
                    for (int bj = 0; bj < 2; ++bj) { *(f32x4*)(orow + bj * HALF) = acc[ai][bj][m][0]; *(f32x4*)(orow + bj * HALF + 4) = acc[ai][bj][m][1]; } }
            return;
        }
        exchange(1, sv, rv, u, wr, wc, fr, fq, lds, wid, lane);
        float* rs = (float*)(ws + WS_RS);
#pragma unroll
        for (int ai = 0; ai < 2; ++ai)
#pragma unroll
            for (int m = 0; m < 4; ++m) {
                bf16_t* hrow = hb + (size_t)(row0 + ai * HALF + m * 16) * DM + col0;
#pragma unroll
                for (int bj = 0; bj < 2; ++bj) { const f32x4 x0 = acc[ai][bj][m][0], x1 = acc[ai][bj][m][1];
                    u32x4 w; w.x = cvt_pk_bf16(x0[0], x0[1]); w.y = cvt_pk_bf16(x0[2], x0[3]); w.z = cvt_pk_bf16(x1[0], x1[1]); w.w = cvt_pk_bf16(x1[2], x1[3]);
                    *(u32x4*)(hrow + bj * HALF) = w; }
                if (u.pn == 0 && wc == 0 && fq == 0) rs[row0 + ai * HALF + m * 16] = rv[ai][m];
            }
    }
};

template <class Epi>
__device__ __forceinline__ void gemm_phase(LAS unsigned char* lds, const Gemm g, const StaticOrder& S, const Epi& E) {
    int tid = threadIdx.x; LAUNDER(tid);
    const int wid = __builtin_amdgcn_readfirstlane(tid >> 6), lane = tid & 63, wr = wid >> 2, wc = wid & 3, fr = lane & 15, fq = lane >> 4;
    const int K = g.K, nt = K / BK, lda = g.lda;
    unsigned voffA[2], voffB[2];
#pragma unroll
    for (int i = 0; i < 2; ++i) { int R, C; stage_rc(tid * 16 + i * 8192, R, C); const int Rb = Epi::PERM ? ((R & ~31) + perm32(R & 31)) : R;
        voffA[i] = (unsigned)(R * lda + C) * 2u; voffB[i] = (unsigned)(Rb * K + C) * 2u; }
    const size_t kstep = (size_t)(BK * 2);
    const size_t hA = (size_t)HALF * lda * 2, hB = (size_t)HALF * K * 2;
    const size_t tA = 2 * hA, tB = 2 * hB;
    const unsigned ldsw = (unsigned)wid * 1024u;
    const int aoff = lds_byte(wr * 64 + fr, fq * 8), boff = lds_byte(wc * 32 + fr, fq * 8);
#define PG8_SA(b, h) (((b) * 2 + (h)) * HTB)
#define PG8_SB(b, h) ((4 + (b) * 2 + (h)) * HTB)
#define PG8_STAGE(bufoff, gbase, voff) do { _Pragma("unroll") for (int _i = 0; _i < 2; ++_i) \
        __builtin_amdgcn_global_load_lds((const unsigned*)((const char*)(gbase) + (voff)[_i]), (LAS unsigned*)(lds + (bufoff) + ldsw + _i * 8192), 16, 0, 0); } while (0)
#define PG8_LDA(dst, b, h) do { _Pragma("unroll") for (int m = 0; m < 4; ++m) _Pragma("unroll") for (int k = 0; k < 2; ++k) dst[m][k] = *(const LAS bf16x8*)(lds + PG8_SA(b, h) + aoff + m * 2048 + k * 1024); } while (0)
#define PG8_LDB(dst, b, h) do { _Pragma("unroll") for (int n = 0; n < 2; ++n) _Pragma("unroll") for (int k = 0; k < 2; ++k) dst[n][k] = *(const LAS bf16x8*)(lds + PG8_SB(b, h) + boff + n * 2048 + k * 1024); } while (0)
#define PG8_MMA(ai, bj, At, Bt) do { __builtin_amdgcn_s_setprio(1); _Pragma("unroll") for (int m = 0; m < 4; ++m) _Pragma("unroll") for (int n = 0; n < 2; ++n) _Pragma("unroll") for (int k = 0; k < 2; ++k) \
        acc[ai][bj][m][n] = __builtin_amdgcn_mfma_f32_16x16x32_bf16(Bt[n][k], At[m][k], acc[ai][bj][m][n], 0, 0, 0); __builtin_amdgcn_s_setprio(0); } while (0)
#define PG8_WAIT_V(n) asm volatile("s_waitcnt vmcnt(" #n ")" ::: "memory")
#define PG8_WAIT_L(n) asm volatile("s_waitcnt lgkmcnt(" #n ")" ::: "memory")
#define PG8_BAR __builtin_amdgcn_s_barrier()
#define PG8_SCHED __builtin_amdgcn_sched_barrier(0)
    Unit cur, nxt; int ui = 0;
    if (!S.next(0, cur)) return;
    f32x4 acc[2][2][4][2];
#pragma unroll
    for (int a = 0; a < 2; ++a)
#pragma unroll
        for (int b = 0; b < 2; ++b)
#pragma unroll
            for (int m = 0; m < 4; ++m)
#pragma unroll
                for (int n = 0; n < 2; ++n) acc[a][b][m][n] = (f32x4){0.f, 0.f, 0.f, 0.f};
    bf16x8 At[4][2], B0[2][2], B1[2][2];
    const char* cA = (const char*)g.A + (size_t)cur.pm * tA; const char* cB = (const char*)g.Bt + (size_t)cur.pn * tB;
    PG8_STAGE(PG8_SB(0, 0), cB, voffB); PG8_STAGE(PG8_SB(0, 1), cB + hB, voffB); PG8_STAGE(PG8_SA(0, 0), cA, voffA); PG8_STAGE(PG8_SA(0, 1), cA + hA, voffA);
    if (wr == 1) PG8_BAR;
    PG8_WAIT_V(2); PG8_BAR;
    PG8_STAGE(PG8_SB(1, 0), cB + kstep, voffB); PG8_STAGE(PG8_SA(1, 0), cA + kstep, voffA); PG8_STAGE(PG8_SB(1, 1), cB + hB + kstep, voffB);
    PG8_WAIT_V(6); PG8_BAR;
    for (;;) {
        const bool has_next = S.next(ui + 1, nxt);
        const char* nA = has_next ? (const char*)g.A + (size_t)nxt.pm * tA : cA; const char* nB = has_next ? (const char*)g.Bt + (size_t)nxt.pn * tB : cB;
        for (int t = 0; t < nt; t += 2) {
            const bool last = (t == nt - 2);
            const char* a1 = cA + (size_t)(t + 1) * kstep;
            const char* a2 = last ? nA : cA + (size_t)(t + 2) * kstep; const char* b2 = last ? nB : cB + (size_t)(t + 2) * kstep;
            const char* a3 = a2 + kstep; const char* b3 = b2 + kstep;
            PG8_LDB(B0, 0, 0); PG8_LDB(B1, 0, 1); PG8_SCHED; PG8_LDA(At, 0, 0); PG8_STAGE(PG8_SA(1, 1), a1 + hA, voffA);
            PG8_WAIT_V(8); PG8_WAIT_L(0); PG8_BAR; PG8_MMA(0, 0, At, B0); PG8_MMA(0, 1, At, B1); PG8_BAR; PG8_SCHED;
            PG8_LDA(At, 0, 1); PG8_STAGE(PG8_SB(0, 0), b2, voffB); PG8_STAGE(PG8_SB(0, 1), b2 + hB, voffB); PG8_STAGE(PG8_SA(0, 0), a2, voffA);
            PG8_WAIT_V(8); PG8_WAIT_L(0); PG8_BAR; PG8_MMA(1, 0, At, B0); PG8_MMA(1, 1, At, B1); PG8_BAR; PG8_SCHED;
            PG8_LDB(B0, 1, 0); PG8_LDB(B1, 1, 1); PG8_SCHED; PG8_LDA(At, 1, 0); PG8_STAGE(PG8_SA(0, 1), a2 + hA, voffA);
            PG8_WAIT_V(8); PG8_WAIT_L(0); PG8_BAR; PG8_MMA(0, 0, At, B0); PG8_MMA(0, 1, At, B1); PG8_BAR; PG8_SCHED;
            PG8_LDA(At, 1, 1); PG8_STAGE(PG8_SB(1, 0), b3, voffB); PG8_STAGE(PG8_SB(1, 1), b3 + hB, voffB); PG8_STAGE(PG8_SA(1, 0), a3, voffA);
            PG8_WAIT_V(8); PG8_WAIT_L(0); PG8_BAR; PG8_MMA(1, 0, At, B0); PG8_MMA(1, 1, At, B1); PG8_BAR; PG8_SCHED;
        }
        if (wr == 0) PG8_BAR;
        if constexpr (Epi::FUSED) E.fused(acc, cur, wr, wc, fr, fq, lds, wid, lane); else E(acc, cur, wr, wc, fr, fq);
        if (!has_next) break;
#pragma unroll
        for (int a = 0; a < 2; ++a)
#pragma unroll
            for (int b = 0; b < 2; ++b)
#pragma unroll
                for (int m = 0; m < 4; ++m)
#pragma unroll
                    for (int n = 0; n < 2; ++n) acc[a][b][m][n] = (f32x4){0.f, 0.f, 0.f, 0.f};
        cur = nxt; cA = nA; cB = nB; ++ui;
        if (wr == 1) PG8_BAR;
    }
    PG8_WAIT_V(0);
    PG8_BAR;
#undef PG8_SA
#undef PG8_SB
#undef PG8_STAGE
#undef PG8_LDA
#undef PG8_LDB
#undef PG8_MMA
#undef PG8_WAIT_V
#undef PG8_WAIT_L
#undef PG8_BAR
#undef PG8_SCHED
}
}

template <int MAP> __device__ __forceinline__ int src_col(int n) {
    if (MAP == 0) return n;
    if (MAP == 1) { if (n < 1280) return n; if (n < 2304) return n + 24; if (n < 2328) return n - 1024; return -1; }
    const int t = n >> 8, w = n & 255; return (w < 128) ? (128 * t + w) : (DFF + 128 * t + (w - 128));
}
constexpr int TP = 65;
template <int MAP> __device__ __forceinline__ void transpose_item(const float* W, int K, int Nsrc, bf16_t* WT, int nblk, int item, LAS float* scr, int lane, const float* gain = nullptr) {
    const int kb = item / nblk, nb = item % nblk, k0 = 64 * kb, n0 = 64 * nb;
    const int nl = 4 * (lane & 15), kr = lane >> 4;
    const int ns = src_col<MAP>(n0 + nl);
    f32x4 v[16];
#pragma unroll
    for (int i = 0; i < 16; ++i) v[i] = (ns >= 0) ? *(const f32x4*)(W + (size_t)(k0 + kr + 4 * i) * Nsrc + ns) : (f32x4){0.f, 0.f, 0.f, 0.f};
    if (gain) {
#pragma unroll
        for (int i = 0; i < 16; ++i) v[i] = v[i] * gain[k0 + kr + 4 * i];
    }
#pragma unroll
    for (int i = 0; i < 16; ++i) { LAS float* d = scr + (kr + 4 * i) * TP + nl; d[0] = v[i][0]; d[1] = v[i][1]; d[2] = v[i][2]; d[3] = v[i][3]; }
    asm volatile("s_waitcnt lgkmcnt(0)" ::: "memory");
    __builtin_amdgcn_wave_barrier();
    const int c = lane & 7;
#pragma unroll
    for (int j = 0; j < 8; ++j) { const int n = (lane >> 3) + 8 * j; const LAS float* s = scr + (8 * c) * TP + n;
        u32x4 o; o.x = cvt_pk_bf16(s[0 * TP], s[1 * TP]); o.y = cvt_pk_bf16(s[2 * TP], s[3 * TP]); o.z = cvt_pk_bf16(s[4 * TP], s[5 * TP]); o.w = cvt_pk_bf16(s[6 * TP], s[7 * TP]);
        *(u32x4*)(WT + (size_t)(n0 + n) * K + k0 + 8 * c) = o; }
    asm volatile("s_waitcnt lgkmcnt(0)" ::: "memory");
    __builtin_amdgcn_wave_barrier();
}

__device__ __forceinline__ void row_pass(const float* x0, bf16_t* hb, const bf16_t* mix, const float* gpost, float* rs, float* fout, int gw, int NGW, int lane) {
    LAUNDER(lane);
    if (x0) {
        for (int m = gw; m < MT; m += NGW) {
            const f32x4* hr = (const f32x4*)(x0 + (size_t)m * DM) + lane;
            f32x4 h[4]; float s2 = 0.f;
#pragma unroll
            for (int j = 0; j < 4; ++j) { h[j] = hr[64 * j]; s2 += (h[j][0] * h[j][0] + h[j][1] * h[j][1]) + (h[j][2] * h[j][2] + h[j][3] * h[j][3]); }
            const float r2 = 1.0f / sqrtf(wave_sum_fast(s2) * (1.0f / DM) + RMS_EPS);
            u32x2* ao = (u32x2*)(hb + (size_t)m * DM) + lane;
#pragma unroll
            for (int j = 0; j < 4; ++j) { u32x2 w; w.x = cvt_pk_bf16(h[j][0], h[j][1]); w.y = cvt_pk_bf16(h[j][2], h[j][3]); ao[64 * j] = w; }
            if (lane == 0) rs[m] = r2;
        }
        return;
    }
    u32x2 hn[4], mn[4];
    if (gw < MT) {
        const u32x2* hr = (const u32x2*)(hb + (size_t)gw * DM) + lane; const u32x2* mr = (const u32x2*)(mix + (size_t)gw * DM) + lane;
#pragma unroll
        for (int j = 0; j < 4; ++j) { hn[j] = hr[64 * j]; mn[j] = mr[64 * j]; }
    }
    for (int m = gw; m < MT; m += NGW) {
        u32x2 hv[4], mv[4];
#pragma unroll
        for (int j = 0; j < 4; ++j) { hv[j] = hn[j]; mv[j] = mn[j]; }
        const int m2 = m + NGW;
        if (m2 < MT) {
            const u32x2* hr = (const u32x2*)(hb + (size_t)m2 * DM) + lane; const u32x2* mr = (const u32x2*)(mix + (size_t)m2 * DM) + lane;
#pragma unroll
            for (int j = 0; j < 4; ++j) { hn[j] = hr[64 * j]; mn[j] = mr[64 * j]; }
        }
        f32x4 h[4], x[4]; float ss = 0.f;
#pragma unroll
        for (int j = 0; j < 4; ++j) {
            h[j] = (f32x4){__uint_as_float(hv[j].x << 16), __uint_as_float(hv[j].x & 0xffff0000u), __uint_as_float(hv[j].y << 16), __uint_as_float(hv[j].y & 0xffff0000u)};
            x[j] = (f32x4){__uint_as_float(mv[j].x << 16), __uint_as_float(mv[j].x & 0xffff0000u), __uint_as_float(mv[j].y << 16), __uint_as_float(mv[j].y & 0xffff0000u)};
            ss += (x[j][0] * x[j][0] + x[j][1] * x[j][1]) + (x[j][2] * x[j][2] + x[j][3] * x[j][3]);
        }
        const float r1 = 1.0f / sqrtf(wave_sum_fast(ss) * (1.0f / DM) + RMS_EPS);
        float s2 = 0.f;
#pragma unroll
        for (int j = 0; j < 4; ++j) { const f32x4 gp = *((const f32x4*)gpost + lane + 64 * j); h[j] = h[j] + x[j] * r1 * gp; s2 += (h[j][0] * h[j][0] + h[j][1] * h[j][1]) + (h[j][2] * h[j][2] + h[j][3] * h[j][3]); }
        if (fout) {
            f32x4* ho = (f32x4*)(fout + (size_t)m * DM) + lane;
#pragma unroll
            for (int j = 0; j < 4; ++j) ho[64 * j] = h[j];
        } else {
            const float r2 = 1.0f / sqrtf(wave_sum_fast(s2) * (1.0f / DM) + RMS_EPS);
            u32x2* ao = (u32x2*)(hb + (size_t)m * DM) + lane;
#pragma unroll
            for (int j = 0; j < 4; ++j) { u32x2 w; w.x = cvt_pk_bf16(h[j][0], h[j][1]); w.y = cvt_pk_bf16(h[j][2], h[j][3]); ao[64 * j] = w; }
            if (lane == 0) rs[m] = r2;
        }
    }
}

constexpr int ZPITCH = 136;
__device__ __forceinline__ void gmlp_unit(const Params& p, int layer, int chunk, LAS unsigned char* lds, int wave, int lane) {
    LAUNDER(lane);
    const unsigned char* ws = P_ws(p);
    const bf16_t* zu = (const bf16_t*)(ws + WS_R1 + R_ZU); const bf16_t* zv = (const bf16_t*)(ws + WS_R1 + R_ZV);
    bf16_t* mixed = (bf16_t*)(ws + WS_AN);
    const float* ln_g = P_in(p, 13) + layer * 512; const float* ln_b = P_in(p, 14) + layer * 512;
    const float* w_s = P_in(p, 15) + (size_t)layer * 8 * 128 * 128 + (size_t)wave * 128 * 128;
    const float* b_s = P_in(p, 16) + layer * 8 * 128 + wave * 128;
    LAS float* stats = (LAS float*)(lds + 8 * 64 * ZPITCH * 2);
    LAS bf16_t* zt = (LAS bf16_t*)(lds + wave * 64 * ZPITCH * 2);
    const int tok0 = chunk * 128;
    __syncthreads();
#pragma unroll
    for (int i = 0; i < 16; ++i) {
        const int t = wave * 16 + i;
        const bf16x8 v = *(const bf16x8*)(zv + (size_t)(tok0 + t) * 512 + lane * 8);
        float s = 0.f, s2 = 0.f;
#pragma unroll
        for (int e = 0; e < 8; ++e) { const float x = bf2f((bf16_t)v[e]); s += x; s2 += x * x; }
        s = wave_sum_fast(s); s2 = wave_sum_fast(s2);
        const float mean = s * (1.0f / 512.0f); const float var = fmaxf(s2 * (1.0f / 512.0f) - mean * mean, 0.f);
        if (lane == 0) { stats[2 * t] = mean; stats[2 * t + 1] = 1.0f / sqrtf(var + LN_EPS); }
    }
    __syncthreads();
    {
        const int dc = lane & 7, d0 = dc * 8;
        const f32x4 g0 = *(const f32x4*)(ln_g + wave * 64 + d0), g1 = *(const f32x4*)(ln_g + wave * 64 + d0 + 4);
        const f32x4 b0 = *(const f32x4*)(ln_b + wave * 64 + d0), b1 = *(const f32x4*)(ln_b + wave * 64 + d0 + 4);
#pragma unroll 8
        for (int i = 0; i < 16; ++i) {
            const int s = (lane >> 3) + 8 * i;
            const bf16x8 v = *(const bf16x8*)(zv + (size_t)(tok0 + s) * 512 + wave * 64 + d0);
            const float mean = stats[2 * s], rstd = stats[2 * s + 1];
#pragma unroll
            for (int e = 0; e < 8; ++e) {
                const float gg = (e < 4) ? g0[e & 3] : g1[e & 3], bb = (e < 4) ? b0[e & 3] : b1[e & 3];
                const float y = (bf2f((bf16_t)v[e]) - mean) * rstd * gg + bb;
                zt[(d0 + e) * ZPITCH + s] = (bf16_t)(cvt_pk_bf16(y, 0.f) & 0xffff);
            }
        }
    }
    asm volatile("s_waitcnt lgkmcnt(0)" ::: "memory");
    __builtin_amdgcn_wave_barrier();
    const int r = lane & 31, h = lane >> 5;
#pragma unroll
    for (int mt = 0; mt < 4; ++mt) {
        f32x16 acc0, acc1;
#pragma unroll
        for (int i = 0; i < 16; ++i) { acc0[i] = 0.f; acc1[i] = 0.f; }
        const int t = 32 * mt + r;
#pragma unroll
        for (int ks = 0; ks < 2 * (mt + 1); ++ks) {
            const int s0 = 16 * ks + 8 * h;
            const f32x4 w0 = *(const f32x4*)(w_s + (size_t)t * 128 + s0), w1 = *(const f32x4*)(w_s + (size_t)t * 128 + s0 + 4);
            float wv[8] = {w0[0], w0[1], w0[2], w0[3], w1[0], w1[1], w1[2], w1[3]};
#pragma unroll
            for (int e = 0; e < 8; ++e) wv[e] = (s0 + e <= t) ? wv[e] : 0.f;
            u32x4 wb; wb.x = cvt_pk_bf16(wv[0], wv[1]); wb.y = cvt_pk_bf16(wv[2], wv[3]); wb.z = cvt_pk_bf16(wv[4], wv[5]); wb.w = cvt_pk_bf16(wv[6], wv[7]);
            const bf16x8 bfrag = __builtin_bit_cast(bf16x8, wb);
            const bf16x8 a0 = *(const LAS bf16x8*)(zt + (r) * ZPITCH + s0);
            const bf16x8 a1 = *(const LAS bf16x8*)(zt + (32 + r) * ZPITCH + s0);
            acc0 = MFMA32(a0, bfrag, acc0);
            acc1 = MFMA32(a1, bfrag, acc1);
        }
        const float bs = b_s[t];
        const size_t rowoff = (size_t)(tok0 + t) * 512 + wave * 64;
        bf16_t* mrow = mixed + (size_t)(tok0 + t) * 1024 + 512 + wave * 64;
#pragma unroll
        for (int dt = 0; dt < 2; ++dt)
#pragma unroll
            for (int i4 = 0; i4 < 4; ++i4) {
                const int d = 32 * dt + 8 * i4 + 4 * h;
                const u32x2 zz = *(const u32x2*)(zu + rowoff + d);
                const float z0 = __uint_as_float(zz.x << 16), z1 = __uint_as_float(zz.x & 0xffff0000u), z2 = __uint_as_float(zz.y << 16), z3 = __uint_as_float(zz.y & 0xffff0000u);
                const f32x16& a = dt ? acc1 : acc0;
                u32x2 o; o.x = cvt_pk_bf16(z0 * (a[4 * i4] + bs), z1 * (a[4 * i4 + 1] + bs)); o.y = cvt_pk_bf16(z2 * (a[4 * i4 + 2] + bs), z3 * (a[4 * i4 + 3] + bs));
                *(u32x2*)(mrow + d) = o;
            }
    }
}

__device__ __forceinline__ void cmp_gemm2(const bf16_t* hidden, const bf16_t* w2t, bf16_t* kcmp, bf16_t* vcmpT, int kv, int row0, int lane) {
    LAUNDER(lane);
    const int r = lane & 31, h = lane >> 5;
    f32x16 acc[2];
#pragma unroll
    for (int i = 0; i < 16; ++i) { acc[0][i] = 0.f; acc[1][i] = 0.f; }
#pragma unroll
    for (int ks = 0; ks < 16; ++ks) {
        const bf16x8 hf = *(const bf16x8*)(hidden + (size_t)(row0 + r) * 256 + ks * 16 + h * 8);
#pragma unroll
        for (int dt = 0; dt < 2; ++dt) {
            const bf16x8 wf = *(const bf16x8*)(w2t + (size_t)(dt * 32 + r) * 256 + ks * 16 + h * 8);
            if (kv == 0) acc[dt] = MFMA32(wf, hf, acc[dt]);
            else         acc[dt] = MFMA32(hf, wf, acc[dt]);
        }
    }
#pragma unroll
    for (int dt = 0; dt < 2; ++dt)
#pragma unroll
        for (int i4 = 0; i4 < 4; ++i4) {
            u32x2 o; o.x = cvt_pk_bf16(acc[dt][4 * i4], acc[dt][4 * i4 + 1]); o.y = cvt_pk_bf16(acc[dt][4 * i4 + 2], acc[dt][4 * i4 + 3]);
            if (kv == 0) *(u32x2*)(kcmp + (size_t)(row0 >> 5) * 2048 + (dt * 2 + (i4 >> 1)) * 512 + (i4 & 1) * 256 + r * 8 + 4 * h) = o;
            else         *(u32x2*)(vcmpT + (size_t)(row0 >> 5) * 2048 + dt * 1024 + (i4 >> 1) * 512 + h * 256 + r * 8 + (i4 & 1) * 4) = o;
        }
}

constexpr int NSA_WAVE_LDS = 19456;
constexpr float NEG_INF = -__builtin_inff();

__device__ __forceinline__ void load_k(bf16x8 (&kf)[4], const bf16_t* Kt, int lane) {
    const int r = lane & 31, h = lane >> 5;
#pragma unroll
    for (int ks = 0; ks < 4; ++ks) kf[ks] = *(const bf16x8*)(Kt + ks * 512 + lane * 8);
}
__device__ __forceinline__ void load_v(bf16x8 (&vf)[2][2], const bf16_t* vT, int lane) {
    const int r = lane & 31, h = lane >> 5;
#pragma unroll
    for (int dt = 0; dt < 2; ++dt)
#pragma unroll
        for (int s = 0; s < 2; ++s) vf[dt][s] = *(const bf16x8*)(vT + dt * 1024 + s * 512 + lane * 8);
}
__device__ __forceinline__ f32x16 qk_tile(const bf16x8 (&kf)[4], const bf16x8 (&qf)[4]) {
    f32x16 s;
#pragma unroll
    for (int i = 0; i < 16; ++i) s[i] = 0.f;
#pragma unroll
    for (int ks = 0; ks < 4; ++ks) s = MFMA32(kf[ks], qf[ks], s);
    return s;
}
template <int STRIDE> __device__ __forceinline__ void score_tile(f32x16& s, int dl, int dmax, bool lane_ok, bool fast, float lutfar, const LAS float* lutr) {
    if (fast) {
#pragma unroll
        for (int i = 0; i < 16; ++i) s[i] = lane_ok ? (s[i] + lutfar) : NEG_INF;
    } else {
#pragma unroll
        for (int i = 0; i < 16; ++i) {
            const int d = dl - STRIDE * ((i & 3) + 8 * (i >> 2));
            const bool ok = lane_ok && d >= 0 && d < dmax;
            const int di = min(max(d, 0), 128);
            s[i] = ok ? (s[i] + lutr[di]) : NEG_INF;
        }
    }
}
__device__ __forceinline__ void pv_tile(f32x16& o0, f32x16& o1, const f32x16& pr, const bf16x8 (&vf)[2][2]) {
#pragma unroll
    for (int s = 0; s < 2; ++s) {
        u32x4 pk; pk.x = cvt_pk_bf16(pr[8 * s], pr[8 * s + 1]); pk.y = cvt_pk_bf16(pr[8 * s + 2], pr[8 * s + 3]); pk.z = cvt_pk_bf16(pr[8 * s + 4], pr[8 * s + 5]); pk.w = cvt_pk_bf16(pr[8 * s + 6], pr[8 * s + 7]);
        const bf16x8 pb = __builtin_bit_cast(bf16x8, pk);
        o0 = MFMA32(vf[0][s], pb, o0);
        o1 = MFMA32(vf[1][s], pb, o1);
    }
}
template <bool FAST> __device__ __forceinline__ void online_step(f32x16& s, float bias, bool lane_ok, float& m, float& l, f32x16& o0, f32x16& o1, const bf16x8 (&vf)[2][2]) {
    float mx = fmaxf(fmaxf(fmaxf(s[0], s[1]), fmaxf(s[2], s[3])), fmaxf(fmaxf(s[4], s[5]), fmaxf(s[6], s[7])));
    mx = fmaxf(mx, fmaxf(fmaxf(fmaxf(s[8], s[9]), fmaxf(s[10], s[11])), fmaxf(fmaxf(s[12], s[13]), fmaxf(s[14], s[15]))));
    if (FAST) { mx += bias; mx = lane_ok ? mx : NEG_INF; }
    mx = xhalf_max(mx);
    if (__any(mx > m + 8.0f)) {
        const float mnew = (mx > m + 8.0f) ? mx : m;
        const float alpha = fast_exp2(m - mnew);
        l *= alpha; m = mnew;
#pragma unroll
        for (int i = 0; i < 16; ++i) { o0[i] *= alpha; o1[i] *= alpha; }
    }
    const float c = FAST ? (lane_ok ? (m - bias) : __builtin_inff()) : m;
    float ps = 0.f;
#pragma unroll
    for (int i = 0; i < 16; ++i) { s[i] = fast_exp2(s[i] - c); ps += s[i]; }
    ps = xhalf_sum(ps);
    l += ps;
    pv_tile(o0, o1, s, vf);
}

#define MFMA8(a, b, c) __builtin_amdgcn_mfma_f32_32x32x16_fp8_fp8((a), (b), (c), 0, 0, 0)
__device__ __forceinline__ void load_k8(long (&kf)[4], const unsigned char* Kt, int lane) {
#pragma unroll
    for (int ks = 0; ks < 4; ++ks) kf[ks] = *(const long*)(Kt + ks * 512 + lane * 8);
}
__device__ __forceinline__ void load_v8(long (&vf)[2][2], const unsigned char* vT, int lane) {
#pragma unroll
    for (int dt = 0; dt < 2; ++dt)
#pragma unroll
        for (int s = 0; s < 2; ++s) vf[dt][s] = *(const long*)(vT + dt * 1024 + s * 512 + lane * 8);
}
__device__ __forceinline__ long pack_fp8x8(float a0, float a1, float a2, float a3, float a4, float a5, float a6, float a7) {
    int w0 = __builtin_amdgcn_cvt_pk_fp8_f32(a0, a1, 0, false); w0 = __builtin_amdgcn_cvt_pk_fp8_f32(a2, a3, w0, true);
    int w1 = __builtin_amdgcn_cvt_pk_fp8_f32(a4, a5, 0, false); w1 = __builtin_amdgcn_cvt_pk_fp8_f32(a6, a7, w1, true);
    return (long)(((unsigned long long)(unsigned)w1 << 32) | (unsigned long long)(unsigned)w0);
}
template <bool FAST> __device__ __forceinline__ void online_step8(f32x16& s, float bias, bool lane_ok, float& m, float& l, f32x16& o0, f32x16& o1, const long (&vf)[2][2]) {
    float mx = fmaxf(fmaxf(fmaxf(s[0], s[1]), fmaxf(s[2], s[3])), fmaxf(fmaxf(s[4], s[5]), fmaxf(s[6], s[7])));
    mx = fmaxf(mx, fmaxf(fmaxf(fmaxf(s[8], s[9]), fmaxf(s[10], s[11])), fmaxf(fmaxf(s[12], s[13]), fmaxf(s[14], s[15]))));
    if (FAST) { mx = mx * QSCALE + bias; mx = lane_ok ? mx : NEG_INF; }
    mx = xhalf_max(mx);
    if (__any(mx > m + 2.0f)) {
        const float mnew = (mx > m + 2.0f) ? mx : m;
        const float alpha = fast_exp2(m - mnew);
        l *= alpha; m = mnew;
#pragma unroll
        for (int i = 0; i < 16; ++i) { o0[i] *= alpha; o1[i] *= alpha; }
    }
    float ps = 0.f;
    if (FAST) {
        const float c = lane_ok ? (m - bias - 6.0f) : __builtin_inff();
#pragma unroll
        for (int i = 0; i < 16; ++i) { s[i] = fast_exp2(__builtin_fmaf(s[i], QSCALE, -c)); ps += s[i]; }
    } else {
        const float c = m - 6.0f;
#pragma unroll
        for (int i = 0; i < 16; ++i) { s[i] = fast_exp2(s[i] - c); ps += s[i]; }
    }
    ps = xhalf_sum(ps);
    l += ps;
#pragma unroll
    for (int t = 0; t < 2; ++t) {
        const long pb = pack_fp8x8(s[8 * t], s[8 * t + 1], s[8 * t + 2], s[8 * t + 3], s[8 * t + 4], s[8 * t + 5], s[8 * t + 6], s[8 * t + 7]);
        o0 = MFMA8(vf[0][t], pb, o0);
        o1 = MFMA8(vf[1][t], pb, o1);
    }
}

__device__ __forceinline__ float max16(const f32x16& s) {
    const float a = fmaxf(fmaxf(fmaxf(s[0], s[1]), fmaxf(s[2], s[3])), fmaxf(fmaxf(s[4], s[5]), fmaxf(s[6], s[7])));
    const float b = fmaxf(fmaxf(fmaxf(s[8], s[9]), fmaxf(s[10], s[11])), fmaxf(fmaxf(s[12], s[13]), fmaxf(s[14], s[15])));
    return fmaxf(a, b);
}
template <bool FAST> __device__ __forceinline__ void online_step8x2(f32x16& sa, f32x16& sb, float bias, bool lane_ok, float& m, float& l, f32x16& o0, f32x16& o1, const long (&va)[2][2], const long (&vb)[2][2]) {
    float mx = fmaxf(max16(sa), max16(sb));
    if (FAST) { mx = mx * QSCALE + bias; mx = lane_ok ? mx : NEG_INF; }
    mx = xhalf_max(mx);
    if (__any(mx > m + 2.0f)) {
        const float mnew = (mx > m + 2.0f) ? mx : m;
        const float alpha = fast_exp2(m - mnew);
        l *= alpha; m = mnew;
#pragma unroll
        for (int i = 0; i < 16; ++i) { o0[i] *= alpha; o1[i] *= alpha; }
    }
    float ps = 0.f, ps2 = 0.f;
    if (FAST) {
        const float c = lane_ok ? (m - bias - 6.0f) : __builtin_inff();
#pragma unroll
        for (int i = 0; i < 16; ++i) { sa[i] = fast_exp2(__builtin_fmaf(sa[i], QSCALE, -c)); ps += sa[i]; sb[i] = fast_exp2(__builtin_fmaf(sb[i], QSCALE, -c)); ps2 += sb[i]; }
    } else {
        const float c = m - 6.0f;
#pragma unroll
        for (int i = 0; i < 16; ++i) { sa[i] = fast_exp2(sa[i] - c); ps += sa[i]; sb[i] = fast_exp2(sb[i] - c); ps2 += sb[i]; }
    }
    ps += ps2;
    ps = xhalf_sum(ps);
    l += ps;
    const long pa0 = pack_fp8x8(sa[0], sa[1], sa[2], sa[3], sa[4], sa[5], sa[6], sa[7]);
    const long pb0 = pack_fp8x8(sb[0], sb[1], sb[2], sb[3], sb[4], sb[5], sb[6], sb[7]);
    o0 = MFMA8(va[0][0], pa0, o0); o1 = MFMA8(va[1][0], pa0, o1);
    const long pa1 = pack_fp8x8(sa[8], sa[9], sa[10], sa[11], sa[12], sa[13], sa[14], sa[15]);
    o0 = MFMA8(vb[0][0], pb0, o0); o1 = MFMA8(vb[1][0], pb0, o1);
    const long pb1 = pack_fp8x8(sb[8], sb[9], sb[10], sb[11], sb[12], sb[13], sb[14], sb[15]);
    o0 = MFMA8(va[0][1], pa1, o0); o1 = MFMA8(va[1][1], pa1, o1);
    o0 = MFMA8(vb[0][1], pb1, o0); o1 = MFMA8(vb[1][1], pb1, o1);
}

__device__ __forceinline__ void nsa_unit(const Params& p, int bg, int jq, LAS unsigned char* lds, int wave, int lane, bool build_lut) {
    LAUNDER(lane);
    const unsigned char* ws = P_ws(p);
    const bf16_t* qb = (const bf16_t*)(ws + WS_R1 + R_Q);
    const bf16_t* kcmp = (const bf16_t*)(ws + WS_R1 + R_KCMP) + (size_t)bg * NCMP * 64;
    const bf16_t* vcmpT = (const bf16_t*)(ws + WS_R1 + R_VCMPT) + (size_t)bg * NCMP * 64;
    const unsigned char* ks8 = ws + WS_R1 + R_KS + (size_t)bg * S * 64;
    const unsigned char* vs8 = ws + WS_R1 + R_VST + (size_t)bg * S * 64;
    const bf16_t* kwb = (const bf16_t*)(ws + WS_R1 + R_KW) + (size_t)bg * S * 64;
    const bf16_t* vwT = (const bf16_t*)(ws + WS_R1 + R_VWT) + (size_t)bg * S * 64;
    const float* gates = (const float*)(ws + WS_R1 + R_GATES);
    bf16_t* mixed = (bf16_t*)(ws + WS_AN);
    const float* relb = P_in(p, 1);
    const int b = bg >> 1, g = bg & 1;
    LAS float* imp = (LAS float*)(lds + wave * NSA_WAVE_LDS);
    LAS unsigned* selw = (LAS unsigned*)(lds + wave * NSA_WAVE_LDS + 8192);
    LAS float* lut = (LAS float*)(lds + wave * NSA_WAVE_LDS + 8192 + 256);
    LAS int* list = (LAS int*)(lds + wave * NSA_WAVE_LDS + 8192 + 256 + 2112);
    const int c = lane & 31, h = lane >> 5, ql = c >> 2, r = c & 3;
    const int tq0 = 64 * jq + 8 * wave, tq = tq0 + ql;
    const size_t tok = (size_t)b * S + tq;

    if (build_lut) {
        for (int e = lane; e < 4 * 129; e += 64) {
            const int rr = e / 129, n = e % 129;
            int bk = n;
            if (n >= 16) bk = 16 + (n >= 19) + (n >= 21) + (n >= 24) + (n >= 27) + (n >= 31) + (n >= 35) + (n >= 40) + (n >= 46) + (n >= 52) + (n >= 59) + (n >= 67) + (n >= 77) + (n >= 87) + (n >= 99) + (n >= 113);
            lut[rr * 132 + n] = relb[bk * 8 + g * 4 + rr] * LOG2E;
        }
    }
    for (int e = lane; e < 2048; e += 64) imp[e] = 0.f;
    {
        const int k = lane & 7; unsigned w = 0u;
        if (k == 0) w |= 1u;
        if ((jq >> 5) == k) w |= 1u << (jq & 31);
        if (jq >= 1 && ((jq - 1) >> 5) == k) w |= 1u << ((jq - 1) & 31);
        selw[lane] = w;
    }
    asm volatile("s_waitcnt lgkmcnt(0)" ::: "memory");
    __builtin_amdgcn_wave_barrier();
    const LAS float* lutr = lut + r * 132;
    const float lutfar = lutr[128];

    bf16x8 qf[4];
#pragma unroll
    for (int ks = 0; ks < 4; ++ks) qf[ks] = *(const bf16x8*)(qb + tok * 512 + (g * 4 + r) * 64 + ks * 16 + h * 8);
    const float g0 = gates[tok * 24 + (g * 4 + r) * 3 + 0], g1 = gates[tok * 24 + (g * 4 + r) * 3 + 1], g2 = gates[tok * 24 + (g * 4 + r) * 3 + 2];

    f32x16 oa0, oa1;
    bf16x8 kf[4], kn[4], vf[2][2];
    {
        const int jmaxw = (tq0 + 7 - 31) >> 4;
        const int ntile = (jmaxw >= 0) ? (jmaxw >> 5) + 1 : 0;
        float m = -1e30f, l = 0.f;
        if (ntile > 0) load_k(kn, kcmp, lane);
        for (int T = 0; T < ntile; ++T) {
#pragma unroll
            for (int ks = 0; ks < 4; ++ks) kf[ks] = kn[ks];
            if (T + 1 < ntile) load_k(kn, kcmp + (size_t)(T + 1) * 2048, lane);
            f32x16 s = qk_tile(kf, qf);
            const int base = 512 * T + 31;
            const bool fast = (tq0 - base - 16 * 31) >= 128;
            score_tile<16>(s, tq - base - 64 * h, 1 << 30, true, fast, lutfar, lutr);
            float mx = s[0];
#pragma unroll
            for (int i = 1; i < 16; ++i) mx = fmaxf(mx, s[i]);
            mx = xhalf_max(mx);
            const float mnew = fmaxf(m, mx);
            float ps = 0.f;
#pragma unroll
            for (int i = 0; i < 16; ++i) ps += fast_exp2(s[i] - mnew);
            ps = xhalf_sum(ps);
            l = l * fast_exp2(m - mnew) + ps; m = mnew;
        }
        const float c2 = (l > 0.f) ? (m + __builtin_amdgcn_logf(l)) : __builtin_inff();
        const float c2f = c2 - lutfar;
        f32x16 o0, o1;
#pragma unroll
        for (int i = 0; i < 16; ++i) { o0[i] = 0.f; o1[i] = 0.f; }
        if (ntile > 0) load_k(kn, kcmp, lane);
        for (int T = 0; T < ntile; ++T) {
#pragma unroll
            for (int ks = 0; ks < 4; ++ks) kf[ks] = kn[ks];
            load_v(vf, vcmpT + (size_t)T * 2048, lane);
            if (T + 1 < ntile) load_k(kn, kcmp + (size_t)(T + 1) * 2048, lane);
            f32x16 s = qk_tile(kf, qf);
            const int base = 512 * T + 31;
            const bool fast = (tq0 - base - 16 * 31) >= 128;
            if (fast) {
#pragma unroll
                for (int i = 0; i < 16; ++i) s[i] = fast_exp2(s[i] - c2f);
            } else {
                score_tile<16>(s, tq - base - 64 * h, 1 << 30, true, false, lutfar, lutr);
#pragma unroll
                for (int i = 0; i < 16; ++i) s[i] = fast_exp2(s[i] - c2);
            }
#pragma unroll
            for (int i4 = 0; i4 < 4; ++i4) {
                float a = (s[4 * i4] + s[4 * i4 + 1]) + (s[4 * i4 + 2] + 0.5f * s[4 * i4 + 3]);
                float bb = 0.5f * s[4 * i4 + 3];
                a = quad_sum(a); bb = quad_sum(bb);
                if (r == i4) {
                    const int n = 8 * T + 2 * i4 + h;
                    atomicAdd((float*)(imp + ql * 256 + n), a);
                    if (n + 1 < 256) atomicAdd((float*)(imp + ql * 256 + n + 1), bb);
                }
            }
            pv_tile(o0, o1, s, vf);
        }
        {
            LAS float* park = (LAS float*)(lds + wave * NSA_WAVE_LDS + 11264);
#pragma unroll
            for (int i = 0; i < 16; ++i) { park[i * 64 + lane] = g0 * o0[i]; park[(16 + i) * 64 + lane] = g0 * o1[i]; }
        }
    }
    asm volatile("s_waitcnt lgkmcnt(0)" ::: "memory");
    __builtin_amdgcn_wave_barrier();
    if (jq >= 3) {
        float val[8][4];
#pragma unroll
        for (int qq = 0; qq < 8; ++qq) {
            const f32x4 iv = *(const LAS f32x4*)(imp + qq * 256 + 4 * lane);
#pragma unroll
            for (int e = 0; e < 4; ++e) { const int n = 4 * lane + e; val[qq][e] = (n >= 1 && n <= jq - 2) ? iv[e] : -1.0f; }
        }
        unsigned mybits[8];
#pragma unroll
        for (int qq = 0; qq < 8; ++qq) mybits[qq] = 0u;
        for (int round = 0; round < 13; ++round) {
#pragma unroll
            for (int qq = 0; qq < 8; ++qq) {
                const float lb = fmaxf(fmaxf(val[qq][0], val[qq][1]), fmaxf(val[qq][2], val[qq][3]));
                const float wm = wave_max_fast(lb);
                const unsigned long long bal = __ballot(lb == wm);
                const int wl = __builtin_ctzll(bal | (1ull << 63));
                const bool win = (lane == wl) && (wm >= 0.f);
                const int e = (val[qq][0] == wm) ? 0 : ((val[qq][1] == wm) ? 1 : ((val[qq][2] == wm) ? 2 : 3));
                mybits[qq] |= win ? (1u << e) : 0u;
                val[qq][0] = (win && e == 0) ? -2.0f : val[qq][0]; val[qq][1] = (win && e == 1) ? -2.0f : val[qq][1];
                val[qq][2] = (win && e == 2) ? -2.0f : val[qq][2]; val[qq][3] = (win && e == 3) ? -2.0f : val[qq][3];
            }
        }
#pragma unroll
        for (int qq = 0; qq < 8; ++qq)
            if (mybits[qq]) atomicOr((unsigned*)(selw + qq * 8 + (lane >> 3)), mybits[qq] << ((lane & 7) * 4));
    }
    asm volatile("s_waitcnt lgkmcnt(0)" ::: "memory");
    __builtin_amdgcn_wave_barrier();
    {
        unsigned uwA = 0u, uwB = 0u;
        if (lane < 8) {
#pragma unroll
            for (int qq = 0; qq < 4; ++qq) { uwA |= selw[qq * 8 + lane]; uwB |= selw[(qq + 4) * 8 + lane]; }
        }
        int cntA = 0, cntB = 0;
        for (int k = 0; k < 8; ++k) {
            unsigned bits = (unsigned)__builtin_amdgcn_readlane((int)uwA, k);
            while (bits) { const int bit = __builtin_ctz(bits); bits &= bits - 1u; if (lane == 0) list[cntA] = 32 * k + bit; ++cntA; }
            bits = (unsigned)__builtin_amdgcn_readlane((int)uwB, k);
            while (bits) { const int bit = __builtin_ctz(bits); bits &= bits - 1u; if (lane == 0) list[64 + cntB] = 32 * k + bit; ++cntB; }
        }
        asm volatile("s_waitcnt lgkmcnt(0)" ::: "memory");
        __builtin_amdgcn_wave_barrier();
        LAS float* ostage = imp;
        const int c16 = lane & 15, fq = lane >> 4, q4 = c16 >> 2, r16 = c16 & 3;
        const LAS float* lutr16 = lut + r16 * 132;
        const float lutfar16 = lutr16[128];
        for (int grp = 0; grp < 2; ++grp) {
            const int cnt = grp ? cntB : cntA, lbase = grp * 64;
            const int tqg = tq0 + 4 * grp + q4, tq0g = tq0 + 4 * grp;
            long q8[2];
            {
                const bf16_t* qp = qb + ((size_t)b * S + tqg) * 512 + (g * 4 + r16) * 64 + 8 * fq;
#pragma unroll
                for (int ks = 0; ks < 2; ++ks) {
                    const bf16x8 qv = *(const bf16x8*)(qp + 32 * ks);
                    float f[8];
#pragma unroll
                    for (int e = 0; e < 8; ++e) f[e] = bf2f((bf16_t)qv[e]) * 4.0f;
                    q8[ks] = pack_fp8x8(f[0], f[1], f[2], f[3], f[4], f[5], f[6], f[7]);
                }
            }
            float m = -1e30f;
            f32x4 lacc = (f32x4){0.f, 0.f, 0.f, 0.f};
            const long ones8 = 0x3838383838383838L;
            f32x4 o[4];
#pragma unroll
            for (int dt = 0; dt < 4; ++dt) o[dt] = (f32x4){0.f, 0.f, 0.f, 0.f};
            const int npair = (cnt + 1) >> 1;
            if (lane == 0 && (cnt & 1)) list[lbase + cnt] = 0;
            asm volatile("s_waitcnt lgkmcnt(0)" ::: "memory");
            __builtin_amdgcn_wave_barrier();
            long k8[2][8], v8[2][8];
            int n0 = __builtin_amdgcn_readfirstlane(list[lbase]), n1 = __builtin_amdgcn_readfirstlane(list[lbase + 1]);
#pragma unroll
            for (int i = 0; i < 4; ++i) { const l64x2 t0 = *(const l64x2*)(ks8 + (size_t)n0 * 4096 + i * 1024 + lane * 16), t1 = *(const l64x2*)(ks8 + (size_t)n1 * 4096 + i * 1024 + lane * 16);
                k8[0][2 * i] = t0[0]; k8[0][2 * i + 1] = t0[1]; k8[1][2 * i] = t1[0]; k8[1][2 * i + 1] = t1[1]; }
            for (int it = 0; it < npair; ++it) {
                const int nb[2] = {n0, n1};
                const bool real1 = (2 * it + 1) < cnt;
#pragma unroll
                for (int u = 0; u < 2; ++u)
#pragma unroll
                    for (int i = 0; i < 4; ++i) { const l64x2 t = *(const l64x2*)(vs8 + (size_t)nb[u] * 4096 + i * 1024 + lane * 16); v8[u][2 * i] = t[0]; v8[u][2 * i + 1] = t[1]; }
                bool ok[2];
                ok[0] = (selw[(grp * 4 + q4) * 8 + (nb[0] >> 5)] >> (nb[0] & 31)) & 1u;
                ok[1] = real1 && ((selw[(grp * 4 + q4) * 8 + (nb[1] >> 5)] >> (nb[1] & 31)) & 1u);
                const int bmax = real1 ? max(nb[0], nb[1]) : nb[0];
                const bool fast = (tq0g - 64 * bmax - 63) >= 128;
                const bool fresh = m < -1e29f;
                const float mref = fresh ? 0.f : m;
                float ini[2];
                ini[0] = fast ? (ok[0] ? -(mref - lutfar16 - 6.0f) : NEG_INF) : 0.f;
                ini[1] = fast ? (ok[1] ? -(mref - lutfar16 - 6.0f) : NEG_INF) : 0.f;
                f32x4 sc[2][4];
#pragma unroll
                for (int u = 0; u < 2; ++u)
#pragma unroll
                    for (int kt = 0; kt < 4; ++kt) {
                        sc[u][kt] = __builtin_amdgcn_mfma_f32_16x16x32_fp8_fp8(k8[u][2 * kt], q8[0], (f32x4){ini[u], ini[u], ini[u], ini[u]}, 0, 0, 0);
                        sc[u][kt] = __builtin_amdgcn_mfma_f32_16x16x32_fp8_fp8(k8[u][2 * kt + 1], q8[1], sc[u][kt], 0, 0, 0);
                    }
                if (it + 1 < npair) {
                    n0 = __builtin_amdgcn_readfirstlane(list[lbase + 2 * it + 2]); n1 = __builtin_amdgcn_readfirstlane(list[lbase + 2 * it + 3]);
#pragma unroll
                    for (int i = 0; i < 4; ++i) { const l64x2 t0 = *(const l64x2*)(ks8 + (size_t)n0 * 4096 + i * 1024 + lane * 16), t1 = *(const l64x2*)(ks8 + (size_t)n1 * 4096 + i * 1024 + lane * 16);
                        k8[0][2 * i] = t0[0]; k8[0][2 * i + 1] = t0[1]; k8[1][2 * i] = t1[0]; k8[1][2 * i + 1] = t1[1]; }
                }
                if (fast) {
                    float t = NEG_INF;
#pragma unroll
                    for (int u = 0; u < 2; ++u) {
                        float tt = fmaxf(fmaxf(fmaxf(sc[u][0][0], sc[u][0][1]), fmaxf(sc[u][0][2], sc[u][0][3])), fmaxf(fmaxf(sc[u][1][0], sc[u][1][1]), fmaxf(sc[u][1][2], sc[u][1][3])));
                        tt = fmaxf(tt, fmaxf(fmaxf(fmaxf(sc[u][2][0], sc[u][2][1]), fmaxf(sc[u][2][2], sc[u][2][3])), fmaxf(fmaxf(sc[u][3][0], sc[u][3][1]), fmaxf(sc[u][3][2], sc[u][3][3]))));
                        t = fmaxf(t, tt);
                    }
                    { auto t1 = __builtin_amdgcn_permlane16_swap(__float_as_uint(t), __float_as_uint(t), false, false); t = fmaxf(__uint_as_float(t1[0]), __uint_as_float(t1[1])); t = xhalf_max(t); }
                    const float mxt = t - 6.0f + mref;
                    const bool need = fresh ? (t > NEG_INF) : (mxt > m + 2.0f);
                    if (__any(need)) {
                        const float mnew = need ? mxt : m;
                        const float delta = need ? (mnew - mref) : 0.f;
                        const float alpha = (need && !fresh) ? fast_exp2(m - mnew) : 1.0f;
                        lacc = lacc * alpha; m = mnew;
#pragma unroll
                        for (int dt = 0; dt < 4; ++dt) o[dt] = o[dt] * alpha;
#pragma unroll
                        for (int u = 0; u < 2; ++u)
#pragma unroll
                            for (int kt = 0; kt < 4; ++kt) sc[u][kt] = sc[u][kt] - delta;
                    }
#pragma unroll
                    for (int u = 0; u < 2; ++u)
#pragma unroll
                        for (int kt = 0; kt < 4; ++kt)
#pragma unroll
                            for (int e = 0; e < 4; ++e) sc[u][kt][e] = fast_exp2(sc[u][kt][e]);
                } else {
                    float mx = NEG_INF;
#pragma unroll
                    for (int u = 0; u < 2; ++u)
#pragma unroll
                        for (int kt = 0; kt < 4; ++kt)
#pragma unroll
                            for (int e = 0; e < 4; ++e) {
                                const int d = tqg - 64 * nb[u] - 16 * kt - 4 * fq - e;
                                const bool okk = ok[u] && d >= 0;
                                const float v = okk ? (sc[u][kt][e] + lutr16[min(max(d, 0), 128)]) : NEG_INF;
                                sc[u][kt][e] = v; mx = fmaxf(mx, v);
                            }
                    { auto t1 = __builtin_amdgcn_permlane16_swap(__float_as_uint(mx), __float_as_uint(mx), false, false); mx = fmaxf(__uint_as_float(t1[0]), __uint_as_float(t1[1])); mx = xhalf_max(mx); }
                    if (__any(mx > m + 2.0f)) {
                        const float mnew = (mx > m + 2.0f) ? mx : m;
                        const float alpha = fast_exp2(m - mnew);
                        lacc = lacc * alpha; m = mnew;
#pragma unroll
                        for (int dt = 0; dt < 4; ++dt) o[dt] = o[dt] * alpha;
                    }
                    const float cexp = m - 6.0f;
#pragma unroll
                    for (int u = 0; u < 2; ++u)
#pragma unroll
                        for (int kt = 0; kt < 4; ++kt)
#pragma unroll
                            for (int e = 0; e < 4; ++e) sc[u][kt][e] = fast_exp2(sc[u][kt][e] - cexp);
                }
#pragma unroll
                for (int u = 0; u < 2; ++u) {
                    const long pb0 = pack_fp8x8(sc[u][0][0], sc[u][0][1], sc[u][0][2], sc[u][0][3], sc[u][1][0], sc[u][1][1], sc[u][1][2], sc[u][1][3]);
                    const long pb1 = pack_fp8x8(sc[u][2][0], sc[u][2][1], sc[u][2][2], sc[u][2][3], sc[u][3][0], sc[u][3][1], sc[u][3][2], sc[u][3][3]);
#pragma unroll
                    for (int dt = 0; dt < 4; ++dt) {
                        o[dt] = __builtin_amdgcn_mfma_f32_16x16x32_fp8_fp8(v8[u][2 * dt], pb0, o[dt], 0, 0, 0);
                        o[dt] = __builtin_amdgcn_mfma_f32_16x16x32_fp8_fp8(v8[u][2 * dt + 1], pb1, o[dt], 0, 0, 0);
                    }
                    lacc = __builtin_amdgcn_mfma_f32_16x16x32_fp8_fp8(ones8, pb0, lacc, 0, 0, 0);
                    lacc = __builtin_amdgcn_mfma_f32_16x16x32_fp8_fp8(ones8, pb1, lacc, 0, 0, 0);
                }
            }
            const float l = lacc[0];
            const float invl = (l > 0.f) ? 1.0f / l : 0.f;
#pragma unroll
            for (int dt = 0; dt < 4; ++dt) *(LAS f32x4*)(ostage + ((grp * 4 + q4) * 4 + r16) * 64 + 16 * dt + 4 * fq) = o[dt] * invl;
        }
        asm volatile("s_waitcnt lgkmcnt(0)" ::: "memory");
        __builtin_amdgcn_wave_barrier();
        {
            const LAS float* park = (const LAS float*)(lds + wave * NSA_WAVE_LDS + 11264);
#pragma unroll
            for (int i = 0; i < 16; ++i) { oa0[i] = park[i * 64 + lane]; oa1[i] = park[(16 + i) * 64 + lane]; }
        }
#pragma unroll
        for (int dt = 0; dt < 2; ++dt)
#pragma unroll
            for (int i4 = 0; i4 < 4; ++i4) {
                const f32x4 v = *(const LAS f32x4*)(ostage + (ql * 4 + r) * 64 + 32 * dt + 8 * i4 + 4 * h);
                if (dt == 0) { oa0[4 * i4] += g1 * v[0]; oa0[4 * i4 + 1] += g1 * v[1]; oa0[4 * i4 + 2] += g1 * v[2]; oa0[4 * i4 + 3] += g1 * v[3]; }
                else         { oa1[4 * i4] += g1 * v[0]; oa1[4 * i4 + 1] += g1 * v[1]; oa1[4 * i4 + 2] += g1 * v[2]; oa1[4 * i4 + 3] += g1 * v[3]; }
            }
        asm volatile("s_waitcnt lgkmcnt(0)" ::: "memory");
        __builtin_amdgcn_wave_barrier();
    }
    {
        {
            const bf16_t* qp = qb + tok * 512 + (g * 4 + r) * 64 + h * 8;
            asm volatile("" : "+v"(qp));
#pragma unroll
            for (int ks = 0; ks < 4; ++ks) qf[ks] = *(const bf16x8*)(qp + ks * 16);
        }
        const int T0 = max(0, (tq0 - 511) >> 5), T1 = (tq0 + 7) >> 5;
        float m = -1e30f, l = 0.f;
        f32x16 o0, o1;
#pragma unroll
        for (int i = 0; i < 16; ++i) { o0[i] = 0.f; o1[i] = 0.f; }
        load_k(kn, kwb + (size_t)(32 * T0) * 64, lane);
        for (int T = T0; T <= T1; ++T) {
#pragma unroll
            for (int ks = 0; ks < 4; ++ks) kf[ks] = kn[ks];
            load_v(vf, vwT + (size_t)T * 2048, lane);
            if (T < T1) load_k(kn, kwb + (size_t)(32 * (T + 1)) * 64, lane);
            const int base = 32 * T;
            f32x16 s = qk_tile(kf, qf);
            if (((tq0 - base - 31) >= 128) && ((tq0 + 7 - base) < 512)) online_step<true>(s, lutfar, true, m, l, o0, o1, vf);
            else { score_tile<1>(s, tq - base - 4 * h, 512, true, false, lutfar, lutr); online_step<false>(s, 0.f, true, m, l, o0, o1, vf); }
        }
        const float sc = (l > 0.f) ? g2 / l : 0.f;
#pragma unroll
        for (int i = 0; i < 16; ++i) { oa0[i] += sc * o0[i]; oa1[i] += sc * o1[i]; }
    }
    bf16_t* orow = mixed + tok * 1024 + (g * 4 + r) * 64;
#pragma unroll
    for (int dt = 0; dt < 2; ++dt)
#pragma unroll
        for (int i4 = 0; i4 < 4; ++i4) {
            const f32x16& a = dt ? oa1 : oa0;
            u32x2 o; o.x = cvt_pk_bf16(a[4 * i4], a[4 * i4 + 1]); o.y = cvt_pk_bf16(a[4 * i4 + 2], a[4 * i4 + 3]);
            *(u32x2*)(orow + 32 * dt + 8 * i4 + 4 * h) = o;
        }
}


#define XB_TMO      128
#define XB_XCNT(j)  (256  + 64 * (j))
#define XB_XSUB(j)  (1280 + 64 * (j))
#define XB_XGEN(j)  (2304 + 64 * (j))
#define XB_TOP      3328
#define XB_TOPGEN   3392
#define XCD_BAR_WORDS 3456
#define XB_SPIN_CAP (1u << 22)
__device__ __forceinline__ unsigned xb_ld(unsigned* p)              { return __hip_atomic_load(p, __ATOMIC_RELAXED, __HIP_MEMORY_SCOPE_AGENT); }
__device__ __forceinline__ unsigned xb_add(unsigned* p, unsigned v) { return __hip_atomic_fetch_add(p, v, __ATOMIC_RELAXED, __HIP_MEMORY_SCOPE_AGENT); }
__device__ __forceinline__ unsigned xb_xcc_id() { return (unsigned)__builtin_amdgcn_s_getreg((3 << 11) | 20) & 0xFu; }
#define XB_SPIN(cond, bar) do { unsigned _sp = 0; while (cond) { __builtin_amdgcn_s_sleep(1); \
    if ((++_sp & 255u) == 0u) { if (xb_ld(&(bar)[XB_TMO])) break; if (_sp > XB_SPIN_CAP) { atomicAdd(&(bar)[XB_TMO], 1u); break; } } } } while (0)
__device__ __forceinline__ void xcd_barrier_complete(unsigned* bar, unsigned x, unsigned& nloc, unsigned& nx) {
    const unsigned G = gridDim.x * gridDim.y * gridDim.z;
    unsigned sum, cnt, mine, sp = 0u;
    for (;;) {
        sum = 0u; cnt = 0u; mine = 0u;
#pragma unroll
        for (unsigned j = 0; j < 16; ++j) { const unsigned c = xb_ld(&bar[XB_XCNT(j)]); sum += c; cnt += (c > 0u) ? 1u : 0u; mine = (j == x) ? c : mine; }
        if (sum == G) break;
        __builtin_amdgcn_s_sleep(1);
        if ((++sp & 255u) == 0u) { if (xb_ld(&bar[XB_TMO])) break; if (sp > XB_SPIN_CAP) { atomicAdd(&bar[XB_TMO], 1u); break; } }
    }
    nloc = mine > 0u ? mine : 1u; nx = cnt > 0u ? cnt : 1u;
}
__device__ __forceinline__ void xcd_barrier(unsigned* bar, volatile LAS unsigned* st) {
    asm volatile("s_waitcnt vmcnt(0)" ::: "memory");
    __syncthreads();
    if (threadIdx.x == 0) {
        const unsigned x = xb_xcc_id();
        __builtin_amdgcn_s_waitcnt(0);
        unsigned nloc = st[0], nx = st[1];
        if (nloc == 0u) { xcd_barrier_complete(bar, x, nloc, nx); st[0] = nloc; st[1] = nx; }
        const unsigned old = xb_add(&bar[XB_XSUB(x)], 1u);
        const unsigned gen = old / nloc;
        if (old + 1u == (gen + 1u) * nloc) {
            __builtin_amdgcn_fence(__ATOMIC_RELEASE, "agent");
            asm volatile("s_waitcnt vmcnt(0)" ::: "memory");
            const unsigned og = xb_add(&bar[XB_TOP], 1u);
            const unsigned tg = og / nx;
            if (og + 1u == (tg + 1u) * nx) xb_add(&bar[XB_TOPGEN], 1u);
            else XB_SPIN(xb_ld(&bar[XB_TOPGEN]) == tg, bar);
            __builtin_amdgcn_fence(__ATOMIC_ACQUIRE, "agent");
            xb_add(&bar[XB_XGEN(x)], 1u);
            asm volatile("s_waitcnt vmcnt(0)" ::: "memory");
        } else {
            XB_SPIN(xb_ld(&bar[XB_XGEN(x)]) == gen, bar);
            __builtin_amdgcn_fence(__ATOMIC_ACQUIRE, "agent");
            asm volatile("s_waitcnt vmcnt(0)" ::: "memory");
        }
    }
    __syncthreads();
}

__global__ void __launch_bounds__(NTHREADS, 2) fwd_megakernel(Params p) {
    extern __shared__ __attribute__((aligned(16))) unsigned char lds_raw[];
    LAS unsigned char* lds = (LAS unsigned char*)lds_raw;
    cg::grid_group grid = cg::this_grid();
#define TID_F ({ int _t = threadIdx.x; LAUNDER(_t); _t; })
#define LANE_F (TID_F & 63)
#define WAVE_F (__builtin_amdgcn_readfirstlane(TID_F >> 6))
    const int G = gridDim.x, bx = blockIdx.x;
    const int NGW = G * NWAVES;
#define GW_F (bx * NWAVES + WAVE_F)
#define FRESH_WS unsigned char* ws = P_ws(p); bf16_t* AN = (bf16_t*)(ws + WS_AN); float* MIX = (float*)(ws + WS_MIX); (void)AN; (void)MIX

    { const int tid = TID_F; if (tid < 16) ((LAS unsigned*)(lds + LDS_BYTES - 64))[tid] = 0u; }
    if (bx == 0) { unsigned* barw = (unsigned*)P_ws(p); for (int i = TID_F; i < XCD_BAR_WORDS; i += NTHREADS) barw[i] = 0u; }
    { const int t = TID_F; if (t < 128) ((unsigned*)(P_ws(p) + WS_XCNT))[bx * 128 + t] = 0u; }
    __syncthreads();
    {
        FRESH_WS;
        const int tid = TID_F, lane = tid & 63, wave = __builtin_amdgcn_readfirstlane(tid >> 6), gw = bx * NWAVES + wave;
        LAS float* scr = (LAS float*)(lds + wave * 17408);
        for (int layer = 0; layer < DEPTH; ++layer) {
            unsigned char* wl = ws + WS_W + (size_t)layer * W_LAYER;
            const int I_IN = 16 * (NINP / 64), I_OUT = 16 * 16, I_GU = 16 * (NGU / 64), I_DN = 44 * 16, I_C1 = 32 * 4, I_C2 = 4 * 1;
            const int NIT = I_IN + I_OUT + I_GU + I_DN + 2 * I_C1 + 2 * I_C2;
            for (int it = gw; it < NIT; it += NGW) {
                int r = it;
                if (r < I_IN) { transpose_item<1>(P_in(p, 6) + (size_t)layer * DM * INW, DM, INW, (bf16_t*)(wl + W_IN), NINP / 64, r, scr, lane, P_in(p, 2) + layer * DM); continue; } r -= I_IN;
                if (r < I_OUT) { transpose_item<0>(P_in(p, 17) + (size_t)layer * DM * DM, DM, DM, (bf16_t*)(wl + W_OUT), 16, r, scr, lane); continue; } r -= I_OUT;
                if (r < I_GU) { transpose_item<2>(P_in(p, 18) + (size_t)layer * DM * NGU, DM, NGU, (bf16_t*)(wl + W_GU), NGU / 64, r, scr, lane, P_in(p, 4) + layer * DM); continue; } r -= I_GU;
                if (r < I_DN) { transpose_item<0>(P_in(p, 19) + (size_t)layer * DFF * DM, DFF, DM, (bf16_t*)(wl + W_DN), 16, r, scr, lane); continue; } r -= I_DN;
                if (r < I_C1) { transpose_item<0>(P_in(p, 8) + (size_t)layer * 2048 * 256, 2048, 256, (bf16_t*)(wl + W_C1K), 4, r, scr, lane); continue; } r -= I_C1;
                if (r < I_C1) { transpose_item<0>(P_in(p, 11) + (size_t)layer * 2048 * 256, 2048, 256, (bf16_t*)(wl + W_C1V), 4, r, scr, lane); continue; } r -= I_C1;
                if (r < I_C2) { transpose_item<0>(P_in(p, 9) + (size_t)layer * 256 * 64, 256, 64, (bf16_t*)(wl + W_C2K), 1, r, scr, lane); continue; } r -= I_C2;
                transpose_item<0>(P_in(p, 12) + (size_t)layer * 256 * 64, 256, 64, (bf16_t*)(wl + W_C2V), 1, r, scr, lane);
            }
        }
        __syncthreads();
        if (bx >= G - 2 * DEPTH) {
            const int id = G - 1 - bx, layer = id >> 1, kv = id & 1;
            const float* pos = P_in(p, kv ? 10 : 7) + (size_t)layer * 2048;
            const float* w1 = P_in(p, kv ? 11 : 8) + (size_t)layer * 2048 * 256;
            LAS float* red = (LAS float*)lds;
            f32x4 acc4 = (f32x4){0.f, 0.f, 0.f, 0.f};
#pragma unroll 8
            for (int i = wave * 256; i < wave * 256 + 256; ++i) { const f32x4 w = *(const f32x4*)(w1 + (size_t)i * 256 + 4 * lane); acc4 = acc4 + w * pos[i]; }
            red[wave * 256 + 4 * lane + 0] = acc4[0]; red[wave * 256 + 4 * lane + 1] = acc4[1]; red[wave * 256 + 4 * lane + 2] = acc4[2]; red[wave * 256 + 4 * lane + 3] = acc4[3];
            __syncthreads();
            if (tid < 256) { float sum = 0.f;
#pragma unroll
                for (int w = 0; w < 8; ++w) sum += red[w * 256 + tid];
                ((float*)(ws + WS_W + (size_t)layer * W_LAYER + (kv ? W_CBV : W_CBK)))[tid] = sum; }
            __syncthreads();
        }
        row_pass(P_in(p, 0), (bf16_t*)(ws + WS_HB), nullptr, nullptr, (float*)(ws + WS_RS), nullptr, gw, NGW, lane);
    }
    grid.sync();
    if (TID_F == 0) (void)xb_add(&((unsigned*)P_ws(p))[XB_XCNT(xb_xcc_id())], 1u);

#pragma unroll 1
    for (int layer = 0; layer < DEPTH; ++layer) {
        const size_t wloff = WS_W + (size_t)layer * W_LAYER;
#ifndef SKIP_PA
        {
            FRESH_WS; unsigned char* wl = ws + wloff;
            pg8::Gemm g{(const bf16_t*)(ws + WS_HB), (const bf16_t*)(wl + W_IN), MT, NINP, DM, DM};
            pg8::StaticOrder so; so.init(MT, NINP, G, bx, REP_PA);
            pg8::EpiIn E{ws + WS_R1, (const float*)(ws + WS_RS)};
            pg8::gemm_phase<pg8::EpiIn>(lds, g, so, E);
        }
#endif
        GSYNC();
#ifndef SKIP_PB
        for (int rep = 0; rep < REP_PB; ++rep) {
            FRESH_WS; unsigned char* wl = ws + wloff;
            for (int kv = 0; kv < 2; ++kv) {
                const int c = kv ? ((bx + (G >> 1)) % G) : bx;
                if (c < 16) {
                    bf16_t* hid = (bf16_t*)(ws + WS_R1 + R_HID) + (size_t)kv * 4096 * 256;
                    pg8::Gemm g{(const bf16_t*)(ws + WS_R1 + (kv ? R_VC : R_KC)), (const bf16_t*)(wl + (kv ? W_C1V : W_C1K)), 4096, 256, 2048, 1024};
                    pg8::StaticOrder so; so.init(4096, 256, G, c);
                    pg8::EpiCmp1 E{hid, (const float*)(wl + (kv ? W_CBV : W_CBK))};
                    pg8::gemm_phase<pg8::EpiCmp1>(lds, g, so, E);
                    pg8::Unit u; so.next(0, u);
                    asm volatile("s_waitcnt vmcnt(0)" ::: "memory");
                    __builtin_amdgcn_fence(__ATOMIC_RELEASE, "agent");
                    __syncthreads();
                    __builtin_amdgcn_fence(__ATOMIC_ACQUIRE, "agent");
                    cmp_gemm2(hid, (const bf16_t*)(wl + (kv ? W_C2V : W_C2K)), (bf16_t*)(ws + WS_R1 + R_KCMP), (bf16_t*)(ws + WS_R1 + R_VCMPT), kv, u.pm * 256 + WAVE_F * 32, LANE_F);
                    __syncthreads();
                }
            }
            if (G == 256) {
                const bool is_cmp = (bx < 16) || (bx >= 128 && bx < 144);
                if (!is_cmp) {
                    const int idx = (bx < 128) ? (bx - 16) : (bx - 32);
                    gmlp_unit(p, layer, idx, lds, WAVE_F, LANE_F);
                    if (idx + 224 < MT / 128) gmlp_unit(p, layer, idx + 224, lds, WAVE_F, LANE_F);
                }
            } else {
                for (int ch = bx; ch < MT / 128; ch += G) gmlp_unit(p, layer, ch, lds, WAVE_F, LANE_F);
            }
        }
#endif
        GSYNC();
        {
#if NSA_ENABLE
            __syncthreads();
            for (int rep = 0; rep < REP_PC; ++rep) {
                if (G == 256) {
                    const int x = bx & 7, y = bx >> 3, bg = x >> 1, j = (x & 1) * 32 + y;
                    for (int i = 0; i < 4; ++i) {
                        const int jq = (i >> 1) * 128 + ((i & 1) ? (127 - j) : j);
                        nsa_unit(p, bg, jq, lds, WAVE_F, LANE_F, i == 0);
                    }
                } else {
                    for (int i = 0; bx + i * G < 1024; ++i) {
                        const int u = bx + i * G;
                        const int bg = u >> 8, x = u & 255;
                        const int jq = (bg & 1) ? (255 - x) : x;
                        nsa_unit(p, bg, jq, lds, WAVE_F, LANE_F, true);
                    }
                }
            }
#else
            FRESH_WS;
            bf16_t* mixed = (bf16_t*)(ws + WS_AN);
            for (int m = GW_F; m < MT; m += NGW) { u32x4* o = (u32x4*)(mixed + (size_t)m * 1024); o[LANE_F] = (u32x4){0u, 0u, 0u, 0u}; }
#endif
        }
        GSYNC();
        {
            FRESH_WS; unsigned char* wl = ws + wloff;
            pg8::Gemm g{AN, (const bf16_t*)(wl + W_OUT), MT, DM, DM, DM};
            pg8::StaticOrder so; so.init(MT, DM, G, bx, 1);
            pg8::EpiNormRes E{ws, P_in(p, 3) + layer * DM, nullptr, 2 * layer};
            pg8::gemm_phase<pg8::EpiNormRes>(lds, g, so, E);
        }
        GSYNC();
#ifndef SKIP_PF
        {
            FRESH_WS; unsigned char* wl = ws + wloff;
            pg8::Gemm g{(const bf16_t*)(ws + WS_HB), (const bf16_t*)(wl + W_GU), MT, NGU, DM, DM};
            pg8::StaticOrder so; so.init(MT, NGU, G, bx, REP_PF);
            pg8::EpiGU E{(bf16_t*)(ws + WS_R1), (const float*)(ws + WS_RS)};
            pg8::gemm_phase<pg8::EpiGU>(lds, g, so, E);
        }
#endif
        GSYNC();
        {
            FRESH_WS; unsigned char* wl = ws + wloff;
            pg8::Gemm g{(const bf16_t*)(ws + WS_R1), (const bf16_t*)(wl + W_DN), MT, DM, DFF, DFF};
            pg8::StaticOrder so; so.init(MT, DM, G, bx, 1);
            pg8::EpiNormRes E{ws, P_in(p, 5) + layer * DM, (layer + 1 < DEPTH) ? nullptr : P_out(p), 2 * layer + 1};
            pg8::gemm_phase<pg8::EpiNormRes>(lds, g, so, E);
        }
        if (layer + 1 < DEPTH) GSYNC();
    }
}

extern "C" void kernel_launch(void* const* d_in, const int* in_sizes, int n_in, void* d_out, int out_size, void* d_ws, size_t ws_size, hipStream_t stream) {
    static int grid = 0;
    if (grid == 0) {
        if (n_in != 20 || out_size != MT * DM || ws_size < WS_END) { fprintf(stderr, "kernel_launch: unexpected shapes (n_in %d out %d ws %zu need %zu)\n", n_in, out_size, ws_size, (size_t)WS_END); grid = -1; return; }
        int dev = 0, cus = 0, per_cu = 0;
        hipGetDevice(&dev);
        hipDeviceGetAttribute(&cus, hipDeviceAttributeMultiprocessorCount, dev);
        if (hipFuncSetAttribute((const void*)fwd_megakernel, hipFuncAttributeMaxDynamicSharedMemorySize, LDS_BYTES) != hipSuccess) { fprintf(stderr, "kernel_launch: hipFuncSetAttribute failed\n"); grid = -1; return; }
        if (hipOccupancyMaxActiveBlocksPerMultiprocessor(&per_cu, (const void*)fwd_megakernel, NTHREADS, LDS_BYTES) != hipSuccess || per_cu < 1) { fprintf(stderr, "kernel_launch: occupancy query says %d\n", per_cu); per_cu = 1; }
        (void)hipGetLastError();
        grid = cus;
        if (grid > 256) grid = 256;
    }
    if (grid < 0) return;
    Params p{};
    for (int i = 0; i < 20; ++i) p.in[i] = (const float*)d_in[i];
    p.out = (float*)d_out; p.ws = (unsigned char*)d_ws;
    void* args[] = {&p};
    hipError_t e = hipLaunchCooperativeKernel((const void*)fwd_megakernel, dim3(grid), dim3(NTHREADS), args, LDS_BYTES, stream);
    if (e != hipSuccess) fprintf(stderr, "cooperative launch failed: %s (grid %d)\n", hipGetErrorString(e), grid);
}
```

```cpp
#include <hip/hip_runtime.h>
#include <hip/hip_cooperative_groups.h>
#include <cstdio>
#include <cstdint>
namespace cg = cooperative_groups;

#define LAS __attribute__((address_space(3)))
typedef unsigned short bf16_t;
typedef short bf16x8 __attribute__((ext_vector_type(8)));
typedef short s16x4 __attribute__((ext_vector_type(4)));
typedef float f32x2 __attribute__((ext_vector_type(2)));
typedef float f32x4 __attribute__((ext_vector_type(4)));
typedef float f32x16 __attribute__((ext_vector_type(16)));
typedef unsigned u32x2 __attribute__((ext_vector_type(2)));
typedef unsigned u32x4 __attribute__((ext_vector_type(4)));
typedef long l64x2 __attribute__((ext_vector_type(2)));

#ifndef REP_PA
#define REP_PA 1
#endif
#ifndef REP_PB
#define REP_PB 1
#endif
#ifndef REP_PC
#define REP_PC 1
#endif
#ifndef REP_PD
#define REP_PD 1
#endif
#ifndef REP_PF
#define REP_PF 1
#endif
#ifndef REP_PG
#define REP_PG 1
#endif
#ifndef SYNC_REP
#define SYNC_REP 1
#endif
#define GSYNC() do { for (int _r = 0; _r < SYNC_REP; ++_r) xcd_barrier((unsigned*)P_ws(p), (volatile LAS unsigned*)(lds + LDS_BYTES - 64)); } while (0)
#ifndef NSA_ENABLE
#define NSA_ENABLE 1
#endif

constexpr int NB = 2, S = 16384, DM = 1024, DEPTH = 4, MT = NB * S;
constexpr int INW = 2328, NINP = 2560, DFF = 2816, NGU = 2 * DFF;
constexpr int NCMP = 1024;
constexpr float RMS_EPS = 1e-6f, LN_EPS = 1e-5f;
constexpr float LOG2E = 1.4426950408889634f;
constexpr float QSCALE = 0.125f * LOG2E;
constexpr int NWAVES = 8, NTHREADS = 512;
constexpr int LDS_BYTES = 156672;

constexpr size_t MiB = 1u << 20;
constexpr size_t WS_W = 1 * MiB, W_LAYER = 26 * MiB;
constexpr size_t W_IN = 0, W_OUT = 5 * MiB, W_GU = 7 * MiB, W_DN = 18 * MiB, W_C1K = 23 * MiB + 512 * 1024, W_C1V = 24 * MiB + 512 * 1024,
                 W_C2K = 25 * MiB + 512 * 1024, W_C2V = W_C2K + 64 * 1024, W_CBK = W_C2V + 64 * 1024, W_CBV = W_CBK + 4096;
constexpr size_t WS_AN = 105 * MiB;
constexpr size_t WS_R1 = 169 * MiB;
constexpr size_t R_Q = 0, R_ZU = 32 * MiB, R_ZV = 64 * MiB, R_KC = 96 * MiB, R_VC = 105 * MiB, R_KS = 114 * MiB, R_VST = 122 * MiB, R_KW = 130 * MiB,
                 R_VWT = 138 * MiB, R_GATES = 146 * MiB, R_HID = 150 * MiB, R_KCMP = 154 * MiB, R_VCMPT = 155 * MiB;
constexpr size_t WS_MIX = 345 * MiB;
constexpr size_t WS_HB = WS_MIX + 64 * MiB;
constexpr size_t WS_RS = 256 * 1024;
constexpr size_t WS_XCNT = 512 * 1024;
constexpr size_t WS_XBUF = WS_MIX;
constexpr size_t WS_END = 473 * MiB;

struct Params {
    const float* in[20];
    float* out;
    unsigned char* ws;
};

typedef const __attribute__((address_space(4))) unsigned char* kargp_t;
__device__ __forceinline__ void* karg_ld(int byte_off) {
    kargp_t k = (kargp_t)__builtin_amdgcn_kernarg_segment_ptr();
    int off = byte_off; asm volatile("" : "+s"(off));
    return *(void* const __attribute__((address_space(4)))*)(k + off);
}
__device__ __forceinline__ const float* P_in(const Params&, int i) { return (const float*)karg_ld(8 * i); }
__device__ __forceinline__ float* P_out(const Params&) { return (float*)karg_ld(160); }
__device__ __forceinline__ unsigned char* P_ws(const Params&) { return (unsigned char*)karg_ld(168); }
__device__ __forceinline__ unsigned cvt_pk_bf16(float lo, float hi) { unsigned r; asm volatile("v_cvt_pk_bf16_f32 %0, %1, %2" : "=v"(r) : "v"(lo), "v"(hi)); return r; }
__device__ __forceinline__ float fast_exp2(float x) { return __builtin_amdgcn_exp2f(x); }
__device__ __forceinline__ float fast_rcp(float x) { return __builtin_amdgcn_rcpf(x); }
__device__ __forceinline__ float gelu_tanh(float x) { const float u = x + 0.044715f * x * x * x; return x * fast_rcp(1.0f + fast_exp2(-2.3022081982f * u)); }
__device__ __forceinline__ float silu_f(float x) { return x * fast_rcp(1.0f + fast_exp2(-LOG2E * x)); }
__device__ __forceinline__ float sigmoid_f(float x) { return fast_rcp(1.0f + fast_exp2(-LOG2E * x)); }
__device__ __forceinline__ float wave_sum(float v) {
#pragma unroll
    for (int o = 1; o < 64; o <<= 1) v += __shfl_xor(v, o);
    return v;
}
__device__ __forceinline__ float wave_max(float v) {
#pragma unroll
    for (int o = 1; o < 64; o <<= 1) v = fmaxf(v, __shfl_xor(v, o));
    return v;
}
template <int CTRL> __device__ __forceinline__ float dpp_f(float x) { return __builtin_bit_cast(float, __builtin_amdgcn_mov_dpp(__builtin_bit_cast(int, x), CTRL, 0xf, 0xf, true)); }
__device__ __forceinline__ float xhalf_max(float x) { auto t = __builtin_amdgcn_permlane32_swap(__float_as_uint(x), __float_as_uint(x), false, false); return fmaxf(__uint_as_float(t[0]), __uint_as_float(t[1])); }
__device__ __forceinline__ float xhalf_sum(float x) { auto t = __builtin_amdgcn_permlane32_swap(__float_as_uint(x), __float_as_uint(x), false, false); return __uint_as_float(t[0]) + __uint_as_float(t[1]); }
__device__ __forceinline__ float quad_sum(float x) { x += dpp_f<0xB1>(x); x += dpp_f<0x4E>(x); return x; }
__device__ __forceinline__ float wave_max_fast(float x) {
    x = fmaxf(x, dpp_f<0xB1>(x)); x = fmaxf(x, dpp_f<0x4E>(x)); x = fmaxf(x, dpp_f<0x141>(x)); x = fmaxf(x, dpp_f<0x128>(x));
    auto s = __builtin_amdgcn_permlane16_swap(__float_as_uint(x), __float_as_uint(x), false, false); x = fmaxf(__uint_as_float(s[0]), __uint_as_float(s[1]));
    return xhalf_max(x);
}
__device__ __forceinline__ float wave_sum_fast(float x) {
    x += dpp_f<0xB1>(x); x += dpp_f<0x4E>(x); x += dpp_f<0x141>(x); x += dpp_f<0x128>(x);
    auto s = __builtin_amdgcn_permlane16_swap(__float_as_uint(x), __float_as_uint(x), false, false); x = __uint_as_float(s[0]) + __uint_as_float(s[1]);
    return xhalf_sum(x);
}
__device__ __forceinline__ float bf2f(bf16_t b) { return __uint_as_float(((unsigned)b) << 16); }
#define LAUNDER(x) asm volatile("" : "+v"(x))
#define MFMA32(a, b, c) __builtin_amdgcn_mfma_f32_32x32x16_bf16((a), (b), (c), 0, 0, 0)

namespace pg8 {
constexpr int BM = 256, BK = 64, HALF = 128, HTB = HALF * BK * 2, STAGE_BYTES = 8 * HTB, NXCD = 8, WGM = 8;
__host__ __device__ __forceinline__ int lds_byte(int r, int c) { const int st = (r >> 4) * 2 + (c >> 5), rr = r & 15, cc = c & 31, ob = rr * 64 + cc * 2; return st * 1024 + (ob ^ (((ob >> 9) & 1) << 5)); }
__host__ __device__ __forceinline__ void stage_rc(int b, int& R, int& C) { const int st = b / 1024, sb = b % 1024, swz = sb ^ (((sb >> 9) & 1) << 5); R = (st >> 1) * 16 + swz / 64; C = (st & 1) * 32 + (swz % 64) / 2; }
__host__ __device__ __forceinline__ int perm32(int rho) { const int n = rho >> 4, i = rho & 15; return 8 * (i >> 2) + 4 * n + (i & 3); }

struct Unit { int pm, pn; };
struct Gemm { const bf16_t* A; const bf16_t* Bt; int M, N, K, lda; };

struct StaticOrder {
    int nM, nN, nwg, G, c, lim;
    __device__ __forceinline__ void init(int M, int N, int G_, int c_, int reps = 1) { nM = M / BM; nN = N / BM; nwg = nM * nN; G = G_; c = c_; const int per = (c < nwg) ? (nwg - c + G - 1) / G : 0; lim = per * reps; }
    __device__ __forceinline__ bool next(int i, Unit& u) const {
        if (i >= lim) return false;
        const int per = (nwg - c + G - 1) / G; const long L = (long)(i % per) * G + c;
        int wgid = (int)L; { const int q = nwg / NXCD, r = nwg % NXCD, xcd = wgid % NXCD, off = wgid / NXCD; wgid = (xcd < r ? xcd * (q + 1) : r * (q + 1) + (xcd - r) * q) + off; }
        const int nig = WGM * nN, gid = wgid / nig, fm = gid * WGM, gsz = (nM - fm) < WGM ? (nM - fm) : WGM;
        u.pm = fm + ((wgid % nig) % gsz); u.pn = (wgid % nig) / gsz; return true;
    }
};

struct EpiF32 {
    static constexpr bool PERM = false, FUSED = false;
    float* C; int ldc;
    __device__ __forceinline__ void operator()(const f32x4 (&acc)[2][2][4][2], const Unit& u, int wr, int wc, int fr, int fq) const {
        const int row0 = u.pm * BM + wr * 64 + fr, col0 = u.pn * BM + wc * 32 + 4 * fq;
#pragma unroll
        for (int ai = 0; ai < 2; ++ai)
#pragma unroll
            for (int m = 0; m < 4; ++m) { float* rowp = C + (size_t)(row0 + ai * HALF + m * 16) * ldc + col0;
#pragma unroll
                for (int bj = 0; bj < 2; ++bj)
#pragma unroll
                    for (int n = 0; n < 2; ++n) *(f32x4*)(rowp + bj * HALF + n * 16) = acc[ai][bj][m][n]; }
    }
};

struct EpiBf16 {
    static constexpr bool PERM = true, FUSED = false;
    bf16_t* C; int ldc;
    __device__ __forceinline__ void operator()(const f32x4 (&acc)[2][2][4][2], const Unit& u, int wr, int wc, int fr, int fq) const {
        const int row0 = u.pm * BM + wr * 64 + fr, col0 = u.pn * BM + wc * 32 + 8 * fq;
#pragma unroll
        for (int ai = 0; ai < 2; ++ai)
#pragma unroll
            for (int m = 0; m < 4; ++m) { bf16_t* rowp = C + (size_t)(row0 + ai * HALF + m * 16) * ldc + col0;
#pragma unroll
                for (int bj = 0; bj < 2; ++bj) { const f32x4 v0 = acc[ai][bj][m][0], v1 = acc[ai][bj][m][1];
                    u32x4 w; w.x = cvt_pk_bf16(v0[0], v0[1]); w.y = cvt_pk_bf16(v0[2], v0[3]); w.z = cvt_pk_bf16(v1[0], v1[1]); w.w = cvt_pk_bf16(v1[2], v1[3]);
                    *(u32x4*)(rowp + bj * HALF) = w; } }
    }
};

struct EpiGU {
    static constexpr bool PERM = true, FUSED = false;
    bf16_t* act; const float* rs;
    __device__ __forceinline__ void operator()(const f32x4 (&acc)[2][2][4][2], const Unit& u, int wr, int wc, int fr, int fq) const {
        const int row0 = u.pm * BM + wr * 64 + fr, col0 = u.pn * HALF + wc * 32 + 8 * fq;
        float rrv[2][4];
#pragma unroll
        for (int ai = 0; ai < 2; ++ai)
#pragma unroll
            for (int m = 0; m < 4; ++m) rrv[ai][m] = rs[row0 + ai * HALF + m * 16];
#pragma unroll
        for (int ai = 0; ai < 2; ++ai)
#pragma unroll
            for (int m = 0; m < 4; ++m) {
                const float rr = rrv[ai][m];
                const f32x4 g0 = acc[ai][0][m][0] * rr, g1 = acc[ai][0][m][1] * rr, u0 = acc[ai][1][m][0] * rr, u1 = acc[ai][1][m][1] * rr;
                u32x4 w;
                w.x = cvt_pk_bf16(silu_f(g0[0]) * u0[0], silu_f(g0[1]) * u0[1]); w.y = cvt_pk_bf16(silu_f(g0[2]) * u0[2], silu_f(g0[3]) * u0[3]);
                w.z = cvt_pk_bf16(silu_f(g1[0]) * u1[0], silu_f(g1[1]) * u1[1]); w.w = cvt_pk_bf16(silu_f(g1[2]) * u1[2], silu_f(g1[3]) * u1[3]);
                *(u32x4*)(act + (size_t)(row0 + ai * HALF + m * 16) * DFF + col0) = w;
            }
    }
};

struct EpiCmp1 {
    static constexpr bool PERM = true, FUSED = false;
    bf16_t* hid; const float* cbias;
    __device__ __forceinline__ void operator()(const f32x4 (&acc)[2][2][4][2], const Unit& u, int wr, int wc, int fr, int fq) const {
        const int row0 = u.pm * BM + wr * 64 + fr;
#pragma unroll
        for (int bj = 0; bj < 2; ++bj) {
            const int col0 = bj * HALF + wc * 32 + 8 * fq;
            const f32x4 b0 = *(const f32x4*)(cbias + col0), b1 = *(const f32x4*)(cbias + col0 + 4);
#pragma unroll
            for (int ai = 0; ai < 2; ++ai)
#pragma unroll
                for (int m = 0; m < 4; ++m) {
                    const f32x4 v0 = acc[ai][bj][m][0] + b0, v1 = acc[ai][bj][m][1] + b1;
                    u32x4 w;
                    w.x = cvt_pk_bf16(gelu_tanh(v0[0]), gelu_tanh(v0[1])); w.y = cvt_pk_bf16(gelu_tanh(v0[2]), gelu_tanh(v0[3]));
                    w.z = cvt_pk_bf16(gelu_tanh(v1[0]), gelu_tanh(v1[1])); w.w = cvt_pk_bf16(gelu_tanh(v1[2]), gelu_tanh(v1[3]));
                    *(u32x4*)(hid + (size_t)(row0 + ai * HALF + m * 16) * 256 + col0) = w;
                }
        }
    }
};

struct EpiIn {
    static constexpr bool PERM = true, FUSED = false;
    unsigned char* r1;
    const float* rs;
    __device__ __forceinline__ void operator()(const f32x4 (&acc)[2][2][4][2], const Unit& u, int wr, int wc, int fr, int fq) const {
        const int pn = u.pn;
        float rrv[2][4];
#pragma unroll
        for (int ai = 0; ai < 2; ++ai)
#pragma unroll
            for (int m = 0; m < 4; ++m) rrv[ai][m] = rs[u.pm * BM + ai * HALF + wr * 64 + m * 16 + fr];
#pragma unroll
        for (int ai = 0; ai < 2; ++ai)
#pragma unroll
            for (int m = 0; m < 4; ++m) {
                const int row = u.pm * BM + ai * HALF + wr * 64 + m * 16 + fr;
                const int b = row >> 14, s = row & (S - 1);
                const float rr = rrv[ai][m];
#pragma unroll
                for (int bj = 0; bj < 2; ++bj) {
                    f32x4 v0 = acc[ai][bj][m][0] * rr, v1 = acc[ai][bj][m][1] * rr;
                    const int cw = bj * HALF + wc * 32 + 8 * fq;
                    if (pn < 2) {
                        v0 = v0 * QSCALE; v1 = v1 * QSCALE;
                        u32x4 w; w.x = cvt_pk_bf16(v0[0], v0[1]); w.y = cvt_pk_bf16(v0[2], v0[3]); w.z = cvt_pk_bf16(v1[0], v1[1]); w.w = cvt_pk_bf16(v1[2], v1[3]);
                        *(u32x4*)((bf16_t*)(r1 + R_Q) + (size_t)row * 512 + pn * 256 + cw) = w;
                    } else if (pn < 5) {
                        const int g = wc >> 1, d = (wc & 1) * 32 + 8 * fq, bg = b * 2 + g;
                        if (pn == 2) {
                            bf16_t* base = (bf16_t*)(r1 + (bj == 0 ? R_KC : R_VC));
                            u32x4 w; w.x = cvt_pk_bf16(v0[0], v0[1]); w.y = cvt_pk_bf16(v0[2], v0[3]); w.z = cvt_pk_bf16(v1[0], v1[1]); w.w = cvt_pk_bf16(v1[2], v1[3]);
                            *(u32x4*)(base + ((size_t)bg * S + s) * 64 + d) = w;
                        } else if (pn == 3) {
                            if (bj == 0) {
                                v0 = v0 * 0.25f; v1 = v1 * 0.25f;
                                int w0 = __builtin_amdgcn_cvt_pk_fp8_f32(v0[0], v0[1], 0, false); w0 = __builtin_amdgcn_cvt_pk_fp8_f32(v0[2], v0[3], w0, true);
                                int w1 = __builtin_amdgcn_cvt_pk_fp8_f32(v1[0], v1[1], 0, false); w1 = __builtin_amdgcn_cvt_pk_fp8_f32(v1[2], v1[3], w1, true);
                                u32x2 w; w.x = (unsigned)w0; w.y = (unsigned)w1;
                                *(u32x2*)(r1 + R_KS + (size_t)bg * S * 64 + (size_t)(s >> 6) * 4096 + ((s >> 4) & 3) * 1024 + (((d >> 3) & 3) * 16 + (s & 15)) * 16 + (d >> 5) * 8) = w;
                            } else {
                                const int kb = s & 63, kp = kb >> 5, k32 = kb & 31, fqv = (k32 >> 2) & 3, jj = ((k32 >> 4) << 2) | (k32 & 3);
                                unsigned char* dst = r1 + R_VST + (size_t)bg * S * 64 + (size_t)(s >> 6) * 4096 + (d >> 4) * 1024 + (fqv * 16 + (d & 15)) * 16 + kp * 8 + jj;
                                const int w0 = __builtin_amdgcn_cvt_pk_fp8_f32(v0[0], v0[1], 0, false), w1 = __builtin_amdgcn_cvt_pk_fp8_f32(v0[2], v0[3], 0, false);
                                const int w2 = __builtin_amdgcn_cvt_pk_fp8_f32(v1[0], v1[1], 0, false), w3 = __builtin_amdgcn_cvt_pk_fp8_f32(v1[2], v1[3], 0, false);
                                dst[0] = (unsigned char)(w0 & 0xff); dst[16] = (unsigned char)((w0 >> 8) & 0xff); dst[32] = (unsigned char)(w1 & 0xff); dst[48] = (unsigned char)((w1 >> 8) & 0xff);
                                dst[64] = (unsigned char)(w2 & 0xff); dst[80] = (unsigned char)((w2 >> 8) & 0xff); dst[96] = (unsigned char)(w3 & 0xff); dst[112] = (unsigned char)((w3 >> 8) & 0xff);
                            }
                        } else if (bj == 0) {
                            bf16_t* base = (bf16_t*)(r1 + R_KW);
                            u32x4 w; w.x = cvt_pk_bf16(v0[0], v0[1]); w.y = cvt_pk_bf16(v0[2], v0[3]); w.z = cvt_pk_bf16(v1[0], v1[1]); w.w = cvt_pk_bf16(v1[2], v1[3]);
                            *(u32x4*)(base + (size_t)bg * S * 64 + (size_t)(s >> 5) * 2048 + (d >> 4) * 512 + ((d >> 3) & 1) * 256 + (s & 31) * 8) = w;
                        } else {
                            const int kk = s & 31;
                            bf16_t* dst = (bf16_t*)(r1 + R_VWT) + (size_t)bg * S * 64 + (size_t)(s >> 5) * 2048 + (d >> 5) * 1024 + (kk >> 4) * 512 + ((kk >> 2) & 1) * 256 + (d & 31) * 8 + ((kk >> 3) & 1) * 4 + (kk & 3);
                            const unsigned w0 = cvt_pk_bf16(v0[0], v0[1]), w1 = cvt_pk_bf16(v0[2], v0[3]), w2 = cvt_pk_bf16(v1[0], v1[1]), w3 = cvt_pk_bf16(v1[2], v1[3]);
                            dst[0] = (bf16_t)(w0 & 0xffff); dst[8] = (bf16_t)(w0 >> 16); dst[16] = (bf16_t)(w1 & 0xffff); dst[24] = (bf16_t)(w1 >> 16);
                            dst[32] = (bf16_t)(w2 & 0xffff); dst[40] = (bf16_t)(w2 >> 16); dst[48] = (bf16_t)(w3 & 0xffff); dst[56] = (bf16_t)(w3 >> 16);
                        }
                    } else if (pn < 9) {
                        bf16_t* base = (bf16_t*)(r1 + ((pn < 7) ? R_ZU : R_ZV)); const int ct = (pn < 7) ? (pn - 5) : (pn - 7);
                        u32x4 w;
                        w.x = cvt_pk_bf16(gelu_tanh(v0[0]), gelu_tanh(v0[1])); w.y = cvt_pk_bf16(gelu_tanh(v0[2]), gelu_tanh(v0[3]));
                        w.z = cvt_pk_bf16(gelu_tanh(v1[0]), gelu_tanh(v1[1])); w.w = cvt_pk_bf16(gelu_tanh(v1[2]), gelu_tanh(v1[3]));
                        *(u32x4*)(base + (size_t)row * 512 + ct * 256 + cw) = w;
                    } else {
                        if (bj == 0 && wc == 0 && fq < 3) {
                            float* gp = (float*)(r1 + R_GATES) + (size_t)row * 24 + 8 * fq;
                            *(f32x4*)gp = (f32x4){sigmoid_f(v0[0]), sigmoid_f(v0[1]), sigmoid_f(v0[2]), sigmoid_f(v0[3])};
                            *(f32x4*)(gp + 4) = (f32x4){sigmoid_f(v1[0]), sigmoid_f(v1[1]), sigmoid_f(v1[2]), sigmoid_f(v1[3])};
                        }
                    }
                }
            }
    }
};

struct EpiNormRes {
    static constexpr bool PERM = true, FUSED = true;
    unsigned char* ws; const float* gpost; float* fout; int inst;
    __device__ __forceinline__ void exchange(int e, float (&sv)[2][4], float (&rv)[2][4], const Unit& u, int wr, int wc, int fr, int fq, LAS unsigned char* lds, int wid, int lane) const {
        LAS float* P = (LAS float*)(lds + 131072);
        LAS float* Sx = P + 1024;
        float* xbuf = (float*)(ws + WS_XBUF) + (size_t)e * MT * 4;
        unsigned* cnt = (unsigned*)(ws + WS_XCNT) + ((size_t)(e * 8 + inst) * 128 + u.pm) * 16;
#pragma unroll
        for (int ai = 0; ai < 2; ++ai)
#pragma unroll
            for (int m = 0; m < 4; ++m) {
                float v = sv[ai][m];
                { auto t1 = __builtin_amdgcn_permlane16_swap(__float_as_uint(v), __float_as_uint(v), false, false); v = __uint_as_float(t1[0]) + __uint_as_float(t1[1]); }
                v = xhalf_sum(v);
                if (fq == 0) P[(ai * HALF + wr * 64 + m * 16 + fr) * 4 + wc] = v;
            }
        asm volatile("s_waitcnt lgkmcnt(0)" ::: "memory"); __builtin_amdgcn_s_barrier(); asm volatile("" ::: "memory");
        const int tid = wid * 64 + lane;
        if (tid < 256) {
            const f32x4 pp = *(const LAS f32x4*)(P + tid * 4);
            __hip_atomic_store(xbuf + ((size_t)u.pm * 256 + tid) * 4 + u.pn, (pp[0] + pp[1]) + (pp[2] + pp[3]), __ATOMIC_RELAXED, __HIP_MEMORY_SCOPE_AGENT);
        }
        asm volatile("s_waitcnt vmcnt(0)" ::: "memory");
        if (wid < 4 && lane == 0) __hip_atomic_fetch_add(cnt, 1u, __ATOMIC_RELAXED, __HIP_MEMORY_SCOPE_AGENT);
        if (wid == 0) {
            unsigned sp = 0;
            while ((unsigned)__builtin_amdgcn_readfirstlane(__hip_atomic_load(cnt, __ATOMIC_RELAXED, __HIP_MEMORY_SCOPE_AGENT)) < 16u) { __builtin_amdgcn_s_sleep(2); if (++sp > (1u << 22)) break; }
            __builtin_amdgcn_fence(__ATOMIC_ACQUIRE, "agent");
        }
        asm volatile("s_waitcnt vmcnt(0) lgkmcnt(0)" ::: "memory"); __builtin_amdgcn_s_barrier(); asm volatile("" ::: "memory");
        if (tid < 256) {
            const float* sl = xbuf + ((size_t)u.pm * 256 + tid) * 4;
            const float t0 = __hip_atomic_load(sl + 0, __ATOMIC_RELAXED, __HIP_MEMORY_SCOPE_AGENT), t1 = __hip_atomic_load(sl + 1, __ATOMIC_RELAXED, __HIP_MEMORY_SCOPE_AGENT);
            const float t2 = __hip_atomic_load(sl + 2, __ATOMIC_RELAXED, __HIP_MEMORY_SCOPE_AGENT), t3 = __hip_atomic_load(sl + 3, __ATOMIC_RELAXED, __HIP_MEMORY_SCOPE_AGENT);
            Sx[tid] = 1.0f / sqrtf(((t0 + t1) + (t2 + t3)) * (1.0f / 1024.0f) + RMS_EPS);
        }
        asm volatile("s_waitcnt vmcnt(0) lgkmcnt(0)" ::: "memory"); __builtin_amdgcn_s_barrier(); asm volatile("" ::: "memory");
#pragma unroll
        for (int ai = 0; ai < 2; ++ai)
#pragma unroll
            for (int m = 0; m < 4; ++m) rv[ai][m] = Sx[ai * HALF + wr * 64 + m * 16 + fr];
    }
    __device__ __forceinline__ void fused(f32x4 (&acc)[2][2][4][2], const Unit& u, int wr, int wc, int fr, int fq, LAS unsigned char* lds, int wid, int lane) const {
        bf16_t* hb = (bf16_t*)(ws + WS_HB);
        const int row0 = u.pm * BM + wr * 64 + fr, col0 = u.pn * BM + wc * 32 + 8 * fq;
        float sv[2][4], rv[2][4];
#pragma unroll
        for (int ai = 0; ai < 2; ++ai)
#pragma unroll
            for (int m = 0; m < 4; ++m) {
                float q = 0.f;
#pragma unroll
                for (int bj = 0; bj < 2; ++bj)
#pragma unroll
                    for (int n = 0; n < 2; ++n) { const f32x4 x = acc[ai][bj][m][n]; q += (x[0] * x[0] + x[1] * x[1]) + (x[2] * x[2] + x[3] * x[3]); }
                sv[ai][m] = q;
            }
        exchange(0, sv, rv, u, wr, wc, fr, fq, lds, wid, lane);
        float dep = 0.f;
#pragma unroll
        for (int ai = 0; ai < 2; ++ai)
#pragma unroll
            for (int m = 0; m < 4; ++m) {
                const bf16_t* hrow = hb + (size_t)(row0 + ai * HALF + m * 16) * DM + col0;
                asm volatile("" : "+v"(hrow) : "v"(dep));
                const float r1 = rv[ai][m];
                float q = 0.f;
#pragma unroll
                for (int bj = 0; bj < 2; ++bj) {
                    const u32x4 hv = *(const u32x4*)(hrow + bj * HALF);
                    const f32x4 h0 = (f32x4){__uint_as_float(hv.x << 16), __uint_as_float(hv.x & 0xffff0000u), __uint_as_float(hv.y << 16), __uint_as_float(hv.y & 0xffff0000u)};
                    const f32x4 h1 = (f32x4){__uint_as_float(hv.z << 16), __uint_as_float(hv.z & 0xffff0000u), __uint_as_float(hv.w << 16), __uint_as_float(hv.w & 0xffff0000u)};
                    const f32x4 gg0 = *(const f32x4*)(gpost + col0 + bj * HALF), gg1 = *(const f32x4*)(gpost + col0 + bj * HALF + 4);
                    f32x4 x0 = h0 + acc[ai][bj][m][0] * r1 * gg0, x1 = h1 + acc[ai][bj][m][1] * r1 * gg1;
                    acc[ai][bj][m][0] = x0; acc[ai][bj][m][1] = x1;
                    q += ((x0[0] * x0[0] + x0[1] * x0[1]) + (x0[2] * x0[2] + x0[3] * x0[3])) + ((x1[0] * x1[0] + x1[1] * x1[1]) + (x1[2] * x1[2] + x1[3] * x1[3]));
                }
                sv[ai][m] = q;
                dep = q;
            }
        if (fout) {
#pragma unroll
            for (int ai = 0; ai < 2; ++ai)
#pragma unroll
                for (int m = 0; m < 4; ++m) { float* orow = fout + (size_t)(row0 + ai * HALF + m * 16) * DM + col0;
#pragma unroll
                    for (int bj = 0; bj < 2; ++bj) { *(f32x4*)(orow + bj * HALF) = acc[ai][bj][m][0]; *(f32x4*)(orow + bj * HALF + 4) = acc[ai][bj][m][1]; } }
            return;
        }
        exchange(1, sv, rv, u, wr, wc, fr, fq, lds, wid, lane);
        float* rs = (float*)(ws + WS_RS);
#pragma unroll
        for (int ai = 0; ai < 2; ++ai)
#pragma unroll
            for (int m = 0; m < 4; ++m) {
                bf16_t* hrow = hb + (size_t)(row0 + ai * HALF + m * 16) * DM + col0;
#pragma unroll
                for (int bj = 0; bj < 2; ++bj) { const f32x4 x0 = acc[ai][bj][m][0], x1 = acc[ai][bj][m][1];
                    u32x4 w; w.x = cvt_pk_bf16(x0[0], x0[1]); w.y = cvt_pk_bf16(x0[2], x0[3]); w.z = cvt_pk_bf16(x1[0], x1[1]); w.w = cvt_pk_bf16(x1[2], x1[3]);
                    *(u32x4*)(hrow + bj * HALF) = w; }
                if (u.pn == 0 && wc == 0 && fq == 0) rs[row0 + ai * HALF + m * 16] = rv[ai][m];
            }
    }
};

template <class Epi>
__device__ __forceinline__ void gemm_phase(LAS unsigned char* lds, const Gemm g, const StaticOrder& S, const Epi& E) {
    int tid = threadIdx.x; LAUNDER(tid);
    const int wid = __builtin_amdgcn_readfirstlane(tid >> 6), lane = tid & 63, wr = wid >> 2, wc = wid & 3, fr = lane & 15, fq = lane >> 4;
    const int K = g.K, nt = K / BK, lda = g.lda;
    unsigned voffA[2], voffB[2];
#pragma unroll
    for (int i = 0; i < 2; ++i) { int R, C; stage_rc(tid * 16 + i * 8192, R, C); const int Rb = Epi::PERM ? ((R & ~31) + perm32(R & 31)) : R;
        voffA[i] = (unsigned)(R * lda + C) * 2u; voffB[i] = (unsigned)(Rb * K + C) * 2u; }
    const size_t kstep = (size_t)(BK * 2);
    const size_t hA = (size_t)HALF * lda * 2, hB = (size_t)HALF * K * 2;
    const size_t tA = 2 * hA, tB = 2 * hB;
    const unsigned ldsw = (unsigned)wid * 1024u;
    const int aoff = lds_byte(wr * 64 + fr, fq * 8), boff = lds_byte(wc * 32 + fr, fq * 8);
#define PG8_SA(b, h) (((b) * 2 + (h)) * HTB)
#define PG8_SB(b, h) ((4 + (b) * 2 + (h)) * HTB)
#define PG8_STAGE(bufoff, gbase, voff) do { _Pragma("unroll") for (int _i = 0; _i < 2; ++_i) \
        __builtin_amdgcn_global_load_lds((const unsigned*)((const char*)(gbase) + (voff)[_i]), (LAS unsigned*)(lds + (bufoff) + ldsw + _i * 8192), 16, 0, 0); } while (0)
#define PG8_LDA(dst, b, h) do { _Pragma("unroll") for (int m = 0; m < 4; ++m) _Pragma("unroll") for (int k = 0; k < 2; ++k) dst[m][k] = *(const LAS bf16x8*)(lds + PG8_SA(b, h) + aoff + m * 2048 + k * 1024); } while (0)
#define PG8_LDB(dst, b, h) do { _Pragma("unroll") for (int n = 0; n < 2; ++n) _Pragma("unroll") for (int k = 0; k < 2; ++k) dst[n][k] = *(const LAS bf16x8*)(lds + PG8_SB(b, h) + boff + n * 2048 + k * 1024); } while (0)
#define PG8_MMA(ai, bj, At, Bt) do { __builtin_amdgcn_s_setprio(1); _Pragma("unroll") for (int m = 0; m < 4; ++m) _Pragma("unroll") for (int n = 0; n < 2; ++n) _Pragma("unroll") for (int k = 0; k < 2; ++k) \
        acc[ai][bj][m][n] = __builtin_amdgcn_mfma_f32_16x16x32_bf16(Bt[n][k], At[m][k], acc[ai][bj][m][n], 0, 0, 0); __builtin_amdgcn_s_setprio(0); } while (0)
#define PG8_WAIT_V(n) asm volatile("s_waitcnt vmcnt(" #n ")" ::: "memory")
#define PG8_WAIT_L(n) asm volatile("s_waitcnt lgkmcnt(" #n ")" ::: "memory")
#define PG8_BAR __builtin_amdgcn_s_barrier()
#define PG8_SCHED __builtin_amdgcn_sched_barrier(0)
    Unit cur, nxt; int ui = 0;
    if (!S.next(0, cur)) return;
    f32x4 acc[2][2][4][2];
#pragma unroll
    for (int a = 0; a < 2; ++a)
#pragma unroll
        for (int b = 0; b < 2; ++b)
#pragma unroll
            for (int m = 0; m < 4; ++m)
#pragma unroll
                for (int n = 0; n < 2; ++n) acc[a][b][m][n] = (f32x4){0.f, 0.f, 0.f, 0.f};
    bf16x8 At[4][2], B0[2][2], B1[2][2];
    const char* cA = (const char*)g.A + (size_t)cur.pm * tA; const char* cB = (const char*)g.Bt + (size_t)cur.pn * tB;
    PG8_STAGE(PG8_SB(0, 0), cB, voffB); PG8_STAGE(PG8_SB(0, 1), cB + hB, voffB); PG8_STAGE(PG8_SA(0, 0), cA, voffA); PG8_STAGE(PG8_SA(0, 1), cA + hA, voffA);
    if (wr == 1) PG8_BAR;
    PG8_WAIT_V(2); PG8_BAR;
    PG8_STAGE(PG8_SB(1, 0), cB + kstep, voffB); PG8_STAGE(PG8_SA(1, 0), cA + kstep, voffA); PG8_STAGE(PG8_SB(1, 1), cB + hB + kstep, voffB);
    PG8_WAIT_V(6); PG8_BAR;
    for (;;) {
        const bool has_next = S.next(ui + 1, nxt);
        const char* nA = has_next ? (const char*)g.A + (size_t)nxt.pm * tA : cA; const char* nB = has_next ? (const char*)g.Bt + (size_t)nxt.pn * tB : cB;
        for (int t = 0; t < nt; t += 2) {
            const bool last = (t == nt - 2);
            const char* a1 = cA + (size_t)(t + 1) * kstep;
            const char* a2 = last ? nA : cA + (size_t)(t + 2) * kstep; const char* b2 = last ? nB : cB + (size_t)(t + 2) * kstep;
            const char* a3 = a2 + kstep; const char* b3 = b2 + kstep;
            PG8_LDB(B0, 0, 0); PG8_LDB(B1, 0, 1); PG8_SCHED; PG8_LDA(At, 0, 0); PG8_STAGE(PG8_SA(1, 1), a1 + hA, voffA);
            PG8_WAIT_V(8); PG8_WAIT_L(0); PG8_BAR; PG8_MMA(0, 0, At, B0); PG8_MMA(0, 1, At, B1); PG8_BAR; PG8_SCHED;
            PG8_LDA(At, 0, 1); PG8_STAGE(PG8_SB(0, 0), b2, voffB); PG8_STAGE(PG8_SB(0, 1), b2 + hB, voffB); PG8_STAGE(PG8_SA(0, 0), a2, voffA);
            PG8_WAIT_V(8); PG8_WAIT_L(0); PG8_BAR; PG8_MMA(1, 0, At, B0); PG8_MMA(1, 1, At, B1); PG8_BAR; PG8_SCHED;
            PG8_LDB(B0, 1, 0); PG8_LDB(B1, 1, 1); PG8_SCHED; PG8_LDA(At, 1, 0); PG8_STAGE(PG8_SA(0, 1), a2 + hA, voffA);
            PG8_WAIT_V(8); PG8_WAIT_L(0); PG8_BAR; PG8_MMA(0, 0, At, B0); PG8_MMA(0, 1, At, B1); PG8_BAR; PG8_SCHED;
            PG8_LDA(At, 1, 1); PG8_STAGE(PG8_SB(1, 0), b3, voffB); PG8_STAGE(PG8_SB(1, 1), b3 + hB, voffB); PG8_STAGE(PG8_SA(1, 0), a3, voffA);
            PG8_WAIT_V(8); PG8_WAIT_L(0); PG8_BAR; PG8_MMA(1, 0, At, B0); PG8_MMA(1, 1, At, B1); PG8_BAR; PG8_SCHED;
        }
        if (wr == 0) PG8_BAR;
        if constexpr (Epi::FUSED) E.fused(acc, cur, wr, wc, fr, fq, lds, wid, lane); else E(acc, cur, wr, wc, fr, fq);
        if (!has_next) break;
#pragma unroll
        for (int a = 0; a < 2; ++a)
#pragma unroll
            for (int b = 0; b < 2; ++b)
#pragma unroll
                for (int m = 0; m < 4; ++m)
#pragma unroll
                    for (int n = 0; n < 2; ++n) acc[a][b][m][n] = (f32x4){0.f, 0.f, 0.f, 0.f};
        cur = nxt; cA = nA; cB = nB; ++ui;
        if (wr == 1) PG8_BAR;
    }
    PG8_WAIT_V(0);
    PG8_BAR;
#undef PG8_SA
#undef PG8_SB
#undef PG8_STAGE
#undef PG8_LDA
#undef PG8_LDB
#undef PG8_MMA
#undef PG8_WAIT_V
#undef PG8_WAIT_L
#undef PG8_BAR
#undef PG8_SCHED
}
}

template <int MAP> __device__ __forceinline__ int src_col(int n) {
    if (MAP == 0) return n;
    if (MAP == 1) { if (n < 1280) return n; if (n < 2304) return n + 24; if (n < 2328) return n - 1024; return -1; }
    const int t = n >> 8, w = n & 255; return (w < 128) ? (128 * t + w) : (DFF + 128 * t + (w - 128));
}
constexpr int TP = 65;
template <int MAP> __device__ __forceinline__ void transpose_item(const float* W, int K, int Nsrc, bf16_t* WT, int nblk, int item, LAS float* scr, int lane, const float* gain = nullptr) {
    const int kb = item / nblk, nb = item % nblk, k0 = 64 * kb, n0 = 64 * nb;
    const int nl = 4 * (lane & 15), kr = lane >> 4;
    const int ns = src_col<MAP>(n0 + nl);
    f32x4 v[16];
#pragma unroll
    for (int i = 0; i < 16; ++i) v[i] = (ns >= 0) ? *(const f32x4*)(W + (size_t)(k0 + kr + 4 * i) * Nsrc + ns) : (f32x4){0.f, 0.f, 0.f, 0.f};
    if (gain) {
#pragma unroll
        for (int i = 0; i < 16; ++i) v[i] = v[i] * gain[k0 + kr + 4 * i];
    }
#pragma unroll
    for (int i = 0; i < 16; ++i) { LAS float* d = scr + (kr + 4 * i) * TP + nl; d[0] = v[i][0]; d[1] = v[i][1]; d[2] = v[i][2]; d[3] = v[i][3]; }
    asm volatile("s_waitcnt lgkmcnt(0)" ::: "memory");
    __builtin_amdgcn_wave_barrier();
    const int c = lane & 7;
#pragma unroll
    for (int j = 0; j < 8; ++j) { const int n = (lane >> 3) + 8 * j; const LAS float* s = scr + (8 * c) * TP + n;
        u32x4 o; o.x = cvt_pk_bf16(s[0 * TP], s[1 * TP]); o.y = cvt_pk_bf16(s[2 * TP], s[3 * TP]); o.z = cvt_pk_bf16(s[4 * TP], s[5 * TP]); o.w = cvt_pk_bf16(s[6 * TP], s[7 * TP]);
        *(u32x4*)(WT + (size_t)(n0 + n) * K + k0 + 8 * c) = o; }
    asm volatile("s_waitcnt lgkmcnt(0)" ::: "memory");
    __builtin_amdgcn_wave_barrier();
}

__device__ __forceinline__ void row_pass(const float* x0, bf16_t* hb, const bf16_t* mix, const float* gpost, float* rs, float* fout, int gw, int NGW, int lane) {
    LAUNDER(lane);
    if (x0) {
        for (int m = gw; m < MT; m += NGW) {
            const f32x4* hr = (const f32x4*)(x0 + (size_t)m * DM) + lane;
            f32x4 h[4]; float s2 = 0.f;
#pragma unroll
            for (int j = 0; j < 4; ++j) { h[j] = hr[64 * j]; s2 += (h[j][0] * h[j][0] + h[j][1] * h[j][1]) + (h[j][2] * h[j][2] + h[j][3] * h[j][3]); }
            const float r2 = 1.0f / sqrtf(wave_sum_fast(s2) * (1.0f / DM) + RMS_EPS);
            u32x2* ao = (u32x2*)(hb + (size_t)m * DM) + lane;
#pragma unroll
            for (int j = 0; j < 4; ++j) { u32x2 w; w.x = cvt_pk_bf16(h[j][0], h[j][1]); w.y = cvt_pk_bf16(h[j][2], h[j][3]); ao[64 * j] = w; }
            if (lane == 0) rs[m] = r2;
        }
        return;
    }
    u32x2 hn[4], mn[4];
    if (gw < MT) {
        const u32x2* hr = (const u32x2*)(hb + (size_t)gw * DM) + lane; const u32x2* mr = (const u32x2*)(mix + (size_t)gw * DM) + lane;
#pragma unroll
        for (int j = 0; j < 4; ++j) { hn[j] = hr[64 * j]; mn[j] = mr[64 * j]; }
    }
    for (int m = gw; m < MT; m += NGW) {
        u32x2 hv[4], mv[4];
#pragma unroll
        for (int j = 0; j < 4; ++j) { hv[j] = hn[j]; mv[j] = mn[j]; }
        const int m2 = m + NGW;
        if (m2 < MT) {
            const u32x2* hr = (const u32x2*)(hb + (size_t)m2 * DM) + lane; const u32x2* mr = (const u32x2*)(mix + (size_t)m2 * DM) + lane;
#pragma unroll
            for (int j = 0; j < 4; ++j) { hn[j] = hr[64 * j]; mn[j] = mr[64 * j]; }
        }
        f32x4 h[4], x[4]; float ss = 0.f;
#pragma unroll
        for (int j = 0; j < 4; ++j) {
            h[j] = (f32x4){__uint_as_float(hv[j].x << 16), __uint_as_float(hv[j].x & 0xffff0000u), __uint_as_float(hv[j].y << 16), __uint_as_float(hv[j].y & 0xffff0000u)};
            x[j] = (f32x4){__uint_as_float(mv[j].x << 16), __uint_as_float(mv[j].x & 0xffff0000u), __uint_as_float(mv[j].y << 16), __uint_as_float(mv[j].y & 0xffff0000u)};
            ss += (x[j][0] * x[j][0] + x[j][1] * x[j][1]) + (x[j][2] * x[j][2] + x[j][3] * x[j][3]);
        }
        const float r1 = 1.0f / sqrtf(wave_sum_fast(ss) * (1.0f / DM) + RMS_EPS);
        float s2 = 0.f;
#pragma unroll
        for (int j = 0; j < 4; ++j) { const f32x4 gp = *((const f32x4*)gpost + lane + 64 * j); h[j] = h[j] + x[j] * r1 * gp; s2 += (h[j][0] * h[j][0] + h[j][1] * h[j][1]) + (h[j][2] * h[j][2] + h[j][3] * h[j][3]); }
        if (fout) {
            f32x4* ho = (f32x4*)(fout + (size_t)m * DM) + lane;
#pragma unroll
            for (int j = 0; j < 4; ++j) ho[64 * j] = h[j];
        } else {
            const float r2 = 1.0f / sqrtf(wave_sum_fast(s2) * (1.0f / DM) + RMS_EPS);
            u32x2* ao = (u32x2*)(hb + (size_t)m * DM) + lane;
#pragma unroll
            for (int j = 0; j < 4; ++j) { u32x2 w; w.x = cvt_pk_bf16(h[j][0], h[j][1]); w.y = cvt_pk_bf16(h[j][2], h[j][3]); ao[64 * j] = w; }
            if (lane == 0) rs[m] = r2;
        }
    }
}

constexpr int ZPITCH = 136;
__device__ __forceinline__ void gmlp_unit(const Params& p, int layer, int chunk, LAS unsigned char* lds, int wave, int lane) {
    LAUNDER(lane);
    const unsigned char* ws = P_ws(p);
    const bf16_t* zu = (const bf16_t*)(ws + WS_R1 + R_ZU); const bf16_t* zv = (const bf16_t*)(ws + WS_R1 + R_ZV);
    bf16_t* mixed = (bf16_t*)(ws + WS_AN);
    const float* ln_g = P_in(p, 13) + layer * 512; const float* ln_b = P_in(p, 14) + layer * 512;
    const float* w_s = P_in(p, 15) + (size_t)layer * 8 * 128 * 128 + (size_t)wave * 128 * 128;
    const float* b_s = P_in(p, 16) + layer * 8 * 128 + wave * 128;
    LAS float* stats = (LAS float*)(lds + 8 * 64 * ZPITCH * 2);
    LAS bf16_t* zt = (LAS bf16_t*)(lds + wave * 64 * ZPITCH * 2);
    const int tok0 = chunk * 128;
    __syncthreads();
    {
        bf16x8 sv[16];
#pragma unroll
        for (int i = 0; i < 16; ++i) sv[i] = *(const bf16x8*)(zv + (size_t)(tok0 + wave * 16 + i) * 512 + lane * 8);
        asm volatile("" ::: "memory");
        float mn[16], rs16[16];
#pragma unroll
        for (int i = 0; i < 16; ++i) {
            float s = 0.f, s2 = 0.f;
#pragma unroll
            for (int e = 0; e < 8; ++e) { const float x = bf2f((bf16_t)sv[i][e]); s += x; s2 += x * x; }
            s = wave_sum_fast(s); s2 = wave_sum_fast(s2);
            const float mean = s * (1.0f / 512.0f); const float var = fmaxf(s2 * (1.0f / 512.0f) - mean * mean, 0.f);
            mn[i] = mean; rs16[i] = 1.0f / sqrtf(var + LN_EPS);
        }
        if (lane == 0) {
#pragma unroll
            for (int i = 0; i < 16; ++i) { stats[2 * (wave * 16 + i)] = mn[i]; stats[2 * (wave * 16 + i) + 1] = rs16[i]; }
        }
    }
    __syncthreads();
    {
        const int dc = lane & 7, d0 = dc * 8;
        const f32x4 g0 = *(const f32x4*)(ln_g + wave * 64 + d0), g1 = *(const f32x4*)(ln_g + wave * 64 + d0 + 4);
        const f32x4 b0 = *(const f32x4*)(ln_b + wave * 64 + d0), b1 = *(const f32x4*)(ln_b + wave * 64 + d0 + 4);
        bf16x8 zq[16];
#pragma unroll
        for (int i = 0; i < 16; ++i) zq[i] = *(const bf16x8*)(zv + (size_t)(tok0 + (lane >> 3) + 8 * i) * 512 + wave * 64 + d0);
#pragma unroll
        for (int i = 0; i < 16; ++i) {
            const int s = (lane >> 3) + 8 * i;
            const float mean = stats[2 * s], rstd = stats[2 * s + 1];
#pragma unroll
            for (int e = 0; e < 8; ++e) {
                const float gg = (e < 4) ? g0[e & 3] : g1[e & 3], bb = (e < 4) ? b0[e & 3] : b1[e & 3];
                const float y = (bf2f((bf16_t)zq[i][e]) - mean) * rstd * gg + bb;
                zt[(d0 + e) * ZPITCH + s] = (bf16_t)(cvt_pk_bf16(y, 0.f) & 0xffff);
            }
        }
    }
    asm volatile("s_waitcnt lgkmcnt(0)" ::: "memory");
    __builtin_amdgcn_wave_barrier();
    const int r = lane & 31, h = lane >> 5;
#pragma unroll
    for (int mt = 0; mt < 4; ++mt) {
        f32x16 acc0, acc1;
#pragma unroll
        for (int i = 0; i < 16; ++i) { acc0[i] = 0.f; acc1[i] = 0.f; }
        const int t = 32 * mt + r;
        const size_t rowoff = (size_t)(tok0 + t) * 512 + wave * 64;
        f32x4 wq[8][2]; u32x2 zz[2][4];
#pragma unroll
        for (int ks = 0; ks < 2 * (mt + 1); ++ks) { wq[ks][0] = *(const f32x4*)(w_s + (size_t)t * 128 + 16 * ks + 8 * h); wq[ks][1] = *(const f32x4*)(w_s + (size_t)t * 128 + 16 * ks + 8 * h + 4); }
#pragma unroll
        for (int dt = 0; dt < 2; ++dt)
#pragma unroll
            for (int i4 = 0; i4 < 4; ++i4) zz[dt][i4] = *(const u32x2*)(zu + rowoff + 32 * dt + 8 * i4 + 4 * h);
        const float bs = b_s[t];
#pragma unroll
        for (int ks = 0; ks < 2 * (mt + 1); ++ks) {
            const int s0 = 16 * ks + 8 * h;
            const f32x4 w0 = wq[ks][0], w1 = wq[ks][1];
            float wv[8] = {w0[0], w0[1], w0[2], w0[3], w1[0], w1[1], w1[2], w1[3]};
#pragma unroll
            for (int e = 0; e < 8; ++e) wv[e] = (s0 + e <= t) ? wv[e] : 0.f;
            u32x4 wb; wb.x = cvt_pk_bf16(wv[0], wv[1]); wb.y = cvt_pk_bf16(wv[2], wv[3]); wb.z = cvt_pk_bf16(wv[4], wv[5]); wb.w = cvt_pk_bf16(wv[6], wv[7]);
            const bf16x8 bfrag = __builtin_bit_cast(bf16x8, wb);
            const bf16x8 a0 = *(const LAS bf16x8*)(zt + (r) * ZPITCH + s0);
            const bf16x8 a1 = *(const LAS bf16x8*)(zt + (32 + r) * ZPITCH + s0);
            acc0 = MFMA32(a0, bfrag, acc0);
            acc1 = MFMA32(a1, bfrag, acc1);
        }
        bf16_t* mrow = mixed + (size_t)(tok0 + t) * 1024 + 512 + wave * 64;
#pragma unroll
        for (int dt = 0; dt < 2; ++dt)
#pragma unroll
            for (int i4 = 0; i4 < 4; ++i4) {
                const int d = 32 * dt + 8 * i4 + 4 * h;
                const u32x2 zv2 = zz[dt][i4];
                const float z0 = __uint_as_float(zv2.x << 16), z1 = __uint_as_float(zv2.x & 0xffff0000u), z2 = __uint_as_float(zv2.y << 16), z3 = __uint_as_float(zv2.y & 0xffff0000u);
                const f32x16& a = dt ? acc1 : acc0;
                u32x2 o; o.x = cvt_pk_bf16(z0 * (a[4 * i4] + bs), z1 * (a[4 * i4 + 1] + bs)); o.y = cvt_pk_bf16(z2 * (a[4 * i4 + 2] + bs), z3 * (a[4 * i4 + 3] + bs));
                *(u32x2*)(mrow + d) = o;
            }
    }
}

__device__ __forceinline__ void cmp_gemm2(const bf16_t* hidden, const bf16_t* w2t, bf16_t* kcmp, bf16_t* vcmpT, int kv, int row0, int lane) {
    LAUNDER(lane);
    const int r = lane & 31, h = lane >> 5;
    f32x16 acc[2];
#pragma unroll
    for (int i = 0; i < 16; ++i) { acc[0][i] = 0.f; acc[1][i] = 0.f; }
#pragma unroll
    for (int ks = 0; ks < 16; ++ks) {
        const bf16x8 hf = *(const bf16x8*)(hidden + (size_t)(row0 + r) * 256 + ks * 16 + h * 8);
#pragma unroll
        for (int dt = 0; dt < 2; ++dt) {
            const bf16x8 wf = *(const bf16x8*)(w2t + (size_t)(dt * 32 + r) * 256 + ks * 16 + h * 8);
            if (kv == 0) acc[dt] = MFMA32(wf, hf, acc[dt]);
            else         acc[dt] = MFMA32(hf, wf, acc[dt]);
        }
    }
#pragma unroll
    for (int dt = 0; dt < 2; ++dt)
#pragma unroll
        for (int i4 = 0; i4 < 4; ++i4) {
            u32x2 o; o.x = cvt_pk_bf16(acc[dt][4 * i4], acc[dt][4 * i4 + 1]); o.y = cvt_pk_bf16(acc[dt][4 * i4 + 2], acc[dt][4 * i4 + 3]);
            if (kv == 0) *(u32x2*)(kcmp + (size_t)(row0 >> 5) * 2048 + (dt * 2 + (i4 >> 1)) * 512 + (i4 & 1) * 256 + r * 8 + 4 * h) = o;
            else         *(u32x2*)(vcmpT + (size_t)(row0 >> 5) * 2048 + dt * 1024 + (i4 >> 1) * 512 + h * 256 + r * 8 + (i4 & 1) * 4) = o;
        }
}

constexpr int NSA_WAVE_LDS = 19456;
constexpr float NEG_INF = -__builtin_inff();

__device__ __forceinline__ void load_k(bf16x8 (&kf)[4], const bf16_t* Kt, int lane) {
    const int r = lane & 31, h = lane >> 5;
#pragma unroll
    for (int ks = 0; ks < 4; ++ks) kf[ks] = *(const bf16x8*)(Kt + ks * 512 + lane * 8);
}
__device__ __forceinline__ void load_v(bf16x8 (&vf)[2][2], const bf16_t* vT, int lane) {
    const int r = lane & 31, h = lane >> 5;
#pragma unroll
    for (int dt = 0; dt < 2; ++dt)
#pragma unroll
        for (int s = 0; s < 2; ++s) vf[dt][s] = *(const bf16x8*)(vT + dt * 1024 + s * 512 + lane * 8);
}
__device__ __forceinline__ f32x16 qk_tile(const bf16x8 (&kf)[4], const bf16x8 (&qf)[4]) {
    f32x16 s;
#pragma unroll
    for (int i = 0; i < 16; ++i) s[i] = 0.f;
#pragma unroll
    for (int ks = 0; ks < 4; ++ks) s = MFMA32(kf[ks], qf[ks], s);
    return s;
}
template <int STRIDE> __device__ __forceinline__ void score_tile(f32x16& s, int dl, int dmax, bool lane_ok, bool fast, float lutfar, const LAS float* lutr) {
    if (fast) {
#pragma unroll
        for (int i = 0; i < 16; ++i) s[i] = lane_ok ? (s[i] + lutfar) : NEG_INF;
    } else {
#pragma unroll
        for (int i = 0; i < 16; ++i) {
            const int d = dl - STRIDE * ((i & 3) + 8 * (i >> 2));
            const bool ok = lane_ok && d >= 0 && d < dmax;
            const int di = min(max(d, 0), 128);
            s[i] = ok ? (s[i] + lutr[di]) : NEG_INF;
        }
    }
}
__device__ __forceinline__ void pv_tile(f32x16& o0, f32x16& o1, const f32x16& pr, const bf16x8 (&vf)[2][2]) {
#pragma unroll
    for (int s = 0; s < 2; ++s) {
        u32x4 pk; pk.x = cvt_pk_bf16(pr[8 * s], pr[8 * s + 1]); pk.y = cvt_pk_bf16(pr[8 * s + 2], pr[8 * s + 3]); pk.z = cvt_pk_bf16(pr[8 * s + 4], pr[8 * s + 5]); pk.w = cvt_pk_bf16(pr[8 * s + 6], pr[8 * s + 7]);
        const bf16x8 pb = __builtin_bit_cast(bf16x8, pk);
        o0 = MFMA32(vf[0][s], pb, o0);
        o1 = MFMA32(vf[1][s], pb, o1);
    }
}
template <bool FAST> __device__ __forceinline__ void online_step(f32x16& s, float bias, bool lane_ok, float& m, float& l, f32x16& o0, f32x16& o1, const bf16x8 (&vf)[2][2]) {
    float mx = fmaxf(fmaxf(fmaxf(s[0], s[1]), fmaxf(s[2], s[3])), fmaxf(fmaxf(s[4], s[5]), fmaxf(s[6], s[7])));
    mx = fmaxf(mx, fmaxf(fmaxf(fmaxf(s[8], s[9]), fmaxf(s[10], s[11])), fmaxf(fmaxf(s[12], s[13]), fmaxf(s[14], s[15]))));
    if (FAST) { mx += bias; mx = lane_ok ? mx : NEG_INF; }
    mx = xhalf_max(mx);
    if (__any(mx > m + 8.0f)) {
        const float mnew = (mx > m + 8.0f) ? mx : m;
        const float alpha = fast_exp2(m - mnew);
        l *= alpha; m = mnew;
#pragma unroll
        for (int i = 0; i < 16; ++i) { o0[i] *= alpha; o1[i] *= alpha; }
    }
    const float c = FAST ? (lane_ok ? (m - bias) : __builtin_inff()) : m;
    float ps = 0.f;
#pragma unroll
    for (int i = 0; i < 16; ++i) { s[i] = fast_exp2(s[i] - c); ps += s[i]; }
    ps = xhalf_sum(ps);
    l += ps;
    pv_tile(o0, o1, s, vf);
}

#define MFMA8(a, b, c) __builtin_amdgcn_mfma_f32_32x32x16_fp8_fp8((a), (b), (c), 0, 0, 0)
__device__ __forceinline__ void load_k8(long (&kf)[4], const unsigned char* Kt, int lane) {
#pragma unroll
    for (int ks = 0; ks < 4; ++ks) kf[ks] = *(const long*)(Kt + ks * 512 + lane * 8);
}
__device__ __forceinline__ void load_v8(long (&vf)[2][2], const unsigned char* vT, int lane) {
#pragma unroll
    for (int dt = 0; dt < 2; ++dt)
#pragma unroll
        for (int s = 0; s < 2; ++s) vf[dt][s] = *(const long*)(vT + dt * 1024 + s * 512 + lane * 8);
}
__device__ __forceinline__ long pack_fp8x8(float a0, float a1, float a2, float a3, float a4, float a5, float a6, float a7) {
    int w0 = __builtin_amdgcn_cvt_pk_fp8_f32(a0, a1, 0, false); w0 = __builtin_amdgcn_cvt_pk_fp8_f32(a2, a3, w0, true);
    int w1 = __builtin_amdgcn_cvt_pk_fp8_f32(a4, a5, 0, false); w1 = __builtin_amdgcn_cvt_pk_fp8_f32(a6, a7, w1, true);
    return (long)(((unsigned long long)(unsigned)w1 << 32) | (unsigned long long)(unsigned)w0);
}
template <bool FAST> __device__ __forceinline__ void online_step8(f32x16& s, float bias, bool lane_ok, float& m, float& l, f32x16& o0, f32x16& o1, const long (&vf)[2][2]) {
    float mx = fmaxf(fmaxf(fmaxf(s[0], s[1]), fmaxf(s[2], s[3])), fmaxf(fmaxf(s[4], s[5]), fmaxf(s[6], s[7])));
    mx = fmaxf(mx, fmaxf(fmaxf(fmaxf(s[8], s[9]), fmaxf(s[10], s[11])), fmaxf(fmaxf(s[12], s[13]), fmaxf(s[14], s[15]))));
    if (FAST) { mx = mx * QSCALE + bias; mx = lane_ok ? mx : NEG_INF; }
    mx = xhalf_max(mx);
    if (__any(mx > m + 2.0f)) {
        const float mnew = (mx > m + 2.0f) ? mx : m;
        const float alpha = fast_exp2(m - mnew);
        l *= alpha; m = mnew;
#pragma unroll
        for (int i = 0; i < 16; ++i) { o0[i] *= alpha; o1[i] *= alpha; }
    }
    float ps = 0.f;
    if (FAST) {
        const float c = lane_ok ? (m - bias - 6.0f) : __builtin_inff();
#pragma unroll
        for (int i = 0; i < 16; ++i) { s[i] = fast_exp2(__builtin_fmaf(s[i], QSCALE, -c)); ps += s[i]; }
    } else {
        const float c = m - 6.0f;
#pragma unroll
        for (int i = 0; i < 16; ++i) { s[i] = fast_exp2(s[i] - c); ps += s[i]; }
    }
    ps = xhalf_sum(ps);
    l += ps;
#pragma unroll
    for (int t = 0; t < 2; ++t) {
        const long pb = pack_fp8x8(s[8 * t], s[8 * t + 1], s[8 * t + 2], s[8 * t + 3], s[8 * t + 4], s[8 * t + 5], s[8 * t + 6], s[8 * t + 7]);
        o0 = MFMA8(vf[0][t], pb, o0);
        o1 = MFMA8(vf[1][t], pb, o1);
    }
}

__device__ __forceinline__ float max16(const f32x16& s) {
    const float a = fmaxf(fmaxf(fmaxf(s[0], s[1]), fmaxf(s[2], s[3])), fmaxf(fmaxf(s[4], s[5]), fmaxf(s[6], s[7])));
    const float b = fmaxf(fmaxf(fmaxf(s[8], s[9]), fmaxf(s[10], s[11])), fmaxf(fmaxf(s[12], s[13]), fmaxf(s[14], s[15])));
    return fmaxf(a, b);
}
template <bool FAST> __device__ __forceinline__ void online_step8x2(f32x16& sa, f32x16& sb, float bias, bool lane_ok, float& m, float& l, f32x16& o0, f32x16& o1, const long (&va)[2][2], const long (&vb)[2][2]) {
    float mx = fmaxf(max16(sa), max16(sb));
    if (FAST) { mx = mx * QSCALE + bias; mx = lane_ok ? mx : NEG_INF; }
    mx = xhalf_max(mx);
    if (__any(mx > m + 2.0f)) {
        const float mnew = (mx > m + 2.0f) ? mx : m;
        const float alpha = fast_exp2(m - mnew);
        l *= alpha; m = mnew;
#pragma unroll
        for (int i = 0; i < 16; ++i) { o0[i] *= alpha; o1[i] *= alpha; }
    }
    float ps = 0.f, ps2 = 0.f;
    if (FAST) {
        const float c = lane_ok ? (m - bias - 6.0f) : __builtin_inff();
#pragma unroll
        for (int i = 0; i < 16; ++i) { sa[i] = fast_exp2(__builtin_fmaf(sa[i], QSCALE, -c)); ps += sa[i]; sb[i] = fast_exp2(__builtin_fmaf(sb[i], QSCALE, -c)); ps2 += sb[i]; }
    } else {
        const float c = m - 6.0f;
#pragma unroll
        for (int i = 0; i < 16; ++i) { sa[i] = fast_exp2(sa[i] - c); ps += sa[i]; sb[i] = fast_exp2(sb[i] - c); ps2 += sb[i]; }
    }
    ps += ps2;
    ps = xhalf_sum(ps);
    l += ps;
    const long pa0 = pack_fp8x8(sa[0], sa[1], sa[2], sa[3], sa[4], sa[5], sa[6], sa[7]);
    const long pb0 = pack_fp8x8(sb[0], sb[1], sb[2], sb[3], sb[4], sb[5], sb[6], sb[7]);
    o0 = MFMA8(va[0][0], pa0, o0); o1 = MFMA8(va[1][0], pa0, o1);
    const long pa1 = pack_fp8x8(sa[8], sa[9], sa[10], sa[11], sa[12], sa[13], sa[14], sa[15]);
    o0 = MFMA8(vb[0][0], pb0, o0); o1 = MFMA8(vb[1][0], pb0, o1);
    const long pb1 = pack_fp8x8(sb[8], sb[9], sb[10], sb[11], sb[12], sb[13], sb[14], sb[15]);
    o0 = MFMA8(va[0][1], pa1, o0); o1 = MFMA8(va[1][1], pa1, o1);
    o0 = MFMA8(vb[0][1], pb1, o0); o1 = MFMA8(vb[1][1], pb1, o1);
}

__device__ __forceinline__ void nsa_unit(const Params& p, int bg, int jq, LAS unsigned char* lds, int wave, int lane, bool build_lut) {
    LAUNDER(lane);
    const unsigned char* ws = P_ws(p);
    const bf16_t* qb = (const bf16_t*)(ws + WS_R1 + R_Q);
    const bf16_t* kcmp = (const bf16_t*)(ws + WS_R1 + R_KCMP) + (size_t)bg * NCMP * 64;
    const bf16_t* vcmpT = (const bf16_t*)(ws + WS_R1 + R_VCMPT) + (size_t)bg * NCMP * 64;
    const unsigned char* ks8 = ws + WS_R1 + R_KS + (size_t)bg * S * 64;
    const unsigned char* vs8 = ws + WS_R1 + R_VST + (size_t)bg * S * 64;
    const bf16_t* kwb = (const bf16_t*)(ws + WS_R1 + R_KW) + (size_t)bg * S * 64;
    const bf16_t* vwT = (const bf16_t*)(ws + WS_R1 + R_VWT) + (size_t)bg * S * 64;
    const float* gates = (const float*)(ws + WS_R1 + R_GATES);
    bf16_t* mixed = (bf16_t*)(ws + WS_AN);
    const float* relb = P_in(p, 1);
    const int b = bg >> 1, g = bg & 1;
    LAS float* imp = (LAS float*)(lds + wave * NSA_WAVE_LDS);
    LAS unsigned* selw = (LAS unsigned*)(lds + wave * NSA_WAVE_LDS + 8192);
    LAS float* lut = (LAS float*)(lds + wave * NSA_WAVE_LDS + 8192 + 256);
    LAS int* list = (LAS int*)(lds + wave * NSA_WAVE_LDS + 8192 + 256 + 2112);
    const int c = lane & 31, h = lane >> 5, ql = c >> 2, r = c & 3;
    const int tq0 = 64 * jq + 8 * wave, tq = tq0 + ql;
    const size_t tok = (size_t)b * S + tq;

    if (build_lut) {
        for (int e = lane; e < 4 * 129; e += 64) {
            const int rr = e / 129, n = e % 129;
            int bk = n;
            if (n >= 16) bk = 16 + (n >= 19) + (n >= 21) + (n >= 24) + (n >= 27) + (n >= 31) + (n >= 35) + (n >= 40) + (n >= 46) + (n >= 52) + (n >= 59) + (n >= 67) + (n >= 77) + (n >= 87) + (n >= 99) + (n >= 113);
            lut[rr * 132 + n] = relb[bk * 8 + g * 4 + rr] * LOG2E;
        }
    }
    for (int e = lane; e < 2048; e += 64) imp[e] = 0.f;
    {
        const int k = lane & 7; unsigned w = 0u;
        if (k == 0) w |= 1u;
        if ((jq >> 5) == k) w |= 1u << (jq & 31);
        if (jq >= 1 && ((jq - 1) >> 5) == k) w |= 1u << ((jq - 1) & 31);
        selw[lane] = w;
    }
    asm volatile("s_waitcnt lgkmcnt(0)" ::: "memory");
    __builtin_amdgcn_wave_barrier();
    const LAS float* lutr = lut + r * 132;
    const float lutfar = lutr[128];

    bf16x8 qf[4];
#pragma unroll
    for (int ks = 0; ks < 4; ++ks) qf[ks] = *(const bf16x8*)(qb + tok * 512 + (g * 4 + r) * 64 + ks * 16 + h * 8);
    const float g0 = gates[tok * 24 + (g * 4 + r) * 3 + 0], g1 = gates[tok * 24 + (g * 4 + r) * 3 + 1], g2 = gates[tok * 24 + (g * 4 + r) * 3 + 2];

    f32x16 oa0, oa1;
    bf16x8 kf[4], kn[4], vf[2][2];
    {
        const int jmaxw = (tq0 + 7 - 31) >> 4;
        const int ntile = (jmaxw >= 0) ? (jmaxw >> 5) + 1 : 0;
        float m = -1e30f, l = 0.f;
        if (ntile > 0) load_k(kn, kcmp, lane);
        for (int T = 0; T < ntile; ++T) {
#pragma unroll
            for (int ks = 0; ks < 4; ++ks) kf[ks] = kn[ks];
            if (T + 1 < ntile) load_k(kn, kcmp + (size_t)(T + 1) * 2048, lane);
            f32x16 s = qk_tile(kf, qf);
            const int base = 512 * T + 31;
            const bool fast = (tq0 - base - 16 * 31) >= 128;
            score_tile<16>(s, tq - base - 64 * h, 1 << 30, true, fast, lutfar, lutr);
            float mx = s[0];
#pragma unroll
            for (int i = 1; i < 16; ++i) mx = fmaxf(mx, s[i]);
            mx = xhalf_max(mx);
            const float mnew = fmaxf(m, mx);
            float ps = 0.f;
#pragma unroll
            for (int i = 0; i < 16; ++i) ps += fast_exp2(s[i] - mnew);
            ps = xhalf_sum(ps);
            l = l * fast_exp2(m - mnew) + ps; m = mnew;
        }
        const float c2 = (l > 0.f) ? (m + __builtin_amdgcn_logf(l)) : __builtin_inff();
        const float c2f = c2 - lutfar;
        f32x16 o0, o1;
#pragma unroll
        for (int i = 0; i < 16; ++i) { o0[i] = 0.f; o1[i] = 0.f; }
        if (ntile > 0) load_k(kn, kcmp, lane);
        for (int T = 0; T < ntile; ++T) {
#pragma unroll
            for (int ks = 0; ks < 4; ++ks) kf[ks] = kn[ks];
            load_v(vf, vcmpT + (size_t)T * 2048, lane);
            if (T + 1 < ntile) load_k(kn, kcmp + (size_t)(T + 1) * 2048, lane);
            f32x16 s = qk_tile(kf, qf);
            const int base = 512 * T + 31;
            const bool fast = (tq0 - base - 16 * 31) >= 128;
            if (fast) {
#pragma unroll
                for (int i = 0; i < 16; ++i) s[i] = fast_exp2(s[i] - c2f);
            } else {
                score_tile<16>(s, tq - base - 64 * h, 1 << 30, true, false, lutfar, lutr);
#pragma unroll
                for (int i = 0; i < 16; ++i) s[i] = fast_exp2(s[i] - c2);
            }
#pragma unroll
            for (int i4 = 0; i4 < 4; ++i4) {
                float a = (s[4 * i4] + s[4 * i4 + 1]) + (s[4 * i4 + 2] + 0.5f * s[4 * i4 + 3]);
                float bb = 0.5f * s[4 * i4 + 3];
                a = quad_sum(a); bb = quad_sum(bb);
                if (r == i4) {
                    const int n = 8 * T + 2 * i4 + h;
                    atomicAdd((float*)(imp + ql * 256 + n), a);
                    if (n + 1 < 256) atomicAdd((float*)(imp + ql * 256 + n + 1), bb);
                }
            }
            pv_tile(o0, o1, s, vf);
        }
        {
            LAS float* park = (LAS float*)(lds + wave * NSA_WAVE_LDS + 11264);
#pragma unroll
            for (int i = 0; i < 16; ++i) { park[i * 64 + lane] = g0 * o0[i]; park[(16 + i) * 64 + lane] = g0 * o1[i]; }
        }
    }
    asm volatile("s_waitcnt lgkmcnt(0)" ::: "memory");
    __builtin_amdgcn_wave_barrier();
    if (jq >= 3) {
        float val[8][4];
#pragma unroll
        for (int qq = 0; qq < 8; ++qq) {
            const f32x4 iv = *(const LAS f32x4*)(imp + qq * 256 + 4 * lane);
#pragma unroll
            for (int e = 0; e < 4; ++e) { const int n = 4 * lane + e; val[qq][e] = (n >= 1 && n <= jq - 2) ? iv[e] : -1.0f; }
        }
        unsigned mybits[8];
#pragma unroll
        for (int qq = 0; qq < 8; ++qq) mybits[qq] = 0u;
        for (int round = 0; round < 13; ++round) {
#pragma unroll
            for (int qq = 0; qq < 8; ++qq) {
                const float lb = fmaxf(fmaxf(val[qq][0], val[qq][1]), fmaxf(val[qq][2], val[qq][3]));
                const float wm = wave_max_fast(lb);
                const unsigned long long bal = __ballot(lb == wm);
                const int wl = __builtin_ctzll(bal | (1ull << 63));
                const bool win = (lane == wl) && (wm >= 0.f);
                const int e = (val[qq][0] == wm) ? 0 : ((val[qq][1] == wm) ? 1 : ((val[qq][2] == wm) ? 2 : 3));
                mybits[qq] |= win ? (1u << e) : 0u;
                val[qq][0] = (win && e == 0) ? -2.0f : val[qq][0]; val[qq][1] = (win && e == 1) ? -2.0f : val[qq][1];
                val[qq][2] = (win && e == 2) ? -2.0f : val[qq][2]; val[qq][3] = (win && e == 3) ? -2.0f : val[qq][3];
            }
        }
#pragma unroll
        for (int qq = 0; qq < 8; ++qq)
            if (mybits[qq]) atomicOr((unsigned*)(selw + qq * 8 + (lane >> 3)), mybits[qq] << ((lane & 7) * 4));
    }
    asm volatile("s_waitcnt lgkmcnt(0)" ::: "memory");
    __builtin_amdgcn_wave_barrier();
    {
        unsigned uwA = 0u, uwB = 0u;
        if (lane < 8) {
#pragma unroll
            for (int qq = 0; qq < 4; ++qq) { uwA |= selw[qq * 8 + lane]; uwB |= selw[(qq + 4) * 8 + lane]; }
        }
        int cntA = 0, cntB = 0;
        for (int k = 0; k < 8; ++k) {
            unsigned bits = (unsigned)__builtin_amdgcn_readlane((int)uwA, k);
            while (bits) { const int bit = __builtin_ctz(bits); bits &= bits - 1u; if (lane == 0) list[cntA] = 32 * k + bit; ++cntA; }
            bits = (unsigned)__builtin_amdgcn_readlane((int)uwB, k);
            while (bits) { const int bit = __builtin_ctz(bits); bits &= bits - 1u; if (lane == 0) list[64 + cntB] = 32 * k + bit; ++cntB; }
        }
        asm volatile("s_waitcnt lgkmcnt(0)" ::: "memory");
        __builtin_amdgcn_wave_barrier();
        LAS float* ostage = imp;
        const int c16 = lane & 15, fq = lane >> 4, q4 = c16 >> 2, r16 = c16 & 3;
        const LAS float* lutr16 = lut + r16 * 132;
        const float lutfar16 = lutr16[128];
        for (int grp = 0; grp < 2; ++grp) {
            const int cnt = grp ? cntB : cntA, lbase = grp * 64;
            const int tqg = tq0 + 4 * grp + q4, tq0g = tq0 + 4 * grp;
            long q8[2];
            {
                const bf16_t* qp = qb + ((size_t)b * S + tqg) * 512 + (g * 4 + r16) * 64 + 8 * fq;
#pragma unroll
                for (int ks = 0; ks < 2; ++ks) {
                    const bf16x8 qv = *(const bf16x8*)(qp + 32 * ks);
                    float f[8];
#pragma unroll
                    for (int e = 0; e < 8; ++e) f[e] = bf2f((bf16_t)qv[e]) * 4.0f;
                    q8[ks] = pack_fp8x8(f[0], f[1], f[2], f[3], f[4], f[5], f[6], f[7]);
                }
            }
            float m = -1e30f;
            f32x4 lacc = (f32x4){0.f, 0.f, 0.f, 0.f};
            const long ones8 = 0x3838383838383838L;
            f32x4 o[4];
#pragma unroll
            for (int dt = 0; dt < 4; ++dt) o[dt] = (f32x4){0.f, 0.f, 0.f, 0.f};
            const int npair = (cnt + 1) >> 1;
            if (lane == 0 && (cnt & 1)) list[lbase + cnt] = 0;
            asm volatile("s_waitcnt lgkmcnt(0)" ::: "memory");
            __builtin_amdgcn_wave_barrier();
            long k8[2][8], v8[2][8];
            int n0 = __builtin_amdgcn_readfirstlane(list[lbase]), n1 = __builtin_amdgcn_readfirstlane(list[lbase + 1]);
#pragma unroll
            for (int i = 0; i < 4; ++i) { const l64x2 t0 = *(const l64x2*)(ks8 + (size_t)n0 * 4096 + i * 1024 + lane * 16), t1 = *(const l64x2*)(ks8 + (size_t)n1 * 4096 + i * 1024 + lane * 16);
                k8[0][2 * i] = t0[0]; k8[0][2 * i + 1] = t0[1]; k8[1][2 * i] = t1[0]; k8[1][2 * i + 1] = t1[1]; }
            for (int it = 0; it < npair; ++it) {
                const int nb[2] = {n0, n1};
                const bool real1 = (2 * it + 1) < cnt;
#pragma unroll
                for (int u = 0; u < 2; ++u)
#pragma unroll
                    for (int i = 0; i < 4; ++i) { const l64x2 t = *(const l64x2*)(vs8 + (size_t)nb[u] * 4096 + i * 1024 + lane * 16); v8[u][2 * i] = t[0]; v8[u][2 * i + 1] = t[1]; }
                bool ok[2];
                ok[0] = (selw[(grp * 4 + q4) * 8 + (nb[0] >> 5)] >> (nb[0] & 31)) & 1u;
                ok[1] = real1 && ((selw[(grp * 4 + q4) * 8 + (nb[1] >> 5)] >> (nb[1] & 31)) & 1u);
                const int bmax = real1 ? max(nb[0], nb[1]) : nb[0];
                const bool fast = (tq0g - 64 * bmax - 63) >= 128;
                const bool fresh = m < -1e29f;
                const float mref = fresh ? 0.f : m;
                float ini[2];
                ini[0] = fast ? (ok[0] ? -(mref - lutfar16 - 6.0f) : NEG_INF) : 0.f;
                ini[1] = fast ? (ok[1] ? -(mref - lutfar16 - 6.0f) : NEG_INF) : 0.f;
                f32x4 sc[2][4];
#pragma unroll
                for (int u = 0; u < 2; ++u)
#pragma unroll
                    for (int kt = 0; kt < 4; ++kt) {
                        sc[u][kt] = __builtin_amdgcn_mfma_f32_16x16x32_fp8_fp8(k8[u][2 * kt], q8[0], (f32x4){ini[u], ini[u], ini[u], ini[u]}, 0, 0, 0);
                        sc[u][kt] = __builtin_amdgcn_mfma_f32_16x16x32_fp8_fp8(k8[u][2 * kt + 1], q8[1], sc[u][kt], 0, 0, 0);
                    }
                if (it + 1 < npair) {
                    n0 = __builtin_amdgcn_readfirstlane(list[lbase + 2 * it + 2]); n1 = __builtin_amdgcn_readfirstlane(list[lbase + 2 * it + 3]);
#pragma unroll
                    for (int i = 0; i < 4; ++i) { const l64x2 t0 = *(const l64x2*)(ks8 + (size_t)n0 * 4096 + i * 1024 + lane * 16), t1 = *(const l64x2*)(ks8 + (size_t)n1 * 4096 + i * 1024 + lane * 16);
                        k8[0][2 * i] = t0[0]; k8[0][2 * i + 1] = t0[1]; k8[1][2 * i] = t1[0]; k8[1][2 * i + 1] = t1[1]; }
                }
                if (fast) {
                    float t = NEG_INF;
#pragma unroll
                    for (int u = 0; u < 2; ++u) {
                        float tt = fmaxf(fmaxf(fmaxf(sc[u][0][0], sc[u][0][1]), fmaxf(sc[u][0][2], sc[u][0][3])), fmaxf(fmaxf(sc[u][1][0], sc[u][1][1]), fmaxf(sc[u][1][2], sc[u][1][3])));
                        tt = fmaxf(tt, fmaxf(fmaxf(fmaxf(sc[u][2][0], sc[u][2][1]), fmaxf(sc[u][2][2], sc[u][2][3])), fmaxf(fmaxf(sc[u][3][0], sc[u][3][1]), fmaxf(sc[u][3][2], sc[u][3][3]))));
                        t = fmaxf(t, tt);
                    }
                    { auto t1 = __builtin_amdgcn_permlane16_swap(__float_as_uint(t), __float_as_uint(t), false, false); t = fmaxf(__uint_as_float(t1[0]), __uint_as_float(t1[1])); t = xhalf_max(t); }
                    const float mxt = t - 6.0f + mref;
                    const bool need = fresh ? (t > NEG_INF) : (mxt > m + 2.0f);
                    if (__any(need)) {
                        const float mnew = need ? mxt : m;
                        const float delta = need ? (mnew - mref) : 0.f;
                        const float alpha = (need && !fresh) ? fast_exp2(m - mnew) : 1.0f;
                        lacc = lacc * alpha; m = mnew;
#pragma unroll
                        for (int dt = 0; dt < 4; ++dt) o[dt] = o[dt] * alpha;
#pragma unroll
                        for (int u = 0; u < 2; ++u)
#pragma unroll
                            for (int kt = 0; kt < 4; ++kt) sc[u][kt] = sc[u][kt] - delta;
                    }
#pragma unroll
                    for (int u = 0; u < 2; ++u)
#pragma unroll
                        for (int kt = 0; kt < 4; ++kt)
#pragma unroll
                            for (int e = 0; e < 4; ++e) sc[u][kt][e] = fast_exp2(sc[u][kt][e]);
                } else {
                    float mx = NEG_INF;
#pragma unroll
                    for (int u = 0; u < 2; ++u)
#pragma unroll
                        for (int kt = 0; kt < 4; ++kt)
#pragma unroll
                            for (int e = 0; e < 4; ++e) {
                                const int d = tqg - 64 * nb[u] - 16 * kt - 4 * fq - e;
                                const bool okk = ok[u] && d >= 0;
                                const float v = okk ? (sc[u][kt][e] + lutr16[min(max(d, 0), 128)]) : NEG_INF;
                                sc[u][kt][e] = v; mx = fmaxf(mx, v);
                            }
                    { auto t1 = __builtin_amdgcn_permlane16_swap(__float_as_uint(mx), __float_as_uint(mx), false, false); mx = fmaxf(__uint_as_float(t1[0]), __uint_as_float(t1[1])); mx = xhalf_max(mx); }
                    if (__any(mx > m + 2.0f)) {
                        const float mnew = (mx > m + 2.0f) ? mx : m;
                        const float alpha = fast_exp2(m - mnew);
                        lacc = lacc * alpha; m = mnew;
#pragma unroll
                        for (int dt = 0; dt < 4; ++dt) o[dt] = o[dt] * alpha;
                    }
                    const float cexp = m - 6.0f;
#pragma unroll
                    for (int u = 0; u < 2; ++u)
#pragma unroll
                        for (int kt = 0; kt < 4; ++kt)
#pragma unroll
                            for (int e = 0; e < 4; ++e) sc[u][kt][e] = fast_exp2(sc[u][kt][e] - cexp);
                }
#pragma unroll
                for (int u = 0; u < 2; ++u) {
                    const long pb0 = pack_fp8x8(sc[u][0][0], sc[u][0][1], sc[u][0][2], sc[u][0][3], sc[u][1][0], sc[u][1][1], sc[u][1][2], sc[u][1][3]);
                    const long pb1 = pack_fp8x8(sc[u][2][0], sc[u][2][1], sc[u][2][2], sc[u][2][3], sc[u][3][0], sc[u][3][1], sc[u][3][2], sc[u][3][3]);
#pragma unroll
                    for (int dt = 0; dt < 4; ++dt) {
                        o[dt] = __builtin_amdgcn_mfma_f32_16x16x32_fp8_fp8(v8[u][2 * dt], pb0, o[dt], 0, 0, 0);
                        o[dt] = __builtin_amdgcn_mfma_f32_16x16x32_fp8_fp8(v8[u][2 * dt + 1], pb1, o[dt], 0, 0, 0);
                    }
                    lacc = __builtin_amdgcn_mfma_f32_16x16x32_fp8_fp8(ones8, pb0, lacc, 0, 0, 0);
                    lacc = __builtin_amdgcn_mfma_f32_16x16x32_fp8_fp8(ones8, pb1, lacc, 0, 0, 0);
                }
            }
            const float l = lacc[0];
            const float invl = (l > 0.f) ? 1.0f / l : 0.f;
#pragma unroll
            for (int dt = 0; dt < 4; ++dt) *(LAS f32x4*)(ostage + ((grp * 4 + q4) * 4 + r16) * 64 + 16 * dt + 4 * fq) = o[dt] * invl;
        }
        asm volatile("s_waitcnt lgkmcnt(0)" ::: "memory");
        __builtin_amdgcn_wave_barrier();
        {
            const LAS float* park = (const LAS float*)(lds + wave * NSA_WAVE_LDS + 11264);
#pragma unroll
            for (int i = 0; i < 16; ++i) { oa0[i] = park[i * 64 + lane]; oa1[i] = park[(16 + i) * 64 + lane]; }
        }
#pragma unroll
        for (int dt = 0; dt < 2; ++dt)
#pragma unroll
            for (int i4 = 0; i4 < 4; ++i4) {
                const f32x4 v = *(const LAS f32x4*)(ostage + (ql * 4 + r) * 64 + 32 * dt + 8 * i4 + 4 * h);
                if (dt == 0) { oa0[4 * i4] += g1 * v[0]; oa0[4 * i4 + 1] += g1 * v[1]; oa0[4 * i4 + 2] += g1 * v[2]; oa0[4 * i4 + 3] += g1 * v[3]; }
                else         { oa1[4 * i4] += g1 * v[0]; oa1[4 * i4 + 1] += g1 * v[1]; oa1[4 * i4 + 2] += g1 * v[2]; oa1[4 * i4 + 3] += g1 * v[3]; }
            }
        asm volatile("s_waitcnt lgkmcnt(0)" ::: "memory");
        __builtin_amdgcn_wave_barrier();
    }
    {
        {
            const bf16_t* qp = qb + tok * 512 + (g * 4 + r) * 64 + h * 8;
            asm volatile("" : "+v"(qp));
#pragma unroll
            for (int ks = 0; ks < 4; ++ks) qf[ks] = *(const bf16x8*)(qp + ks * 16);
        }
        const int T0 = max(0, (tq0 - 511) >> 5), T1 = (tq0 + 7) >> 5;
        float m = -1e30f, l = 0.f;
        f32x16 o0, o1;
#pragma unroll
        for (int i = 0; i < 16; ++i) { o0[i] = 0.f; o1[i] = 0.f; }
        load_k(kn, kwb + (size_t)(32 * T0) * 64, lane);
        for (int T = T0; T <= T1; ++T) {
#pragma unroll
            for (int ks = 0; ks < 4; ++ks) kf[ks] = kn[ks];
            load_v(vf, vwT + (size_t)T * 2048, lane);
            if (T < T1) load_k(kn, kwb + (size_t)(32 * (T + 1)) * 64, lane);
            const int base = 32 * T;
            f32x16 s = qk_tile(kf, qf);
            if (((tq0 - base - 31) >= 128) && ((tq0 + 7 - base) < 512)) online_step<true>(s, lutfar, true, m, l, o0, o1, vf);
            else { score_tile<1>(s, tq - base - 4 * h, 512, true, false, lutfar, lutr); online_step<false>(s, 0.f, true, m, l, o0, o1, vf); }
        }
        const float sc = (l > 0.f) ? g2 / l : 0.f;
#pragma unroll
        for (int i = 0; i < 16; ++i) { oa0[i] += sc * o0[i]; oa1[i] += sc * o1[i]; }
    }
    bf16_t* orow = mixed + tok * 1024 + (g * 4 + r) * 64;
#pragma unroll
    for (int dt = 0; dt < 2; ++dt)
#pragma unroll
        for (int i4 = 0; i4 < 4; ++i4) {
            const f32x16& a = dt ? oa1 : oa0;
            u32x2 o; o.x = cvt_pk_bf16(a[4 * i4], a[4 * i4 + 1]); o.y = cvt_pk_bf16(a[4 * i4 + 2], a[4 * i4 + 3]);
            *(u32x2*)(orow + 32 * dt + 8 * i4 + 4 * h) = o;
        }
}


#define XB_TMO      128
#define XB_XCNT(j)  (256  + 64 * (j))
#define XB_XSUB(j)  (1280 + 64 * (j))
#define XB_XGEN(j)  (2304 + 64 * (j))
#define XB_TOP      3328
#define XB_TOPGEN   3392
#define XCD_BAR_WORDS 3456
#define XB_SPIN_CAP (1u << 22)
__device__ __forceinline__ unsigned xb_ld(unsigned* p)              { return __hip_atomic_load(p, __ATOMIC_RELAXED, __HIP_MEMORY_SCOPE_AGENT); }
__device__ __forceinline__ unsigned xb_add(unsigned* p, unsigned v) { return __hip_atomic_fetch_add(p, v, __ATOMIC_RELAXED, __HIP_MEMORY_SCOPE_AGENT); }
__device__ __forceinline__ unsigned xb_xcc_id() { return (unsigned)__builtin_amdgcn_s_getreg((3 << 11) | 20) & 0xFu; }
#define XB_SPIN(cond, bar) do { unsigned _sp = 0; while (cond) { __builtin_amdgcn_s_sleep(1); \
    if ((++_sp & 255u) == 0u) { if (xb_ld(&(bar)[XB_TMO])) break; if (_sp > XB_SPIN_CAP) { atomicAdd(&(bar)[XB_TMO], 1u); break; } } } } while (0)
__device__ __forceinline__ void xcd_barrier_complete(unsigned* bar, unsigned x, unsigned& nloc, unsigned& nx) {
    const unsigned G = gridDim.x * gridDim.y * gridDim.z;
    unsigned sum, cnt, mine, sp = 0u;
    for (;;) {
        sum = 0u; cnt = 0u; mine = 0u;
#pragma unroll
        for (unsigned j = 0; j < 16; ++j) { const unsigned c = xb_ld(&bar[XB_XCNT(j)]); sum += c; cnt += (c > 0u) ? 1u : 0u; mine = (j == x) ? c : mine; }
        if (sum == G) break;
        __builtin_amdgcn_s_sleep(1);
        if ((++sp & 255u) == 0u) { if (xb_ld(&bar[XB_TMO])) break; if (sp > XB_SPIN_CAP) { atomicAdd(&bar[XB_TMO], 1u); break; } }
    }
    nloc = mine > 0u ? mine : 1u; nx = cnt > 0u ? cnt : 1u;
}
__device__ __forceinline__ void xcd_barrier(unsigned* bar, volatile LAS unsigned* st) {
    asm volatile("s_waitcnt vmcnt(0)" ::: "memory");
    __syncthreads();
    if (threadIdx.x == 0) {
        const unsigned x = xb_xcc_id();
        __builtin_amdgcn_s_waitcnt(0);
        unsigned nloc = st[0], nx = st[1];
        if (nloc == 0u) { xcd_barrier_complete(bar, x, nloc, nx); st[0] = nloc; st[1] = nx; }
        const unsigned old = xb_add(&bar[XB_XSUB(x)], 1u);
        const unsigned gen = old / nloc;
        if (old + 1u == (gen + 1u) * nloc) {
            __builtin_amdgcn_fence(__ATOMIC_RELEASE, "agent");
            asm volatile("s_waitcnt vmcnt(0)" ::: "memory");
            const unsigned og = xb_add(&bar[XB_TOP], 1u);
            const unsigned tg = og / nx;
            if (og + 1u == (tg + 1u) * nx) xb_add(&bar[XB_TOPGEN], 1u);
            else XB_SPIN(xb_ld(&bar[XB_TOPGEN]) == tg, bar);
            __builtin_amdgcn_fence(__ATOMIC_ACQUIRE, "agent");
            xb_add(&bar[XB_XGEN(x)], 1u);
            asm volatile("s_waitcnt vmcnt(0)" ::: "memory");
        } else {
            XB_SPIN(xb_ld(&bar[XB_XGEN(x)]) == gen, bar);
            __builtin_amdgcn_fence(__ATOMIC_ACQUIRE, "agent");
            asm volatile("s_waitcnt vmcnt(0)" ::: "memory");
        }
    }
    __syncthreads();
}

__global__ void __launch_bounds__(NTHREADS, 2) fwd_megakernel(Params p) {
    extern __shared__ __attribute__((aligned(16))) unsigned char lds_raw[];
    LAS unsigned char* lds = (LAS unsigned char*)lds_raw;
    cg::grid_group grid = cg::this_grid();
#define TID_F ({ int _t = threadIdx.x; LAUNDER(_t); _t; })
#define LANE_F (TID_F & 63)
#define WAVE_F (__builtin_amdgcn_readfirstlane(TID_F >> 6))
    const int G = gridDim.x, bx = blockIdx.x;
    const int NGW = G * NWAVES;
#define GW_F (bx * NWAVES + WAVE_F)
#define FRESH_WS unsigned char* ws = P_ws(p); bf16_t* AN = (bf16_t*)(ws + WS_AN); float* MIX = (float*)(ws + WS_MIX); (void)AN; (void)MIX

    { const int tid = TID_F; if (tid < 16) ((LAS unsigned*)(lds + LDS_BYTES - 64))[tid] = 0u; }
    if (bx == 0) { unsigned* barw = (unsigned*)P_ws(p); for (int i = TID_F; i < XCD_BAR_WORDS; i += NTHREADS) barw[i] = 0u; }
    { const int t = TID_F; if (t < 128) ((unsigned*)(P_ws(p) + WS_XCNT))[bx * 128 + t] = 0u; }
    __syncthreads();
    {
        FRESH_WS;
        const int tid = TID_F, lane = tid & 63, wave = __builtin_amdgcn_readfirstlane(tid >> 6), gw = bx * NWAVES + wave;
        LAS float* scr = (LAS float*)(lds + wave * 17408);
        for (int layer = 0; layer < DEPTH; ++layer) {
            unsigned char* wl = ws + WS_W + (size_t)layer * W_LAYER;
            const int I_IN = 16 * (NINP / 64), I_OUT = 16 * 16, I_GU = 16 * (NGU / 64), I_DN = 44 * 16, I_C1 = 32 * 4, I_C2 = 4 * 1;
            const int NIT = I_IN + I_OUT + I_GU + I_DN + 2 * I_C1 + 2 * I_C2;
            for (int it = gw; it < NIT; it += NGW) {
                int r = it;
                if (r < I_IN) { transpose_item<1>(P_in(p, 6) + (size_t)layer * DM * INW, DM, INW, (bf16_t*)(wl + W_IN), NINP / 64, r, scr, lane, P_in(p, 2) + layer * DM); continue; } r -= I_IN;
                if (r < I_OUT) { transpose_item<0>(P_in(p, 17) + (size_t)layer * DM * DM, DM, DM, (bf16_t*)(wl + W_OUT), 16, r, scr, lane); continue; } r -= I_OUT;
                if (r < I_GU) { transpose_item<2>(P_in(p, 18) + (size_t)layer * DM * NGU, DM, NGU, (bf16_t*)(wl + W_GU), NGU / 64, r, scr, lane, P_in(p, 4) + layer * DM); continue; } r -= I_GU;
                if (r < I_DN) { transpose_item<0>(P_in(p, 19) + (size_t)layer * DFF * DM, DFF, DM, (bf16_t*)(wl + W_DN), 16, r, scr, lane); continue; } r -= I_DN;
                if (r < I_C1) { transpose_item<0>(P_in(p, 8) + (size_t)layer * 2048 * 256, 2048, 256, (bf16_t*)(wl + W_C1K), 4, r, scr, lane); continue; } r -= I_C1;
                if (r < I_C1) { transpose_item<0>(P_in(p, 11) + (size_t)layer * 2048 * 256, 2048, 256, (bf16_t*)(wl + W_C1V), 4, r, scr, lane); continue; } r -= I_C1;
                if (r < I_C2) { transpose_item<0>(P_in(p, 9) + (size_t)layer * 256 * 64, 256, 64, (bf16_t*)(wl + W_C2K), 1, r, scr, lane); continue; } r -= I_C2;
                transpose_item<0>(P_in(p, 12) + (size_t)layer * 256 * 64, 256, 64, (bf16_t*)(wl + W_C2V), 1, r, scr, lane);
            }
        }
        __syncthreads();
        if (bx >= G - 2 * DEPTH) {
            const int id = G - 1 - bx, layer = id >> 1, kv = id & 1;
            const float* pos = P_in(p, kv ? 10 : 7) + (size_t)layer * 2048;
            const float* w1 = P_in(p, kv ? 11 : 8) + (size_t)layer * 2048 * 256;
            LAS float* red = (LAS float*)lds;
            f32x4 acc4 = (f32x4){0.f, 0.f, 0.f, 0.f};
#pragma unroll 8
            for (int i = wave * 256; i < wave * 256 + 256; ++i) { const f32x4 w = *(const f32x4*)(w1 + (size_t)i * 256 + 4 * lane); acc4 = acc4 + w * pos[i]; }
            red[wave * 256 + 4 * lane + 0] = acc4[0]; red[wave * 256 + 4 * lane + 1] = acc4[1]; red[wave * 256 + 4 * lane + 2] = acc4[2]; red[wave * 256 + 4 * lane + 3] = acc4[3];
            __syncthreads();
            if (tid < 256) { float sum = 0.f;
#pragma unroll
                for (int w = 0; w < 8; ++w) sum += red[w * 256 + tid];
                ((float*)(ws + WS_W + (size_t)layer * W_LAYER + (kv ? W_CBV : W_CBK)))[tid] = sum; }
            __syncthreads();
        }
        row_pass(P_in(p, 0), (bf16_t*)(ws + WS_HB), nullptr, nullptr, (float*)(ws + WS_RS), nullptr, gw, NGW, lane);
    }
    grid.sync();
    if (TID_F == 0) (void)xb_add(&((unsigned*)P_ws(p))[XB_XCNT(xb_xcc_id())], 1u);

#pragma unroll 1
    for (int layer = 0; layer < DEPTH; ++layer) {
        const size_t wloff = WS_W + (size_t)layer * W_LAYER;
#ifndef SKIP_PA
        {
            FRESH_WS; unsigned char* wl = ws + wloff;
            pg8::Gemm g{(const bf16_t*)(ws + WS_HB), (const bf16_t*)(wl + W_IN), MT, NINP, DM, DM};
            pg8::StaticOrder so; so.init(MT, NINP, G, bx, REP_PA);
            pg8::EpiIn E{ws + WS_R1, (const float*)(ws + WS_RS)};
            pg8::gemm_phase<pg8::EpiIn>(lds, g, so, E);
        }
#endif
        GSYNC();
#ifndef SKIP_PB
        for (int rep = 0; rep < REP_PB; ++rep) {
            FRESH_WS; unsigned char* wl = ws + wloff;
            for (int kv = 0; kv < 2; ++kv) {
                const int c = kv ? ((bx + (G >> 1)) % G) : bx;
                if (c < 16) {
                    bf16_t* hid = (bf16_t*)(ws + WS_R1 + R_HID) + (size_t)kv * 4096 * 256;
                    pg8::Gemm g{(const bf16_t*)(ws + WS_R1 + (kv ? R_VC : R_KC)), (const bf16_t*)(wl + (kv ? W_C1V : W_C1K)), 4096, 256, 2048, 1024};
                    pg8::StaticOrder so; so.init(4096, 256, G, c);
                    pg8::EpiCmp1 E{hid, (const float*)(wl + (kv ? W_CBV : W_CBK))};
                    pg8::gemm_phase<pg8::EpiCmp1>(lds, g, so, E);
                    pg8::Unit u; so.next(0, u);
                    asm volatile("s_waitcnt vmcnt(0)" ::: "memory");
                    __builtin_amdgcn_fence(__ATOMIC_RELEASE, "agent");
                    __syncthreads();
                    __builtin_amdgcn_fence(__ATOMIC_ACQUIRE, "agent");
                    cmp_gemm2(hid, (const bf16_t*)(wl + (kv ? W_C2V : W_C2K)), (bf16_t*)(ws + WS_R1 + R_KCMP), (bf16_t*)(ws + WS_R1 + R_VCMPT), kv, u.pm * 256 + WAVE_F * 32, LANE_F);
                    __syncthreads();
                }
            }
            if (G == 256) {
                const bool is_cmp = (bx < 16) || (bx >= 128 && bx < 144);
                if (!is_cmp) {
                    const int idx = (bx < 128) ? (bx - 16) : (bx - 32);
                    gmlp_unit(p, layer, idx, lds, WAVE_F, LANE_F);
                    if (idx + 224 < MT / 128) gmlp_unit(p, layer, idx + 224, lds, WAVE_F, LANE_F);
                }
            } else {
                for (int ch = bx; ch < MT / 128; ch += G) gmlp_unit(p, layer, ch, lds, WAVE_F, LANE_F);
            }
        }
#endif
        GSYNC();
        {
#if NSA_ENABLE
            __syncthreads();
            for (int rep = 0; rep < REP_PC; ++rep) {
                if (G == 256) {
                    const int x = bx & 7, y = bx >> 3, bg = x >> 1, j = (x & 1) * 32 + y;
                    for (int i = 0; i < 4; ++i) {
                        const int jq = (i >> 1) * 128 + ((i & 1) ? (127 - j) : j);
                        nsa_unit(p, bg, jq, lds, WAVE_F, LANE_F, i == 0);
                    }
                } else {
                    for (int i = 0; bx + i * G < 1024; ++i) {
                        const int u = bx + i * G;
                        const int bg = u >> 8, x = u & 255;
                        const int jq = (bg & 1) ? (255 - x) : x;
                        nsa_unit(p, bg, jq, lds, WAVE_F, LANE_F, true);
                    }
                }
            }
#else
            FRESH_WS;
            bf16_t* mixed = (bf16_t*)(ws + WS_AN);
            for (int m = GW_F; m < MT; m += NGW) { u32x4* o = (u32x4*)(mixed + (size_t)m * 1024); o[LANE_F] = (u32x4){0u, 0u, 0u, 0u}; }
#endif
        }
        GSYNC();
        {
            FRESH_WS; unsigned char* wl = ws + wloff;
            pg8::Gemm g{AN, (const bf16_t*)(wl + W_OUT), MT, DM, DM, DM};
            pg8::StaticOrder so; so.init(MT, DM, G, bx, 1);
            pg8::EpiNormRes E{ws, P_in(p, 3) + layer * DM, nullptr, 2 * layer};
            pg8::gemm_phase<pg8::EpiNormRes>(lds, g, so, E);
        }
        GSYNC();
#ifndef SKIP_PF
        {
            FRESH_WS; unsigned char* wl = ws + wloff;
            pg8::Gemm g{(const bf16_t*)(ws + WS_HB), (const bf16_t*)(wl + W_GU), MT, NGU, DM, DM};
            pg8::StaticOrder so; so.init(MT, NGU, G, bx, REP_PF);
            pg8::EpiGU E{(bf16_t*)(ws + WS_R1), (const float*)(ws + WS_RS)};
            pg8::gemm_phase<pg8::EpiGU>(lds, g, so, E);
        }
#endif
        GSYNC();
        {
            FRESH_WS; unsigned char* wl = ws + wloff;
            pg8::Gemm g{(const bf16_t*)(ws + WS_R1), (const bf16_t*)(wl + W_DN), MT, DM, DFF, DFF};
            pg8::StaticOrder so; so.init(MT, DM, G, bx, 1);
            pg8::EpiNormRes E{ws, P_in(p, 5) + layer * DM, (layer + 1 < DEPTH) ? nullptr : P_out(p), 2 * layer + 1};
            pg8::gemm_phase<pg8::EpiNormRes>(lds, g, so, E);
        }
        if (layer + 1 < DEPTH) GSYNC();
    }
}

extern "C" void kernel_launch(void* const* d_in, const int* in_sizes, int n_in, void* d_out, int out_size, void* d_ws, size_t ws_size, hipStream_t stream) {
    static int grid = 0;
    if (grid == 0) {
        if (n_in != 20 || out_size != MT * DM || ws_size < WS_END) { fprintf(stderr, "kernel_launch: unexpected shapes (n_in %d out %d ws %zu need %zu)\n", n_in, out_size, ws_size, (size_t)WS_END); grid = -1; return; }
        int dev = 0, cus = 0, per_cu = 0;
        hipGetDevice(&dev);
        hipDeviceGetAttribute(&cus, hipDeviceAttributeMultiprocessorCount, dev);
        if (hipFuncSetAttribute((const void*)fwd_megakernel, hipFuncAttributeMaxDynamicSharedMemorySize, LDS_BYTES) != hipSuccess) { fprintf(stderr, "kernel_launch: hipFuncSetAttribute failed\n"); grid = -1; return; }
        if (hipOccupancyMaxActiveBlocksPerMultiprocessor(&per_cu, (const void*)fwd_megakernel, NTHREADS, LDS_BYTES) != hipSuccess || per_cu < 1) { fprintf(stderr, "kernel_launch: occupancy query says %d\n", per_cu); per_cu = 1; }
        (void)hipGetLastError();
        grid = cus;
        if (grid > 256) grid = 256;
    }
    if (grid < 0) return;
    Params p{};
    for (int i = 0; i < 20; ++i) p.in[i] = (const float*)d_in[i];
    p.out = (float*)d_out; p.ws = (unsigned char*)d_ws;
    void* args[] = {&p};
    hipError_t e = hipLaunchCooperativeKernel((const void*)fwd_megakernel, dim3(grid), dim3(NTHREADS), args, LDS_BYTES, stream);
    if (e != hipSuccess) fprintf(stderr, "cooperative launch failed: %s (grid %d)\n", hipGetErrorString(e), grid);
}
```

```cpp
#include <hip/hip_runtime.h>
#include <hip/hip_cooperative_groups.h>
#include <cstdio>
#include <cstdint>
namespace cg = cooperative_groups;

#define LAS __attribute__((address_space(3)))
typedef unsigned short bf16_t;
typedef short bf16x8 __attribute__((ext_vector_type(8)));
typedef short s16x4 __attribute__((ext_vector_type(4)));
typedef float f32x2 __attribute__((ext_vector_type(2)));
typedef float f32x4 __attribute__((ext_vector_type(4)));
typedef float f32x16 __attribute__((ext_vector_type(16)));
typedef unsigned u32x2 __attribute__((ext_vector_type(2)));
typedef unsigned u32x4 __attribute__((ext_vector_type(4)));
typedef long l64x2 __attribute__((ext_vector_type(2)));

#ifndef REP_PA
#define REP_PA 1
#endif
#ifndef REP_PB
#define REP_PB 1
#endif
#ifndef REP_PC
#define REP_PC 1
#endif
#ifndef REP_PD
#define REP_PD 1
#endif
#ifndef REP_PF
#define REP_PF 1
#endif
#ifndef REP_PG
#define REP_PG 1
#endif
#ifndef SYNC_REP
#define SYNC_REP 1
#endif
#define GSYNC() do { for (int _r = 0; _r < SYNC_REP; ++_r) xcd_barrier((unsigned*)P_ws(p), (volatile LAS unsigned*)(lds + LDS_BYTES - 64)); } while (0)
#ifndef NSA_ENABLE
#define NSA_ENABLE 1
#endif

constexpr int NB = 2, S = 16384, DM = 1024, DEPTH = 4, MT = NB * S;
constexpr int INW = 2328, NINP = 2560, DFF = 2816, NGU = 2 * DFF;
constexpr int NCMP = 1024;
constexpr float RMS_EPS = 1e-6f, LN_EPS = 1e-5f;
constexpr float LOG2E = 1.4426950408889634f;
constexpr float QSCALE = 0.125f * LOG2E;
constexpr int NWAVES = 8, NTHREADS = 512;
constexpr int LDS_BYTES = 156672;

constexpr size_t MiB = 1u << 20;
constexpr size_t WS_W = 1 * MiB, W_LAYER = 26 * MiB;
constexpr size_t W_IN = 0, W_OUT = 5 * MiB, W_GU = 7 * MiB, W_DN = 18 * MiB, W_C1K = 23 * MiB + 512 * 1024, W_C1V = 24 * MiB + 512 * 1024,
                 W_C2K = 25 * MiB + 512 * 1024, W_C2V = W_C2K + 64 * 1024, W_CBK = W_C2V + 64 * 1024, W_CBV = W_CBK + 4096;
constexpr size_t WS_AN = 105 * MiB;
constexpr size_t WS_R1 = 169 * MiB;
constexpr size_t R_Q = 0, R_ZU = 32 * MiB, R_ZV = 64 * MiB, R_KC = 96 * MiB, R_VC = 105 * MiB, R_KS = 114 * MiB, R_VST = 122 * MiB, R_KW = 130 * MiB,
                 R_VWT = 138 * MiB, R_GATES = 146 * MiB, R_HID = 150 * MiB, R_KCMP = 154 * MiB, R_VCMPT = 155 * MiB;
constexpr size_t WS_MIX = 345 * MiB;
constexpr size_t WS_HB = WS_MIX + 64 * MiB;
constexpr size_t WS_RS = 256 * 1024;
constexpr size_t WS_XCNT = 512 * 1024;
constexpr size_t WS_XBUF = WS_MIX;
constexpr size_t WS_END = 473 * MiB;

struct Params {
    const float* in[20];
    float* out;
    unsigned char* ws;
};

typedef const __attribute__((address_space(4))) unsigned char* kargp_t;
__device__ __forceinline__ void* karg_ld(int byte_off) {
    kargp_t k = (kargp_t)__builtin_amdgcn_kernarg_segment_ptr();
    int off = byte_off; asm volatile("" : "+s"(off));
    return *(void* const __attribute__((address_space(4)))*)(k + off);
}
__device__ __forceinline__ const float* P_in(const Params&, int i) { return (const float*)karg_ld(8 * i); }
__device__ __forceinline__ float* P_out(const Params&) { return (float*)karg_ld(160); }
__device__ __forceinline__ unsigned char* P_ws(const Params&) { return (unsigned char*)karg_ld(168); }
__device__ __forceinline__ unsigned cvt_pk_bf16(float lo, float hi) { unsigned r; asm volatile("v_cvt_pk_bf16_f32 %0, %1, %2" : "=v"(r) : "v"(lo), "v"(hi)); return r; }
__device__ __forceinline__ float fast_exp2(float x) { return __builtin_amdgcn_exp2f(x); }
__device__ __forceinline__ float fast_rcp(float x) { return __builtin_amdgcn_rcpf(x); }
__device__ __forceinline__ float gelu_tanh(float x) { const float u = x + 0.044715f * x * x * x; return x * fast_rcp(1.0f + fast_exp2(-2.3022081982f * u)); }
__device__ __forceinline__ float silu_f(float x) { return x * fast_rcp(1.0f + fast_exp2(-LOG2E * x)); }
__device__ __forceinline__ float sigmoid_f(float x) { return fast_rcp(1.0f + fast_exp2(-LOG2E * x)); }
__device__ __forceinline__ float wave_sum(float v) {
#pragma unroll
    for (int o = 1; o < 64; o <<= 1) v += __shfl_xor(v, o);
    return v;
}
__device__ __forceinline__ float wave_max(float v) {
#pragma unroll
    for (int o = 1; o < 64; o <<= 1) v = fmaxf(v, __shfl_xor(v, o));
    return v;
}
template <int CTRL> __device__ __forceinline__ float dpp_f(float x) { return __builtin_bit_cast(float, __builtin_amdgcn_mov_dpp(__builtin_bit_cast(int, x), CTRL, 0xf, 0xf, true)); }
__device__ __forceinline__ float xhalf_max(float x) { auto t = __builtin_amdgcn_permlane32_swap(__float_as_uint(x), __float_as_uint(x), false, false); return fmaxf(__uint_as_float(t[0]), __uint_as_float(t[1])); }
__device__ __forceinline__ float xhalf_sum(float x) { auto t = __builtin_amdgcn_permlane32_swap(__float_as_uint(x), __float_as_uint(x), false, false); return __uint_as_float(t[0]) + __uint_as_float(t[1]); }
__device__ __forceinline__ float quad_sum(float x) { x += dpp_f<0xB1>(x); x += dpp_f<0x4E>(x); return x; }
__device__ __forceinline__ float wave_max_fast(float x) {
    x = fmaxf(x, dpp_f<0xB1>(x)); x = fmaxf(x, dpp_f<0x4E>(x)); x = fmaxf(x, dpp_f<0x141>(x)); x = fmaxf(x, dpp_f<0x128>(x));
    auto s = __builtin_amdgcn_permlane16_swap(__float_as_uint(x), __float_as_uint(x), false, false); x = fmaxf(__uint_as_float(s[0]), __uint_as_float(s[1]));
    return xhalf_max(x);
}
__device__ __forceinline__ float wave_sum_fast(float x) {
    x += dpp_f<0xB1>(x); x += dpp_f<0x4E>(x); x += dpp_f<0x141>(x); x += dpp_f<0x128>(x);
    auto s = __builtin_amdgcn_permlane16_swap(__float_as_uint(x), __float_as_uint(x), false, false); x = __uint_as_float(s[0]) + __uint_as_float(s[1]);
    return xhalf_sum(x);
}
__device__ __forceinline__ float bf2f(bf16_t b) { return __uint_as_float(((unsigned)b) << 16); }
#define LAUNDER(x) asm volatile("" : "+v"(x))
#define MFMA32(a, b, c) __builtin_amdgcn_mfma_f32_32x32x16_bf16((a), (b), (c), 0, 0, 0)

namespace pg8 {
constexpr int BM = 256, BK = 64, HALF = 128, HTB = HALF * BK * 2, STAGE_BYTES = 8 * HTB, NXCD = 8, WGM = 8;
__host__ __device__ __forceinline__ int lds_byte(int r, int c) { const int st = (r >> 4) * 2 + (c >> 5), rr = r & 15, cc = c & 31, ob = rr * 64 + cc * 2; return st * 1024 + (ob ^ (((ob >> 9) & 1) << 5)); }
__host__ __device__ __forceinline__ void stage_rc(int b, int& R, int& C) { const int st = b / 1024, sb = b % 1024, swz = sb ^ (((sb >> 9) & 1) << 5); R = (st >> 1) * 16 + swz / 64; C = (st & 1) * 32 + (swz % 64) / 2; }
__host__ __device__ __forceinline__ int perm32(int rho) { const int n = rho >> 4, i = rho & 15; return 8 * (i >> 2) + 4 * n + (i & 3); }

struct Unit { int pm, pn; };
struct Gemm { const bf16_t* A; const bf16_t* Bt; int M, N, K, lda; };

struct StaticOrder {
    int nM, nN, nwg, G, c, lim;
    __device__ __forceinline__ void init(int M, int N, int G_, int c_, int reps = 1) { nM = M / BM; nN = N / BM; nwg = nM * nN; G = G_; c = c_; const int per = (c < nwg) ? (nwg - c + G - 1) / G : 0; lim = per * reps; }
    __device__ __forceinline__ bool next(int i, Unit& u) const {
        if (i >= lim) return false;
        const int per = (nwg - c + G - 1) / G; const long L = (long)(i % per) * G + c;
        int wgid = (int)L; { const int q = nwg / NXCD, r = nwg % NXCD, xcd = wgid % NXCD, off = wgid / NXCD; wgid = (xcd < r ? xcd * (q + 1) : r * (q + 1) + (xcd - r) * q) + off; }
        const int nig = WGM * nN, gid = wgid / nig, fm = gid * WGM, gsz = (nM - fm) < WGM ? (nM - fm) : WGM;
        u.pm = fm + ((wgid % nig) % gsz); u.pn = (wgid % nig) / gsz; return true;
    }
};

struct EpiF32 {
    static constexpr bool PERM = false, FUSED = false;
    float* C; int ldc;
    __device__ __forceinline__ void operator()(const f32x4 (&acc)[2][2][4][2], const Unit& u, int wr, int wc, int fr, int fq) const {
        const int row0 = u.pm * BM + wr * 64 + fr, col0 = u.pn * BM + wc * 32 + 4 * fq;
#pragma unroll
        for (int ai = 0; ai < 2; ++ai)
#pragma unroll
            for (int m = 0; m < 4; ++m) { float* rowp = C + (size_t)(row0 + ai * HALF + m * 16) * ldc + col0;
#pragma unroll
                for (int bj = 0; bj < 2; ++bj)
#pragma unroll
                    for (int n = 0; n < 2; ++n) *(f32x4*)(rowp + bj * HALF + n * 16) = acc[ai][bj][m][n]; }
    }
};

struct EpiBf16 {
    static constexpr bool PERM = true, FUSED = false;
    bf16_t* C; int ldc;
    __device__ __forceinline__ void operator()(const f32x4 (&acc)[2][2][4][2], const Unit& u, int wr, int wc, int fr, int fq) const {
        const int row0 = u.pm * BM + wr * 64 + fr, col0 = u.pn * BM + wc * 32 + 8 * fq;
#pragma unroll
        for (int ai = 0; ai < 2; ++ai)
#pragma unroll
            for (int m = 0; m < 4; ++m) { bf16_t* rowp = C + (size_t)(row0 + ai * HALF + m * 16) * ldc + col0;
#pragma unroll
                for (int bj = 0; bj < 2; ++bj) { const f32x4 v0 = acc[ai][bj][m][0], v1 = acc[ai][bj][m][1];
                    u32x4 w; w.x = cvt_pk_bf16(v0[0], v0[1]); w.y = cvt_pk_bf16(v0[2], v0[3]); w.z = cvt_pk_bf16(v1[0], v1[1]); w.w = cvt_pk_bf16(v1[2], v1[3]);
                    *(u32x4*)(rowp + bj * HALF) = w; } }
    }
};

struct EpiGU {
    static constexpr bool PERM = true, FUSED = false;
    bf16_t* act; const float* rs;
    __device__ __forceinline__ void operator()(const f32x4 (&acc)[2][2][4][2], const Unit& u, int wr, int wc, int fr, int fq) const {
        const int row0 = u.pm * BM + wr * 64 + fr, col0 = u.pn * HALF + wc * 32 + 8 * fq;
        float rrv[2][4];
#pragma unroll
        for (int ai = 0; ai < 2; ++ai)
#pragma unroll
            for (int m = 0; m < 4; ++m) rrv[ai][m] = rs[row0 + ai * HALF + m * 16];
#pragma unroll
        for (int ai = 0; ai < 2; ++ai)
#pragma unroll
            for (int m = 0; m < 4; ++m) {
                const float rr = rrv[ai][m];
                const f32x4 g0 = acc[ai][0][m][0] * rr, g1 = acc[ai][0][m][1] * rr, u0 = acc[ai][1][m][0] * rr, u1 = acc[ai][1][m][1] * rr;
                u32x4 w;
                w.x = cvt_pk_bf16(silu_f(g0[0]) * u0[0], silu_f(g0[1]) * u0[1]); w.y = cvt_pk_bf16(silu_f(g0[2]) * u0[2], silu_f(g0[3]) * u0[3]);
                w.z = cvt_pk_bf16(silu_f(g1[0]) * u1[0], silu_f(g1[1]) * u1[1]); w.w = cvt_pk_bf16(silu_f(g1[2]) * u1[2], silu_f(g1[3]) * u1[3]);
                *(u32x4*)(act + (size_t)(row0 + ai * HALF + m * 16) * DFF + col0) = w;
            }
    }
};

struct EpiCmp1 {
    static constexpr bool PERM = true, FUSED = false;
    bf16_t* hid; const float* cbias;
    __device__ __forceinline__ void operator()(const f32x4 (&acc)[2][2][4][2], const Unit& u, int wr, int wc, int fr, int fq) const {
        const int row0 = u.pm * BM + wr * 64 + fr;
#pragma unroll
        for (int bj = 0; bj < 2; ++bj) {
            const int col0 = bj * HALF + wc * 32 + 8 * fq;
            const f32x4 b0 = *(const f32x4*)(cbias + col0), b1 = *(const f32x4*)(cbias + col0 + 4);
#pragma unroll
            for (int ai = 0; ai < 2; ++ai)
#pragma unroll
                for (int m = 0; m < 4; ++m) {
                    const f32x4 v0 = acc[ai][bj][m][0] + b0, v1 = acc[ai][bj][m][1] + b1;
                    u32x4 w;
                    w.x = cvt_pk_bf16(gelu_tanh(v0[0]), gelu_tanh(v0[1])); w.y = cvt_pk_bf16(gelu_tanh(v0[2]), gelu_tanh(v0[3]));
                    w.z = cvt_pk_bf16(gelu_tanh(v1[0]), gelu_tanh(v1[1])); w.w = cvt_pk_bf16(gelu_tanh(v1[2]), gelu_tanh(v1[3]));
                    *(u32x4*)(hid + (size_t)(row0 + ai * HALF + m * 16) * 256 + col0) = w;
                }
        }
    }
};

struct EpiIn {
    static constexpr bool PERM = true, FUSED = false;
    unsigned char* r1;
    const float* rs;
    __device__ __forceinline__ void operator()(const f32x4 (&acc)[2][2][4][2], const Unit& u, int wr, int wc, int fr, int fq) const {
        const int pn = u.pn;
        float rrv[2][4];
#pragma unroll
        for (int ai = 0; ai < 2; ++ai)
#pragma unroll
            for (int m = 0; m < 4; ++m) rrv[ai][m] = rs[u.pm * BM + ai * HALF + wr * 64 + m * 16 + fr];
#pragma unroll
        for (int ai = 0; ai < 2; ++ai)
#pragma unroll
            for (int m = 0; m < 4; ++m) {
                const int row = u.pm * BM + ai * HALF + wr * 64 + m * 16 + fr;
                const int b = row >> 14, s = row & (S - 1);
                const float rr = rrv[ai][m];
#pragma unroll
                for (int bj = 0; bj < 2; ++bj) {
                    f32x4 v0 = acc[ai][bj][m][0] * rr, v1 = acc[ai][bj][m][1] * rr;
                    const int cw = bj * HALF + wc * 32 + 8 * fq;
                    if (pn < 2) {
                        v0 = v0 * QSCALE; v1 = v1 * QSCALE;
                        u32x4 w; w.x = cvt_pk_bf16(v0[0], v0[1]); w.y = cvt_pk_bf16(v0[2], v0[3]); w.z = cvt_pk_bf16(v1[0], v1[1]); w.w = cvt_pk_bf16(v1[2], v1[3]);
                        *(u32x4*)((bf16_t*)(r1 + R_Q) + (size_t)row * 512 + pn * 256 + cw) = w;
                    } else if (pn < 5) {
                        const int g = wc >> 1, d = (wc & 1) * 32 + 8 * fq, bg = b * 2 + g;
                        if (pn == 2) {
                            bf16_t* base = (bf16_t*)(r1 + (bj == 0 ? R_KC : R_VC));
                            u32x4 w; w.x = cvt_pk_bf16(v0[0], v0[1]); w.y = cvt_pk_bf16(v0[2], v0[3]); w.z = cvt_pk_bf16(v1[0], v1[1]); w.w = cvt_pk_bf16(v1[2], v1[3]);
                            *(u32x4*)(base + ((size_t)bg * S + s) * 64 + d) = w;
                        } else if (pn == 3) {
                            if (bj == 0) {
                                v0 = v0 * 0.25f; v1 = v1 * 0.25f;
                                int w0 = __builtin_amdgcn_cvt_pk_fp8_f32(v0[0], v0[1], 0, false); w0 = __builtin_amdgcn_cvt_pk_fp8_f32(v0[2], v0[3], w0, true);
                                int w1 = __builtin_amdgcn_cvt_pk_fp8_f32(v1[0], v1[1], 0, false); w1 = __builtin_amdgcn_cvt_pk_fp8_f32(v1[2], v1[3], w1, true);
                                u32x2 w; w.x = (unsigned)w0; w.y = (unsigned)w1;
                                *(u32x2*)(r1 + R_KS + (size_t)bg * S * 64 + (size_t)(s >> 6) * 4096 + ((s >> 4) & 3) * 1024 + (((d >> 3) & 3) * 16 + (s & 15)) * 16 + (d >> 5) * 8) = w;
                            } else {
                                const int kb = s & 63, kp = kb >> 5, k32 = kb & 31, fqv = (k32 >> 2) & 3, jj = ((k32 >> 4) << 2) | (k32 & 3);
                                unsigned char* dst = r1 + R_VST + (size_t)bg * S * 64 + (size_t)(s >> 6) * 4096 + (d >> 4) * 1024 + (fqv * 16 + (d & 15)) * 16 + kp * 8 + jj;
                                const int w0 = __builtin_amdgcn_cvt_pk_fp8_f32(v0[0], v0[1], 0, false), w1 = __builtin_amdgcn_cvt_pk_fp8_f32(v0[2], v0[3], 0, false);
                                const int w2 = __builtin_amdgcn_cvt_pk_fp8_f32(v1[0], v1[1], 0, false), w3 = __builtin_amdgcn_cvt_pk_fp8_f32(v1[2], v1[3], 0, false);
                                dst[0] = (unsigned char)(w0 & 0xff); dst[16] = (unsigned char)((w0 >> 8) & 0xff); dst[32] = (unsigned char)(w1 & 0xff); dst[48] = (unsigned char)((w1 >> 8) & 0xff);
                                dst[64] = (unsigned char)(w2 & 0xff); dst[80] = (unsigned char)((w2 >> 8) & 0xff); dst[96] = (unsigned char)(w3 & 0xff); dst[112] = (unsigned char)((w3 >> 8) & 0xff);
                            }
                        } else if (bj == 0) {
                            bf16_t* base = (bf16_t*)(r1 + R_KW);
                            u32x4 w; w.x = cvt_pk_bf16(v0[0], v0[1]); w.y = cvt_pk_bf16(v0[2], v0[3]); w.z = cvt_pk_bf16(v1[0], v1[1]); w.w = cvt_pk_bf16(v1[2], v1[3]);
                            *(u32x4*)(base + (size_t)bg * S * 64 + (size_t)(s >> 5) * 2048 + (d >> 4) * 512 + ((d >> 3) & 1) * 256 + (s & 31) * 8) = w;
                        } else {
                            const int kk = s & 31;
                            bf16_t* dst = (bf16_t*)(r1 + R_VWT) + (size_t)bg * S * 64 + (size_t)(s >> 5) * 2048 + (d >> 5) * 1024 + (kk >> 4) * 512 + ((kk >> 2) & 1) * 256 + (d & 31) * 8 + ((kk >> 3) & 1) * 4 + (kk & 3);
                            const unsigned w0 = cvt_pk_bf16(v0[0], v0[1]), w1 = cvt_pk_bf16(v0[2], v0[3]), w2 = cvt_pk_bf16(v1[0], v1[1]), w3 = cvt_pk_bf16(v1[2], v1[3]);
                            dst[0] = (bf16_t)(w0 & 0xffff); dst[8] = (bf16_t)(w0 >> 16); dst[16] = (bf16_t)(w1 & 0xffff); dst[24] = (bf16_t)(w1 >> 16);
                            dst[32] = (bf16_t)(w2 & 0xffff); dst[40] = (bf16_t)(w2 >> 16); dst[48] = (bf16_t)(w3 & 0xffff); dst[56] = (bf16_t)(w3 >> 16);
                        }
                    } else if (pn < 9) {
                        bf16_t* base = (bf16_t*)(r1 + ((pn < 7) ? R_ZU : R_ZV)); const int ct = (pn < 7) ? (pn - 5) : (pn - 7);
                        u32x4 w;
                        w.x = cvt_pk_bf16(gelu_tanh(v0[0]), gelu_tanh(v0[1])); w.y = cvt_pk_bf16(gelu_tanh(v0[2]), gelu_tanh(v0[3]));
                        w.z = cvt_pk_bf16(gelu_tanh(v1[0]), gelu_tanh(v1[1])); w.w = cvt_pk_bf16(gelu_tanh(v1[2]), gelu_tanh(v1[3]));
                        *(u32x4*)(base + (size_t)row * 512 + ct * 256 + cw) = w;
                    } else {
                        if (bj == 0 && wc == 0 && fq < 3) {
                            float* gp = (float*)(r1 + R_GATES) + (size_t)row * 24 + 8 * fq;
                            *(f32x4*)gp = (f32x4){sigmoid_f(v0[0]), sigmoid_f(v0[1]), sigmoid_f(v0[2]), sigmoid_f(v0[3])};
                            *(f32x4*)(gp + 4) = (f32x4){sigmoid_f(v1[0]), sigmoid_f(v1[1]), sigmoid_f(v1[2]), sigmoid_f(v1[3])};
                        }
                    }
                }
            }
    }
};

struct EpiNormRes {
    static constexpr bool PERM = true, FUSED = true;
    unsigned char* ws; const float* gpost; float* fout; int inst;
    __device__ __forceinline__ void exchange(int e, float (&sv)[2][4], float (&rv)[2][4], const Unit& u, int wr, int wc, int fr, int fq, LAS unsigned char* lds, int wid, int lane) const {
        LAS float* P = (LAS float*)(lds + 131072);
        LAS float* Sx = P + 1024;
        float* xbuf = (float*)(ws + WS_XBUF) + (size_t)e * MT * 4;
        unsigned* cnt = (unsigned*)(ws + WS_XCNT) + ((size_t)(e * 8 + inst) * 128 + u.pm) * 16;
#pragma unroll
        for (int ai = 0; ai < 2; ++ai)
#pragma unroll
            for (int m = 0; m < 4; ++m) {
                float v = sv[ai][m];
                { auto t1 = __builtin_amdgcn_permlane16_swap(__float_as_uint(v), __float_as_uint(v), false, false); v = __uint_as_float(t1[0]) + __uint_as_float(t1[1]); }
                v = xhalf_sum(v);
                if (fq == 0) P[(ai * HALF + wr * 64 + m * 16 + fr) * 4 + wc] = v;
            }
        asm volatile("s_waitcnt lgkmcnt(0)" ::: "memory"); __builtin_amdgcn_s_barrier(); asm volatile("" ::: "memory");
        const int tid = wid * 64 + lane;
        if (tid < 256) {
            const f32x4 pp = *(const LAS f32x4*)(P + tid * 4);
            __hip_atomic_store(xbuf + ((size_t)u.pm * 256 + tid) * 4 + u.pn, (pp[0] + pp[1]) + (pp[2] + pp[3]), __ATOMIC_RELAXED, __HIP_MEMORY_SCOPE_AGENT);
        }
        asm volatile("s_waitcnt vmcnt(0)" ::: "memory");
        if (wid < 4 && lane == 0) __hip_atomic_fetch_add(cnt, 1u, __ATOMIC_RELAXED, __HIP_MEMORY_SCOPE_AGENT);
        if (wid == 0) {
            unsigned sp = 0;
            while ((unsigned)__builtin_amdgcn_readfirstlane(__hip_atomic_load(cnt, __ATOMIC_RELAXED, __HIP_MEMORY_SCOPE_AGENT)) < 16u) { __builtin_amdgcn_s_sleep(2); if (++sp > (1u << 22)) break; }
            __builtin_amdgcn_fence(__ATOMIC_ACQUIRE, "agent");
        }
        asm volatile("s_waitcnt vmcnt(0) lgkmcnt(0)" ::: "memory"); __builtin_amdgcn_s_barrier(); asm volatile("" ::: "memory");
        if (tid < 256) {
            const float* sl = xbuf + ((size_t)u.pm * 256 + tid) * 4;
            const float t0 = __hip_atomic_load(sl + 0, __ATOMIC_RELAXED, __HIP_MEMORY_SCOPE_AGENT), t1 = __hip_atomic_load(sl + 1, __ATOMIC_RELAXED, __HIP_MEMORY_SCOPE_AGENT);
            const float t2 = __hip_atomic_load(sl + 2, __ATOMIC_RELAXED, __HIP_MEMORY_SCOPE_AGENT), t3 = __hip_atomic_load(sl + 3, __ATOMIC_RELAXED, __HIP_MEMORY_SCOPE_AGENT);
            Sx[tid] = 1.0f / sqrtf(((t0 + t1) + (t2 + t3)) * (1.0f / 1024.0f) + RMS_EPS);
        }
        asm volatile("s_waitcnt vmcnt(0) lgkmcnt(0)" ::: "memory"); __builtin_amdgcn_s_barrier(); asm volatile("" ::: "memory");
#pragma unroll
        for (int ai = 0; ai < 2; ++ai)
#pragma unroll
            for (int m = 0; m < 4; ++m) rv[ai][m] = Sx[ai * HALF + wr * 64 + m * 16 + fr];
    }
    __device__ __forceinline__ void fused(f32x4 (&acc)[2][2][4][2], const Unit& u, int wr, int wc, int fr, int fq, LAS unsigned char* lds, int wid, int lane) const {
        bf16_t* hb = (bf16_t*)(ws + WS_HB);
        const int row0 = u.pm * BM + wr * 64 + fr, col0 = u.pn * BM + wc * 32 + 8 * fq;
        float sv[2][4], rv[2][4];
#pragma unroll
        for (int ai = 0; ai < 2; ++ai)
#pragma unroll
            for (int m = 0; m < 4; ++m) {
                float q = 0.f;
#pragma unroll
                for (int bj = 0; bj < 2; ++bj)
#pragma unroll
                    for (int n = 0; n < 2; ++n) { const f32x4 x = acc[ai][bj][m][n]; q += (x[0] * x[0] + x[1] * x[1]) + (x[2] * x[2] + x[3] * x[3]); }
                sv[ai][m] = q;
            }
        exchange(0, sv, rv, u, wr, wc, fr, fq, lds, wid, lane);
        float dep = 0.f;
#pragma unroll
        for (int ai = 0; ai < 2; ++ai)
#pragma unroll
            for (int m = 0; m < 4; ++m) {
                const bf16_t* hrow = hb + (size_t)(row0 + ai * HALF + m * 16) * DM + col0;
                asm volatile("" : "+v"(hrow) : "v"(dep));
                const float r1 = rv[ai][m];
                float q = 0.f;
#pragma unroll
                for (int bj = 0; bj < 2; ++bj) {
                    const u32x4 hv = *(const u32x4*)(hrow + bj * HALF);
                    const f32x4 h0 = (f32x4){__uint_as_float(hv.x << 16), __uint_as_float(hv.x & 0xffff0000u), __uint_as_float(hv.y << 16), __uint_as_float(hv.y & 0xffff0000u)};
                    const f32x4 h1 = (f32x4){__uint_as_float(hv.z << 16), __uint_as_float(hv.z & 0xffff0000u), __uint_as_float(hv.w << 16), __uint_as_float(hv.w & 0xffff0000u)};
                    const f32x4 gg0 = *(const f32x4*)(gpost + col0 + bj * HALF), gg1 = *(const f32x4*)(gpost + col0 + bj * HALF + 4);
                    f32x4 x0 = h0 + acc[ai][bj][m][0] * r1 * gg0, x1 = h1 + acc[ai][bj][m][1] * r1 * gg1;
                    acc[ai][bj][m][0] = x0; acc[ai][bj][m][1] = x1;
                    q += ((x0[0] * x0[0] + x0[1] * x0[1]) + (x0[2] * x0[2] + x0[3] * x0[3])) + ((x1[0] * x1[0] + x1[1] * x1[1]) + (x1[2] * x1[2] + x1[3] * x1[3]));
                }
                sv[ai][m] = q;
                dep = q;
            }
        if (fout) {
#pragma unroll
            for (int ai = 0; ai < 2; ++ai)
#pragma unroll
                for (int m = 0; m < 4; ++m) { float* orow = fout + (size_t)(row0 + ai * HALF + m * 16) * DM + col0;
#pragma unroll
                    for (int bj = 0; bj < 2; ++bj) { *(f32x4*)(orow + bj * HALF) = acc[ai][bj][m][0]; *(f32x4*)(orow + bj * HALF + 4) = acc[ai][bj][m][1]; } }
            return;
        }
        exchange(1, sv, rv, u, wr, wc, fr, fq, lds, wid, lane);
        float* rs = (float*)(ws + WS_RS);
#pragma unroll
        for (int ai = 0; ai < 2; ++ai)
#pragma unroll
            for (int m = 0; m < 4; ++m) {
                bf16_t* hrow = hb + (size_t)(row0 + ai * HALF + m * 16) * DM + col0;
#pragma unroll
                for (int bj = 0; bj < 2; ++bj) { const f32x4 x0 = acc[ai][bj][m][0], x1 = acc[ai][bj][m][1];
                    u32x4 w; w.x = cvt_pk_bf16(x0[0], x0[1]); w.y = cvt_pk_bf16(x0[2], x0[3]); w.z = cvt_pk_bf16(x1[0], x1[1]); w.w = cvt_pk_bf16(x1[2], x1[3]);
                    *(u32x4*)(hrow + bj * HALF) = w; }
                if (u.pn == 0 && wc == 0 && fq == 0) rs[row0 + ai * HALF + m * 16] = rv[ai][m];
            }
    }
};

template <class Epi>
__device__ __forceinline__ void gemm_phase(LAS unsigned char* lds, const Gemm g, const StaticOrder& S, const Epi& E) {
    int tid = threadIdx.x; LAUNDER(tid);
    const int wid = __builtin_amdgcn_readfirstlane(tid >> 6), lane = tid & 63, wr = wid >> 2, wc = wid & 3, fr = lane & 15, fq = lane >> 4;
    const int K = g.K, nt = K / BK, lda = g.lda;
    unsigned voffA[2], voffB[2];
#pragma unroll
    for (int i = 0; i < 2; ++i) { int R, C; stage_rc(tid * 16 + i * 8192, R, C); const int Rb = Epi::PERM ? ((R & ~31) + perm32(R & 31)) : R;
        voffA[i] = (unsigned)(R * lda + C) * 2u; voffB[i] = (unsigned)(Rb * K + C) * 2u; }
    const size_t kstep = (size_t)(BK * 2);
    const size_t hA = (size_t)HALF * lda * 2, hB = (size_t)HALF * K * 2;
    const size_t tA = 2 * hA, tB = 2 * hB;
    const unsigned ldsw = (unsigned)wid * 1024u;
    const int aoff = lds_byte(wr * 64 + fr, fq * 8), boff = lds_byte(wc * 32 + fr, fq * 8);
#define PG8_SA(b, h) (((b) * 2 + (h)) * HTB)
#define PG8_SB(b, h) ((4 + (b) * 2 + (h)) * HTB)
#define PG8_STAGE(bufoff, gbase, voff) do { _Pragma("unroll") for (int _i = 0; _i < 2; ++_i) \
        __builtin_amdgcn_global_load_lds((const unsigned*)((const char*)(gbase) + (voff)[_i]), (LAS unsigned*)(lds + (bufoff) + ldsw + _i * 8192), 16, 0, 0); } while (0)
#define PG8_LDA(dst, b, h) do { _Pragma("unroll") for (int m = 0; m < 4; ++m) _Pragma("unroll") for (int k = 0; k < 2; ++k) dst[m][k] = *(const LAS bf16x8*)(lds + PG8_SA(b, h) + aoff + m * 2048 + k * 1024); } while (0)
#define PG8_LDB(dst, b, h) do { _Pragma("unroll") for (int n = 0; n < 2; ++n) _Pragma("unroll") for (int k = 0; k < 2; ++k) dst[n][k] = *(const LAS bf16x8*)(lds + PG8_SB(b, h) + boff + n * 2048 + k * 1024); } while (0)
#define PG8_MMA(ai, bj, At, Bt) do { __builtin_amdgcn_s_setprio(1); _Pragma("unroll") for (int m = 0; m < 4; ++m) _Pragma("unroll") for (int n = 0; n < 2; ++n) _Pragma("unroll") for (int k = 0; k < 2; ++k) \
        acc[ai][bj][m][n] = __builtin_amdgcn_mfma_f32_16x16x32_bf16(Bt[n][k], At[m][k], acc[ai][bj][m][n], 0, 0, 0); __builtin_amdgcn_s_setprio(0); } while (0)
#define PG8_WAIT_V(n) asm volatile("s_waitcnt vmcnt(" #n ")" ::: "memory")
#define PG8_WAIT_L(n) asm volatile("s_waitcnt lgkmcnt(" #n ")" ::: "memory")
#define PG8_BAR __builtin_amdgcn_s_barrier()
#define PG8_SCHED __builtin_amdgcn_sched_barrier(0)
    Unit cur, nxt; int ui = 0;
    if (!S.next(0, cur)) return;
    f32x4 acc[2][2][4][2];
#pragma unroll
    for (int a = 0; a < 2; ++a)
#pragma unroll
        for (int b = 0; b < 2; ++b)
#pragma unroll
            for (int m = 0; m < 4; ++m)
#pragma unroll
                for (int n = 0; n < 2; ++n) acc[a][b][m][n] = (f32x4){0.f, 0.f, 0.f, 0.f};
    bf16x8 At[4][2], B0[2][2], B1[2][2];
    const char* cA = (const char*)g.A + (size_t)cur.pm * tA; const char* cB = (const char*)g.Bt + (size_t)cur.pn * tB;
    PG8_STAGE(PG8_SB(0, 0), cB, voffB); PG8_STAGE(PG8_SB(0, 1), cB + hB, voffB); PG8_STAGE(PG8_SA(0, 0), cA, voffA); PG8_STAGE(PG8_SA(0, 1), cA + hA, voffA);
    if (wr == 1) PG8_BAR;
    PG8_WAIT_V(2); PG8_BAR;
    PG8_STAGE(PG8_SB(1, 0), cB + kstep, voffB); PG8_STAGE(PG8_SA(1, 0), cA + kstep, voffA); PG8_STAGE(PG8_SB(1, 1), cB + hB + kstep, voffB);
    PG8_WAIT_V(6); PG8_BAR;
    for (;;) {
        const bool has_next = S.next(ui + 1, nxt);
        const char* nA = has_next ? (const char*)g.A + (size_t)nxt.pm * tA : cA; const char* nB = has_next ? (const char*)g.Bt + (size_t)nxt.pn * tB : cB;
        for (int t = 0; t < nt; t += 2) {
            const bool last = (t == nt - 2);
            const char* a1 = cA + (size_t)(t + 1) * kstep;
            const char* a2 = last ? nA : cA + (size_t)(t + 2) * kstep; const char* b2 = last ? nB : cB + (size_t)(t + 2) * kstep;
            const char* a3 = a2 + kstep; const char* b3 = b2 + kstep;
            PG8_LDB(B0, 0, 0); PG8_LDB(B1, 0, 1); PG8_SCHED; PG8_LDA(At, 0, 0); PG8_STAGE(PG8_SA(1, 1), a1 + hA, voffA);
            PG8_WAIT_V(8); PG8_WAIT_L(0); PG8_BAR; PG8_MMA(0, 0, At, B0); PG8_MMA(0, 1, At, B1); PG8_BAR; PG8_SCHED;
            PG8_LDA(At, 0, 1); PG8_STAGE(PG8_SB(0, 0), b2, voffB); PG8_STAGE(PG8_SB(0, 1), b2 + hB, voffB); PG8_STAGE(PG8_SA(0, 0), a2, voffA);
            PG8_WAIT_V(8); PG8_WAIT_L(0); PG8_BAR; PG8_MMA(1, 0, At, B0); PG8_MMA(1, 1, At, B1); PG8_BAR; PG8_SCHED;
            PG8_LDB(B0, 1, 0); PG8_LDB(B1, 1, 1); PG8_SCHED; PG8_LDA(At, 1, 0); PG8_STAGE(PG8_SA(0, 1), a2 + hA, voffA);
            PG8_WAIT_V(8); PG8_WAIT_L(0); PG8_BAR; PG8_MMA(0, 0, At, B0); PG8_MMA(0, 1, At, B1); PG8_BAR; PG8_SCHED;
            PG8_LDA(At, 1, 1); PG8_STAGE(PG8_SB(1, 0), b3, voffB); PG8_STAGE(PG8_SB(1, 1), b3 + hB, voffB); PG8_STAGE(PG8_SA(1, 0), a3, voffA);
            PG8_WAIT_V(8); PG8_WAIT_L(0); PG8_BAR; PG8_MMA(1, 0, At, B0); PG8_MMA(1, 1, At, B1); PG8_BAR; PG8_SCHED;
        }
        if (wr == 0) PG8_BAR;
        if constexpr (Epi::FUSED) E.fused(acc, cur, wr, wc, fr, fq, lds, wid, lane); else E(acc, cur, wr, wc, fr, fq);
        if (!has_next) break;
#pragma unroll
        for (int a = 0; a < 2; ++a)
#pragma unroll
            for (int b = 0; b < 2; ++b)
#pragma unroll
                for (int m = 0; m < 4; ++m)
#pragma unroll
                    for (int n = 0; n < 2; ++n) acc[a][b][m][n] = (f32x4){0.f, 0.f, 0.f, 0.f};
        cur = nxt; cA = nA; cB = nB; ++ui;
        if (wr == 1) PG8_BAR;
    }
    PG8_WAIT_V(0);
    PG8_BAR;
#undef PG8_SA
#undef PG8_SB
#undef PG8_STAGE
#undef PG8_LDA
#undef PG8_LDB
#undef PG8_MMA
#undef PG8_WAIT_V
#undef PG8_WAIT_L
#undef PG8_BAR
#undef PG8_SCHED
}
}

template <int MAP> __device__ __forceinline__ int src_col(int n) {
    if (MAP == 0) return n;
    if (MAP == 1) { if (n < 1280) return n; if (n < 2304) return n + 24; if (n < 2328) return n - 1024; return -1; }
    const int t = n >> 8, w = n & 255; return (w < 128) ? (128 * t + w) : (DFF + 128 * t + (w - 128));
}
constexpr int TP = 65;
template <int MAP> __device__ __forceinline__ void transpose_item(const float* W, int K, int Nsrc, bf16_t* WT, int nblk, int item, LAS float* scr, int lane, const float* gain = nullptr) {
    const int kb = item / nblk, nb = item % nblk, k0 = 64 * kb, n0 = 64 * nb;
    const int nl = 4 * (lane & 15), kr = lane >> 4;
    const int ns = src_col<MAP>(n0 + nl);
    f32x4 v[16];
#pragma unroll
    for (int i = 0; i < 16; ++i) v[i] = (ns >= 0) ? *(const f32x4*)(W + (size_t)(k0 + kr + 4 * i) * Nsrc + ns) : (f32x4){0.f, 0.f, 0.f, 0.f};
    if (gain) {
#pragma unroll
        for (int i = 0; i < 16; ++i) v[i] = v[i] * gain[k0 + kr + 4 * i];
    }
#pragma unroll
    for (int i = 0; i < 16; ++i) { LAS float* d = scr + (kr + 4 * i) * TP + nl; d[0] = v[i][0]; d[1] = v[i][1]; d[2] = v[i][2]; d[3] = v[i][3]; }
    asm volatile("s_waitcnt lgkmcnt(0)" ::: "memory");
    __builtin_amdgcn_wave_barrier();
    const int c = lane & 7;
#pragma unroll
    for (int j = 0; j < 8; ++j) { const int n = (lane >> 3) + 8 * j; const LAS float* s = scr + (8 * c) * TP + n;
        u32x4 o; o.x = cvt_pk_bf16(s[0 * TP], s[1 * TP]); o.y = cvt_pk_bf16(s[2 * TP], s[3 * TP]); o.z = cvt_pk_bf16(s[4 * TP], s[5 * TP]); o.w = cvt_pk_bf16(s[6 * TP], s[7 * TP]);
        *(u32x4*)(WT + (size_t)(n0 + n) * K + k0 + 8 * c) = o; }
    asm volatile("s_waitcnt lgkmcnt(0)" ::: "memory");
    __builtin_amdgcn_wave_barrier();
}

__device__ __forceinline__ void row_pass(const float* x0, bf16_t* hb, const bf16_t* mix, const float* gpost, float* rs, float* fout, int gw, int NGW, int lane) {
    LAUNDER(lane);
    if (x0) {
        for (int m = gw; m < MT; m += NGW) {
            const f32x4* hr = (const f32x4*)(x0 + (size_t)m * DM) + lane;
            f32x4 h[4]; float s2 = 0.f;
#pragma unroll
            for (int j = 0; j < 4; ++j) { h[j] = hr[64 * j]; s2 += (h[j][0] * h[j][0] + h[j][1] * h[j][1]) + (h[j][2] * h[j][2] + h[j][3] * h[j][3]); }
            const float r2 = 1.0f / sqrtf(wave_sum_fast(s2) * (1.0f / DM) + RMS_EPS);
            u32x2* ao = (u32x2*)(hb + (size_t)m * DM) + lane;
#pragma unroll
            for (int j = 0; j < 4; ++j) { u32x2 w; w.x = cvt_pk_bf16(h[j][0], h[j][1]); w.y = cvt_pk_bf16(h[j][2], h[j][3]); ao[64 * j] = w; }
            if (lane == 0) rs[m] = r2;
        }
        return;
    }
    u32x2 hn[4], mn[4];
    if (gw < MT) {
        const u32x2* hr = (const u32x2*)(hb + (size_t)gw * DM) + lane; const u32x2* mr = (const u32x2*)(mix + (size_t)gw * DM) + lane;
#pragma unroll
        for (int j = 0; j < 4; ++j) { hn[j] = hr[64 * j]; mn[j] = mr[64 * j]; }
    }
    for (int m = gw; m < MT; m += NGW) {
        u32x2 hv[4], mv[4];
#pragma unroll
        for (int j = 0; j < 4; ++j) { hv[j] = hn[j]; mv[j] = mn[j]; }
        const int m2 = m + NGW;
        if (m2 < MT) {
            const u32x2* hr = (const u32x2*)(hb + (size_t)m2 * DM) + lane; const u32x2* mr = (const u32x2*)(mix + (size_t)m2 * DM) + lane;
#pragma unroll
            for (int j = 0; j < 4; ++j) { hn[j] = hr[64 * j]; mn[j] = mr[64 * j]; }
        }
        f32x4 h[4], x[4]; float ss = 0.f;
#pragma unroll
        for (int j = 0; j < 4; ++j) {
            h[j] = (f32x4){__uint_as_float(hv[j].x << 16), __uint_as_float(hv[j].x & 0xffff0000u), __uint_as_float(hv[j].y << 16), __uint_as_float(hv[j].y & 0xffff0000u)};
            x[j] = (f32x4){__uint_as_float(mv[j].x << 16), __uint_as_float(mv[j].x & 0xffff0000u), __uint_as_float(mv[j].y << 16), __uint_as_float(mv[j].y & 0xffff0000u)};
            ss += (x[j][0] * x[j][0] + x[j][1] * x[j][1]) + (x[j][2] * x[j][2] + x[j][3] * x[j][3]);
        }
        const float r1 = 1.0f / sqrtf(wave_sum_fast(ss) * (1.0f / DM) + RMS_EPS);
        float s2 = 0.f;
#pragma unroll
        for (int j = 0; j < 4; ++j) { const f32x4 gp = *((const f32x4*)gpost + lane + 64 * j); h[j] = h[j] + x[j] * r1 * gp; s2 += (h[j][0] * h[j][0] + h[j][1] * h[j][1]) + (h[j][2] * h[j][2] + h[j][3] * h[j][3]); }
        if (fout) {
            f32x4* ho = (f32x4*)(fout + (size_t)m * DM) + lane;
#pragma unroll
            for (int j = 0; j < 4; ++j) ho[64 * j] = h[j];
        } else {
            const float r2 = 1.0f / sqrtf(wave_sum_fast(s2) * (1.0f / DM) + RMS_EPS);
            u32x2* ao = (u32x2*)(hb + (size_t)m * DM) + lane;
#pragma unroll
            for (int j = 0; j < 4; ++j) { u32x2 w; w.x = cvt_pk_bf16(h[j][0], h[j][1]); w.y = cvt_pk_bf16(h[j][2], h[j][3]); ao[64 * j] = w; }
            if (lane == 0) rs[m] = r2;
        }
    }
}

constexpr int ZPITCH = 136;
__device__ __forceinline__ void gmlp_unit(const Params& p, int layer, int chunk, LAS unsigned char* lds, int wave, int lane) {
    LAUNDER(lane);
    const unsigned char* ws = P_ws(p);
    const bf16_t* zu = (const bf16_t*)(ws + WS_R1 + R_ZU); const bf16_t* zv = (const bf16_t*)(ws + WS_R1 + R_ZV);
    bf16_t* mixed = (bf16_t*)(ws + WS_AN);
    const float* ln_g = P_in(p, 13) + layer * 512; const float* ln_b = P_in(p, 14) + layer * 512;
    const float* w_s = P_in(p, 15) + (size_t)layer * 8 * 128 * 128 + (size_t)wave * 128 * 128;
    const float* b_s = P_in(p, 16) + layer * 8 * 128 + wave * 128;
    LAS float* stats = (LAS float*)(lds + 8 * 64 * ZPITCH * 2);
    LAS bf16_t* zt = (LAS bf16_t*)(lds + wave * 64 * ZPITCH * 2);
    const int tok0 = chunk * 128;
    __syncthreads();
    {
        bf16x8 sv[16];
#pragma unroll
        for (int i = 0; i < 16; ++i) sv[i] = *(const bf16x8*)(zv + (size_t)(tok0 + wave * 16 + i) * 512 + lane * 8);
        asm volatile("" ::: "memory");
        float mn[16], rs16[16];
#pragma unroll
        for (int i = 0; i < 16; ++i) {
            float s = 0.f, s2 = 0.f;
#pragma unroll
            for (int e = 0; e < 8; ++e) { const float x = bf2f((bf16_t)sv[i][e]); s += x; s2 += x * x; }
            s = wave_sum_fast(s); s2 = wave_sum_fast(s2);
            const float mean = s * (1.0f / 512.0f); const float var = fmaxf(s2 * (1.0f / 512.0f) - mean * mean, 0.f);
            mn[i] = mean; rs16[i] = 1.0f / sqrtf(var + LN_EPS);
        }
        if (lane == 0) {
#pragma unroll
            for (int i = 0; i < 16; ++i) { stats[2 * (wave * 16 + i)] = mn[i]; stats[2 * (wave * 16 + i) + 1] = rs16[i]; }
        }
    }
    __syncthreads();
    {
        const int dc = lane & 7, d0 = dc * 8;
        const f32x4 g0 = *(const f32x4*)(ln_g + wave * 64 + d0), g1 = *(const f32x4*)(ln_g + wave * 64 + d0 + 4);
        const f32x4 b0 = *(const f32x4*)(ln_b + wave * 64 + d0), b1 = *(const f32x4*)(ln_b + wave * 64 + d0 + 4);
        bf16x8 zq[16];
#pragma unroll
        for (int i = 0; i < 16; ++i) zq[i] = *(const bf16x8*)(zv + (size_t)(tok0 + (lane >> 3) + 8 * i) * 512 + wave * 64 + d0);
#pragma unroll
        for (int i = 0; i < 16; ++i) {
            const int s = (lane >> 3) + 8 * i;
            const float mean = stats[2 * s], rstd = stats[2 * s + 1];
#pragma unroll
            for (int e = 0; e < 8; ++e) {
                const float gg = (e < 4) ? g0[e & 3] : g1[e & 3], bb = (e < 4) ? b0[e & 3] : b1[e & 3];
                const float y = (bf2f((bf16_t)zq[i][e]) - mean) * rstd * gg + bb;
                zt[(d0 + e) * ZPITCH + s] = (bf16_t)(cvt_pk_bf16(y, 0.f) & 0xffff);
            }
        }
    }
    asm volatile("s_waitcnt lgkmcnt(0)" ::: "memory");
    __builtin_amdgcn_wave_barrier();
    const int r = lane & 31, h = lane >> 5;
#pragma unroll
    for (int mt = 0; mt < 4; ++mt) {
        f32x16 acc0, acc1;
#pragma unroll
        for (int i = 0; i < 16; ++i) { acc0[i] = 0.f; acc1[i] = 0.f; }
        const int t = 32 * mt + r;
        const size_t rowoff = (size_t)(tok0 + t) * 512 + wave * 64;
        f32x4 wq[8][2]; u32x2 zz[2][4];
#pragma unroll
        for (int ks = 0; ks < 2 * (mt + 1); ++ks) { wq[ks][0] = *(const f32x4*)(w_s + (size_t)t * 128 + 16 * ks + 8 * h); wq[ks][1] = *(const f32x4*)(w_s + (size_t)t * 128 + 16 * ks + 8 * h + 4); }
#pragma unroll
        for (int dt = 0; dt < 2; ++dt)
#pragma unroll
            for (int i4 = 0; i4 < 4; ++i4) zz[dt][i4] = *(const u32x2*)(zu + rowoff + 32 * dt + 8 * i4 + 4 * h);
        const float bs = b_s[t];
#pragma unroll
        for (int ks = 0; ks < 2 * (mt + 1); ++ks) {
            const int s0 = 16 * ks + 8 * h;
            const f32x4 w0 = wq[ks][0], w1 = wq[ks][1];
            float wv[8] = {w0[0], w0[1], w0[2], w0[3], w1[0], w1[1], w1[2], w1[3]};
#pragma unroll
            for (int e = 0; e < 8; ++e) wv[e] = (s0 + e <= t) ? wv[e] : 0.f;
            u32x4 wb; wb.x = cvt_pk_bf16(wv[0], wv[1]); wb.y = cvt_pk_bf16(wv[2], wv[3]); wb.z = cvt_pk_bf16(wv[4], wv[5]); wb.w = cvt_pk_bf16(wv[6], wv[7]);
            const bf16x8 bfrag = __builtin_bit_cast(bf16x8, wb);
            const bf16x8 a0 = *(const LAS bf16x8*)(zt + (r) * ZPITCH + s0);
            const bf16x8 a1 = *(const LAS bf16x8*)(zt + (32 + r) * ZPITCH + s0);
            acc0 = MFMA32(a0, bfrag, acc0);
            acc1 = MFMA32(a1, bfrag, acc1);
        }
        bf16_t* mrow = mixed + (size_t)(tok0 + t) * 1024 + 512 + wave * 64;
#pragma unroll
        for (int dt = 0; dt < 2; ++dt)
#pragma unroll
            for (int i4 = 0; i4 < 4; ++i4) {
                const int d = 32 * dt + 8 * i4 + 4 * h;
                const u32x2 zv2 = zz[dt][i4];
                const float z0 = __uint_as_float(zv2.x << 16), z1 = __uint_as_float(zv2.x & 0xffff0000u), z2 = __uint_as_float(zv2.y << 16), z3 = __uint_as_float(zv2.y & 0xffff0000u);
                const f32x16& a = dt ? acc1 : acc0;
                u32x2 o; o.x = cvt_pk_bf16(z0 * (a[4 * i4] + bs), z1 * (a[4 * i4 + 1] + bs)); o.y = cvt_pk_bf16(z2 * (a[4 * i4 + 2] + bs), z3 * (a[4 * i4 + 3] + bs));
                *(u32x2*)(mrow + d) = o;
            }
    }
}

__device__ __forceinline__ void cmp_gemm2(const bf16_t* hidden, const bf16_t* w2t, bf16_t* kcmp, bf16_t* vcmpT, int kv, int row0, int lane) {
    LAUNDER(lane);
    const int r = lane & 31, h = lane >> 5;
    f32x16 acc[2];
#pragma unroll
    for (int i = 0; i < 16; ++i) { acc[0][i] = 0.f; acc[1][i] = 0.f; }
#pragma unroll
    for (int ks = 0; ks < 16; ++ks) {
        const bf16x8 hf = *(const bf16x8*)(hidden + (size_t)(row0 + r) * 256 + ks * 16 + h * 8);
#pragma unroll
        for (int dt = 0; dt < 2; ++dt) {
            const bf16x8 wf = *(const bf16x8*)(w2t + (size_t)(dt * 32 + r) * 256 + ks * 16 + h * 8);
            if (kv == 0) acc[dt] = MFMA32(wf, hf, acc[dt]);
            else         acc[dt] = MFMA32(hf, wf, acc[dt]);
        }
    }
#pragma unroll
    for (int dt = 0; dt < 2; ++dt)
#pragma unroll
        for (int i4 = 0; i4 < 4; ++i4) {
            u32x2 o; o.x = cvt_pk_bf16(acc[dt][4 * i4], acc[dt][4 * i4 + 1]); o.y = cvt_pk_bf16(acc[dt][4 * i4 + 2], acc[dt][4 * i4 + 3]);
            if (kv == 0) *(u32x2*)(kcmp + (size_t)(row0 >> 5) * 2048 + (dt * 2 + (i4 >> 1)) * 512 + (i4 & 1) * 256 + r * 8 + 4 * h) = o;
            else         *(u32x2*)(vcmpT + (size_t)(row0 >> 5) * 2048 + dt * 1024 + (i4 >> 1) * 512 + h * 256 + r * 8 + (i4 & 1) * 4) = o;
        }
}

constexpr int NSA_WAVE_LDS = 19456;
constexpr float NEG_INF = -__builtin_inff();

__device__ __forceinline__ void load_k(bf16x8 (&kf)[4], const bf16_t* Kt, int lane) {
    const int r = lane & 31, h = lane >> 5;
#pragma unroll
    for (int ks = 0; ks < 4; ++ks) kf[ks] = *(const bf16x8*)(Kt + ks * 512 + lane * 8);
}
__device__ __forceinline__ void load_v(bf16x8 (&vf)[2][2], const bf16_t* vT, int lane) {
    const int r = lane & 31, h = lane >> 5;
#pragma unroll
    for (int dt = 0; dt < 2; ++dt)
#pragma unroll
        for (int s = 0; s < 2; ++s) vf[dt][s] = *(const bf16x8*)(vT + dt * 1024 + s * 512 + lane * 8);
}
__device__ __forceinline__ f32x16 qk_tile(const bf16x8 (&kf)[4], const bf16x8 (&qf)[4]) {
    f32x16 s;
#pragma unroll
    for (int i = 0; i < 16; ++i) s[i] = 0.f;
#pragma unroll
    for (int ks = 0; ks < 4; ++ks) s = MFMA32(kf[ks], qf[ks], s);
    return s;
}
template <int STRIDE> __device__ __forceinline__ void score_tile(f32x16& s, int dl, int dmax, bool lane_ok, bool fast, float lutfar, const LAS float* lutr) {
    if (fast) {
#pragma unroll
        for (int i = 0; i < 16; ++i) s[i] = lane_ok ? (s[i] + lutfar) : NEG_INF;
    } else {
#pragma unroll
        for (int i = 0; i < 16; ++i) {
            const int d = dl - STRIDE * ((i & 3) + 8 * (i >> 2));
            const bool ok = lane_ok && d >= 0 && d < dmax;
            const int di = min(max(d, 0), 128);
            s[i] = ok ? (s[i] + lutr[di]) : NEG_INF;
        }
    }
}
__device__ __forceinline__ void pv_tile(f32x16& o0, f32x16& o1, const f32x16& pr, const bf16x8 (&vf)[2][2]) {
#pragma unroll
    for (int s = 0; s < 2; ++s) {
        u32x4 pk; pk.x = cvt_pk_bf16(pr[8 * s], pr[8 * s + 1]); pk.y = cvt_pk_bf16(pr[8 * s + 2], pr[8 * s + 3]); pk.z = cvt_pk_bf16(pr[8 * s + 4], pr[8 * s + 5]); pk.w = cvt_pk_bf16(pr[8 * s + 6], pr[8 * s + 7]);
        const bf16x8 pb = __builtin_bit_cast(bf16x8, pk);
        o0 = MFMA32(vf[0][s], pb, o0);
        o1 = MFMA32(vf[1][s], pb, o1);
    }
}
template <bool FAST> __device__ __forceinline__ void online_step(f32x16& s, float bias, bool lane_ok, float& m, float& l, f32x16& o0, f32x16& o1, const bf16x8 (&vf)[2][2]) {
    float mx = fmaxf(fmaxf(fmaxf(s[0], s[1]), fmaxf(s[2], s[3])), fmaxf(fmaxf(s[4], s[5]), fmaxf(s[6], s[7])));
    mx = fmaxf(mx, fmaxf(fmaxf(fmaxf(s[8], s[9]), fmaxf(s[10], s[11])), fmaxf(fmaxf(s[12], s[13]), fmaxf(s[14], s[15]))));
    if (FAST) { mx += bias; mx = lane_ok ? mx : NEG_INF; }
    mx = xhalf_max(mx);
    if (__any(mx > m + 8.0f)) {
        const float mnew = (mx > m + 8.0f) ? mx : m;
        const float alpha = fast_exp2(m - mnew);
        l *= alpha; m = mnew;
#pragma unroll
        for (int i = 0; i < 16; ++i) { o0[i] *= alpha; o1[i] *= alpha; }
    }
    const float c = FAST ? (lane_ok ? (m - bias) : __builtin_inff()) : m;
    float ps = 0.f;
#pragma unroll
    for (int i = 0; i < 16; ++i) { s[i] = fast_exp2(s[i] - c); ps += s[i]; }
    ps = xhalf_sum(ps);
    l += ps;
    pv_tile(o0, o1, s, vf);
}

#define MFMA8(a, b, c) __builtin_amdgcn_mfma_f32_32x32x16_fp8_fp8((a), (b), (c), 0, 0, 0)
__device__ __forceinline__ void load_k8(long (&kf)[4], const unsigned char* Kt, int lane) {
#pragma unroll
    for (int ks = 0; ks < 4; ++ks) kf[ks] = *(const long*)(Kt + ks * 512 + lane * 8);
}
__device__ __forceinline__ void load_v8(long (&vf)[2][2], const unsigned char* vT, int lane) {
#pragma unroll
    for (int dt = 0; dt < 2; ++dt)
#pragma unroll
        for (int s = 0; s < 2; ++s) vf[dt][s] = *(const long*)(vT + dt * 1024 + s * 512 + lane * 8);
}
__device__ __forceinline__ long pack_fp8x8(float a0, float a1, float a2, float a3, float a4, float a5, float a6, float a7) {
    int w0 = __builtin_amdgcn_cvt_pk_fp8_f32(a0, a1, 0, false); w0 = __builtin_amdgcn_cvt_pk_fp8_f32(a2, a3, w0, true);
    int w1 = __builtin_amdgcn_cvt_pk_fp8_f32(a4, a5, 0, false); w1 = __builtin_amdgcn_cvt_pk_fp8_f32(a6, a7, w1, true);
    return (long)(((unsigned long long)(unsigned)w1 << 32) | (unsigned long long)(unsigned)w0);
}
template <bool FAST> __device__ __forceinline__ void online_step8(f32x16& s, float bias, bool lane_ok, float& m, float& l, f32x16& o0, f32x16& o1, const long (&vf)[2][2]) {
    float mx = fmaxf(fmaxf(fmaxf(s[0], s[1]), fmaxf(s[2], s[3])), fmaxf(fmaxf(s[4], s[5]), fmaxf(s[6], s[7])));
    mx = fmaxf(mx, fmaxf(fmaxf(fmaxf(s[8], s[9]), fmaxf(s[10], s[11])), fmaxf(fmaxf(s[12], s[13]), fmaxf(s[14], s[15]))));
    if (FAST) { mx = mx * QSCALE + bias; mx = lane_ok ? mx : NEG_INF; }
    mx = xhalf_max(mx);
    if (__any(mx > m + 2.0f)) {
        const float mnew = (mx > m + 2.0f) ? mx : m;
        const float alpha = fast_exp2(m - mnew);
        l *= alpha; m = mnew;
#pragma unroll
        for (int i = 0; i < 16; ++i) { o0[i] *= alpha; o1[i] *= alpha; }
    }
    float ps = 0.f;
    if (FAST) {
        const float c = lane_ok ? (m - bias - 6.0f) : __builtin_inff();
#pragma unroll
        for (int i = 0; i < 16; ++i) { s[i] = fast_exp2(__builtin_fmaf(s[i], QSCALE, -c)); ps += s[i]; }
    } else {
        const float c = m - 6.0f;
#pragma unroll
        for (int i = 0; i < 16; ++i) { s[i] = fast_exp2(s[i] - c); ps += s[i]; }
    }
    ps = xhalf_sum(ps);
    l += ps;
#pragma unroll
    for (int t = 0; t < 2; ++t) {
        const long pb = pack_fp8x8(s[8 * t], s[8 * t + 1], s[8 * t + 2], s[8 * t + 3], s[8 * t + 4], s[8 * t + 5], s[8 * t + 6], s[8 * t + 7]);
        o0 = MFMA8(vf[0][t], pb, o0);
        o1 = MFMA8(vf[1][t], pb, o1);
    }
}

__device__ __forceinline__ float max16(const f32x16& s) {
    const float a = fmaxf(fmaxf(fmaxf(s[0], s[1]), fmaxf(s[2], s[3])), fmaxf(fmaxf(s[4], s[5]), fmaxf(s[6], s[7])));
    const float b = fmaxf(fmaxf(fmaxf(s[8], s[9]), fmaxf(s[10], s[11])), fmaxf(fmaxf(s[12], s[13]), fmaxf(s[14], s[15])));
    return fmaxf(a, b);
}
template <bool FAST> __device__ __forceinline__ void online_step8x2(f32x16& sa, f32x16& sb, float bias, bool lane_ok, float& m, float& l, f32x16& o0, f32x16& o1, const long (&va)[2][2], const long (&vb)[2][2]) {
    float mx = fmaxf(max16(sa), max16(sb));
    if (FAST) { mx = mx * QSCALE + bias; mx = lane_ok ? mx : NEG_INF; }
    mx = xhalf_max(mx);
    if (__any(mx > m + 2.0f)) {
        const float mnew = (mx > m + 2.0f) ? mx : m;
        const float alpha = fast_exp2(m - mnew);
        l *= alpha; m = mnew;
#pragma unroll
        for (int i = 0; i < 16; ++i) { o0[i] *= alpha; o1[i] *= alpha; }
    }
    float ps = 0.f, ps2 = 0.f;
    if (FAST) {
        const float c = lane_ok ? (m - bias - 6.0f) : __builtin_inff();
#pragma unroll
        for (int i = 0; i < 16; ++i) { sa[i] = fast_exp2(__builtin_fmaf(sa[i], QSCALE, -c)); ps += sa[i]; sb[i] = fast_exp2(__builtin_fmaf(sb[i], QSCALE, -c)); ps2 += sb[i]; }
    } else {
        const float c = m - 6.0f;
#pragma unroll
        for (int i = 0; i < 16; ++i) { sa[i] = fast_exp2(sa[i] - c); ps += sa[i]; sb[i] = fast_exp2(sb[i] - c); ps2 += sb[i]; }
    }
    ps += ps2;
    ps = xhalf_sum(ps);
    l += ps;
    const long pa0 = pack_fp8x8(sa[0], sa[1], sa[2], sa[3], sa[4], sa[5], sa[6], sa[7]);
    const long pb0 = pack_fp8x8(sb[0], sb[1], sb[2], sb[3], sb[4], sb[5], sb[6], sb[7]);
    o0 = MFMA8(va[0][0], pa0, o0); o1 = MFMA8(va[1][0], pa0, o1);
    const long pa1 = pack_fp8x8(sa[8], sa[9], sa[10], sa[11], sa[12], sa[13], sa[14], sa[15]);
    o0 = MFMA8(vb[0][0], pb0, o0); o1 = MFMA8(vb[1][0], pb0, o1);
    const long pb1 = pack_fp8x8(sb[8], sb[9], sb[10], sb[11], sb[12], sb[13], sb[14], sb[15]);
    o0 = MFMA8(va[0][1], pa1, o0); o1 = MFMA8(va[1][1], pa1, o1);
    o0 = MFMA8(vb[0][1], pb1, o0); o1 = MFMA8(vb[1][1], pb1, o1);
}

__device__ __forceinline__ void nsa_unit(const Params& p, int bg, int jq, LAS unsigned char* lds, int wave, int lane, bool build_lut) {
    LAUNDER(lane);
    const unsigned char* ws = P_ws(p);
    const bf16_t* qb = (const bf16_t*)(ws + WS_R1 + R_Q);
    const bf16_t* kcmp = (const bf16_t*)(ws + WS_R1 + R_KCMP) + (size_t)bg * NCMP * 64;
    const bf16_t* vcmpT = (const bf16_t*)(ws + WS_R1 + R_VCMPT) + (size_t)bg * NCMP * 64;
    const unsigned char* ks8 = ws + WS_R1 + R_KS + (size_t)bg * S * 64;
    const unsigned char* vs8 = ws + WS_R1 + R_VST + (size_t)bg * S * 64;
    const bf16_t* kwb = (const bf16_t*)(ws + WS_R1 + R_KW) + (size_t)bg * S * 64;
    const bf16_t* vwT = (const bf16_t*)(ws + WS_R1 + R_VWT) + (size_t)bg * S * 64;
    const float* gates = (const float*)(ws + WS_R1 + R_GATES);
    bf16_t* mixed = (bf16_t*)(ws + WS_AN);
    const float* relb = P_in(p, 1);
    const int b = bg >> 1, g = bg & 1;
    LAS float* imp = (LAS float*)(lds + wave * NSA_WAVE_LDS);
    LAS unsigned* selw = (LAS unsigned*)(lds + wave * NSA_WAVE_LDS + 8192);
    LAS float* lut = (LAS float*)(lds + wave * NSA_WAVE_LDS + 8192 + 256);
    LAS int* list = (LAS int*)(lds + wave * NSA_WAVE_LDS + 8192 + 256 + 2112);
    const int c = lane & 31, h = lane >> 5, ql = c >> 2, r = c & 3;
    const int tq0 = 64 * jq + 8 * wave, tq = tq0 + ql;
    const size_t tok = (size_t)b * S + tq;

    if (build_lut) {
        for (int e = lane; e < 4 * 129; e += 64) {
            const int rr = e / 129, n = e % 129;
            int bk = n;
            if (n >= 16) bk = 16 + (n >= 19) + (n >= 21) + (n >= 24) + (n >= 27) + (n >= 31) + (n >= 35) + (n >= 40) + (n >= 46) + (n >= 52) + (n >= 59) + (n >= 67) + (n >= 77) + (n >= 87) + (n >= 99) + (n >= 113);
            lut[rr * 132 + n] = relb[bk * 8 + g * 4 + rr] * LOG2E;
        }
    }
    for (int e = lane; e < 2048; e += 64) imp[e] = 0.f;
    {
        const int k = lane & 7; unsigned w = 0u;
        if (k == 0) w |= 1u;
        if ((jq >> 5) == k) w |= 1u << (jq & 31);
        if (jq >= 1 && ((jq - 1) >> 5) == k) w |= 1u << ((jq - 1) & 31);
        selw[lane] = w;
    }
    asm volatile("s_waitcnt lgkmcnt(0)" ::: "memory");
    __builtin_amdgcn_wave_barrier();
    const LAS float* lutr = lut + r * 132;
    const float lutfar = lutr[128];

    bf16x8 qf[4];
#pragma unroll
    for (int ks = 0; ks < 4; ++ks) qf[ks] = *(const bf16x8*)(qb + tok * 512 + (g * 4 + r) * 64 + ks * 16 + h * 8);
    const float g0 = gates[tok * 24 + (g * 4 + r) * 3 + 0], g1 = gates[tok * 24 + (g * 4 + r) * 3 + 1], g2 = gates[tok * 24 + (g * 4 + r) * 3 + 2];

    f32x16 oa0, oa1;
    bf16x8 kf[4], kn[4], vf[2][2];
    {
        const int jmaxw = (tq0 + 7 - 31) >> 4;
        const int ntile = (jmaxw >= 0) ? (jmaxw >> 5) + 1 : 0;
        float m = -1e30f, l = 0.f;
        if (ntile > 0) load_k(kn, kcmp, lane);
        for (int T = 0; T < ntile; ++T) {
#pragma unroll
            for (int ks = 0; ks < 4; ++ks) kf[ks] = kn[ks];
            if (T + 1 < ntile) load_k(kn, kcmp + (size_t)(T + 1) * 2048, lane);
            f32x16 s = qk_tile(kf, qf);
            const int base = 512 * T + 31;
            const bool fast = (tq0 - base - 16 * 31) >= 128;
            score_tile<16>(s, tq - base - 64 * h, 1 << 30, true, fast, lutfar, lutr);
            float mx = s[0];
#pragma unroll
            for (int i = 1; i < 16; ++i) mx = fmaxf(mx, s[i]);
            mx = xhalf_max(mx);
            const float mnew = fmaxf(m, mx);
            float ps = 0.f;
#pragma unroll
            for (int i = 0; i < 16; ++i) ps += fast_exp2(s[i] - mnew);
            ps = xhalf_sum(ps);
            l = l * fast_exp2(m - mnew) + ps; m = mnew;
        }
        const float c2 = (l > 0.f) ? (m + __builtin_amdgcn_logf(l)) : __builtin_inff();
        const float c2f = c2 - lutfar;
        f32x16 o0, o1;
#pragma unroll
        for (int i = 0; i < 16; ++i) { o0[i] = 0.f; o1[i] = 0.f; }
        if (ntile > 0) load_k(kn, kcmp, lane);
        for (int T = 0; T < ntile; ++T) {
#pragma unroll
            for (int ks = 0; ks < 4; ++ks) kf[ks] = kn[ks];
            load_v(vf, vcmpT + (size_t)T * 2048, lane);
            if (T + 1 < ntile) load_k(kn, kcmp + (size_t)(T + 1) * 2048, lane);
            f32x16 s = qk_tile(kf, qf);
            const int base = 512 * T + 31;
            const bool fast = (tq0 - base - 16 * 31) >= 128;
            if (fast) {
#pragma unroll
                for (int i = 0; i < 16; ++i) s[i] = fast_exp2(s[i] - c2f);
            } else {
                score_tile<16>(s, tq - base - 64 * h, 1 << 30, true, false, lutfar, lutr);
#pragma unroll
                for (int i = 0; i < 16; ++i) s[i] = fast_exp2(s[i] - c2);
            }
#pragma unroll
            for (int i4 = 0; i4 < 4; ++i4) {
                float a = (s[4 * i4] + s[4 * i4 + 1]) + (s[4 * i4 + 2] + 0.5f * s[4 * i4 + 3]);
                float bb = 0.5f * s[4 * i4 + 3];
                a = quad_sum(a); bb = quad_sum(bb);
                if (r == i4) {
                    const int n = 8 * T + 2 * i4 + h;
                    atomicAdd((float*)(imp + ql * 256 + n), a);
                    if (n + 1 < 256) atomicAdd((float*)(imp + ql * 256 + n + 1), bb);
                }
            }
            pv_tile(o0, o1, s, vf);
        }
        {
            LAS float* park = (LAS float*)(lds + wave * NSA_WAVE_LDS + 11264);
#pragma unroll
            for (int i = 0; i < 16; ++i) { park[i * 64 + lane] = g0 * o0[i]; park[(16 + i) * 64 + lane] = g0 * o1[i]; }
        }
    }
    asm volatile("s_waitcnt lgkmcnt(0)" ::: "memory");
    __builtin_amdgcn_wave_barrier();
    if (jq >= 3) {
        float val[8][4];
#pragma unroll
        for (int qq = 0; qq < 8; ++qq) {
            const f32x4 iv = *(const LAS f32x4*)(imp + qq * 256 + 4 * lane);
#pragma unroll
            for (int e = 0; e < 4; ++e) { const int n = 4 * lane + e; val[qq][e] = (n >= 1 && n <= jq - 2) ? iv[e] : -1.0f; }
        }
        unsigned mybits[8];
#pragma unroll
        for (int qq = 0; qq < 8; ++qq) mybits[qq] = 0u;
        for (int round = 0; round < 13; ++round) {
#pragma unroll
            for (int qq = 0; qq < 8; ++qq) {
                const float lb = fmaxf(fmaxf(val[qq][0], val[qq][1]), fmaxf(val[qq][2], val[qq][3]));
                const float wm = wave_max_fast(lb);
                const unsigned long long bal = __ballot(lb == wm);
                const int wl = __builtin_ctzll(bal | (1ull << 63));
                const bool win = (lane == wl) && (wm >= 0.f);
                const int e = (val[qq][0] == wm) ? 0 : ((val[qq][1] == wm) ? 1 : ((val[qq][2] == wm) ? 2 : 3));
                mybits[qq] |= win ? (1u << e) : 0u;
                val[qq][0] = (win && e == 0) ? -2.0f : val[qq][0]; val[qq][1] = (win && e == 1) ? -2.0f : val[qq][1];
                val[qq][2] = (win && e == 2) ? -2.0f : val[qq][2]; val[qq][3] = (win && e == 3) ? -2.0f : val[qq][3];
            }
        }
#pragma unroll
        for (int qq = 0; qq < 8; ++qq)
            if (mybits[qq]) atomicOr((unsigned*)(selw + qq * 8 + (lane >> 3)), mybits[qq] << ((lane & 7) * 4));
    }
    asm volatile("s_waitcnt lgkmcnt(0)" ::: "memory");
    __builtin_amdgcn_wave_barrier();
    {
        unsigned uwA = 0u, uwB = 0u;
        if (lane < 8) {
#pragma unroll
            for (int qq = 0; qq < 4; ++qq) { uwA |= selw[qq * 8 + lane]; uwB |= selw[(qq + 4) * 8 + lane]; }
        }
        int cntA = 0, cntB = 0;
#pragma unroll
        for (int k = 0; k < 8; ++k) {
            const unsigned ba = (unsigned)__builtin_amdgcn_readlane((int)uwA, k), bb2 = (unsigned)__builtin_amdgcn_readlane((int)uwB, k);
            if (lane < 32) {
                const unsigned below = (1u << lane) - 1u;
                if ((ba >> lane) & 1u) list[cntA + __builtin_popcount(ba & below)] = 32 * k + lane;
                if ((bb2 >> lane) & 1u) list[64 + cntB + __builtin_popcount(bb2 & below)] = 32 * k + lane;
            }
            cntA += __builtin_popcount(ba); cntB += __builtin_popcount(bb2);
        }
        asm volatile("s_waitcnt lgkmcnt(0)" ::: "memory");
        __builtin_amdgcn_wave_barrier();
        LAS float* ostage = imp;
        const int c16 = lane & 15, fq = lane >> 4, q4 = c16 >> 2, r16 = c16 & 3;
        const LAS float* lutr16 = lut + r16 * 132;
        const float lutfar16 = lutr16[128];
        for (int grp = 0; grp < 2; ++grp) {
            const int cnt = grp ? cntB : cntA, lbase = grp * 64;
            const int tqg = tq0 + 4 * grp + q4, tq0g = tq0 + 4 * grp;
            long q8[2];
            {
                const bf16_t* qp = qb + ((size_t)b * S + tqg) * 512 + (g * 4 + r16) * 64 + 8 * fq;
#pragma unroll
                for (int ks = 0; ks < 2; ++ks) {
                    const bf16x8 qv = *(const bf16x8*)(qp + 32 * ks);
                    float f[8];
#pragma unroll
                    for (int e = 0; e < 8; ++e) f[e] = bf2f((bf16_t)qv[e]) * 4.0f;
                    q8[ks] = pack_fp8x8(f[0], f[1], f[2], f[3], f[4], f[5], f[6], f[7]);
                }
            }
            float m = -1e30f;
            f32x4 lacc = (f32x4){0.f, 0.f, 0.f, 0.f};
            const long ones8 = 0x3838383838383838L;
            f32x4 o[4];
#pragma unroll
            for (int dt = 0; dt < 4; ++dt) o[dt] = (f32x4){0.f, 0.f, 0.f, 0.f};
            const int npair = (cnt + 1) >> 1;
            if (lane == 0 && (cnt & 1)) list[lbase + cnt] = 0;
            asm volatile("s_waitcnt lgkmcnt(0)" ::: "memory");
            __builtin_amdgcn_wave_barrier();
            long k8[2][8], v8[2][8];
            int n0 = __builtin_amdgcn_readfirstlane(list[lbase]), n1 = __builtin_amdgcn_readfirstlane(list[lbase + 1]);
#pragma unroll
            for (int i = 0; i < 4; ++i) { const l64x2 t0 = *(const l64x2*)(ks8 + (size_t)n0 * 4096 + i * 1024 + lane * 16), t1 = *(const l64x2*)(ks8 + (size_t)n1 * 4096 + i * 1024 + lane * 16);
                k8[0][2 * i] = t0[0]; k8[0][2 * i + 1] = t0[1]; k8[1][2 * i] = t1[0]; k8[1][2 * i + 1] = t1[1]; }
            for (int it = 0; it < npair; ++it) {
                const int nb[2] = {n0, n1};
                const bool real1 = (2 * it + 1) < cnt;
#pragma unroll
                for (int u = 0; u < 2; ++u)
#pragma unroll
                    for (int i = 0; i < 4; ++i) { const l64x2 t = *(const l64x2*)(vs8 + (size_t)nb[u] * 4096 + i * 1024 + lane * 16); v8[u][2 * i] = t[0]; v8[u][2 * i + 1] = t[1]; }
                bool ok[2];
                ok[0] = (selw[(grp * 4 + q4) * 8 + (nb[0] >> 5)] >> (nb[0] & 31)) & 1u;
                ok[1] = real1 && ((selw[(grp * 4 + q4) * 8 + (nb[1] >> 5)] >> (nb[1] & 31)) & 1u);
                const int bmax = real1 ? max(nb[0], nb[1]) : nb[0];
                const bool fast = (tq0g - 64 * bmax - 63) >= 128;
                const bool fresh = m < -1e29f;
                const float mref = fresh ? 0.f : m;
                float ini[2];
                ini[0] = fast ? (ok[0] ? -(mref - lutfar16 - 6.0f) : NEG_INF) : 0.f;
                ini[1] = fast ? (ok[1] ? -(mref - lutfar16 - 6.0f) : NEG_INF) : 0.f;
                f32x4 sc[2][4];
#pragma unroll
                for (int u = 0; u < 2; ++u)
#pragma unroll
                    for (int kt = 0; kt < 4; ++kt) {
                        sc[u][kt] = __builtin_amdgcn_mfma_f32_16x16x32_fp8_fp8(k8[u][2 * kt], q8[0], (f32x4){ini[u], ini[u], ini[u], ini[u]}, 0, 0, 0);
                        sc[u][kt] = __builtin_amdgcn_mfma_f32_16x16x32_fp8_fp8(k8[u][2 * kt + 1], q8[1], sc[u][kt], 0, 0, 0);
                    }
                if (it + 1 < npair) {
                    n0 = __builtin_amdgcn_readfirstlane(list[lbase + 2 * it + 2]); n1 = __builtin_amdgcn_readfirstlane(list[lbase + 2 * it + 3]);
#pragma unroll
                    for (int i = 0; i < 4; ++i) { const l64x2 t0 = *(const l64x2*)(ks8 + (size_t)n0 * 4096 + i * 1024 + lane * 16), t1 = *(const l64x2*)(ks8 + (size_t)n1 * 4096 + i * 1024 + lane * 16);
                        k8[0][2 * i] = t0[0]; k8[0][2 * i + 1] = t0[1]; k8[1][2 * i] = t1[0]; k8[1][2 * i + 1] = t1[1]; }
                }
                if (fast) {
                    float t = NEG_INF;
#pragma unroll
                    for (int u = 0; u < 2; ++u) {
                        float tt = fmaxf(fmaxf(fmaxf(sc[u][0][0], sc[u][0][1]), fmaxf(sc[u][0][2], sc[u][0][3])), fmaxf(fmaxf(sc[u][1][0], sc[u][1][1]), fmaxf(sc[u][1][2], sc[u][1][3])));
                        tt = fmaxf(tt, fmaxf(fmaxf(fmaxf(sc[u][2][0], sc[u][2][1]), fmaxf(sc[u][2][2], sc[u][2][3])), fmaxf(fmaxf(sc[u][3][0], sc[u][3][1]), fmaxf(sc[u][3][2], sc[u][3][3]))));
                        t = fmaxf(t, tt);
                    }
                    { auto t1 = __builtin_amdgcn_permlane16_swap(__float_as_uint(t), __float_as_uint(t), false, false); t = fmaxf(__uint_as_float(t1[0]), __uint_as_float(t1[1])); t = xhalf_max(t); }
                    const float mxt = t - 6.0f + mref;
                    const bool need = fresh ? (t > NEG_INF) : (mxt > m + 2.0f);
                    if (__any(need)) {
                        const float mnew = need ? mxt : m;
                        const float delta = need ? (mnew - mref) : 0.f;
                        const float alpha = (need && !fresh) ? fast_exp2(m - mnew) : 1.0f;
                        lacc = lacc * alpha; m = mnew;
#pragma unroll
                        for (int dt = 0; dt < 4; ++dt) o[dt] = o[dt] * alpha;
#pragma unroll
                        for (int u = 0; u < 2; ++u)
#pragma unroll
                            for (int kt = 0; kt < 4; ++kt) sc[u][kt] = sc[u][kt] - delta;
                    }
#pragma unroll
                    for (int u = 0; u < 2; ++u)
#pragma unroll
                        for (int kt = 0; kt < 4; ++kt)
#pragma unroll
                            for (int e = 0; e < 4; ++e) sc[u][kt][e] = fast_exp2(sc[u][kt][e]);
                } else {
                    float mx = NEG_INF;
#pragma unroll
                    for (int u = 0; u < 2; ++u)
#pragma unroll
                        for (int kt = 0; kt < 4; ++kt)
#pragma unroll
                            for (int e = 0; e < 4; ++e) {
                                const int d = tqg - 64 * nb[u] - 16 * kt - 4 * fq - e;
                                const bool okk = ok[u] && d >= 0;
                                const float v = okk ? (sc[u][kt][e] + lutr16[min(max(d, 0), 128)]) : NEG_INF;
                                sc[u][kt][e] = v; mx = fmaxf(mx, v);
                            }
                    { auto t1 = __builtin_amdgcn_permlane16_swap(__float_as_uint(mx), __float_as_uint(mx), false, false); mx = fmaxf(__uint_as_float(t1[0]), __uint_as_float(t1[1])); mx = xhalf_max(mx); }
                    if (__any(mx > m + 2.0f)) {
                        const float mnew = (mx > m + 2.0f) ? mx : m;
                        const float alpha = fast_exp2(m - mnew);
                        lacc = lacc * alpha; m = mnew;
#pragma unroll
                        for (int dt = 0; dt < 4; ++dt) o[dt] = o[dt] * alpha;
                    }
                    const float cexp = m - 6.0f;
#pragma unroll
                    for (int u = 0; u < 2; ++u)
#pragma unroll
                        for (int kt = 0; kt < 4; ++kt)
#pragma unroll
                            for (int e = 0; e < 4; ++e) sc[u][kt][e] = fast_exp2(sc[u][kt][e] - cexp);
                }
#pragma unroll
                for (int u = 0; u < 2; ++u) {
                    const long pb0 = pack_fp8x8(sc[u][0][0], sc[u][0][1], sc[u][0][2], sc[u][0][3], sc[u][1][0], sc[u][1][1], sc[u][1][2], sc[u][1][3]);
                    const long pb1 = pack_fp8x8(sc[u][2][0], sc[u][2][1], sc[u][2][2], sc[u][2][3], sc[u][3][0], sc[u][3][1], sc[u][3][2], sc[u][3][3]);
#pragma unroll
                    for (int dt = 0; dt < 4; ++dt) {
                        o[dt] = __builtin_amdgcn_mfma_f32_16x16x32_fp8_fp8(v8[u][2 * dt], pb0, o[dt], 0, 0, 0);
                        o[dt] = __builtin_amdgcn_mfma_f32_16x16x32_fp8_fp8(v8[u][2 * dt + 1], pb1, o[dt], 0, 0, 0);
                    }
                    lacc = __builtin_amdgcn_mfma_f32_16x16x32_fp8_fp8(ones8, pb0, lacc, 0, 0, 0);
                    lacc = __builtin_amdgcn_mfma_f32_16x16x32_fp8_fp8(ones8, pb1, lacc, 0, 0, 0);
                }
            }
            const float l = lacc[0];
            const float invl = (l > 0.f) ? 1.0f / l : 0.f;
#pragma unroll
            for (int dt = 0; dt < 4; ++dt) *(LAS f32x4*)(ostage + ((grp * 4 + q4) * 4 + r16) * 64 + 16 * dt + 4 * fq) = o[dt] * invl;
        }
        asm volatile("s_waitcnt lgkmcnt(0)" ::: "memory");
        __builtin_amdgcn_wave_barrier();
        {
            const LAS float* park = (const LAS float*)(lds + wave * NSA_WAVE_LDS + 11264);
#pragma unroll
            for (int i = 0; i < 16; ++i) { oa0[i] = park[i * 64 + lane]; oa1[i] = park[(16 + i) * 64 + lane]; }
        }
#pragma unroll
        for (int dt = 0; dt < 2; ++dt)
#pragma unroll
            for (int i4 = 0; i4 < 4; ++i4) {
                const f32x4 v = *(const LAS f32x4*)(ostage + (ql * 4 + r) * 64 + 32 * dt + 8 * i4 + 4 * h);
                if (dt == 0) { oa0[4 * i4] += g1 * v[0]; oa0[4 * i4 + 1] += g1 * v[1]; oa0[4 * i4 + 2] += g1 * v[2]; oa0[4 * i4 + 3] += g1 * v[3]; }
                else         { oa1[4 * i4] += g1 * v[0]; oa1[4 * i4 + 1] += g1 * v[1]; oa1[4 * i4 + 2] += g1 * v[2]; oa1[4 * i4 + 3] += g1 * v[3]; }
            }
        asm volatile("s_waitcnt lgkmcnt(0)" ::: "memory");
        __builtin_amdgcn_wave_barrier();
    }
    {
        {
            const bf16_t* qp = qb + tok * 512 + (g * 4 + r) * 64 + h * 8;
            asm volatile("" : "+v"(qp));
#pragma unroll
            for (int ks = 0; ks < 4; ++ks) qf[ks] = *(const bf16x8*)(qp + ks * 16);
        }
        const int T0 = max(0, (tq0 - 511) >> 5), T1 = (tq0 + 7) >> 5;
        float m = -1e30f, l = 0.f;
        f32x16 o0, o1;
#pragma unroll
        for (int i = 0; i < 16; ++i) { o0[i] = 0.f; o1[i] = 0.f; }
        load_k(kn, kwb + (size_t)(32 * T0) * 64, lane);
        for (int T = T0; T <= T1; ++T) {
#pragma unroll
            for (int ks = 0; ks < 4; ++ks) kf[ks] = kn[ks];
            load_v(vf, vwT + (size_t)T * 2048, lane);
            if (T < T1) load_k(kn, kwb + (size_t)(32 * (T + 1)) * 64, lane);
            const int base = 32 * T;
            f32x16 s = qk_tile(kf, qf);
            if (((tq0 - base - 31) >= 128) && ((tq0 + 7 - base) < 512)) online_step<true>(s, lutfar, true, m, l, o0, o1, vf);
            else { score_tile<1>(s, tq - base - 4 * h, 512, true, false, lutfar, lutr); online_step<false>(s, 0.f, true, m, l, o0, o1, vf); }
        }
        const float sc = (l > 0.f) ? g2 / l : 0.f;
#pragma unroll
        for (int i = 0; i < 16; ++i) { oa0[i] += sc * o0[i]; oa1[i] += sc * o1[i]; }
    }
    bf16_t* orow = mixed + tok * 1024 + (g * 4 + r) * 64;
#pragma unroll
    for (int dt = 0; dt < 2; ++dt)
#pragma unroll
        for (int i4 = 0; i4 < 4; ++i4) {
            const f32x16& a = dt ? oa1 : oa0;
            u32x2 o; o.x = cvt_pk_bf16(a[4 * i4], a[4 * i4 + 1]); o.y = cvt_pk_bf16(a[4 * i4 + 2], a[4 * i4 + 3]);
            *(u32x2*)(orow + 32 * dt + 8 * i4 + 4 * h) = o;
        }
}


#define XB_TMO      128
#define XB_XCNT(j)  (256  + 64 * (j))
#define XB_XSUB(j)  (1280 + 64 * (j))
#define XB_XGEN(j)  (2304 + 64 * (j))
#define XB_TOP      3328
#define XB_TOPGEN   3392
#define XCD_BAR_WORDS 3456
#define XB_SPIN_CAP (1u << 22)
__device__ __forceinline__ unsigned xb_ld(unsigned* p)              { return __hip_atomic_load(p, __ATOMIC_RELAXED, __HIP_MEMORY_SCOPE_AGENT); }
__device__ __forceinline__ unsigned xb_add(unsigned* p, unsigned v) { return __hip_atomic_fetch_add(p, v, __ATOMIC_RELAXED, __HIP_MEMORY_SCOPE_AGENT); }
__device__ __forceinline__ unsigned xb_xcc_id() { return (unsigned)__builtin_amdgcn_s_getreg((3 << 11) | 20) & 0xFu; }
#define XB_SPIN(cond, bar) do { unsigned _sp = 0; while (cond) { __builtin_amdgcn_s_sleep(1); \
    if ((++_sp & 255u) == 0u) { if (xb_ld(&(bar)[XB_TMO])) break; if (_sp > XB_SPIN_CAP) { atomicAdd(&(bar)[XB_TMO], 1u); break; } } } } while (0)
__device__ __forceinline__ void xcd_barrier_complete(unsigned* bar, unsigned x, unsigned& nloc, unsigned& nx) {
    const unsigned G = gridDim.x * gridDim.y * gridDim.z;
    unsigned sum, cnt, mine, sp = 0u;
    for (;;) {
        sum = 0u; cnt = 0u; mine = 0u;
#pragma unroll
        for (unsigned j = 0; j < 16; ++j) { const unsigned c = xb_ld(&bar[XB_XCNT(j)]); sum += c; cnt += (c > 0u) ? 1u : 0u; mine = (j == x) ? c : mine; }
        if (sum == G) break;
        __builtin_amdgcn_s_sleep(1);
        if ((++sp & 255u) == 0u) { if (xb_ld(&bar[XB_TMO])) break; if (sp > XB_SPIN_CAP) { atomicAdd(&bar[XB_TMO], 1u); break; } }
    }
    nloc = mine > 0u ? mine : 1u; nx = cnt > 0u ? cnt : 1u;
}
__device__ __forceinline__ void xcd_barrier(unsigned* bar, volatile LAS unsigned* st) {
    asm volatile("s_waitcnt vmcnt(0)" ::: "memory");
    __syncthreads();
    if (threadIdx.x == 0) {
        const unsigned x = xb_xcc_id();
        __builtin_amdgcn_s_waitcnt(0);
        unsigned nloc = st[0], nx = st[1];
        if (nloc == 0u) { xcd_barrier_complete(bar, x, nloc, nx); st[0] = nloc; st[1] = nx; }
        const unsigned old = xb_add(&bar[XB_XSUB(x)], 1u);
        const unsigned gen = old / nloc;
        if (old + 1u == (gen + 1u) * nloc) {
            __builtin_amdgcn_fence(__ATOMIC_RELEASE, "agent");
            asm volatile("s_waitcnt vmcnt(0)" ::: "memory");
            const unsigned og = xb_add(&bar[XB_TOP], 1u);
            const unsigned tg = og / nx;
            if (og + 1u == (tg + 1u) * nx) xb_add(&bar[XB_TOPGEN], 1u);
            else XB_SPIN(xb_ld(&bar[XB_TOPGEN]) == tg, bar);
            __builtin_amdgcn_fence(__ATOMIC_ACQUIRE, "agent");
            xb_add(&bar[XB_XGEN(x)], 1u);
            asm volatile("s_waitcnt vmcnt(0)" ::: "memory");
        } else {
            XB_SPIN(xb_ld(&bar[XB_XGEN(x)]) == gen, bar);
            __builtin_amdgcn_fence(__ATOMIC_ACQUIRE, "agent");
            asm volatile("s_waitcnt vmcnt(0)" ::: "memory");
        }
    }
    __syncthreads();
}

__global__ void __launch_bounds__(NTHREADS, 2) fwd_megakernel(Params p) {
    extern __shared__ __attribute__((aligned(16))) unsigned char lds_raw[];
    LAS unsigned char* lds = (LAS unsigned char*)lds_raw;
    cg::grid_group grid = cg::this_grid();
#define TID_F ({ int _t = threadIdx.x; LAUNDER(_t); _t; })
#define LANE_F (TID_F & 63)
#define WAVE_F (__builtin_amdgcn_readfirstlane(TID_F >> 6))
    const int G = gridDim.x, bx = blockIdx.x;
    const int NGW = G * NWAVES;
#define GW_F (bx * NWAVES + WAVE_F)
#define FRESH_WS unsigned char* ws = P_ws(p); bf16_t* AN = (bf16_t*)(ws + WS_AN); float* MIX = (float*)(ws + WS_MIX); (void)AN; (void)MIX

    { const int tid = TID_F; if (tid < 16) ((LAS unsigned*)(lds + LDS_BYTES - 64))[tid] = 0u; }
    if (bx == 0) { unsigned* barw = (unsigned*)P_ws(p); for (int i = TID_F; i < XCD_BAR_WORDS; i += NTHREADS) barw[i] = 0u; }
    { const int t = TID_F; if (t < 128) ((unsigned*)(P_ws(p) + WS_XCNT))[bx * 128 + t] = 0u; }
    __syncthreads();
    {
        FRESH_WS;
        const int tid = TID_F, lane = tid & 63, wave = __builtin_amdgcn_readfirstlane(tid >> 6), gw = bx * NWAVES + wave;
        LAS float* scr = (LAS float*)(lds + wave * 17408);
        for (int layer = 0; layer < DEPTH; ++layer) {
            unsigned char* wl = ws + WS_W + (size_t)layer * W_LAYER;
            const int I_IN = 16 * (NINP / 64), I_OUT = 16 * 16, I_GU = 16 * (NGU / 64), I_DN = 44 * 16, I_C1 = 32 * 4, I_C2 = 4 * 1;
            const int NIT = I_IN + I_OUT + I_GU + I_DN + 2 * I_C1 + 2 * I_C2;
            for (int it = gw; it < NIT; it += NGW) {
                int r = it;
                if (r < I_IN) { transpose_item<1>(P_in(p, 6) + (size_t)layer * DM * INW, DM, INW, (bf16_t*)(wl + W_IN), NINP / 64, r, scr, lane, P_in(p, 2) + layer * DM); continue; } r -= I_IN;
                if (r < I_OUT) { transpose_item<0>(P_in(p, 17) + (size_t)layer * DM * DM, DM, DM, (bf16_t*)(wl + W_OUT), 16, r, scr, lane); continue; } r -= I_OUT;
                if (r < I_GU) { transpose_item<2>(P_in(p, 18) + (size_t)layer * DM * NGU, DM, NGU, (bf16_t*)(wl + W_GU), NGU / 64, r, scr, lane, P_in(p, 4) + layer * DM); continue; } r -= I_GU;
                if (r < I_DN) { transpose_item<0>(P_in(p, 19) + (size_t)layer * DFF * DM, DFF, DM, (bf16_t*)(wl + W_DN), 16, r, scr, lane); continue; } r -= I_DN;
                if (r < I_C1) { transpose_item<0>(P_in(p, 8) + (size_t)layer * 2048 * 256, 2048, 256, (bf16_t*)(wl + W_C1K), 4, r, scr, lane); continue; } r -= I_C1;
                if (r < I_C1) { transpose_item<0>(P_in(p, 11) + (size_t)layer * 2048 * 256, 2048, 256, (bf16_t*)(wl + W_C1V), 4, r, scr, lane); continue; } r -= I_C1;
                if (r < I_C2) { transpose_item<0>(P_in(p, 9) + (size_t)layer * 256 * 64, 256, 64, (bf16_t*)(wl + W_C2K), 1, r, scr, lane); continue; } r -= I_C2;
                transpose_item<0>(P_in(p, 12) + (size_t)layer * 256 * 64, 256, 64, (bf16_t*)(wl + W_C2V), 1, r, scr, lane);
            }
        }
        __syncthreads();
        if (bx >= G - 2 * DEPTH) {
            const int id = G - 1 - bx, layer = id >> 1, kv = id & 1;
            const float* pos = P_in(p, kv ? 10 : 7) + (size_t)layer * 2048;
            const float* w1 = P_in(p, kv ? 11 : 8) + (size_t)layer * 2048 * 256;
            LAS float* red = (LAS float*)lds;
            f32x4 acc4 = (f32x4){0.f, 0.f, 0.f, 0.f};
#pragma unroll 8
            for (int i = wave * 256; i < wave * 256 + 256; ++i) { const f32x4 w = *(const f32x4*)(w1 + (size_t)i * 256 + 4 * lane); acc4 = acc4 + w * pos[i]; }
            red[wave * 256 + 4 * lane + 0] = acc4[0]; red[wave * 256 + 4 * lane + 1] = acc4[1]; red[wave * 256 + 4 * lane + 2] = acc4[2]; red[wave * 256 + 4 * lane + 3] = acc4[3];
            __syncthreads();
            if (tid < 256) { float sum = 0.f;
#pragma unroll
                for (int w = 0; w < 8; ++w) sum += red[w * 256 + tid];
                ((float*)(ws + WS_W + (size_t)layer * W_LAYER + (kv ? W_CBV : W_CBK)))[tid] = sum; }
            __syncthreads();
        }
        row_pass(P_in(p, 0), (bf16_t*)(ws + WS_HB), nullptr, nullptr, (float*)(ws + WS_RS), nullptr, gw, NGW, lane);
    }
    grid.sync();
    if (TID_F == 0) (void)xb_add(&((unsigned*)P_ws(p))[XB_XCNT(xb_xcc_id())], 1u);

#pragma unroll 1
    for (int layer = 0; layer < DEPTH; ++layer) {
        const size_t wloff = WS_W + (size_t)layer * W_LAYER;
#ifndef SKIP_PA
        {
            FRESH_WS; unsigned char* wl = ws + wloff;
            pg8::Gemm g{(const bf16_t*)(ws + WS_HB), (const bf16_t*)(wl + W_IN), MT, NINP, DM, DM};
            pg8::StaticOrder so; so.init(MT, NINP, G, bx, REP_PA);
            pg8::EpiIn E{ws + WS_R1, (const float*)(ws + WS_RS)};
            pg8::gemm_phase<pg8::EpiIn>(lds, g, so, E);
        }
#endif
        GSYNC();
#ifndef SKIP_PB
        for (int rep = 0; rep < REP_PB; ++rep) {
            FRESH_WS; unsigned char* wl = ws + wloff;
            for (int kv = 0; kv < 2; ++kv) {
                const int c = kv ? ((bx + (G >> 1)) % G) : bx;
                if (c < 16) {
                    bf16_t* hid = (bf16_t*)(ws + WS_R1 + R_HID) + (size_t)kv * 4096 * 256;
                    pg8::Gemm g{(const bf16_t*)(ws + WS_R1 + (kv ? R_VC : R_KC)), (const bf16_t*)(wl + (kv ? W_C1V : W_C1K)), 4096, 256, 2048, 1024};
                    pg8::StaticOrder so; so.init(4096, 256, G, c);
                    pg8::EpiCmp1 E{hid, (const float*)(wl + (kv ? W_CBV : W_CBK))};
                    pg8::gemm_phase<pg8::EpiCmp1>(lds, g, so, E);
                    pg8::Unit u; so.next(0, u);
                    asm volatile("s_waitcnt vmcnt(0)" ::: "memory");
                    __builtin_amdgcn_fence(__ATOMIC_RELEASE, "agent");
                    __syncthreads();
                    __builtin_amdgcn_fence(__ATOMIC_ACQUIRE, "agent");
                    cmp_gemm2(hid, (const bf16_t*)(wl + (kv ? W_C2V : W_C2K)), (bf16_t*)(ws + WS_R1 + R_KCMP), (bf16_t*)(ws + WS_R1 + R_VCMPT), kv, u.pm * 256 + WAVE_F * 32, LANE_F);
                    __syncthreads();
                }
            }
            if (G == 256) {
                const bool is_cmp = (bx < 16) || (bx >= 128 && bx < 144);
                if (!is_cmp) {
                    const int idx = (bx < 128) ? (bx - 16) : (bx - 32);
                    gmlp_unit(p, layer, idx, lds, WAVE_F, LANE_F);
                    if (idx + 224 < MT / 128) gmlp_unit(p, layer, idx + 224, lds, WAVE_F, LANE_F);
                }
            } else {
                for (int ch = bx; ch < MT / 128; ch += G) gmlp_unit(p, layer, ch, lds, WAVE_F, LANE_F);
            }
        }
#endif
        GSYNC();
        {
#if NSA_ENABLE
            __syncthreads();
            for (int rep = 0; rep < REP_PC; ++rep) {
                if (G == 256) {
                    const int x = bx & 7, y = bx >> 3, bg = x >> 1, j = (x & 1) * 32 + y;
                    for (int i = 0; i < 4; ++i) {
                        const int jq = (i >> 1) * 128 + ((i & 1) ? (127 - j) : j);
                        nsa_unit(p, bg, jq, lds, WAVE_F, LANE_F, i == 0);
                    }
                } else {
                    for (int i = 0; bx + i * G < 1024; ++i) {
                        const int u = bx + i * G;
                        const int bg = u >> 8, x = u & 255;
                        const int jq = (bg & 1) ? (255 - x) : x;
                        nsa_unit(p, bg, jq, lds, WAVE_F, LANE_F, true);
                    }
                }
            }
#else
            FRESH_WS;
            bf16_t* mixed = (bf16_t*)(ws + WS_AN);
            for (int m = GW_F; m < MT; m += NGW) { u32x4* o = (u32x4*)(mixed + (size_t)m * 1024); o[LANE_F] = (u32x4){0u, 0u, 0u, 0u}; }
#endif
        }
        GSYNC();
        {
            FRESH_WS; unsigned char* wl = ws + wloff;
            pg8::Gemm g{AN, (const bf16_t*)(wl + W_OUT), MT, DM, DM, DM};
            pg8::StaticOrder so; so.init(MT, DM, G, bx, 1);
            pg8::EpiNormRes E{ws, P_in(p, 3) + layer * DM, nullptr, 2 * layer};
            pg8::gemm_phase<pg8::EpiNormRes>(lds, g, so, E);
        }
        GSYNC();
#ifndef SKIP_PF
        {
            FRESH_WS; unsigned char* wl = ws + wloff;
            pg8::Gemm g{(const bf16_t*)(ws + WS_HB), (const bf16_t*)(wl + W_GU), MT, NGU, DM, DM};
            pg8::StaticOrder so; so.init(MT, NGU, G, bx, REP_PF);
            pg8::EpiGU E{(bf16_t*)(ws + WS_R1), (const float*)(ws + WS_RS)};
            pg8::gemm_phase<pg8::EpiGU>(lds, g, so, E);
        }
#endif
        GSYNC();
        {
            FRESH_WS; unsigned char* wl = ws + wloff;
            pg8::Gemm g{(const bf16_t*)(ws + WS_R1), (const bf16_t*)(wl + W_DN), MT, DM, DFF, DFF};
            pg8::StaticOrder so; so.init(MT, DM, G, bx, 1);
            pg8::EpiNormRes E{ws, P_in(p, 5) + layer * DM, (layer + 1 < DEPTH) ? nullptr : P_out(p), 2 * layer + 1};
            pg8::gemm_phase<pg8::EpiNormRes>(lds, g, so, E);
        }
        if (layer + 1 < DEPTH) GSYNC();
    }
}

extern "C" void kernel_launch(void* const* d_in, const int* in_sizes, int n_in, void* d_out, int out_size, void* d_ws, size_t ws_size, hipStream_t stream) {
    static int grid = 0;
    if (grid == 0) {
        if (n_in != 20 || out_size != MT * DM || ws_size < WS_END) { fprintf(stderr, "kernel_launch: unexpected shapes (n_in %d out %d ws %zu need %zu)\n", n_in, out_size, ws_size, (size_t)WS_END); grid = -1; return; }
        int dev = 0, cus = 0, per_cu = 0;
        hipGetDevice(&dev);
        hipDeviceGetAttribute(&cus, hipDeviceAttributeMultiprocessorCount, dev);
        if (hipFuncSetAttribute((const void*)fwd_megakernel, hipFuncAttributeMaxDynamicSharedMemorySize, LDS_BYTES) != hipSuccess) { fprintf(stderr, "kernel_launch: hipFuncSetAttribute failed\n"); grid = -1; return; }
        if (hipOccupancyMaxActiveBlocksPerMultiprocessor(&per_cu, (const void*)fwd_megakernel, NTHREADS, LDS_BYTES) != hipSuccess || per_cu < 1) { fprintf(stderr, "kernel_launch: occupancy query says %d\n", per_cu); per_cu = 1; }
        (void)hipGetLastError();
        grid = cus;
        if (grid > 256) grid = 256;
    }
    if (grid < 0) return;
    Params p{};
    for (int i = 0; i < 20; ++i) p.in[i] = (const float*)d_in[i];
    p.out = (float*)d_out; p.ws = (unsigned char*)d_ws;
    void* args[] = {&p};
    hipError_t e = hipLaunchCooperativeKernel((const void*)fwd_megakernel, dim3(grid), dim3(NTHREADS), args, LDS_BYTES, stream);
    if (e != hipSuccess) fprintf(stderr, "cooperative launch failed: %s (grid %d)\n", hipGetErrorString(e), grid);
}
```

```cpp
#include <hip/hip_runtime.h>
#include <hip/hip_cooperative_groups.h>
#include <cstdio>
#include <cstdint>
namespace cg = cooperative_groups;

#define LAS __attribute__((address_space(3)))
typedef unsigned short bf16_t;
typedef short bf16x8 __attribute__((ext_vector_type(8)));
typedef short s16x4 __attribute__((ext_vector_type(4)));
typedef float f32x2 __attribute__((ext_vector_type(2)));
typedef float f32x4 __attribute__((ext_vector_type(4)));
typedef float f32x16 __attribute__((ext_vector_type(16)));
typedef unsigned u32x2 __attribute__((ext_vector_type(2)));
typedef unsigned u32x4 __attribute__((ext_vector_type(4)));
typedef long l64x2 __attribute__((ext_vector_type(2)));

#ifndef REP_PA
#define REP_PA 1
#endif
#ifndef REP_PB
#define REP_PB 1
#endif
#ifndef REP_PC
#define REP_PC 1
#endif
#ifndef REP_PD
#define REP_PD 1
#endif
#ifndef REP_PF
#define REP_PF 1
#endif
#ifndef REP_PG
#define REP_PG 1
#endif
#ifndef SYNC_REP
#define SYNC_REP 1
#endif
#define GSYNC() do { for (int _r = 0; _r < SYNC_REP; ++_r) xcd_barrier((unsigned*)P_ws(p), (volatile LAS unsigned*)(lds + LDS_BYTES - 64)); } while (0)
#ifndef NSA_ENABLE
#define NSA_ENABLE 1
#endif

constexpr int NB = 2, S = 16384, DM = 1024, DEPTH = 4, MT = NB * S;
constexpr int INW = 2328, NINP = 2560, DFF = 2816, NGU = 2 * DFF;
constexpr int NCMP = 1024;
constexpr float RMS_EPS = 1e-6f, LN_EPS = 1e-5f;
constexpr float LOG2E = 1.4426950408889634f;
constexpr float QSCALE = 0.125f * LOG2E;
constexpr int NWAVES = 8, NTHREADS = 512;
constexpr int LDS_BYTES = 156672;

constexpr size_t MiB = 1u << 20;
constexpr size_t WS_W = 1 * MiB, W_LAYER = 26 * MiB;
constexpr size_t W_IN = 0, W_OUT = 5 * MiB, W_GU = 7 * MiB, W_DN = 18 * MiB, W_C1K = 23 * MiB + 512 * 1024, W_C1V = 24 * MiB + 512 * 1024,
                 W_C2K = 25 * MiB + 512 * 1024, W_C2V = W_C2K + 64 * 1024, W_CBK = W_C2V + 64 * 1024, W_CBV = W_CBK + 4096;
constexpr size_t WS_AN = 105 * MiB;
constexpr size_t WS_R1 = 169 * MiB;
constexpr size_t R_Q = 0, R_ZU = 32 * MiB, R_ZV = 64 * MiB, R_KC = 96 * MiB, R_VC = 105 * MiB, R_KS = 114 * MiB, R_VST = 122 * MiB, R_KW = 130 * MiB,
                 R_VWT = 138 * MiB, R_GATES = 146 * MiB, R_HID = 150 * MiB, R_KCMP = 154 * MiB, R_VCMPT = 155 * MiB;
constexpr size_t WS_MIX = 345 * MiB;
constexpr size_t WS_HB = WS_MIX + 64 * MiB;
constexpr size_t WS_RS = 256 * 1024;
constexpr size_t WS_XCNT = 512 * 1024;
constexpr size_t WS_XBUF = WS_MIX;
constexpr size_t WS_END = 473 * MiB;

struct Params {
    const float* in[20];
    float* out;
    unsigned char* ws;
};

typedef const __attribute__((address_space(4))) unsigned char* kargp_t;
__device__ __forceinline__ void* karg_ld(int byte_off) {
    kargp_t k = (kargp_t)__builtin_amdgcn_kernarg_segment_ptr();
    int off = byte_off; asm volatile("" : "+s"(off));
    return *(void* const __attribute__((address_space(4)))*)(k + off);
}
__device__ __forceinline__ const float* P_in(const Params&, int i) { return (const float*)karg_ld(8 * i); }
__device__ __forceinline__ float* P_out(const Params&) { return (float*)karg_ld(160); }
__device__ __forceinline__ unsigned char* P_ws(const Params&) { return (unsigned char*)karg_ld(168); }
__device__ __forceinline__ unsigned cvt_pk_bf16(float lo, float hi) { unsigned r; asm volatile("v_cvt_pk_bf16_f32 %0, %1, %2" : "=v"(r) : "v"(lo), "v"(hi)); return r; }
__device__ __forceinline__ float fast_exp2(float x) { return __builtin_amdgcn_exp2f(x); }
__device__ __forceinline__ float fast_rcp(float x) { return __builtin_amdgcn_rcpf(x); }
__device__ __forceinline__ float gelu_tanh(float x) { const float u = x + 0.044715f * x * x * x; return x * fast_rcp(1.0f + fast_exp2(-2.3022081982f * u)); }
__device__ __forceinline__ float silu_f(float x) { return x * fast_rcp(1.0f + fast_exp2(-LOG2E * x)); }
__device__ __forceinline__ float sigmoid_f(float x) { return fast_rcp(1.0f + fast_exp2(-LOG2E * x)); }
__device__ __forceinline__ float wave_sum(float v) {
#pragma unroll
    for (int o = 1; o < 64; o <<= 1) v += __shfl_xor(v, o);
    return v;
}
__device__ __forceinline__ float wave_max(float v) {
#pragma unroll
    for (int o = 1; o < 64; o <<= 1) v = fmaxf(v, __shfl_xor(v, o));
    return v;
}
template <int CTRL> __device__ __forceinline__ float dpp_f(float x) { return __builtin_bit_cast(float, __builtin_amdgcn_mov_dpp(__builtin_bit_cast(int, x), CTRL, 0xf, 0xf, true)); }
__device__ __forceinline__ float xhalf_max(float x) { auto t = __builtin_amdgcn_permlane32_swap(__float_as_uint(x), __float_as_uint(x), false, false); return fmaxf(__uint_as_float(t[0]), __uint_as_float(t[1])); }
__device__ __forceinline__ float xhalf_sum(float x) { auto t = __builtin_amdgcn_permlane32_swap(__float_as_uint(x), __float_as_uint(x), false, false); return __uint_as_float(t[0]) + __uint_as_float(t[1]); }
__device__ __forceinline__ float quad_sum(float x) { x += dpp_f<0xB1>(x); x += dpp_f<0x4E>(x); return x; }
__device__ __forceinline__ float wave_max_fast(float x) {
    x = fmaxf(x, dpp_f<0xB1>(x)); x = fmaxf(x, dpp_f<0x4E>(x)); x = fmaxf(x, dpp_f<0x141>(x)); x = fmaxf(x, dpp_f<0x128>(x));
    auto s = __builtin_amdgcn_permlane16_swap(__float_as_uint(x), __float_as_uint(x), false, false); x = fmaxf(__uint_as_float(s[0]), __uint_as_float(s[1]));
    return xhalf_max(x);
}
__device__ __forceinline__ float wave_sum_fast(float x) {
    x += dpp_f<0xB1>(x); x += dpp_f<0x4E>(x); x += dpp_f<0x141>(x); x += dpp_f<0x128>(x);
    auto s = __builtin_amdgcn_permlane16_swap(__float_as_uint(x), __float_as_uint(x), false, false); x = __uint_as_float(s[0]) + __uint_as_float(s[1]);
    return xhalf_sum(x);
}
__device__ __forceinline__ float bf2f(bf16_t b) { return __uint_as_float(((unsigned)b) << 16); }
#define LAUNDER(x) asm volatile("" : "+v"(x))
#define MFMA32(a, b, c) __builtin_amdgcn_mfma_f32_32x32x16_bf16((a), (b), (c), 0, 0, 0)

namespace pg8 {
constexpr int BM = 256, BK = 64, HALF = 128, HTB = HALF * BK * 2, STAGE_BYTES = 8 * HTB, NXCD = 8, WGM = 8;
__host__ __device__ __forceinline__ int lds_byte(int r, int c) { const int st = (r >> 4) * 2 + (c >> 5), rr = r & 15, cc = c & 31, ob = rr * 64 + cc * 2; return st * 1024 + (ob ^ (((ob >> 9) & 1) << 5)); }
__host__ __device__ __forceinline__ void stage_rc(int b, int& R, int& C) { const int st = b / 1024, sb = b % 1024, swz = sb ^ (((sb >> 9) & 1) << 5); R = (st >> 1) * 16 + swz / 64; C = (st & 1) * 32 + (swz % 64) / 2; }
__host__ __device__ __forceinline__ int perm32(int rho) { const int n = rho >> 4, i = rho & 15; return 8 * (i >> 2) + 4 * n + (i & 3); }

struct Unit { int pm, pn; };
struct Gemm { const bf16_t* A; const bf16_t* Bt; int M, N, K, lda; };

struct StaticOrder {
    int nM, nN, nwg, G, c, lim;
    __device__ __forceinline__ void init(int M, int N, int G_, int c_, int reps = 1) { nM = M / BM; nN = N / BM; nwg = nM * nN; G = G_; c = c_; const int per = (c < nwg) ? (nwg - c + G - 1) / G : 0; lim = per * reps; }
    __device__ __forceinline__ bool next(int i, Unit& u) const {
        if (i >= lim) return false;
        const int per = (nwg - c + G - 1) / G; const long L = (long)(i % per) * G + c;
        int wgid = (int)L; { const int q = nwg / NXCD, r = nwg % NXCD, xcd = wgid % NXCD, off = wgid / NXCD; wgid = (xcd < r ? xcd * (q + 1) : r * (q + 1) + (xcd - r) * q) + off; }
        const int nig = WGM * nN, gid = wgid / nig, fm = gid * WGM, gsz = (nM - fm) < WGM ? (nM - fm) : WGM;
        u.pm = fm + ((wgid % nig) % gsz); u.pn = (wgid % nig) / gsz; return true;
    }
};

struct EpiF32 {
    static constexpr bool PERM = false, FUSED = false;
    float* C; int ldc;
    __device__ __forceinline__ void operator()(const f32x4 (&acc)[2][2][4][2], const Unit& u, int wr, int wc, int fr, int fq) const {
        const int row0 = u.pm * BM + wr * 64 + fr, col0 = u.pn * BM + wc * 32 + 4 * fq;
#pragma unroll
        for (int ai = 0; ai < 2; ++ai)
#pragma unroll
            for (int m = 0; m < 4; ++m) { float* rowp = C + (size_t)(row0 + ai * HALF + m * 16) * ldc + col0;
#pragma unroll
                for (int bj = 0; bj < 2; ++bj)
#pragma unroll
                    for (int n = 0; n < 2; ++n) *(f32x4*)(rowp + bj * HALF + n * 16) = acc[ai][bj][m][n]; }
    }
};

struct EpiBf16 {
    static constexpr bool PERM = true, FUSED = false;
    bf16_t* C; int ldc;
    __device__ __forceinline__ void operator()(const f32x4 (&acc)[2][2][4][2], const Unit& u, int wr, int wc, int fr, int fq) const {
        const int row0 = u.pm * BM + wr * 64 + fr, col0 = u.pn * BM + wc * 32 + 8 * fq;
#pragma unroll
        for (int ai = 0; ai < 2; ++ai)
#pragma unroll
            for (int m = 0; m < 4; ++m) { bf16_t* rowp = C + (size_t)(row0 + ai * HALF + m * 16) * ldc + col0;
#pragma unroll
                for (int bj = 0; bj < 2; ++bj) { const f32x4 v0 = acc[ai][bj][m][0], v1 = acc[ai][bj][m][1];
                    u32x4 w; w.x = cvt_pk_bf16(v0[0], v0[1]); w.y = cvt_pk_bf16(v0[2], v0[3]); w.z = cvt_pk_bf16(v1[0], v1[1]); w.w = cvt_pk_bf16(v1[2], v1[3]);
                    *(u32x4*)(rowp + bj * HALF) = w; } }
    }
};

struct EpiGU {
    static constexpr bool PERM = true, FUSED = false;
    bf16_t* act; const float* rs;
    __device__ __forceinline__ void operator()(const f32x4 (&acc)[2][2][4][2], const Unit& u, int wr, int wc, int fr, int fq) const {
        const int row0 = u.pm * BM + wr * 64 + fr, col0 = u.pn * HALF + wc * 32 + 8 * fq;
        float rrv[2][4];
#pragma unroll
        for (int ai = 0; ai < 2; ++ai)
#pragma unroll
            for (int m = 0; m < 4; ++m) rrv[ai][m] = rs[row0 + ai * HALF + m * 16];
#pragma unroll
        for (int ai = 0; ai < 2; ++ai)
#pragma unroll
            for (int m = 0; m < 4; ++m) {
                const float rr = rrv[ai][m];
                const f32x4 g0 = acc[ai][0][m][0] * rr, g1 = acc[ai][0][m][1] * rr, u0 = acc[ai][1][m][0] * rr, u1 = acc[ai][1][m][1] * rr;
                u32x4 w;
                w.x = cvt_pk_bf16(silu_f(g0[0]) * u0[0], silu_f(g0[1]) * u0[1]); w.y = cvt_pk_bf16(silu_f(g0[2]) * u0[2], silu_f(g0[3]) * u0[3]);
                w.z = cvt_pk_bf16(silu_f(g1[0]) * u1[0], silu_f(g1[1]) * u1[1]); w.w = cvt_pk_bf16(silu_f(g1[2]) * u1[2], silu_f(g1[3]) * u1[3]);
                *(u32x4*)(act + (size_t)(row0 + ai * HALF + m * 16) * DFF + col0) = w;
            }
    }
};

struct EpiCmp1 {
    static constexpr bool PERM = true, FUSED = false;
    bf16_t* hid; const float* cbias;
    __device__ __forceinline__ void operator()(const f32x4 (&acc)[2][2][4][2], const Unit& u, int wr, int wc, int fr, int fq) const {
        const int row0 = u.pm * BM + wr * 64 + fr;
#pragma unroll
        for (int bj = 0; bj < 2; ++bj) {
            const int col0 = bj * HALF + wc * 32 + 8 * fq;
            const f32x4 b0 = *(const f32x4*)(cbias + col0), b1 = *(const f32x4*)(cbias + col0 + 4);
#pragma unroll
            for (int ai = 0; ai < 2; ++ai)
#pragma unroll
                for (int m = 0; m < 4; ++m) {
                    const f32x4 v0 = acc[ai][bj][m][0] + b0, v1 = acc[ai][bj][m][1] + b1;
                    u32x4 w;
                    w.x = cvt_pk_bf16(gelu_tanh(v0[0]), gelu_tanh(v0[1])); w.y = cvt_pk_bf16(gelu_tanh(v0[2]), gelu_tanh(v0[3]));
                    w.z = cvt_pk_bf16(gelu_tanh(v1[0]), gelu_tanh(v1[1])); w.w = cvt_pk_bf16(gelu_tanh(v1[2]), gelu_tanh(v1[3]));
                    *(u32x4*)(hid + (size_t)(row0 + ai * HALF + m * 16) * 256 + col0) = w;
                }
        }
    }
};

struct EpiIn {
    static constexpr bool PERM = true, FUSED = false;
    unsigned char* r1;
    const float* rs;
    __device__ __forceinline__ void operator()(const f32x4 (&acc)[2][2][4][2], const Unit& u, int wr, int wc, int fr, int fq) const {
        const int pn = u.pn;
        float rrv[2][4];
#pragma unroll
        for (int ai = 0; ai < 2; ++ai)
#pragma unroll
            for (int m = 0; m < 4; ++m) rrv[ai][m] = rs[u.pm * BM + ai * HALF + wr * 64 + m * 16 + fr];
#pragma unroll
        for (int ai = 0; ai < 2; ++ai)
#pragma unroll
            for (int m = 0; m < 4; ++m) {
                const int row = u.pm * BM + ai * HALF + wr * 64 + m * 16 + fr;
                const int b = row >> 14, s = row & (S - 1);
                const float rr = rrv[ai][m];
#pragma unroll
                for (int bj = 0; bj < 2; ++bj) {
                    f32x4 v0 = acc[ai][bj][m][0] * rr, v1 = acc[ai][bj][m][1] * rr;
                    const int cw = bj * HALF + wc * 32 + 8 * fq;
                    if (pn < 2) {
                        v0 = v0 * QSCALE; v1 = v1 * QSCALE;
                        u32x4 w; w.x = cvt_pk_bf16(v0[0], v0[1]); w.y = cvt_pk_bf16(v0[2], v0[3]); w.z = cvt_pk_bf16(v1[0], v1[1]); w.w = cvt_pk_bf16(v1[2], v1[3]);
                        *(u32x4*)((bf16_t*)(r1 + R_Q) + (size_t)row * 512 + pn * 256 + cw) = w;
                    } else if (pn < 5) {
                        const int g = wc >> 1, d = (wc & 1) * 32 + 8 * fq, bg = b * 2 + g;
                        if (pn == 2) {
                            bf16_t* base = (bf16_t*)(r1 + (bj == 0 ? R_KC : R_VC));
                            u32x4 w; w.x = cvt_pk_bf16(v0[0], v0[1]); w.y = cvt_pk_bf16(v0[2], v0[3]); w.z = cvt_pk_bf16(v1[0], v1[1]); w.w = cvt_pk_bf16(v1[2], v1[3]);
                            *(u32x4*)(base + ((size_t)bg * S + s) * 64 + d) = w;
                        } else if (pn == 3) {
                            if (bj == 0) {
                                v0 = v0 * 0.25f; v1 = v1 * 0.25f;
                                int w0 = __builtin_amdgcn_cvt_pk_fp8_f32(v0[0], v0[1], 0, false); w0 = __builtin_amdgcn_cvt_pk_fp8_f32(v0[2], v0[3], w0, true);
                                int w1 = __builtin_amdgcn_cvt_pk_fp8_f32(v1[0], v1[1], 0, false); w1 = __builtin_amdgcn_cvt_pk_fp8_f32(v1[2], v1[3], w1, true);
                                u32x2 w; w.x = (unsigned)w0; w.y = (unsigned)w1;
                                *(u32x2*)(r1 + R_KS + (size_t)bg * S * 64 + (size_t)(s >> 6) * 4096 + ((s >> 4) & 3) * 1024 + (((d >> 3) & 3) * 16 + (s & 15)) * 16 + (d >> 5) * 8) = w;
                            } else {
                                const int kb = s & 63, kp = kb >> 5, k32 = kb & 31, fqv = (k32 >> 2) & 3, jj = ((k32 >> 4) << 2) | (k32 & 3);
                                unsigned char* dst = r1 + R_VST + (size_t)bg * S * 64 + (size_t)(s >> 6) * 4096 + (d >> 4) * 1024 + (fqv * 16 + (d & 15)) * 16 + kp * 8 + jj;
                                const int w0 = __builtin_amdgcn_cvt_pk_fp8_f32(v0[0], v0[1], 0, false), w1 = __builtin_amdgcn_cvt_pk_fp8_f32(v0[2], v0[3], 0, false);
                                const int w2 = __builtin_amdgcn_cvt_pk_fp8_f32(v1[0], v1[1], 0, false), w3 = __builtin_amdgcn_cvt_pk_fp8_f32(v1[2], v1[3], 0, false);
                                dst[0] = (unsigned char)(w0 & 0xff); dst[16] = (unsigned char)((w0 >> 8) & 0xff); dst[32] = (unsigned char)(w1 & 0xff); dst[48] = (unsigned char)((w1 >> 8) & 0xff);
                                dst[64] = (unsigned char)(w2 & 0xff); dst[80] = (unsigned char)((w2 >> 8) & 0xff); dst[96] = (unsigned char)(w3 & 0xff); dst[112] = (unsigned char)((w3 >> 8) & 0xff);
                            }
                        } else if (bj == 0) {
                            bf16_t* base = (bf16_t*)(r1 + R_KW);
                            u32x4 w; w.x = cvt_pk_bf16(v0[0], v0[1]); w.y = cvt_pk_bf16(v0[2], v0[3]); w.z = cvt_pk_bf16(v1[0], v1[1]); w.w = cvt_pk_bf16(v1[2], v1[3]);
                            *(u32x4*)(base + (size_t)bg * S * 64 + (size_t)(s >> 5) * 2048 + (d >> 4) * 512 + ((d >> 3) & 1) * 256 + (s & 31) * 8) = w;
                        } else {
                            const int kk = s & 31;
                            bf16_t* dst = (bf16_t*)(r1 + R_VWT) + (size_t)bg * S * 64 + (size_t)(s >> 5) * 2048 + (d >> 5) * 1024 + (kk >> 4) * 512 + ((kk >> 2) & 1) * 256 + (d & 31) * 8 + ((kk >> 3) & 1) * 4 + (kk & 3);
                            const unsigned w0 = cvt_pk_bf16(v0[0], v0[1]), w1 = cvt_pk_bf16(v0[2], v0[3]), w2 = cvt_pk_bf16(v1[0], v1[1]), w3 = cvt_pk_bf16(v1[2], v1[3]);
                            dst[0] = (bf16_t)(w0 & 0xffff); dst[8] = (bf16_t)(w0 >> 16); dst[16] = (bf16_t)(w1 & 0xffff); dst[24] = (bf16_t)(w1 >> 16);
                            dst[32] = (bf16_t)(w2 & 0xffff); dst[40] = (bf16_t)(w2 >> 16); dst[48] = (bf16_t)(w3 & 0xffff); dst[56] = (bf16_t)(w3 >> 16);
                        }
                    } else if (pn < 9) {
                        bf16_t* base = (bf16_t*)(r1 + ((pn < 7) ? R_ZU : R_ZV)); const int ct = (pn < 7) ? (pn - 5) : (pn - 7);
                        u32x4 w;
                        w.x = cvt_pk_bf16(gelu_tanh(v0[0]), gelu_tanh(v0[1])); w.y = cvt_pk_bf16(gelu_tanh(v0[2]), gelu_tanh(v0[3]));
                        w.z = cvt_pk_bf16(gelu_tanh(v1[0]), gelu_tanh(v1[1])); w.w = cvt_pk_bf16(gelu_tanh(v1[2]), gelu_tanh(v1[3]));
                        *(u32x4*)(base + (size_t)row * 512 + ct * 256 + cw) = w;
                    } else {
                        if (bj == 0 && wc == 0 && fq < 3) {
                            float* gp = (float*)(r1 + R_GATES) + (size_t)row * 24 + 8 * fq;
                            *(f32x4*)gp = (f32x4){sigmoid_f(v0[0]), sigmoid_f(v0[1]), sigmoid_f(v0[2]), sigmoid_f(v0[3])};
                            *(f32x4*)(gp + 4) = (f32x4){sigmoid_f(v1[0]), sigmoid_f(v1[1]), sigmoid_f(v1[2]), sigmoid_f(v1[3])};
                        }
                    }
                }
            }
    }
};

struct EpiNormRes {
    static constexpr bool PERM = true, FUSED = true;
    unsigned char* ws; const float* gpost; float* fout; int inst;
    __device__ __forceinline__ void exchange(int e, float (&sv)[2][4], float (&rv)[2][4], const Unit& u, int wr, int wc, int fr, int fq, LAS unsigned char* lds, int wid, int lane) const {
        LAS float* P = (LAS float*)(lds + 131072);
        LAS float* Sx = P + 1024;
        float* xbuf = (float*)(ws + WS_XBUF) + (size_t)e * MT * 4;
        unsigned* cnt = (unsigned*)(ws + WS_XCNT) + ((size_t)(e * 8 + inst) * 128 + u.pm) * 16;
#pragma unroll
        for (int ai = 0; ai < 2; ++ai)
#pragma unroll
            for (int m = 0; m < 4; ++m) {
                float v = sv[ai][m];
                { auto t1 = __builtin_amdgcn_permlane16_swap(__float_as_uint(v), __float_as_uint(v), false, false); v = __uint_as_float(t1[0]) + __uint_as_float(t1[1]); }
                v = xhalf_sum(v);
                if (fq == 0) P[(ai * HALF + wr * 64 + m * 16 + fr) * 4 + wc] = v;
            }
        asm volatile("s_waitcnt lgkmcnt(0)" ::: "memory"); __builtin_amdgcn_s_barrier(); asm volatile("" ::: "memory");
        const int tid = wid * 64 + lane;
        if (tid < 256) {
            const f32x4 pp = *(const LAS f32x4*)(P + tid * 4);
            __hip_atomic_store(xbuf + ((size_t)u.pm * 256 + tid) * 4 + u.pn, (pp[0] + pp[1]) + (pp[2] + pp[3]), __ATOMIC_RELAXED, __HIP_MEMORY_SCOPE_AGENT);
        }
        asm volatile("s_waitcnt vmcnt(0)" ::: "memory");
        if (wid < 4 && lane == 0) __hip_atomic_fetch_add(cnt, 1u, __ATOMIC_RELAXED, __HIP_MEMORY_SCOPE_AGENT);
        if (wid == 0) {
            unsigned sp = 0;
            while ((unsigned)__builtin_amdgcn_readfirstlane(__hip_atomic_load(cnt, __ATOMIC_RELAXED, __HIP_MEMORY_SCOPE_AGENT)) < 16u) { __builtin_amdgcn_s_sleep(2); if (++sp > (1u << 22)) break; }
            __builtin_amdgcn_fence(__ATOMIC_ACQUIRE, "agent");
        }
        asm volatile("s_waitcnt vmcnt(0) lgkmcnt(0)" ::: "memory"); __builtin_amdgcn_s_barrier(); asm volatile("" ::: "memory");
        if (tid < 256) {
            const float* sl = xbuf + ((size_t)u.pm * 256 + tid) * 4;
            const float t0 = __hip_atomic_load(sl + 0, __ATOMIC_RELAXED, __HIP_MEMORY_SCOPE_AGENT), t1 = __hip_atomic_load(sl + 1, __ATOMIC_RELAXED, __HIP_MEMORY_SCOPE_AGENT);
            const float t2 = __hip_atomic_load(sl + 2, __ATOMIC_RELAXED, __HIP_MEMORY_SCOPE_AGENT), t3 = __hip_atomic_load(sl + 3, __ATOMIC_RELAXED, __HIP_MEMORY_SCOPE_AGENT);
            Sx[tid] = 1.0f / sqrtf(((t0 + t1) + (t2 + t3)) * (1.0f / 1024.0f) + RMS_EPS);
        }
        asm volatile("s_waitcnt vmcnt(0) lgkmcnt(0)" ::: "memory"); __builtin_amdgcn_s_barrier(); asm volatile("" ::: "memory");
#pragma unroll
        for (int ai = 0; ai < 2; ++ai)
#pragma unroll
            for (int m = 0; m < 4; ++m) rv[ai][m] = Sx[ai * HALF + wr * 64 + m * 16 + fr];
    }
    __device__ __forceinline__ void fused(f32x4 (&acc)[2][2][4][2], const Unit& u, int wr, int wc, int fr, int fq, LAS unsigned char* lds, int wid, int lane) const {
        bf16_t* hb = (bf16_t*)(ws + WS_HB);
        const int row0 = u.pm * BM + wr * 64 + fr, col0 = u.pn * BM + wc * 32 + 8 * fq;
        float sv[2][4], rv[2][4];
#pragma unroll
        for (int ai = 0; ai < 2; ++ai)
#pragma unroll
            for (int m = 0; m < 4; ++m) {
                float q = 0.f;
#pragma unroll
                for (int bj = 0; bj < 2; ++bj)
#pragma unroll
                    for (int n = 0; n < 2; ++n) { const f32x4 x = acc[ai][bj][m][n]; q += (x[0] * x[0] + x[1] * x[1]) + (x[2] * x[2] + x[3] * x[3]); }
                sv[ai][m] = q;
            }
        exchange(0, sv, rv, u, wr, wc, fr, fq, lds, wid, lane);
        float dep = 0.f;
#pragma unroll
        for (int ai = 0; ai < 2; ++ai)
#pragma unroll
            for (int m = 0; m < 4; ++m) {
                const bf16_t* hrow = hb + (size_t)(row0 + ai * HALF + m * 16) * DM + col0;
                asm volatile("" : "+v"(hrow) : "v"(dep));
                const float r1 = rv[ai][m];
                float q = 0.f;
#pragma unroll
                for (int bj = 0; bj < 2; ++bj) {
                    const u32x4 hv = *(const u32x4*)(hrow + bj * HALF);
                    const f32x4 h0 = (f32x4){__uint_as_float(hv.x << 16), __uint_as_float(hv.x & 0xffff0000u), __uint_as_float(hv.y << 16), __uint_as_float(hv.y & 0xffff0000u)};
                    const f32x4 h1 = (f32x4){__uint_as_float(hv.z << 16), __uint_as_float(hv.z & 0xffff0000u), __uint_as_float(hv.w << 16), __uint_as_float(hv.w & 0xffff0000u)};
                    const f32x4 gg0 = *(const f32x4*)(gpost + col0 + bj * HALF), gg1 = *(const f32x4*)(gpost + col0 + bj * HALF + 4);
                    f32x4 x0 = h0 + acc[ai][bj][m][0] * r1 * gg0, x1 = h1 + acc[ai][bj][m][1] * r1 * gg1;
                    acc[ai][bj][m][0] = x0; acc[ai][bj][m][1] = x1;
                    q += ((x0[0] * x0[0] + x0[1] * x0[1]) + (x0[2] * x0[2] + x0[3] * x0[3])) + ((x1[0] * x1[0] + x1[1] * x1[1]) + (x1[2] * x1[2] + x1[3] * x1[3]));
                }
                sv[ai][m] = q;
                dep = q;
            }
        if (fout) {
#pragma unroll
            for (int ai = 0; ai < 2; ++ai)
#pragma unroll
                for (int m = 0; m < 4; ++m) { float* orow = fout + (size_t)(row0 + ai * HALF + m * 16) * DM + col0;
#pragma unroll
                    for (int bj = 0; bj < 2; ++bj) { *(f32x4*)(orow + bj * HALF) = acc[ai][bj][m][0]; *(f32x4*)(orow + bj * HALF + 4) = acc[ai][bj][m][1]; } }
            return;
        }
        exchange(1, sv, rv, u, wr, wc, fr, fq, lds, wid, lane);
        float* rs = (float*)(ws + WS_RS);
#pragma unroll
        for (int ai = 0; ai < 2; ++ai)
#pragma unroll
            for (int m = 0; m < 4; ++m) {
                bf16_t* hrow = hb + (size_t)(row0 + ai * HALF + m * 16) * DM + col0;
#pragma unroll
                for (int bj = 0; bj < 2; ++bj) { const f32x4 x0 = acc[ai][bj][m][0], x1 = acc[ai][bj][m][1];
                    u32x4 w; w.x = cvt_pk_bf16(x0[0], x0[1]); w.y = cvt_pk_bf16(x0[2], x0[3]); w.z = cvt_pk_bf16(x1[0], x1[1]); w.w = cvt_pk_bf16(x1[2], x1[3]);
                    *(u32x4*)(hrow + bj * HALF) = w; }
                if (u.pn == 0 && wc == 0 && fq == 0) rs[row0 + ai * HALF + m * 16] = rv[ai][m];
            }
    }
};

template <class Epi>
__device__ __forceinline__ void gemm_phase(LAS unsigned char* lds, const Gemm g, const StaticOrder& S, const Epi& E) {
    int tid = threadIdx.x; LAUNDER(tid);
    const int wid = __builtin_amdgcn_readfirstlane(tid >> 6), lane = tid & 63, wr = wid >> 2, wc = wid & 3, fr = lane & 15, fq = lane >> 4;
    const int K = g.K, nt = K / BK, lda = g.lda;
    unsigned voffA[2], voffB[2];
#pragma unroll
    for (int i = 0; i < 2; ++i) { int R, C; stage_rc(tid * 16 + i * 8192, R, C); const int Rb = Epi::PERM ? ((R & ~31) + perm32(R & 31)) : R;
        voffA[i] = (unsigned)(R * lda + C) * 2u; voffB[i] = (unsigned)(Rb * K + C) * 2u; }
    const size_t kstep = (size_t)(BK * 2);
    const size_t hA = (size_t)HALF * lda * 2, hB = (size_t)HALF * K * 2;
    const size_t tA = 2 * hA, tB = 2 * hB;
    const unsigned ldsw = (unsigned)wid * 1024u;
    const int aoff = lds_byte(wr * 64 + fr, fq * 8), boff = lds_byte(wc * 32 + fr, fq * 8);
#define PG8_SA(b, h) (((b) * 2 + (h)) * HTB)
#define PG8_SB(b, h) ((4 + (b) * 2 + (h)) * HTB)
#define PG8_STAGE(bufoff, gbase, voff) do { _Pragma("unroll") for (int _i = 0; _i < 2; ++_i) \
        __builtin_amdgcn_global_load_lds((const unsigned*)((const char*)(gbase) + (voff)[_i]), (LAS unsigned*)(lds + (bufoff) + ldsw + _i * 8192), 16, 0, 0); } while (0)
#define PG8_LDA(dst, b, h) do { _Pragma("unroll") for (int m = 0; m < 4; ++m) _Pragma("unroll") for (int k = 0; k < 2; ++k) dst[m][k] = *(const LAS bf16x8*)(lds + PG8_SA(b, h) + aoff + m * 2048 + k * 1024); } while (0)
#define PG8_LDB(dst, b, h) do { _Pragma("unroll") for (int n = 0; n < 2; ++n) _Pragma("unroll") for (int k = 0; k < 2; ++k) dst[n][k] = *(const LAS bf16x8*)(lds + PG8_SB(b, h) + boff + n * 2048 + k * 1024); } while (0)
#define PG8_MMA(ai, bj, At, Bt) do { __builtin_amdgcn_s_setprio(1); _Pragma("unroll") for (int m = 0; m < 4; ++m) _Pragma("unroll") for (int n = 0; n < 2; ++n) _Pragma("unroll") for (int k = 0; k < 2; ++k) \
        acc[ai][bj][m][n] = __builtin_amdgcn_mfma_f32_16x16x32_bf16(Bt[n][k], At[m][k], acc[ai][bj][m][n], 0, 0, 0); __builtin_amdgcn_s_setprio(0); } while (0)
#define PG8_WAIT_V(n) asm volatile("s_waitcnt vmcnt(" #n ")" ::: "memory")
#define PG8_WAIT_L(n) asm volatile("s_waitcnt lgkmcnt(" #n ")" ::: "memory")
#define PG8_BAR __builtin_amdgcn_s_barrier()
#define PG8_SCHED __builtin_amdgcn_sched_barrier(0)
    Unit cur, nxt; int ui = 0;
    if (!S.next(0, cur)) return;
    f32x4 acc[2][2][4][2];
#pragma unroll
    for (int a = 0; a < 2; ++a)
#pragma unroll
        for (int b = 0; b < 2; ++b)
#pragma unroll
            for (int m = 0; m < 4; ++m)
#pragma unroll
                for (int n = 0; n < 2; ++n) acc[a][b][m][n] = (f32x4){0.f, 0.f, 0.f, 0.f};
    bf16x8 At[4][2], B0[2][2], B1[2][2];
    const char* cA = (const char*)g.A + (size_t)cur.pm * tA; const char* cB = (const char*)g.Bt + (size_t)cur.pn * tB;
    PG8_STAGE(PG8_SB(0, 0), cB, voffB); PG8_STAGE(PG8_SB(0, 1), cB + hB, voffB); PG8_STAGE(PG8_SA(0, 0), cA, voffA); PG8_STAGE(PG8_SA(0, 1), cA + hA, voffA);
    if (wr == 1) PG8_BAR;
    PG8_WAIT_V(2); PG8_BAR;
    PG8_STAGE(PG8_SB(1, 0), cB + kstep, voffB); PG8_STAGE(PG8_SA(1, 0), cA + kstep, voffA); PG8_STAGE(PG8_SB(1, 1), cB + hB + kstep, voffB);
    PG8_WAIT_V(6); PG8_BAR;
    for (;;) {
        const bool has_next = S.next(ui + 1, nxt);
        const char* nA = has_next ? (const char*)g.A + (size_t)nxt.pm * tA : cA; const char* nB = has_next ? (const char*)g.Bt + (size_t)nxt.pn * tB : cB;
        for (int t = 0; t < nt; t += 2) {
            const bool last = (t == nt - 2);
            const char* a1 = cA + (size_t)(t + 1) * kstep;
            const char* a2 = last ? nA : cA + (size_t)(t + 2) * kstep; const char* b2 = last ? nB : cB + (size_t)(t + 2) * kstep;
            const char* a3 = a2 + kstep; const char* b3 = b2 + kstep;
            PG8_LDB(B0, 0, 0); PG8_LDB(B1, 0, 1); PG8_SCHED; PG8_LDA(At, 0, 0); PG8_STAGE(PG8_SA(1, 1), a1 + hA, voffA);
            PG8_WAIT_V(8); PG8_WAIT_L(0); PG8_BAR; PG8_MMA(0, 0, At, B0); PG8_MMA(0, 1, At, B1); PG8_BAR; PG8_SCHED;
            PG8_LDA(At, 0, 1); PG8_STAGE(PG8_SB(0, 0), b2, voffB); PG8_STAGE(PG8_SB(0, 1), b2 + hB, voffB); PG8_STAGE(PG8_SA(0, 0), a2, voffA);
            PG8_WAIT_V(8); PG8_WAIT_L(0); PG8_BAR; PG8_MMA(1, 0, At, B0); PG8_MMA(1, 1, At, B1); PG8_BAR; PG8_SCHED;
            PG8_LDB(B0, 1, 0); PG8_LDB(B1, 1, 1); PG8_SCHED; PG8_LDA(At, 1, 0); PG8_STAGE(PG8_SA(0, 1), a2 + hA, voffA);
            PG8_WAIT_V(8); PG8_WAIT_L(0); PG8_BAR; PG8_MMA(0, 0, At, B0); PG8_MMA(0, 1, At, B1); PG8_BAR; PG8_SCHED;
            PG8_LDA(At, 1, 1); PG8_STAGE(PG8_SB(1, 0), b3, voffB); PG8_STAGE(PG8_SB(1, 1), b3 + hB, voffB); PG8_STAGE(PG8_SA(1, 0), a3, voffA);
            PG8_WAIT_V(8); PG8_WAIT_L(0); PG8_BAR; PG8_MMA(1, 0, At, B0); PG8_MMA(1, 1, At, B1); PG8_BAR; PG8_SCHED;
        }
        if (wr == 0) PG8_BAR;
        if constexpr (Epi::FUSED) E.fused(acc, cur, wr, wc, fr, fq, lds, wid, lane); else E(acc, cur, wr, wc, fr, fq);
        if (!has_next) break;
#pragma unroll
        for (int a = 0; a < 2; ++a)
#pragma unroll
            for (int b = 0; b < 2; ++b)
#pragma unroll
                for (int m = 0; m < 4; ++m)
#pragma unroll
                    for (int n = 0; n < 2; ++n) acc[a][b][m][n] = (f32x4){0.f, 0.f, 0.f, 0.f};
        cur = nxt; cA = nA; cB = nB; ++ui;
        if (wr == 1) PG8_BAR;
    }
    PG8_WAIT_V(0);
    PG8_BAR;
#undef PG8_SA
#undef PG8_SB
#undef PG8_STAGE
#undef PG8_LDA
#undef PG8_LDB
#undef PG8_MMA
#undef PG8_WAIT_V
#undef PG8_WAIT_L
#undef PG8_BAR
#undef PG8_SCHED
}
}

template <int MAP> __device__ __forceinline__ int src_col(int n) {
    if (MAP == 0) return n;
    if (MAP == 1) { if (n < 1280) return n; if (n < 2304) return n + 24; if (n < 2328) return n - 1024; return -1; }
    const int t = n >> 8, w = n & 255; return (w < 128) ? (128 * t + w) : (DFF + 128 * t + (w - 128));
}
constexpr int TP = 65;
template <int MAP> __device__ __forceinline__ void transpose_item(const float* W, int K, int Nsrc, bf16_t* WT, int nblk, int item, LAS float* scr, int lane, const float* gain = nullptr) {
    const int kb = item / nblk, nb = item % nblk, k0 = 64 * kb, n0 = 64 * nb;
    const int nl = 4 * (lane & 15), kr = lane >> 4;
    const int ns = src_col<MAP>(n0 + nl);
    f32x4 v[16];
#pragma unroll
    for (int i = 0; i < 16; ++i) v[i] = (ns >= 0) ? *(const f32x4*)(W + (size_t)(k0 + kr + 4 * i) * Nsrc + ns) : (f32x4){0.f, 0.f, 0.f, 0.f};
    if (gain) {
#pragma unroll
        for (int i = 0; i < 16; ++i) v[i] = v[i] * gain[k0 + kr + 4 * i];
    }
#pragma unroll
    for (int i = 0; i < 16; ++i) { LAS float* d = scr + (kr + 4 * i) * TP + nl; d[0] = v[i][0]; d[1] = v[i][1]; d[2] = v[i][2]; d[3] = v[i][3]; }
    asm volatile("s_waitcnt lgkmcnt(0)" ::: "memory");
    __builtin_amdgcn_wave_barrier();
    const int c = lane & 7;
#pragma unroll
    for (int j = 0; j < 8; ++j) { const int n = (lane >> 3) + 8 * j; const LAS float* s = scr + (8 * c) * TP + n;
        u32x4 o; o.x = cvt_pk_bf16(s[0 * TP], s[1 * TP]); o.y = cvt_pk_bf16(s[2 * TP], s[3 * TP]); o.z = cvt_pk_bf16(s[4 * TP], s[5 * TP]); o.w = cvt_pk_bf16(s[6 * TP], s[7 * TP]);
        *(u32x4*)(WT + (size_t)(n0 + n) * K + k0 + 8 * c) = o; }
    asm volatile("s_waitcnt lgkmcnt(0)" ::: "memory");
    __builtin_amdgcn_wave_barrier();
}

__device__ __forceinline__ void row_pass(const float* x0, bf16_t* hb, const bf16_t* mix, const float* gpost, float* rs, float* fout, int gw, int NGW, int lane) {
    LAUNDER(lane);
    if (x0) {
        for (int m = gw; m < MT; m += NGW) {
            const f32x4* hr = (const f32x4*)(x0 + (size_t)m * DM) + lane;
            f32x4 h[4]; float s2 = 0.f;
#pragma unroll
            for (int j = 0; j < 4; ++j) { h[j] = hr[64 * j]; s2 += (h[j][0] * h[j][0] + h[j][1] * h[j][1]) + (h[j][2] * h[j][2] + h[j][3] * h[j][3]); }
            const float r2 = 1.0f / sqrtf(wave_sum_fast(s2) * (1.0f / DM) + RMS_EPS);
            u32x2* ao = (u32x2*)(hb + (size_t)m * DM) + lane;
#pragma unroll
            for (int j = 0; j < 4; ++j) { u32x2 w; w.x = cvt_pk_bf16(h[j][0], h[j][1]); w.y = cvt_pk_bf16(h[j][2], h[j][3]); ao[64 * j] = w; }
            if (lane == 0) rs[m] = r2;
        }
        return;
    }
    u32x2 hn[4], mn[4];
    if (gw < MT) {
        const u32x2* hr = (const u32x2*)(hb + (size_t)gw * DM) + lane; const u32x2* mr = (const u32x2*)(mix + (size_t)gw * DM) + lane;
#pragma unroll
        for (int j = 0; j < 4; ++j) { hn[j] = hr[64 * j]; mn[j] = mr[64 * j]; }
    }
    for (int m = gw; m < MT; m += NGW) {
        u32x2 hv[4], mv[4];
#pragma unroll
        for (int j = 0; j < 4; ++j) { hv[j] = hn[j]; mv[j] = mn[j]; }
        const int m2 = m + NGW;
        if (m2 < MT) {
            const u32x2* hr = (const u32x2*)(hb + (size_t)m2 * DM) + lane; const u32x2* mr = (const u32x2*)(mix + (size_t)m2 * DM) + lane;
#pragma unroll
            for (int j = 0; j < 4; ++j) { hn[j] = hr[64 * j]; mn[j] = mr[64 * j]; }
        }
        f32x4 h[4], x[4]; float ss = 0.f;
#pragma unroll
        for (int j = 0; j < 4; ++j) {
            h[j] = (f32x4){__uint_as_float(hv[j].x << 16), __uint_as_float(hv[j].x & 0xffff0000u), __uint_as_float(hv[j].y << 16), __uint_as_float(hv[j].y & 0xffff0000u)};
            x[j] = (f32x4){__uint_as_float(mv[j].x << 16), __uint_as_float(mv[j].x & 0xffff0000u), __uint_as_float(mv[j].y << 16), __uint_as_float(mv[j].y & 0xffff0000u)};
            ss += (x[j][0] * x[j][0] + x[j][1] * x[j][1]) + (x[j][2] * x[j][2] + x[j][3] * x[j][3]);
        }
        const float r1 = 1.0f / sqrtf(wave_sum_fast(ss) * (1.0f / DM) + RMS_EPS);
        float s2 = 0.f;
#pragma unroll
        for (int j = 0; j < 4; ++j) { const f32x4 gp = *((const f32x4*)gpost + lane + 64 * j); h[j] = h[j] + x[j] * r1 * gp; s2 += (h[j][0] * h[j][0] + h[j][1] * h[j][1]) + (h[j][2] * h[j][2] + h[j][3] * h[j][3]); }
        if (fout) {
            f32x4* ho = (f32x4*)(fout + (size_t)m * DM) + lane;
#pragma unroll
            for (int j = 0; j < 4; ++j) ho[64 * j] = h[j];
        } else {
            const float r2 = 1.0f / sqrtf(wave_sum_fast(s2) * (1.0f / DM) + RMS_EPS);
            u32x2* ao = (u32x2*)(hb + (size_t)m * DM) + lane;
#pragma unroll
            for (int j = 0; j < 4; ++j) { u32x2 w; w.x = cvt_pk_bf16(h[j][0], h[j][1]); w.y = cvt_pk_bf16(h[j][2], h[j][3]); ao[64 * j] = w; }
            if (lane == 0) rs[m] = r2;
        }
    }
}

constexpr int ZPITCH = 136;
__device__ __forceinline__ void gmlp_unit(const Params& p, int layer, int chunk, LAS unsigned char* lds, int wave, int lane) {
    LAUNDER(lane);
    const unsigned char* ws = P_ws(p);
    const bf16_t* zu = (const bf16_t*)(ws + WS_R1 + R_ZU); const bf16_t* zv = (const bf16_t*)(ws + WS_R1 + R_ZV);
    bf16_t* mixed = (bf16_t*)(ws + WS_AN);
    const float* ln_g = P_in(p, 13) + layer * 512; const float* ln_b = P_in(p, 14) + layer * 512;
    const float* w_s = P_in(p, 15) + (size_t)layer * 8 * 128 * 128 + (size_t)wave * 128 * 128;
    const float* b_s = P_in(p, 16) + layer * 8 * 128 + wave * 128;
    LAS float* stats = (LAS float*)(lds + 8 * 64 * ZPITCH * 2);
    LAS bf16_t* zt = (LAS bf16_t*)(lds + wave * 64 * ZPITCH * 2);
    const int tok0 = chunk * 128;
    __syncthreads();
    {
        bf16x8 sv[16];
#pragma unroll
        for (int i = 0; i < 16; ++i) sv[i] = *(const bf16x8*)(zv + (size_t)(tok0 + wave * 16 + i) * 512 + lane * 8);
        asm volatile("" ::: "memory");
        float mn[16], rs16[16];
#pragma unroll
        for (int i = 0; i < 16; ++i) {
            float s = 0.f, s2 = 0.f;
#pragma unroll
            for (int e = 0; e < 8; ++e) { const float x = bf2f((bf16_t)sv[i][e]); s += x; s2 += x * x; }
            s = wave_sum_fast(s); s2 = wave_sum_fast(s2);
            const float mean = s * (1.0f / 512.0f); const float var = fmaxf(s2 * (1.0f / 512.0f) - mean * mean, 0.f);
            mn[i] = mean; rs16[i] = 1.0f / sqrtf(var + LN_EPS);
        }
        if (lane == 0) {
#pragma unroll
            for (int i = 0; i < 16; ++i) { stats[2 * (wave * 16 + i)] = mn[i]; stats[2 * (wave * 16 + i) + 1] = rs16[i]; }
        }
    }
    __syncthreads();
    {
        const int dc = lane & 7, d0 = dc * 8;
        const f32x4 g0 = *(const f32x4*)(ln_g + wave * 64 + d0), g1 = *(const f32x4*)(ln_g + wave * 64 + d0 + 4);
        const f32x4 b0 = *(const f32x4*)(ln_b + wave * 64 + d0), b1 = *(const f32x4*)(ln_b + wave * 64 + d0 + 4);
        bf16x8 zq[16];
#pragma unroll
        for (int i = 0; i < 16; ++i) zq[i] = *(const bf16x8*)(zv + (size_t)(tok0 + (lane >> 3) + 8 * i) * 512 + wave * 64 + d0);
#pragma unroll
        for (int i = 0; i < 16; ++i) {
            const int s = (lane >> 3) + 8 * i;
            const float mean = stats[2 * s], rstd = stats[2 * s + 1];
#pragma unroll
            for (int e = 0; e < 8; ++e) {
                const float gg = (e < 4) ? g0[e & 3] : g1[e & 3], bb = (e < 4) ? b0[e & 3] : b1[e & 3];
                const float y = (bf2f((bf16_t)zq[i][e]) - mean) * rstd * gg + bb;
                zt[(d0 + e) * ZPITCH + s] = (bf16_t)(cvt_pk_bf16(y, 0.f) & 0xffff);
            }
        }
    }
    asm volatile("s_waitcnt lgkmcnt(0)" ::: "memory");
    __builtin_amdgcn_wave_barrier();
    const int r = lane & 31, h = lane >> 5;
#pragma unroll
    for (int mt = 0; mt < 4; ++mt) {
        f32x16 acc0, acc1;
#pragma unroll
        for (int i = 0; i < 16; ++i) { acc0[i] = 0.f; acc1[i] = 0.f; }
        const int t = 32 * mt + r;
        const size_t rowoff = (size_t)(tok0 + t) * 512 + wave * 64;
        f32x4 wq[8][2]; u32x2 zz[2][4];
#pragma unroll
        for (int ks = 0; ks < 2 * (mt + 1); ++ks) { wq[ks][0] = *(const f32x4*)(w_s + (size_t)t * 128 + 16 * ks + 8 * h); wq[ks][1] = *(const f32x4*)(w_s + (size_t)t * 128 + 16 * ks + 8 * h + 4); }
#pragma unroll
        for (int dt = 0; dt < 2; ++dt)
#pragma unroll
            for (int i4 = 0; i4 < 4; ++i4) zz[dt][i4] = *(const u32x2*)(zu + rowoff + 32 * dt + 8 * i4 + 4 * h);
        const float bs = b_s[t];
#pragma unroll
        for (int ks = 0; ks < 2 * (mt + 1); ++ks) {
            const int s0 = 16 * ks + 8 * h;
            const f32x4 w0 = wq[ks][0], w1 = wq[ks][1];
            float wv[8] = {w0[0], w0[1], w0[2], w0[3], w1[0], w1[1], w1[2], w1[3]};
#pragma unroll
            for (int e = 0; e < 8; ++e) wv[e] = (s0 + e <= t) ? wv[e] : 0.f;
            u32x4 wb; wb.x = cvt_pk_bf16(wv[0], wv[1]); wb.y = cvt_pk_bf16(wv[2], wv[3]); wb.z = cvt_pk_bf16(wv[4], wv[5]); wb.w = cvt_pk_bf16(wv[6], wv[7]);
            const bf16x8 bfrag = __builtin_bit_cast(bf16x8, wb);
            const bf16x8 a0 = *(const LAS bf16x8*)(zt + (r) * ZPITCH + s0);
            const bf16x8 a1 = *(const LAS bf16x8*)(zt + (32 + r) * ZPITCH + s0);
            acc0 = MFMA32(a0, bfrag, acc0);
            acc1 = MFMA32(a1, bfrag, acc1);
        }
        bf16_t* mrow = mixed + (size_t)(tok0 + t) * 1024 + 512 + wave * 64;
#pragma unroll
        for (int dt = 0; dt < 2; ++dt)
#pragma unroll
            for (int i4 = 0; i4 < 4; ++i4) {
                const int d = 32 * dt + 8 * i4 + 4 * h;
                const u32x2 zv2 = zz[dt][i4];
                const float z0 = __uint_as_float(zv2.x << 16), z1 = __uint_as_float(zv2.x & 0xffff0000u), z2 = __uint_as_float(zv2.y << 16), z3 = __uint_as_float(zv2.y & 0xffff0000u);
                const f32x16& a = dt ? acc1 : acc0;
                u32x2 o; o.x = cvt_pk_bf16(z0 * (a[4 * i4] + bs), z1 * (a[4 * i4 + 1] + bs)); o.y = cvt_pk_bf16(z2 * (a[4 * i4 + 2] + bs), z3 * (a[4 * i4 + 3] + bs));
                *(u32x2*)(mrow + d) = o;
            }
    }
}

__device__ __forceinline__ void cmp_gemm2(const bf16_t* hidden, const bf16_t* w2t, bf16_t* kcmp, bf16_t* vcmpT, int kv, int row0, int lane) {
    LAUNDER(lane);
    const int r = lane & 31, h = lane >> 5;
    f32x16 acc[2];
#pragma unroll
    for (int i = 0; i < 16; ++i) { acc[0][i] = 0.f; acc[1][i] = 0.f; }
#pragma unroll
    for (int ks = 0; ks < 16; ++ks) {
        const bf16x8 hf = *(const bf16x8*)(hidden + (size_t)(row0 + r) * 256 + ks * 16 + h * 8);
#pragma unroll
        for (int dt = 0; dt < 2; ++dt) {
            const bf16x8 wf = *(const bf16x8*)(w2t + (size_t)(dt * 32 + r) * 256 + ks * 16 + h * 8);
            if (kv == 0) acc[dt] = MFMA32(wf, hf, acc[dt]);
            else         acc[dt] = MFMA32(hf, wf, acc[dt]);
        }
    }
#pragma unroll
    for (int dt = 0; dt < 2; ++dt)
#pragma unroll
        for (int i4 = 0; i4 < 4; ++i4) {
            u32x2 o; o.x = cvt_pk_bf16(acc[dt][4 * i4], acc[dt][4 * i4 + 1]); o.y = cvt_pk_bf16(acc[dt][4 * i4 + 2], acc[dt][4 * i4 + 3]);
            if (kv == 0) *(u32x2*)(kcmp + (size_t)(row0 >> 5) * 2048 + (dt * 2 + (i4 >> 1)) * 512 + (i4 & 1) * 256 + r * 8 + 4 * h) = o;
            else         *(u32x2*)(vcmpT + (size_t)(row0 >> 5) * 2048 + dt * 1024 + (i4 >> 1) * 512 + h * 256 + r * 8 + (i4 & 1) * 4) = o;
        }
}

constexpr int NSA_WAVE_LDS = 19456;
constexpr float NEG_INF = -__builtin_inff();

__device__ __forceinline__ void load_k(bf16x8 (&kf)[4], const bf16_t* Kt, int lane) {
    const int r = lane & 31, h = lane >> 5;
#pragma unroll
    for (int ks = 0; ks < 4; ++ks) kf[ks] = *(const bf16x8*)(Kt + ks * 512 + lane * 8);
}
__device__ __forceinline__ void load_v(bf16x8 (&vf)[2][2], const bf16_t* vT, int lane) {
    const int r = lane & 31, h = lane >> 5;
#pragma unroll
    for (int dt = 0; dt < 2; ++dt)
#pragma unroll
        for (int s = 0; s < 2; ++s) vf[dt][s] = *(const bf16x8*)(vT + dt * 1024 + s * 512 + lane * 8);
}
__device__ __forceinline__ f32x16 qk_tile(const bf16x8 (&kf)[4], const bf16x8 (&qf)[4]) {
    f32x16 s;
#pragma unroll
    for (int i = 0; i < 16; ++i) s[i] = 0.f;
#pragma unroll
    for (int ks = 0; ks < 4; ++ks) s = MFMA32(kf[ks], qf[ks], s);
    return s;
}
template <int STRIDE> __device__ __forceinline__ void score_tile(f32x16& s, int dl, int dmax, bool lane_ok, bool fast, float lutfar, const LAS float* lutr) {
    if (fast) {
#pragma unroll
        for (int i = 0; i < 16; ++i) s[i] = lane_ok ? (s[i] + lutfar) : NEG_INF;
    } else {
#pragma unroll
        for (int i = 0; i < 16; ++i) {
            const int d = dl - STRIDE * ((i & 3) + 8 * (i >> 2));
            const bool ok = lane_ok && d >= 0 && d < dmax;
            const int di = min(max(d, 0), 128);
            s[i] = ok ? (s[i] + lutr[di]) : NEG_INF;
        }
    }
}
__device__ __forceinline__ void pv_tile(f32x16& o0, f32x16& o1, const f32x16& pr, const bf16x8 (&vf)[2][2]) {
#pragma unroll
    for (int s = 0; s < 2; ++s) {
        u32x4 pk; pk.x = cvt_pk_bf16(pr[8 * s], pr[8 * s + 1]); pk.y = cvt_pk_bf16(pr[8 * s + 2], pr[8 * s + 3]); pk.z = cvt_pk_bf16(pr[8 * s + 4], pr[8 * s + 5]); pk.w = cvt_pk_bf16(pr[8 * s + 6], pr[8 * s + 7]);
        const bf16x8 pb = __builtin_bit_cast(bf16x8, pk);
        o0 = MFMA32(vf[0][s], pb, o0);
        o1 = MFMA32(vf[1][s], pb, o1);
    }
}
template <bool FAST> __device__ __forceinline__ void online_step(f32x16& s, float bias, bool lane_ok, float& m, float& l, f32x16& o0, f32x16& o1, const bf16x8 (&vf)[2][2]) {
    float mx = fmaxf(fmaxf(fmaxf(s[0], s[1]), fmaxf(s[2], s[3])), fmaxf(fmaxf(s[4], s[5]), fmaxf(s[6], s[7])));
    mx = fmaxf(mx, fmaxf(fmaxf(fmaxf(s[8], s[9]), fmaxf(s[10], s[11])), fmaxf(fmaxf(s[12], s[13]), fmaxf(s[14], s[15]))));
    if (FAST) { mx += bias; mx = lane_ok ? mx : NEG_INF; }
    mx = xhalf_max(mx);
    if (__any(mx > m + 8.0f)) {
        const float mnew = (mx > m + 8.0f) ? mx : m;
        const float alpha = fast_exp2(m - mnew);
        l *= alpha; m = mnew;
#pragma unroll
        for (int i = 0; i < 16; ++i) { o0[i] *= alpha; o1[i] *= alpha; }
    }
    const float c = FAST ? (lane_ok ? (m - bias) : __builtin_inff()) : m;
    float ps = 0.f;
#pragma unroll
    for (int i = 0; i < 16; ++i) { s[i] = fast_exp2(s[i] - c); ps += s[i]; }
    ps = xhalf_sum(ps);
    l += ps;
    pv_tile(o0, o1, s, vf);
}

#define MFMA8(a, b, c) __builtin_amdgcn_mfma_f32_32x32x16_fp8_fp8((a), (b), (c), 0, 0, 0)
__device__ __forceinline__ void load_k8(long (&kf)[4], const unsigned char* Kt, int lane) {
#pragma unroll
    for (int ks = 0; ks < 4; ++ks) kf[ks] = *(const long*)(Kt + ks * 512 + lane * 8);
}
__device__ __forceinline__ void load_v8(long (&vf)[2][2], const unsigned char* vT, int lane) {
#pragma unroll
    for (int dt = 0; dt < 2; ++dt)
#pragma unroll
        for (int s = 0; s < 2; ++s) vf[dt][s] = *(const long*)(vT + dt * 1024 + s * 512 + lane * 8);
}
__device__ __forceinline__ long pack_fp8x8(float a0, float a1, float a2, float a3, float a4, float a5, float a6, float a7) {
    int w0 = __builtin_amdgcn_cvt_pk_fp8_f32(a0, a1, 0, false); w0 = __builtin_amdgcn_cvt_pk_fp8_f32(a2, a3, w0, true);
    int w1 = __builtin_amdgcn_cvt_pk_fp8_f32(a4, a5, 0, false); w1 = __builtin_amdgcn_cvt_pk_fp8_f32(a6, a7, w1, true);
    return (long)(((unsigned long long)(unsigned)w1 << 32) | (unsigned long long)(unsigned)w0);
}
template <bool FAST> __device__ __forceinline__ void online_step8(f32x16& s, float bias, bool lane_ok, float& m, float& l, f32x16& o0, f32x16& o1, const long (&vf)[2][2]) {
    float mx = fmaxf(fmaxf(fmaxf(s[0], s[1]), fmaxf(s[2], s[3])), fmaxf(fmaxf(s[4], s[5]), fmaxf(s[6], s[7])));
    mx = fmaxf(mx, fmaxf(fmaxf(fmaxf(s[8], s[9]), fmaxf(s[10], s[11])), fmaxf(fmaxf(s[12], s[13]), fmaxf(s[14], s[15]))));
    if (FAST) { mx = mx * QSCALE + bias; mx = lane_ok ? mx : NEG_INF; }
    mx = xhalf_max(mx);
    if (__any(mx > m + 2.0f)) {
        const float mnew = (mx > m + 2.0f) ? mx : m;
        const float alpha = fast_exp2(m - mnew);
        l *= alpha; m = mnew;
#pragma unroll
        for (int i = 0; i < 16; ++i) { o0[i] *= alpha; o1[i] *= alpha; }
    }
    float ps = 0.f;
    if (FAST) {
        const float c = lane_ok ? (m - bias - 6.0f) : __builtin_inff();
#pragma unroll
        for (int i = 0; i < 16; ++i) { s[i] = fast_exp2(__builtin_fmaf(s[i], QSCALE, -c)); ps += s[i]; }
    } else {
        const float c = m - 6.0f;
#pragma unroll
        for (int i = 0; i < 16; ++i) { s[i] = fast_exp2(s[i] - c); ps += s[i]; }
    }
    ps = xhalf_sum(ps);
    l += ps;
#pragma unroll
    for (int t = 0; t < 2; ++t) {
        const long pb = pack_fp8x8(s[8 * t], s[8 * t + 1], s[8 * t + 2], s[8 * t + 3], s[8 * t + 4], s[8 * t + 5], s[8 * t + 6], s[8 * t + 7]);
        o0 = MFMA8(vf[0][t], pb, o0);
        o1 = MFMA8(vf[1][t], pb, o1);
    }
}

__device__ __forceinline__ float max16(const f32x16& s) {
    const float a = fmaxf(fmaxf(fmaxf(s[0], s[1]), fmaxf(s[2], s[3])), fmaxf(fmaxf(s[4], s[5]), fmaxf(s[6], s[7])));
    const float b = fmaxf(fmaxf(fmaxf(s[8], s[9]), fmaxf(s[10], s[11])), fmaxf(fmaxf(s[12], s[13]), fmaxf(s[14], s[15])));
    return fmaxf(a, b);
}
template <bool FAST> __device__ __forceinline__ void online_step8x2(f32x16& sa, f32x16& sb, float bias, bool lane_ok, float& m, float& l, f32x16& o0, f32x16& o1, const long (&va)[2][2], const long (&vb)[2][2]) {
    float mx = fmaxf(max16(sa), max16(sb));
    if (FAST) { mx = mx * QSCALE + bias; mx = lane_ok ? mx : NEG_INF; }
    mx = xhalf_max(mx);
    if (__any(mx > m + 2.0f)) {
        const float mnew = (mx > m + 2.0f) ? mx : m;
        const float alpha = fast_exp2(m - mnew);
        l *= alpha; m = mnew;
#pragma unroll
        for (int i = 0; i < 16; ++i) { o0[i] *= alpha; o1[i] *= alpha; }
    }
    float ps = 0.f, ps2 = 0.f;
    if (FAST) {
        const float c = lane_ok ? (m - bias - 6.0f) : __builtin_inff();
#pragma unroll
        for (int i = 0; i < 16; ++i) { sa[i] = fast_exp2(__builtin_fmaf(sa[i], QSCALE, -c)); ps += sa[i]; sb[i] = fast_exp2(__builtin_fmaf(sb[i], QSCALE, -c)); ps2 += sb[i]; }
    } else {
        const float c = m - 6.0f;
#pragma unroll
        for (int i = 0; i < 16; ++i) { sa[i] = fast_exp2(sa[i] - c); ps += sa[i]; sb[i] = fast_exp2(sb[i] - c); ps2 += sb[i]; }
    }
    ps += ps2;
    ps = xhalf_sum(ps);
    l += ps;
    const long pa0 = pack_fp8x8(sa[0], sa[1], sa[2], sa[3], sa[4], sa[5], sa[6], sa[7]);
    const long pb0 = pack_fp8x8(sb[0], sb[1], sb[2], sb[3], sb[4], sb[5], sb[6], sb[7]);
    o0 = MFMA8(va[0][0], pa0, o0); o1 = MFMA8(va[1][0], pa0, o1);
    const long pa1 = pack_fp8x8(sa[8], sa[9], sa[10], sa[11], sa[12], sa[13], sa[14], sa[15]);
    o0 = MFMA8(vb[0][0], pb0, o0); o1 = MFMA8(vb[1][0], pb0, o1);
    const long pb1 = pack_fp8x8(sb[8], sb[9], sb[10], sb[11], sb[12], sb[13], sb[14], sb[15]);
    o0 = MFMA8(va[0][1], pa1, o0); o1 = MFMA8(va[1][1], pa1, o1);
    o0 = MFMA8(vb[0][1], pb1, o0); o1 = MFMA8(vb[1][1], pb1, o1);
}

__device__ __forceinline__ void nsa_unit(const Params& p, int bg, int jq, LAS unsigned char* lds, int wave, int lane, bool build_lut) {
    LAUNDER(lane);
    const unsigned char* ws = P_ws(p);
    const bf16_t* qb = (const bf16_t*)(ws + WS_R1 + R_Q);
    const bf16_t* kcmp = (const bf16_t*)(ws + WS_R1 + R_KCMP) + (size_t)bg * NCMP * 64;
    const bf16_t* vcmpT = (const bf16_t*)(ws + WS_R1 + R_VCMPT) + (size_t)bg * NCMP * 64;
    const unsigned char* ks8 = ws + WS_R1 + R_KS + (size_t)bg * S * 64;
    const unsigned char* vs8 = ws + WS_R1 + R_VST + (size_t)bg * S * 64;
    const bf16_t* kwb = (const bf16_t*)(ws + WS_R1 + R_KW) + (size_t)bg * S * 64;
    const bf16_t* vwT = (const bf16_t*)(ws + WS_R1 + R_VWT) + (size_t)bg * S * 64;
    const float* gates = (const float*)(ws + WS_R1 + R_GATES);
    bf16_t* mixed = (bf16_t*)(ws + WS_AN);
    const float* relb = P_in(p, 1);
    const int b = bg >> 1, g = bg & 1;
    LAS float* imp = (LAS float*)(lds + wave * NSA_WAVE_LDS);
    LAS unsigned* selw = (LAS unsigned*)(lds + wave * NSA_WAVE_LDS + 8192);
    LAS float* lut = (LAS float*)(lds + wave * NSA_WAVE_LDS + 8192 + 256);
    LAS int* list = (LAS int*)(lds + wave * NSA_WAVE_LDS + 8192 + 256 + 2112);
    const int c = lane & 31, h = lane >> 5, ql = c >> 2, r = c & 3;
    const int tq0 = 64 * jq + 8 * wave, tq = tq0 + ql;
    const size_t tok = (size_t)b * S + tq;

    if (build_lut) {
        for (int e = lane; e < 4 * 129; e += 64) {
            const int rr = e / 129, n = e % 129;
            int bk = n;
            if (n >= 16) bk = 16 + (n >= 19) + (n >= 21) + (n >= 24) + (n >= 27) + (n >= 31) + (n >= 35) + (n >= 40) + (n >= 46) + (n >= 52) + (n >= 59) + (n >= 67) + (n >= 77) + (n >= 87) + (n >= 99) + (n >= 113);
            lut[rr * 132 + n] = relb[bk * 8 + g * 4 + rr] * LOG2E;
        }
    }
    for (int e = lane; e < 2048; e += 64) imp[e] = 0.f;
    {
        const int k = lane & 7; unsigned w = 0u;
        if (k == 0) w |= 1u;
        if ((jq >> 5) == k) w |= 1u << (jq & 31);
        if (jq >= 1 && ((jq - 1) >> 5) == k) w |= 1u << ((jq - 1) & 31);
        selw[lane] = w;
    }
    asm volatile("s_waitcnt lgkmcnt(0)" ::: "memory");
    __builtin_amdgcn_wave_barrier();
    const LAS float* lutr = lut + r * 132;
    const float lutfar = lutr[128];

    bf16x8 qf[4];
#pragma unroll
    for (int ks = 0; ks < 4; ++ks) qf[ks] = *(const bf16x8*)(qb + tok * 512 + (g * 4 + r) * 64 + ks * 16 + h * 8);
    const float g0 = gates[tok * 24 + (g * 4 + r) * 3 + 0], g1 = gates[tok * 24 + (g * 4 + r) * 3 + 1], g2 = gates[tok * 24 + (g * 4 + r) * 3 + 2];

    f32x16 oa0, oa1;
    bf16x8 kf[4], kn[4], vf[2][2];
    {
        const int jmaxw = (tq0 + 7 - 31) >> 4;
        const int ntile = (jmaxw >= 0) ? (jmaxw >> 5) + 1 : 0;
        float m = -1e30f, l = 0.f;
        if (ntile > 0) load_k(kn, kcmp, lane);
        for (int T = 0; T < ntile; ++T) {
#pragma unroll
            for (int ks = 0; ks < 4; ++ks) kf[ks] = kn[ks];
            if (T + 1 < ntile) load_k(kn, kcmp + (size_t)(T + 1) * 2048, lane);
            f32x16 s = qk_tile(kf, qf);
            const int base = 512 * T + 31;
            const bool fast = (tq0 - base - 16 * 31) >= 128;
            score_tile<16>(s, tq - base - 64 * h, 1 << 30, true, fast, lutfar, lutr);
            float mx = s[0];
#pragma unroll
            for (int i = 1; i < 16; ++i) mx = fmaxf(mx, s[i]);
            mx = xhalf_max(mx);
            const float mnew = fmaxf(m, mx);
            float ps = 0.f;
#pragma unroll
            for (int i = 0; i < 16; ++i) ps += fast_exp2(s[i] - mnew);
            ps = xhalf_sum(ps);
            l = l * fast_exp2(m - mnew) + ps; m = mnew;
        }
        const float c2 = (l > 0.f) ? (m + __builtin_amdgcn_logf(l)) : __builtin_inff();
        const float c2f = c2 - lutfar;
        f32x16 o0, o1;
#pragma unroll
        for (int i = 0; i < 16; ++i) { o0[i] = 0.f; o1[i] = 0.f; }
        if (ntile > 0) load_k(kn, kcmp, lane);
        for (int T = 0; T < ntile; ++T) {
#pragma unroll
            for (int ks = 0; ks < 4; ++ks) kf[ks] = kn[ks];
            load_v(vf, vcmpT + (size_t)T * 2048, lane);
            if (T + 1 < ntile) load_k(kn, kcmp + (size_t)(T + 1) * 2048, lane);
            f32x16 s = qk_tile(kf, qf);
            const int base = 512 * T + 31;
            const bool fast = (tq0 - base - 16 * 31) >= 128;
            if (fast) {
#pragma unroll
                for (int i = 0; i < 16; ++i) s[i] = fast_exp2(s[i] - c2f);
            } else {
                score_tile<16>(s, tq - base - 64 * h, 1 << 30, true, false, lutfar, lutr);
#pragma unroll
                for (int i = 0; i < 16; ++i) s[i] = fast_exp2(s[i] - c2);
            }
#pragma unroll
            for (int i4 = 0; i4 < 4; ++i4) {
                float a = (s[4 * i4] + s[4 * i4 + 1]) + (s[4 * i4 + 2] + 0.5f * s[4 * i4 + 3]);
                float bb = 0.5f * s[4 * i4 + 3];
                a = quad_sum(a); bb = quad_sum(bb);
                if (r == i4) {
                    const int n = 8 * T + 2 * i4 + h;
                    atomicAdd((float*)(imp + ql * 256 + n), a);
                    if (n + 1 < 256) atomicAdd((float*)(imp + ql * 256 + n + 1), bb);
                }
            }
            pv_tile(o0, o1, s, vf);
        }
        {
            LAS float* park = (LAS float*)(lds + wave * NSA_WAVE_LDS + 11264);
#pragma unroll
            for (int i = 0; i < 16; ++i) { park[i * 64 + lane] = g0 * o0[i]; park[(16 + i) * 64 + lane] = g0 * o1[i]; }
        }
    }
    asm volatile("s_waitcnt lgkmcnt(0)" ::: "memory");
    __builtin_amdgcn_wave_barrier();
    if (jq >= 3) {
        const int tj = lane & 7;
        int val[32];
#pragma unroll
        for (int c4 = 0; c4 < 8; ++c4) {
            const f32x4 iv = *(const LAS f32x4*)(imp + (lane >> 3) * 256 + 32 * tj + 4 * c4);
#pragma unroll
            for (int e = 0; e < 4; ++e) {
                const int n = 32 * tj + 4 * c4 + e;
                const int key = (int)((__float_as_uint(iv[e]) & 0x7fffff00u) | (unsigned)(255 - n));
                val[4 * c4 + e] = (n >= 1 && n <= jq - 2) ? key : -1;
            }
        }
        unsigned myw = 0u;
        for (int round = 0; round < 13; ++round) {
            int lm = val[0];
#pragma unroll
            for (int e = 1; e < 32; ++e) lm = max(lm, val[e]);
            int gm = max(lm, __builtin_amdgcn_mov_dpp(lm, 0xB1, 0xf, 0xf, true));
            gm = max(gm, __builtin_amdgcn_mov_dpp(gm, 0x4E, 0xf, 0xf, true));
            gm = max(gm, __builtin_amdgcn_mov_dpp(gm, 0x141, 0xf, 0xf, true));
            const int n = 255 - (gm & 0xff);
            myw |= (gm >= 0 && (n >> 5) == tj) ? (1u << (n & 31)) : 0u;
#pragma unroll
            for (int e = 0; e < 32; ++e) val[e] = (val[e] == gm) ? -1 : val[e];
        }
        selw[lane] |= myw;
    }
    asm volatile("s_waitcnt lgkmcnt(0)" ::: "memory");
    __builtin_amdgcn_wave_barrier();
    {
        unsigned uwA = 0u, uwB = 0u;
        if (lane < 8) {
#pragma unroll
            for (int qq = 0; qq < 4; ++qq) { uwA |= selw[qq * 8 + lane]; uwB |= selw[(qq + 4) * 8 + lane]; }
        }
        int cntA = 0, cntB = 0;
#pragma unroll
        for (int k = 0; k < 8; ++k) {
            const unsigned ba = (unsigned)__builtin_amdgcn_readlane((int)uwA, k), bb2 = (unsigned)__builtin_amdgcn_readlane((int)uwB, k);
            if (lane < 32) {
                const unsigned below = (1u << lane) - 1u;
                if ((ba >> lane) & 1u) list[cntA + __builtin_popcount(ba & below)] = 32 * k + lane;
                if ((bb2 >> lane) & 1u) list[64 + cntB + __builtin_popcount(bb2 & below)] = 32 * k + lane;
            }
            cntA += __builtin_popcount(ba); cntB += __builtin_popcount(bb2);
        }
        asm volatile("s_waitcnt lgkmcnt(0)" ::: "memory");
        __builtin_amdgcn_wave_barrier();
        LAS float* ostage = imp;
        const int c16 = lane & 15, fq = lane >> 4, q4 = c16 >> 2, r16 = c16 & 3;
        const LAS float* lutr16 = lut + r16 * 132;
        const float lutfar16 = lutr16[128];
        for (int grp = 0; grp < 2; ++grp) {
            const int cnt = grp ? cntB : cntA, lbase = grp * 64;
            const int tqg = tq0 + 4 * grp + q4, tq0g = tq0 + 4 * grp;
            long q8[2];
            {
                const bf16_t* qp = qb + ((size_t)b * S + tqg) * 512 + (g * 4 + r16) * 64 + 8 * fq;
#pragma unroll
                for (int ks = 0; ks < 2; ++ks) {
                    const bf16x8 qv = *(const bf16x8*)(qp + 32 * ks);
                    float f[8];
#pragma unroll
                    for (int e = 0; e < 8; ++e) f[e] = bf2f((bf16_t)qv[e]) * 4.0f;
                    q8[ks] = pack_fp8x8(f[0], f[1], f[2], f[3], f[4], f[5], f[6], f[7]);
                }
            }
            float m = -1e30f;
            f32x4 lacc = (f32x4){0.f, 0.f, 0.f, 0.f};
            const long ones8 = 0x3838383838383838L;
            f32x4 o[4];
#pragma unroll
            for (int dt = 0; dt < 4; ++dt) o[dt] = (f32x4){0.f, 0.f, 0.f, 0.f};
            const int npair = (cnt + 1) >> 1;
            if (lane == 0 && (cnt & 1)) list[lbase + cnt] = 0;
            asm volatile("s_waitcnt lgkmcnt(0)" ::: "memory");
            __builtin_amdgcn_wave_barrier();
            long k8[2][8], v8[2][8];
            int n0 = __builtin_amdgcn_readfirstlane(list[lbase]), n1 = __builtin_amdgcn_readfirstlane(list[lbase + 1]);
#pragma unroll
            for (int i = 0; i < 4; ++i) { const l64x2 t0 = *(const l64x2*)(ks8 + (size_t)n0 * 4096 + i * 1024 + lane * 16), t1 = *(const l64x2*)(ks8 + (size_t)n1 * 4096 + i * 1024 + lane * 16);
                k8[0][2 * i] = t0[0]; k8[0][2 * i + 1] = t0[1]; k8[1][2 * i] = t1[0]; k8[1][2 * i + 1] = t1[1]; }
            for (int it = 0; it < npair; ++it) {
                const int nb[2] = {n0, n1};
                const bool real1 = (2 * it + 1) < cnt;
#pragma unroll
                for (int u = 0; u < 2; ++u)
#pragma unroll
                    for (int i = 0; i < 4; ++i) { const l64x2 t = *(const l64x2*)(vs8 + (size_t)nb[u] * 4096 + i * 1024 + lane * 16); v8[u][2 * i] = t[0]; v8[u][2 * i + 1] = t[1]; }
                bool ok[2];
                ok[0] = (selw[(grp * 4 + q4) * 8 + (nb[0] >> 5)] >> (nb[0] & 31)) & 1u;
                ok[1] = real1 && ((selw[(grp * 4 + q4) * 8 + (nb[1] >> 5)] >> (nb[1] & 31)) & 1u);
                const int bmax = real1 ? max(nb[0], nb[1]) : nb[0];
                const bool fast = (tq0g - 64 * bmax - 63) >= 128;
                const bool fresh = m < -1e29f;
                const float mref = fresh ? 0.f : m;
                float ini[2];
                ini[0] = fast ? (ok[0] ? -(mref - lutfar16 - 6.0f) : NEG_INF) : 0.f;
                ini[1] = fast ? (ok[1] ? -(mref - lutfar16 - 6.0f) : NEG_INF) : 0.f;
                f32x4 sc[2][4];
#pragma unroll
                for (int u = 0; u < 2; ++u)
#pragma unroll
                    for (int kt = 0; kt < 4; ++kt) {
                        sc[u][kt] = __builtin_amdgcn_mfma_f32_16x16x32_fp8_fp8(k8[u][2 * kt], q8[0], (f32x4){ini[u], ini[u], ini[u], ini[u]}, 0, 0, 0);
                        sc[u][kt] = __builtin_amdgcn_mfma_f32_16x16x32_fp8_fp8(k8[u][2 * kt + 1], q8[1], sc[u][kt], 0, 0, 0);
                    }
                if (it + 1 < npair) {
                    n0 = __builtin_amdgcn_readfirstlane(list[lbase + 2 * it + 2]); n1 = __builtin_amdgcn_readfirstlane(list[lbase + 2 * it + 3]);
#pragma unroll
                    for (int i = 0; i < 4; ++i) { const l64x2 t0 = *(const l64x2*)(ks8 + (size_t)n0 * 4096 + i * 1024 + lane * 16), t1 = *(const l64x2*)(ks8 + (size_t)n1 * 4096 + i * 1024 + lane * 16);
                        k8[0][2 * i] = t0[0]; k8[0][2 * i + 1] = t0[1]; k8[1][2 * i] = t1[0]; k8[1][2 * i + 1] = t1[1]; }
                }
                if (fast) {
                    float t = NEG_INF;
#pragma unroll
                    for (int u = 0; u < 2; ++u) {
                        float tt = fmaxf(fmaxf(fmaxf(sc[u][0][0], sc[u][0][1]), fmaxf(sc[u][0][2], sc[u][0][3])), fmaxf(fmaxf(sc[u][1][0], sc[u][1][1]), fmaxf(sc[u][1][2], sc[u][1][3])));
                        tt = fmaxf(tt, fmaxf(fmaxf(fmaxf(sc[u][2][0], sc[u][2][1]), fmaxf(sc[u][2][2], sc[u][2][3])), fmaxf(fmaxf(sc[u][3][0], sc[u][3][1]), fmaxf(sc[u][3][2], sc[u][3][3]))));
                        t = fmaxf(t, tt);
                    }
                    { auto t1 = __builtin_amdgcn_permlane16_swap(__float_as_uint(t), __float_as_uint(t), false, false); t = fmaxf(__uint_as_float(t1[0]), __uint_as_float(t1[1])); t = xhalf_max(t); }
                    const float mxt = t - 6.0f + mref;
                    const bool need = fresh ? (t > NEG_INF) : (mxt > m + 2.0f);
                    if (__any(need)) {
                        const float mnew = need ? mxt : m;
                        const float delta = need ? (mnew - mref) : 0.f;
                        const float alpha = (need && !fresh) ? fast_exp2(m - mnew) : 1.0f;
                        lacc = lacc * alpha; m = mnew;
#pragma unroll
                        for (int dt = 0; dt < 4; ++dt) o[dt] = o[dt] * alpha;
#pragma unroll
                        for (int u = 0; u < 2; ++u)
#pragma unroll
                            for (int kt = 0; kt < 4; ++kt) sc[u][kt] = sc[u][kt] - delta;
                    }
#pragma unroll
                    for (int u = 0; u < 2; ++u)
#pragma unroll
                        for (int kt = 0; kt < 4; ++kt)
#pragma unroll
                            for (int e = 0; e < 4; ++e) sc[u][kt][e] = fast_exp2(sc[u][kt][e]);
                } else {
                    float mx = NEG_INF;
#pragma unroll
                    for (int u = 0; u < 2; ++u)
#pragma unroll
                        for (int kt = 0; kt < 4; ++kt)
#pragma unroll
                            for (int e = 0; e < 4; ++e) {
                                const int d = tqg - 64 * nb[u] - 16 * kt - 4 * fq - e;
                                const bool okk = ok[u] && d >= 0;
                                const float v = okk ? (sc[u][kt][e] + lutr16[min(max(d, 0), 128)]) : NEG_INF;
                                sc[u][kt][e] = v; mx = fmaxf(mx, v);
                            }
                    { auto t1 = __builtin_amdgcn_permlane16_swap(__float_as_uint(mx), __float_as_uint(mx), false, false); mx = fmaxf(__uint_as_float(t1[0]), __uint_as_float(t1[1])); mx = xhalf_max(mx); }
                    if (__any(mx > m + 2.0f)) {
                        const float mnew = (mx > m + 2.0f) ? mx : m;
                        const float alpha = fast_exp2(m - mnew);
                        lacc = lacc * alpha; m = mnew;
#pragma unroll
                        for (int dt = 0; dt < 4; ++dt) o[dt] = o[dt] * alpha;
                    }
                    const float cexp = m - 6.0f;
#pragma unroll
                    for (int u = 0; u < 2; ++u)
#pragma unroll
                        for (int kt = 0; kt < 4; ++kt)
#pragma unroll
                            for (int e = 0; e < 4; ++e) sc[u][kt][e] = fast_exp2(sc[u][kt][e] - cexp);
                }
#pragma unroll
                for (int u = 0; u < 2; ++u) {
                    const long pb0 = pack_fp8x8(sc[u][0][0], sc[u][0][1], sc[u][0][2], sc[u][0][3], sc[u][1][0], sc[u][1][1], sc[u][1][2], sc[u][1][3]);
                    const long pb1 = pack_fp8x8(sc[u][2][0], sc[u][2][1], sc[u][2][2], sc[u][2][3], sc[u][3][0], sc[u][3][1], sc[u][3][2], sc[u][3][3]);
#pragma unroll
                    for (int dt = 0; dt < 4; ++dt) {
                        o[dt] = __builtin_amdgcn_mfma_f32_16x16x32_fp8_fp8(v8[u][2 * dt], pb0, o[dt], 0, 0, 0);
                        o[dt] = __builtin_amdgcn_mfma_f32_16x16x32_fp8_fp8(v8[u][2 * dt + 1], pb1, o[dt], 0, 0, 0);
                    }
                    lacc = __builtin_amdgcn_mfma_f32_16x16x32_fp8_fp8(ones8, pb0, lacc, 0, 0, 0);
                    lacc = __builtin_amdgcn_mfma_f32_16x16x32_fp8_fp8(ones8, pb1, lacc, 0, 0, 0);
                }
            }
            const float l = lacc[0];
            const float invl = (l > 0.f) ? 1.0f / l : 0.f;
#pragma unroll
            for (int dt = 0; dt < 4; ++dt) *(LAS f32x4*)(ostage + ((grp * 4 + q4) * 4 + r16) * 64 + 16 * dt + 4 * fq) = o[dt] * invl;
        }
        asm volatile("s_waitcnt lgkmcnt(0)" ::: "memory");
        __builtin_amdgcn_wave_barrier();
        {
            const LAS float* park = (const LAS float*)(lds + wave * NSA_WAVE_LDS + 11264);
#pragma unroll
            for (int i = 0; i < 16; ++i) { oa0[i] = park[i * 64 + lane]; oa1[i] = park[(16 + i) * 64 + lane]; }
        }
#pragma unroll
        for (int dt = 0; dt < 2; ++dt)
#pragma unroll
            for (int i4 = 0; i4 < 4; ++i4) {
                const f32x4 v = *(const LAS f32x4*)(ostage + (ql * 4 + r) * 64 + 32 * dt + 8 * i4 + 4 * h);
                if (dt == 0) { oa0[4 * i4] += g1 * v[0]; oa0[4 * i4 + 1] += g1 * v[1]; oa0[4 * i4 + 2] += g1 * v[2]; oa0[4 * i4 + 3] += g1 * v[3]; }
                else         { oa1[4 * i4] += g1 * v[0]; oa1[4 * i4 + 1] += g1 * v[1]; oa1[4 * i4 + 2] += g1 * v[2]; oa1[4 * i4 + 3] += g1 * v[3]; }
            }
        asm volatile("s_waitcnt lgkmcnt(0)" ::: "memory");
        __builtin_amdgcn_wave_barrier();
    }
    {
        {
            const bf16_t* qp = qb + tok * 512 + (g * 4 + r) * 64 + h * 8;
            asm volatile("" : "+v"(qp));
#pragma unroll
            for (int ks = 0; ks < 4; ++ks) qf[ks] = *(const bf16x8*)(qp + ks * 16);
        }
        const int T0 = max(0, (tq0 - 511) >> 5), T1 = (tq0 + 7) >> 5;
        float m = -1e30f, l = 0.f;
        f32x16 o0, o1;
#pragma unroll
        for (int i = 0; i < 16; ++i) { o0[i] = 0.f; o1[i] = 0.f; }
        load_k(kn, kwb + (size_t)(32 * T0) * 64, lane);
        for (int T = T0; T <= T1; ++T) {
#pragma unroll
            for (int ks = 0; ks < 4; ++ks) kf[ks] = kn[ks];
            load_v(vf, vwT + (size_t)T * 2048, lane);
            if (T < T1) load_k(kn, kwb + (size_t)(32 * (T + 1)) * 64, lane);
            const int base = 32 * T;
            f32x16 s = qk_tile(kf, qf);
            if (((tq0 - base - 31) >= 128) && ((tq0 + 7 - base) < 512)) online_step<true>(s, lutfar, true, m, l, o0, o1, vf);
            else { score_tile<1>(s, tq - base - 4 * h, 512, true, false, lutfar, lutr); online_step<false>(s, 0.f, true, m, l, o0, o1, vf); }
        }
        const float sc = (l > 0.f) ? g2 / l : 0.f;
#pragma unroll
        for (int i = 0; i < 16; ++i) { oa0[i] += sc * o0[i]; oa1[i] += sc * o1[i]; }
    }
    bf16_t* orow = mixed + tok * 1024 + (g * 4 + r) * 64;
#pragma unroll
    for (int dt = 0; dt < 2; ++dt)
#pragma unroll
        for (int i4 = 0; i4 < 4; ++i4) {
            const f32x16& a = dt ? oa1 : oa0;
            u32x2 o; o.x = cvt_pk_bf16(a[4 * i4], a[4 * i4 + 1]); o.y = cvt_pk_bf16(a[4 * i4 + 2], a[4 * i4 + 3]);
            *(u32x2*)(orow + 32 * dt + 8 * i4 + 4 * h) = o;
        }
}


#define XB_TMO      128
#define XB_XCNT(j)  (256  + 64 * (j))
#define XB_XSUB(j)  (1280 + 64 * (j))
#define XB_XGEN(j)  (2304 + 64 * (j))
#define XB_TOP      3328
#define XB_TOPGEN   3392
#define XCD_BAR_WORDS 3456
#define XB_SPIN_CAP (1u << 22)
__device__ __forceinline__ unsigned xb_ld(unsigned* p)              { return __hip_atomic_load(p, __ATOMIC_RELAXED, __HIP_MEMORY_SCOPE_AGENT); }
__device__ __forceinline__ unsigned xb_add(unsigned* p, unsigned v) { return __hip_atomic_fetch_add(p, v, __ATOMIC_RELAXED, __HIP_MEMORY_SCOPE_AGENT); }
__device__ __forceinline__ unsigned xb_xcc_id() { return (unsigned)__builtin_amdgcn_s_getreg((3 << 11) | 20) & 0xFu; }
#define XB_SPIN(cond, bar) do { unsigned _sp = 0; while (cond) { __builtin_amdgcn_s_sleep(1); \
    if ((++_sp & 255u) == 0u) { if (xb_ld(&(bar)[XB_TMO])) break; if (_sp > XB_SPIN_CAP) { atomicAdd(&(bar)[XB_TMO], 1u); break; } } } } while (0)
__device__ __forceinline__ void xcd_barrier_complete(unsigned* bar, unsigned x, unsigned& nloc, unsigned& nx) {
    const unsigned G = gridDim.x * gridDim.y * gridDim.z;
    unsigned sum, cnt, mine, sp = 0u;
    for (;;) {
        sum = 0u; cnt = 0u; mine = 0u;
#pragma unroll
        for (unsigned j = 0; j < 16; ++j) { const unsigned c = xb_ld(&bar[XB_XCNT(j)]); sum += c; cnt += (c > 0u) ? 1u : 0u; mine = (j == x) ? c : mine; }
        if (sum == G) break;
        __builtin_amdgcn_s_sleep(1);
        if ((++sp & 255u) == 0u) { if (xb_ld(&bar[XB_TMO])) break; if (sp > XB_SPIN_CAP) { atomicAdd(&bar[XB_TMO], 1u); break; } }
    }
    nloc = mine > 0u ? mine : 1u; nx = cnt > 0u ? cnt : 1u;
}
__device__ __forceinline__ void xcd_barrier(unsigned* bar, volatile LAS unsigned* st) {
    asm volatile("s_waitcnt vmcnt(0)" ::: "memory");
    __syncthreads();
    if (threadIdx.x == 0) {
        const unsigned x = xb_xcc_id();
        __builtin_amdgcn_s_waitcnt(0);
        unsigned nloc = st[0], nx = st[1];
        if (nloc == 0u) { xcd_barrier_complete(bar, x, nloc, nx); st[0] = nloc; st[1] = nx; }
        const unsigned old = xb_add(&bar[XB_XSUB(x)], 1u);
        const unsigned gen = old / nloc;
        if (old + 1u == (gen + 1u) * nloc) {
            __builtin_amdgcn_fence(__ATOMIC_RELEASE, "agent");
            asm volatile("s_waitcnt vmcnt(0)" ::: "memory");
            const unsigned og = xb_add(&bar[XB_TOP], 1u);
            const unsigned tg = og / nx;
            if (og + 1u == (tg + 1u) * nx) xb_add(&bar[XB_TOPGEN], 1u);
            else XB_SPIN(xb_ld(&bar[XB_TOPGEN]) == tg, bar);
            __builtin_amdgcn_fence(__ATOMIC_ACQUIRE, "agent");
            xb_add(&bar[XB_XGEN(x)], 1u);
            asm volatile("s_waitcnt vmcnt(0)" ::: "memory");
        } else {
            XB_SPIN(xb_ld(&bar[XB_XGEN(x)]) == gen, bar);
            __builtin_amdgcn_fence(__ATOMIC_ACQUIRE, "agent");
            asm volatile("s_waitcnt vmcnt(0)" ::: "memory");
        }
    }
    __syncthreads();
}

__global__ void __launch_bounds__(NTHREADS, 2) fwd_megakernel(Params p) {
    extern __shared__ __attribute__((aligned(16))) unsigned char lds_raw[];
    LAS unsigned char* lds = (LAS unsigned char*)lds_raw;
    cg::grid_group grid = cg::this_grid();
#define TID_F ({ int _t = threadIdx.x; LAUNDER(_t); _t; })
#define LANE_F (TID_F & 63)
#define WAVE_F (__builtin_amdgcn_readfirstlane(TID_F >> 6))
    const int G = gridDim.x, bx = blockIdx.x;
    const int NGW = G * NWAVES;
#define GW_F (bx * NWAVES + WAVE_F)
#define FRESH_WS unsigned char* ws = P_ws(p); bf16_t* AN = (bf16_t*)(ws + WS_AN); float* MIX = (float*)(ws + WS_MIX); (void)AN; (void)MIX

    { const int tid = TID_F; if (tid < 16) ((LAS unsigned*)(lds + LDS_BYTES - 64))[tid] = 0u; }
    if (bx == 0) { unsigned* barw = (unsigned*)P_ws(p); for (int i = TID_F; i < XCD_BAR_WORDS; i += NTHREADS) barw[i] = 0u; }
    { const int t = TID_F; if (t < 128) ((unsigned*)(P_ws(p) + WS_XCNT))[bx * 128 + t] = 0u; }
    __syncthreads();
    {
        FRESH_WS;
        const int tid = TID_F, lane = tid & 63, wave = __builtin_amdgcn_readfirstlane(tid >> 6), gw = bx * NWAVES + wave;
        LAS float* scr = (LAS float*)(lds + wave * 17408);
        for (int layer = 0; layer < DEPTH; ++layer) {
            unsigned char* wl = ws + WS_W + (size_t)layer * W_LAYER;
            const int I_IN = 16 * (NINP / 64), I_OUT = 16 * 16, I_GU = 16 * (NGU / 64), I_DN = 44 * 16, I_C1 = 32 * 4, I_C2 = 4 * 1;
            const int NIT = I_IN + I_OUT + I_GU + I_DN + 2 * I_C1 + 2 * I_C2;
            for (int it = gw; it < NIT; it += NGW) {
                int r = it;
                if (r < I_IN) { transpose_item<1>(P_in(p, 6) + (size_t)layer * DM * INW, DM, INW, (bf16_t*)(wl + W_IN), NINP / 64, r, scr, lane, P_in(p, 2) + layer * DM); continue; } r -= I_IN;
                if (r < I_OUT) { transpose_item<0>(P_in(p, 17) + (size_t)layer * DM * DM, DM, DM, (bf16_t*)(wl + W_OUT), 16, r, scr, lane); continue; } r -= I_OUT;
                if (r < I_GU) { transpose_item<2>(P_in(p, 18) + (size_t)layer * DM * NGU, DM, NGU, (bf16_t*)(wl + W_GU), NGU / 64, r, scr, lane, P_in(p, 4) + layer * DM); continue; } r -= I_GU;
                if (r < I_DN) { transpose_item<0>(P_in(p, 19) + (size_t)layer * DFF * DM, DFF, DM, (bf16_t*)(wl + W_DN), 16, r, scr, lane); continue; } r -= I_DN;
                if (r < I_C1) { transpose_item<0>(P_in(p, 8) + (size_t)layer * 2048 * 256, 2048, 256, (bf16_t*)(wl + W_C1K), 4, r, scr, lane); continue; } r -= I_C1;
                if (r < I_C1) { transpose_item<0>(P_in(p, 11) + (size_t)layer * 2048 * 256, 2048, 256, (bf16_t*)(wl + W_C1V), 4, r, scr, lane); continue; } r -= I_C1;
                if (r < I_C2) { transpose_item<0>(P_in(p, 9) + (size_t)layer * 256 * 64, 256, 64, (bf16_t*)(wl + W_C2K), 1, r, scr, lane); continue; } r -= I_C2;
                transpose_item<0>(P_in(p, 12) + (size_t)layer * 256 * 64, 256, 64, (bf16_t*)(wl + W_C2V), 1, r, scr, lane);
            }
        }
        __syncthreads();
        if (bx >= G - 2 * DEPTH) {
            const int id = G - 1 - bx, layer = id >> 1, kv = id & 1;
            const float* pos = P_in(p, kv ? 10 : 7) + (size_t)layer * 2048;
            const float* w1 = P_in(p, kv ? 11 : 8) + (size_t)layer * 2048 * 256;
            LAS float* red = (LAS float*)lds;
            f32x4 acc4 = (f32x4){0.f, 0.f, 0.f, 0.f};
#pragma unroll 8
            for (int i = wave * 256; i < wave * 256 + 256; ++i) { const f32x4 w = *(const f32x4*)(w1 + (size_t)i * 256 + 4 * lane); acc4 = acc4 + w * pos[i]; }
            red[wave * 256 + 4 * lane + 0] = acc4[0]; red[wave * 256 + 4 * lane + 1] = acc4[1]; red[wave * 256 + 4 * lane + 2] = acc4[2]; red[wave * 256 + 4 * lane + 3] = acc4[3];
            __syncthreads();
            if (tid < 256) { float sum = 0.f;
#pragma unroll
                for (int w = 0; w < 8; ++w) sum += red[w * 256 + tid];
                ((float*)(ws + WS_W + (size_t)layer * W_LAYER + (kv ? W_CBV : W_CBK)))[tid] = sum; }
            __syncthreads();
        }
        row_pass(P_in(p, 0), (bf16_t*)(ws + WS_HB), nullptr, nullptr, (float*)(ws + WS_RS), nullptr, gw, NGW, lane);
    }
    grid.sync();
    if (TID_F == 0) (void)xb_add(&((unsigned*)P_ws(p))[XB_XCNT(xb_xcc_id())], 1u);

#pragma unroll 1
    for (int layer = 0; layer < DEPTH; ++layer) {
        const size_t wloff = WS_W + (size_t)layer * W_LAYER;
#ifndef SKIP_PA
        {
            FRESH_WS; unsigned char* wl = ws + wloff;
            pg8::Gemm g{(const bf16_t*)(ws + WS_HB), (const bf16_t*)(wl + W_IN), MT, NINP, DM, DM};
            pg8::StaticOrder so; so.init(MT, NINP, G, bx, REP_PA);
            pg8::EpiIn E{ws + WS_R1, (const float*)(ws + WS_RS)};
            pg8::gemm_phase<pg8::EpiIn>(lds, g, so, E);
        }
#endif
        GSYNC();
#ifndef SKIP_PB
        for (int rep = 0; rep < REP_PB; ++rep) {
            FRESH_WS; unsigned char* wl = ws + wloff;
            for (int kv = 0; kv < 2; ++kv) {
                const int c = kv ? ((bx + (G >> 1)) % G) : bx;
                if (c < 16) {
                    bf16_t* hid = (bf16_t*)(ws + WS_R1 + R_HID) + (size_t)kv * 4096 * 256;
                    pg8::Gemm g{(const bf16_t*)(ws + WS_R1 + (kv ? R_VC : R_KC)), (const bf16_t*)(wl + (kv ? W_C1V : W_C1K)), 4096, 256, 2048, 1024};
                    pg8::StaticOrder so; so.init(4096, 256, G, c);
                    pg8::EpiCmp1 E{hid, (const float*)(wl + (kv ? W_CBV : W_CBK))};
                    pg8::gemm_phase<pg8::EpiCmp1>(lds, g, so, E);
                    pg8::Unit u; so.next(0, u);
                    asm volatile("s_waitcnt vmcnt(0)" ::: "memory");
                    __builtin_amdgcn_fence(__ATOMIC_RELEASE, "agent");
                    __syncthreads();
                    __builtin_amdgcn_fence(__ATOMIC_ACQUIRE, "agent");
                    cmp_gemm2(hid, (const bf16_t*)(wl + (kv ? W_C2V : W_C2K)), (bf16_t*)(ws + WS_R1 + R_KCMP), (bf16_t*)(ws + WS_R1 + R_VCMPT), kv, u.pm * 256 + WAVE_F * 32, LANE_F);
                    __syncthreads();
                }
            }
            if (G == 256) {
                const bool is_cmp = (bx < 16) || (bx >= 128 && bx < 144);
                if (!is_cmp) {
                    const int idx = (bx < 128) ? (bx - 16) : (bx - 32);
                    gmlp_unit(p, layer, idx, lds, WAVE_F, LANE_F);
                    if (idx + 224 < MT / 128) gmlp_unit(p, layer, idx + 224, lds, WAVE_F, LANE_F);
                }
            } else {
                for (int ch = bx; ch < MT / 128; ch += G) gmlp_unit(p, layer, ch, lds, WAVE_F, LANE_F);
            }
        }
#endif
        GSYNC();
        {
#if NSA_ENABLE
            __syncthreads();
            for (int rep = 0; rep < REP_PC; ++rep) {
                if (G == 256) {
                    const int x = bx & 7, y = bx >> 3, bg = x >> 1, j = (x & 1) * 32 + y;
                    for (int i = 0; i < 4; ++i) {
                        const int jq = (i >> 1) * 128 + ((i & 1) ? (127 - j) : j);
                        nsa_unit(p, bg, jq, lds, WAVE_F, LANE_F, i == 0);
                    }
                } else {
                    for (int i = 0; bx + i * G < 1024; ++i) {
                        const int u = bx + i * G;
                        const int bg = u >> 8, x = u & 255;
                        const int jq = (bg & 1) ? (255 - x) : x;
                        nsa_unit(p, bg, jq, lds, WAVE_F, LANE_F, true);
                    }
                }
            }
#else
            FRESH_WS;
            bf16_t* mixed = (bf16_t*)(ws + WS_AN);
            for (int m = GW_F; m < MT; m += NGW) { u32x4* o = (u32x4*)(mixed + (size_t)m * 1024); o[LANE_F] = (u32x4){0u, 0u, 0u, 0u}; }
#endif
        }
        GSYNC();
        {
            FRESH_WS; unsigned char* wl = ws + wloff;
            pg8::Gemm g{AN, (const bf16_t*)(wl + W_OUT), MT, DM, DM, DM};
            pg8::StaticOrder so; so.init(MT, DM, G, bx, 1);
            pg8::EpiNormRes E{ws, P_in(p, 3) + layer * DM, nullptr, 2 * layer};
            pg8::gemm_phase<pg8::EpiNormRes>(lds, g, so, E);
        }
        GSYNC();
#ifndef SKIP_PF
        {
            FRESH_WS; unsigned char* wl = ws + wloff;
            pg8::Gemm g{(const bf16_t*)(ws + WS_HB), (const bf16_t*)(wl + W_GU), MT, NGU, DM, DM};
            pg8::StaticOrder so; so.init(MT, NGU, G, bx, REP_PF);
            pg8::EpiGU E{(bf16_t*)(ws + WS_R1), (const float*)(ws + WS_RS)};
            pg8::gemm_phase<pg8::EpiGU>(lds, g, so, E);
        }
#endif
        GSYNC();
        {
            FRESH_WS; unsigned char* wl = ws + wloff;
            pg8::Gemm g{(const bf16_t*)(ws + WS_R1), (const bf16_t*)(wl + W_DN), MT, DM, DFF, DFF};
            pg8::StaticOrder so; so.init(MT, DM, G, bx, 1);
            pg8::EpiNormRes E{ws, P_in(p, 5) + layer * DM, (layer + 1 < DEPTH) ? nullptr : P_out(p), 2 * layer + 1};
            pg8::gemm_phase<pg8::EpiNormRes>(lds, g, so, E);
        }
        if (layer + 1 < DEPTH) GSYNC();
    }
}

extern "C" void kernel_launch(void* const* d_in, const int* in_sizes, int n_in, void* d_out, int out_size, void* d_ws, size_t ws_size, hipStream_t stream) {
    static int grid = 0;
    if (grid == 0) {
        if (n_in != 20 || out_size != MT * DM || ws_size < WS_END) { fprintf(stderr, "kernel_launch: unexpected shapes (n_in %d out %d ws %zu need %zu)\n", n_in, out_size, ws_size, (size_t)WS_END); grid = -1; return; }
        int dev = 0, cus = 0, per_cu = 0;
        hipGetDevice(&dev);
        hipDeviceGetAttribute(&cus, hipDeviceAttributeMultiprocessorCount, dev);
        if (hipFuncSetAttribute((const void*)fwd_megakernel, hipFuncAttributeMaxDynamicSharedMemorySize, LDS_BYTES) != hipSuccess) { fprintf(stderr, "kernel_launch: hipFuncSetAttribute failed\n"); grid = -1; return; }
        if (hipOccupancyMaxActiveBlocksPerMultiprocessor(&per_cu, (const void*)fwd_megakernel, NTHREADS, LDS_BYTES) != hipSuccess || per_cu < 1) { fprintf(stderr, "kernel_launch: occupancy query says %d\n", per_cu); per_cu = 1; }
        (void)hipGetLastError();
        grid = cus;
        if (grid > 256) grid = 256;
    }
    if (grid < 0) return;
    Params p{};
    for (int i = 0; i < 20; ++i) p.in[i] = (const float*)d_in[i];
    p.out = (float*)d_out; p.ws = (unsigned char*)d_ws;
    void* args[] = {&p};
    hipError_t e = hipLaunchCooperativeKernel((const void*)fwd_megakernel, dim3(grid), dim3(NTHREADS), args, LDS_BYTES, stream);
    if (e != hipSuccess) fprintf(stderr, "cooperative launch failed: %s (grid %d)\n", hipGetErrorString(e), grid);
}
```

```cpp
#include <hip/hip_runtime.h>
#include <hip/hip_cooperative_groups.h>
#include <cstdio>
#include <cstdint>
namespace cg = cooperative_groups;

#define LAS __attribute__((address_space(3)))
typedef unsigned short bf16_t;
typedef short bf16x8 __attribute__((ext_vector_type(8)));
typedef short s16x4 __attribute__((ext_vector_type(4)));
typedef float f32x2 __attribute__((ext_vector_type(2)));
typedef float f32x4 __attribute__((ext_vector_type(4)));
typedef float f32x16 __attribute__((ext_vector_type(16)));
typedef unsigned u32x2 __attribute__((ext_vector_type(2)));
typedef unsigned u32x4 __attribute__((ext_vector_type(4)));
typedef long l64x2 __attribute__((ext_vector_type(2)));

#ifndef REP_PA
#define REP_PA 1
#endif
#ifndef REP_PB
#define REP_PB 1
#endif
#ifndef REP_PC
#define REP_PC 1
#endif
#ifndef REP_PD
#define REP_PD 1
#endif
#ifndef REP_PF
#define REP_PF 1
#endif
#ifndef REP_PG
#define REP_PG 1
#endif
#ifndef SYNC_REP
#define SYNC_REP 1
#endif
#define GSYNC() do { for (int _r = 0; _r < SYNC_REP; ++_r) xcd_barrier((unsigned*)P_ws(p), (volatile LAS unsigned*)(lds + LDS_BYTES - 64)); } while (0)
#ifndef NSA_ENABLE
#define NSA_ENABLE 1
#endif

constexpr int NB = 2, S = 16384, DM = 1024, DEPTH = 4, MT = NB * S;
constexpr int INW = 2328, NINP = 2560, DFF = 2816, NGU = 2 * DFF;
constexpr int NCMP = 1024;
constexpr float RMS_EPS = 1e-6f, LN_EPS = 1e-5f;
constexpr float LOG2E = 1.4426950408889634f;
constexpr float QSCALE = 0.125f * LOG2E;
constexpr int NWAVES = 8, NTHREADS = 512;
constexpr int LDS_BYTES = 156672;

constexpr size_t MiB = 1u << 20;
constexpr size_t WS_W = 1 * MiB, W_LAYER = 26 * MiB;
constexpr size_t W_IN = 0, W_OUT = 5 * MiB, W_GU = 7 * MiB, W_DN = 18 * MiB, W_C1K = 23 * MiB + 512 * 1024, W_C1V = 24 * MiB + 512 * 1024,
                 W_C2K = 25 * MiB + 512 * 1024, W_C2V = W_C2K + 64 * 1024, W_CBK = W_C2V + 64 * 1024, W_CBV = W_CBK + 4096;
constexpr size_t WS_AN = 105 * MiB;
constexpr size_t WS_R1 = 169 * MiB;
constexpr size_t R_Q = 0, R_ZU = 32 * MiB, R_ZV = 64 * MiB, R_KC = 96 * MiB, R_VC = 105 * MiB, R_KS = 114 * MiB, R_VST = 122 * MiB, R_KW = 130 * MiB,
                 R_VWT = 138 * MiB, R_GATES = 146 * MiB, R_HID = 150 * MiB, R_KCMP = 154 * MiB, R_VCMPT = 155 * MiB;
constexpr size_t WS_MIX = 345 * MiB;
constexpr size_t WS_HB = WS_MIX + 64 * MiB;
constexpr size_t WS_RS = 256 * 1024;
constexpr size_t WS_XCNT = 512 * 1024;
constexpr size_t WS_XBUF = WS_MIX;
constexpr size_t WS_END = 473 * MiB;

struct Params {
    const float* in[20];
    float* out;
    unsigned char* ws;
};

typedef const __attribute__((address_space(4))) unsigned char* kargp_t;
__device__ __forceinline__ void* karg_ld(int byte_off) {
    kargp_t k = (kargp_t)__builtin_amdgcn_kernarg_segment_ptr();
    int off = byte_off; asm volatile("" : "+s"(off));
    return *(void* const __attribute__((address_space(4)))*)(k + off);
}
__device__ __forceinline__ const float* P_in(const Params&, int i) { return (const float*)karg_ld(8 * i); }
__device__ __forceinline__ float* P_out(const Params&) { return (float*)karg_ld(160); }
__device__ __forceinline__ unsigned char* P_ws(const Params&) { return (unsigned char*)karg_ld(168); }
__device__ __forceinline__ unsigned cvt_pk_bf16(float lo, float hi) { unsigned r; asm volatile("v_cvt_pk_bf16_f32 %0, %1, %2" : "=v"(r) : "v"(lo), "v"(hi)); return r; }
__device__ __forceinline__ float fast_exp2(float x) { return __builtin_amdgcn_exp2f(x); }
__device__ __forceinline__ float fast_rcp(float x) { return __builtin_amdgcn_rcpf(x); }
__device__ __forceinline__ float gelu_tanh(float x) { const float u = x + 0.044715f * x * x * x; return x * fast_rcp(1.0f + fast_exp2(-2.3022081982f * u)); }
__device__ __forceinline__ float silu_f(float x) { return x * fast_rcp(1.0f + fast_exp2(-LOG2E * x)); }
__device__ __forceinline__ float sigmoid_f(float x) { return fast_rcp(1.0f + fast_exp2(-LOG2E * x)); }
__device__ __forceinline__ float wave_sum(float v) {
#pragma unroll
    for (int o = 1; o < 64; o <<= 1) v += __shfl_xor(v, o);
    return v;
}
__device__ __forceinline__ float wave_max(float v) {
#pragma unroll
    for (int o = 1; o < 64; o <<= 1) v = fmaxf(v, __shfl_xor(v, o));
    return v;
}
template <int CTRL> __device__ __forceinline__ float dpp_f(float x) { return __builtin_bit_cast(float, __builtin_amdgcn_mov_dpp(__builtin_bit_cast(int, x), CTRL, 0xf, 0xf, true)); }
__device__ __forceinline__ float xhalf_max(float x) { auto t = __builtin_amdgcn_permlane32_swap(__float_as_uint(x), __float_as_uint(x), false, false); return fmaxf(__uint_as_float(t[0]), __uint_as_float(t[1])); }
__device__ __forceinline__ float xhalf_sum(float x) { auto t = __builtin_amdgcn_permlane32_swap(__float_as_uint(x), __float_as_uint(x), false, false); return __uint_as_float(t[0]) + __uint_as_float(t[1]); }
__device__ __forceinline__ float quad_sum(float x) { x += dpp_f<0xB1>(x); x += dpp_f<0x4E>(x); return x; }
__device__ __forceinline__ float wave_max_fast(float x) {
    x = fmaxf(x, dpp_f<0xB1>(x)); x = fmaxf(x, dpp_f<0x4E>(x)); x = fmaxf(x, dpp_f<0x141>(x)); x = fmaxf(x, dpp_f<0x128>(x));
    auto s = __builtin_amdgcn_permlane16_swap(__float_as_uint(x), __float_as_uint(x), false, false); x = fmaxf(__uint_as_float(s[0]), __uint_as_float(s[1]));
    return xhalf_max(x);
}
__device__ __forceinline__ float wave_sum_fast(float x) {
    x += dpp_f<0xB1>(x); x += dpp_f<0x4E>(x); x += dpp_f<0x141>(x); x += dpp_f<0x128>(x);
    auto s = __builtin_amdgcn_permlane16_swap(__float_as_uint(x), __float_as_uint(x), false, false); x = __uint_as_float(s[0]) + __uint_as_float(s[1]);
    return xhalf_sum(x);
}
__device__ __forceinline__ float bf2f(bf16_t b) { return __uint_as_float(((unsigned)b) << 16); }
#define LAUNDER(x) asm volatile("" : "+v"(x))
#define MFMA32(a, b, c) __builtin_amdgcn_mfma_f32_32x32x16_bf16((a), (b), (c), 0, 0, 0)

namespace pg8 {
constexpr int BM = 256, BK = 64, HALF = 128, HTB = HALF * BK * 2, STAGE_BYTES = 8 * HTB, NXCD = 8, WGM = 8;
__host__ __device__ __forceinline__ int lds_byte(int r, int c) { const int st = (r >> 4) * 2 + (c >> 5), rr = r & 15, cc = c & 31, ob = rr * 64 + cc * 2; return st * 1024 + (ob ^ (((ob >> 9) & 1) << 5)); }
__host__ __device__ __forceinline__ void stage_rc(int b, int& R, int& C) { const int st = b / 1024, sb = b % 1024, swz = sb ^ (((sb >> 9) & 1) << 5); R = (st >> 1) * 16 + swz / 64; C = (st & 1) * 32 + (swz % 64) / 2; }
__host__ __device__ __forceinline__ int perm32(int rho) { const int n = rho >> 4, i = rho & 15; return 8 * (i >> 2) + 4 * n + (i & 3); }

struct Unit { int pm, pn; };
struct Gemm { const bf16_t* A; const bf16_t* Bt; int M, N, K, lda; };

struct StaticOrder {
    int nM, nN, nwg, G, c, lim;
    __device__ __forceinline__ void init(int M, int N, int G_, int c_, int reps = 1) { nM = M / BM; nN = N / BM; nwg = nM * nN; G = G_; c = c_; const int per = (c < nwg) ? (nwg - c + G - 1) / G : 0; lim = per * reps; }
    __device__ __forceinline__ bool next(int i, Unit& u) const {
        if (i >= lim) return false;
        const int per = (nwg - c + G - 1) / G; const long L = (long)(i % per) * G + c;
        int wgid = (int)L; { const int q = nwg / NXCD, r = nwg % NXCD, xcd = wgid % NXCD, off = wgid / NXCD; wgid = (xcd < r ? xcd * (q + 1) : r * (q + 1) + (xcd - r) * q) + off; }
        const int nig = WGM * nN, gid = wgid / nig, fm = gid * WGM, gsz = (nM - fm) < WGM ? (nM - fm) : WGM;
        u.pm = fm + ((wgid % nig) % gsz); u.pn = (wgid % nig) / gsz; return true;
    }
};

struct EpiF32 {
    static constexpr bool PERM = false, FUSED = false;
    float* C; int ldc;
    __device__ __forceinline__ void operator()(const f32x4 (&acc)[2][2][4][2], const Unit& u, int wr, int wc, int fr, int fq) const {
        const int row0 = u.pm * BM + wr * 64 + fr, col0 = u.pn * BM + wc * 32 + 4 * fq;
#pragma unroll
        for (int ai = 0; ai < 2; ++ai)
#pragma unroll
            for (int m = 0; m < 4; ++m) { float* rowp = C + (size_t)(row0 + ai * HALF + m * 16) * ldc + col0;
#pragma unroll
                for (int bj = 0; bj < 2; ++bj)
#pragma unroll
                    for (int n = 0; n < 2; ++n) *(f32x4*)(rowp + bj * HALF + n * 16) = acc[ai][bj][m][n]; }
    }
};

struct EpiBf16 {
    static constexpr bool PERM = true, FUSED = false;
    bf16_t* C; int ldc;
    __device__ __forceinline__ void operator()(const f32x4 (&acc)[2][2][4][2], const Unit& u, int wr, int wc, int fr, int fq) const {
        const int row0 = u.pm * BM + wr * 64 + fr, col0 = u.pn * BM + wc * 32 + 8 * fq;
#pragma unroll
        for (int ai = 0; ai < 2; ++ai)
#pragma unroll
            for (int m = 0; m < 4; ++m) { bf16_t* rowp = C + (size_t)(row0 + ai * HALF + m * 16) * ldc + col0;
#pragma unroll
                for (int bj = 0; bj < 2; ++bj) { const f32x4 v0 = acc[ai][bj][m][0], v1 = acc[ai][bj][m][1];
                    u32x4 w; w.x = cvt_pk_bf16(v0[0], v0[1]); w.y = cvt_pk_bf16(v0[2], v0[3]); w.z = cvt_pk_bf16(v1[0], v1[1]); w.w = cvt_pk_bf16(v1[2], v1[3]);
                    *(u32x4*)(rowp + bj * HALF) = w; } }
    }
};

struct EpiGU {
    static constexpr bool PERM = true, FUSED = false;
    bf16_t* act; const float* rs;
    __device__ __forceinline__ void operator()(const f32x4 (&acc)[2][2][4][2], const Unit& u, int wr, int wc, int fr, int fq) const {
        const int row0 = u.pm * BM + wr * 64 + fr, col0 = u.pn * HALF + wc * 32 + 8 * fq;
        float rrv[2][4];
#pragma unroll
        for (int ai = 0; ai < 2; ++ai)
#pragma unroll
            for (int m = 0; m < 4; ++m) rrv[ai][m] = rs[row0 + ai * HALF + m * 16];
#pragma unroll
        for (int ai = 0; ai < 2; ++ai)
#pragma unroll
            for (int m = 0; m < 4; ++m) {
                const float rr = rrv[ai][m];
                const f32x4 g0 = acc[ai][0][m][0] * rr, g1 = acc[ai][0][m][1] * rr, u0 = acc[ai][1][m][0] * rr, u1 = acc[ai][1][m][1] * rr;
                u32x4 w;
                w.x = cvt_pk_bf16(silu_f(g0[0]) * u0[0], silu_f(g0[1]) * u0[1]); w.y = cvt_pk_bf16(silu_f(g0[2]) * u0[2], silu_f(g0[3]) * u0[3]);
                w.z = cvt_pk_bf16(silu_f(g1[0]) * u1[0], silu_f(g1[1]) * u1[1]); w.w = cvt_pk_bf16(silu_f(g1[2]) * u1[2], silu_f(g1[3]) * u1[3]);
                *(u32x4*)(act + (size_t)(row0 + ai * HALF + m * 16) * DFF + col0) = w;
            }
    }
};

struct EpiCmp1 {
    static constexpr bool PERM = true, FUSED = false;
    bf16_t* hid; const float* cbias;
    __device__ __forceinline__ void operator()(const f32x4 (&acc)[2][2][4][2], const Unit& u, int wr, int wc, int fr, int fq) const {
        const int row0 = u.pm * BM + wr * 64 + fr;
#pragma unroll
        for (int bj = 0; bj < 2; ++bj) {
            const int col0 = bj * HALF + wc * 32 + 8 * fq;
            const f32x4 b0 = *(const f32x4*)(cbias + col0), b1 = *(const f32x4*)(cbias + col0 + 4);
#pragma unroll
            for (int ai = 0; ai < 2; ++ai)
#pragma unroll
                for (int m = 0; m < 4; ++m) {
                    const f32x4 v0 = acc[ai][bj][m][0] + b0, v1 = acc[ai][bj][m][1] + b1;
                    u32x4 w;
                    w.x = cvt_pk_bf16(gelu_tanh(v0[0]), gelu_tanh(v0[1])); w.y = cvt_pk_bf16(gelu_tanh(v0[2]), gelu_tanh(v0[3]));
                    w.z = cvt_pk_bf16(gelu_tanh(v1[0]), gelu_tanh(v1[1])); w.w = cvt_pk_bf16(gelu_tanh(v1[2]), gelu_tanh(v1[3]));
                    *(u32x4*)(hid + (size_t)(row0 + ai * HALF + m * 16) * 256 + col0) = w;
                }
        }
    }
};

struct EpiIn {
    static constexpr bool PERM = true, FUSED = false;
    unsigned char* r1;
    const float* rs;
    __device__ __forceinline__ void operator()(const f32x4 (&acc)[2][2][4][2], const Unit& u, int wr, int wc, int fr, int fq) const {
        const int pn = u.pn;
        float rrv[2][4];
#pragma unroll
        for (int ai = 0; ai < 2; ++ai)
#pragma unroll
            for (int m = 0; m < 4; ++m) rrv[ai][m] = rs[u.pm * BM + ai * HALF + wr * 64 + m * 16 + fr];
#pragma unroll
        for (int ai = 0; ai < 2; ++ai)
#pragma unroll
            for (int m = 0; m < 4; ++m) {
                const int row = u.pm * BM + ai * HALF + wr * 64 + m * 16 + fr;
                const int b = row >> 14, s = row & (S - 1);
                const float rr = rrv[ai][m];
#pragma unroll
                for (int bj = 0; bj < 2; ++bj) {
                    f32x4 v0 = acc[ai][bj][m][0] * rr, v1 = acc[ai][bj][m][1] * rr;
                    const int cw = bj * HALF + wc * 32 + 8 * fq;
                    if (pn < 2) {
                        v0 = v0 * QSCALE; v1 = v1 * QSCALE;
                        u32x4 w; w.x = cvt_pk_bf16(v0[0], v0[1]); w.y = cvt_pk_bf16(v0[2], v0[3]); w.z = cvt_pk_bf16(v1[0], v1[1]); w.w = cvt_pk_bf16(v1[2], v1[3]);
                        *(u32x4*)((bf16_t*)(r1 + R_Q) + (size_t)row * 512 + pn * 256 + cw) = w;
                    } else if (pn < 5) {
                        const int g = wc >> 1, d = (wc & 1) * 32 + 8 * fq, bg = b * 2 + g;
                        if (pn == 2) {
                            bf16_t* base = (bf16_t*)(r1 + (bj == 0 ? R_KC : R_VC));
                            u32x4 w; w.x = cvt_pk_bf16(v0[0], v0[1]); w.y = cvt_pk_bf16(v0[2], v0[3]); w.z = cvt_pk_bf16(v1[0], v1[1]); w.w = cvt_pk_bf16(v1[2], v1[3]);
                            *(u32x4*)(base + ((size_t)bg * S + s) * 64 + d) = w;
                        } else if (pn == 3) {
                            if (bj == 0) {
                                v0 = v0 * 0.25f; v1 = v1 * 0.25f;
                                int w0 = __builtin_amdgcn_cvt_pk_fp8_f32(v0[0], v0[1], 0, false); w0 = __builtin_amdgcn_cvt_pk_fp8_f32(v0[2], v0[3], w0, true);
                                int w1 = __builtin_amdgcn_cvt_pk_fp8_f32(v1[0], v1[1], 0, false); w1 = __builtin_amdgcn_cvt_pk_fp8_f32(v1[2], v1[3], w1, true);
                                u32x2 w; w.x = (unsigned)w0; w.y = (unsigned)w1;
                                *(u32x2*)(r1 + R_KS + (size_t)bg * S * 64 + (size_t)(s >> 6) * 4096 + ((s >> 4) & 3) * 1024 + (((d >> 3) & 3) * 16 + (s & 15)) * 16 + (d >> 5) * 8) = w;
                            } else {
                                const int kb = s & 63, kp = kb >> 5, k32 = kb & 31, fqv = (k32 >> 2) & 3, jj = ((k32 >> 4) << 2) | (k32 & 3);
                                unsigned char* dst = r1 + R_VST + (size_t)bg * S * 64 + (size_t)(s >> 6) * 4096 + (d >> 4) * 1024 + (fqv * 16 + (d & 15)) * 16 + kp * 8 + jj;
                                const int w0 = __builtin_amdgcn_cvt_pk_fp8_f32(v0[0], v0[1], 0, false), w1 = __builtin_amdgcn_cvt_pk_fp8_f32(v0[2], v0[3], 0, false);
                                const int w2 = __builtin_amdgcn_cvt_pk_fp8_f32(v1[0], v1[1], 0, false), w3 = __builtin_amdgcn_cvt_pk_fp8_f32(v1[2], v1[3], 0, false);
                                dst[0] = (unsigned char)(w0 & 0xff); dst[16] = (unsigned char)((w0 >> 8) & 0xff); dst[32] = (unsigned char)(w1 & 0xff); dst[48] = (unsigned char)((w1 >> 8) & 0xff);
                                dst[64] = (unsigned char)(w2 & 0xff); dst[80] = (unsigned char)((w2 >> 8) & 0xff); dst[96] = (unsigned char)(w3 & 0xff); dst[112] = (unsigned char)((w3 >> 8) & 0xff);
                            }
                        } else if (bj == 0) {
                            bf16_t* base = (bf16_t*)(r1 + R_KW);
                            u32x4 w; w.x = cvt_pk_bf16(v0[0], v0[1]); w.y = cvt_pk_bf16(v0[2], v0[3]); w.z = cvt_pk_bf16(v1[0], v1[1]); w.w = cvt_pk_bf16(v1[2], v1[3]);
                            *(u32x4*)(base + (size_t)bg * S * 64 + (size_t)(s >> 5) * 2048 + (d >> 4) * 512 + ((d >> 3) & 1) * 256 + (s & 31) * 8) = w;
                        } else {
                            const int kk = s & 31;
                            bf16_t* dst = (bf16_t*)(r1 + R_VWT) + (size_t)bg * S * 64 + (size_t)(s >> 5) * 2048 + (d >> 5) * 1024 + (kk >> 4) * 512 + ((kk >> 2) & 1) * 256 + (d & 31) * 8 + ((kk >> 3) & 1) * 4 + (kk & 3);
                            const unsigned w0 = cvt_pk_bf16(v0[0], v0[1]), w1 = cvt_pk_bf16(v0[2], v0[3]), w2 = cvt_pk_bf16(v1[0], v1[1]), w3 = cvt_pk_bf16(v1[2], v1[3]);
                            dst[0] = (bf16_t)(w0 & 0xffff); dst[8] = (bf16_t)(w0 >> 16); dst[16] = (bf16_t)(w1 & 0xffff); dst[24] = (bf16_t)(w1 >> 16);
                            dst[32] = (bf16_t)(w2 & 0xffff); dst[40] = (bf16_t)(w2 >> 16); dst[48] = (bf16_t)(w3 & 0xffff); dst[56] = (bf16_t)(w3 >> 16);
                        }
                    } else if (pn < 9) {
                        bf16_t* base = (bf16_t*)(r1 + ((pn < 7) ? R_ZU : R_ZV)); const int ct = (pn < 7) ? (pn - 5) : (pn - 7);
                        u32x4 w;
                        w.x = cvt_pk_bf16(gelu_tanh(v0[0]), gelu_tanh(v0[1])); w.y = cvt_pk_bf16(gelu_tanh(v0[2]), gelu_tanh(v0[3]));
                        w.z = cvt_pk_bf16(gelu_tanh(v1[0]), gelu_tanh(v1[1])); w.w = cvt_pk_bf16(gelu_tanh(v1[2]), gelu_tanh(v1[3]));
                        *(u32x4*)(base + (size_t)row * 512 + ct * 256 + cw) = w;
                    } else {
                        if (bj == 0 && wc == 0 && fq < 3) {
                            float* gp = (float*)(r1 + R_GATES) + (size_t)row * 24 + 8 * fq;
                            *(f32x4*)gp = (f32x4){sigmoid_f(v0[0]), sigmoid_f(v0[1]), sigmoid_f(v0[2]), sigmoid_f(v0[3])};
                            *(f32x4*)(gp + 4) = (f32x4){sigmoid_f(v1[0]), sigmoid_f(v1[1]), sigmoid_f(v1[2]), sigmoid_f(v1[3])};
                        }
                    }
                }
            }
    }
};

struct EpiNormRes {
    static constexpr bool PERM = true, FUSED = true;
    unsigned char* ws; const float* gpost; float* fout; int inst;
    __device__ __forceinline__ void exchange(int e, float (&sv)[2][4], float (&rv)[2][4], const Unit& u, int wr, int wc, int fr, int fq, LAS unsigned char* lds, int wid, int lane) const {
        LAS float* P = (LAS float*)(lds + 131072);
        LAS float* Sx = P + 1024;
        float* xbuf = (float*)(ws + WS_XBUF) + (size_t)e * MT * 4;
        unsigned* cnt = (unsigned*)(ws + WS_XCNT) + ((size_t)(e * 8 + inst) * 128 + u.pm) * 16;
#pragma unroll
        for (int ai = 0; ai < 2; ++ai)
#pragma unroll
            for (int m = 0; m < 4; ++m) {
                float v = sv[ai][m];
                { auto t1 = __builtin_amdgcn_permlane16_swap(__float_as_uint(v), __float_as_uint(v), false, false); v = __uint_as_float(t1[0]) + __uint_as_float(t1[1]); }
                v = xhalf_sum(v);
                if (fq == 0) P[(ai * HALF + wr * 64 + m * 16 + fr) * 4 + wc] = v;
            }
        asm volatile("s_waitcnt lgkmcnt(0)" ::: "memory"); __builtin_amdgcn_s_barrier(); asm volatile("" ::: "memory");
        const int tid = wid * 64 + lane;
        if (tid < 256) {
            const f32x4 pp = *(const LAS f32x4*)(P + tid * 4);
            __hip_atomic_store(xbuf + ((size_t)u.pm * 256 + tid) * 4 + u.pn, (pp[0] + pp[1]) + (pp[2] + pp[3]), __ATOMIC_RELAXED, __HIP_MEMORY_SCOPE_AGENT);
        }
        asm volatile("s_waitcnt vmcnt(0)" ::: "memory");
        if (wid < 4 && lane == 0) __hip_atomic_fetch_add(cnt, 1u, __ATOMIC_RELAXED, __HIP_MEMORY_SCOPE_AGENT);
        if (wid == 0) {
            unsigned sp = 0;
            while ((unsigned)__builtin_amdgcn_readfirstlane(__hip_atomic_load(cnt, __ATOMIC_RELAXED, __HIP_MEMORY_SCOPE_AGENT)) < 16u) { __builtin_amdgcn_s_sleep(2); if (++sp > (1u << 22)) break; }
            __builtin_amdgcn_fence(__ATOMIC_ACQUIRE, "agent");
        }
        asm volatile("s_waitcnt vmcnt(0) lgkmcnt(0)" ::: "memory"); __builtin_amdgcn_s_barrier(); asm volatile("" ::: "memory");
        if (tid < 256) {
            const float* sl = xbuf + ((size_t)u.pm * 256 + tid) * 4;
            const float t0 = __hip_atomic_load(sl + 0, __ATOMIC_RELAXED, __HIP_MEMORY_SCOPE_AGENT), t1 = __hip_atomic_load(sl + 1, __ATOMIC_RELAXED, __HIP_MEMORY_SCOPE_AGENT);
            const float t2 = __hip_atomic_load(sl + 2, __ATOMIC_RELAXED, __HIP_MEMORY_SCOPE_AGENT), t3 = __hip_atomic_load(sl + 3, __ATOMIC_RELAXED, __HIP_MEMORY_SCOPE_AGENT);
            Sx[tid] = 1.0f / sqrtf(((t0 + t1) + (t2 + t3)) * (1.0f / 1024.0f) + RMS_EPS);
        }
        asm volatile("s_waitcnt vmcnt(0) lgkmcnt(0)" ::: "memory"); __builtin_amdgcn_s_barrier(); asm volatile("" ::: "memory");
#pragma unroll
        for (int ai = 0; ai < 2; ++ai)
#pragma unroll
            for (int m = 0; m < 4; ++m) rv[ai][m] = Sx[ai * HALF + wr * 64 + m * 16 + fr];
    }
    __device__ __forceinline__ void fused(f32x4 (&acc)[2][2][4][2], const Unit& u, int wr, int wc, int fr, int fq, LAS unsigned char* lds, int wid, int lane) const {
        bf16_t* hb = (bf16_t*)(ws + WS_HB);
        const int row0 = u.pm * BM + wr * 64 + fr, col0 = u.pn * BM + wc * 32 + 8 * fq;
        float sv[2][4], rv[2][4];
#pragma unroll
        for (int ai = 0; ai < 2; ++ai)
#pragma unroll
            for (int m = 0; m < 4; ++m) {
                float q = 0.f;
#pragma unroll
                for (int bj = 0; bj < 2; ++bj)
#pragma unroll
                    for (int n = 0; n < 2; ++n) { const f32x4 x = acc[ai][bj][m][n]; q += (x[0] * x[0] + x[1] * x[1]) + (x[2] * x[2] + x[3] * x[3]); }
                sv[ai][m] = q;
            }
        exchange(0, sv, rv, u, wr, wc, fr, fq, lds, wid, lane);
        float dep = 0.f;
#pragma unroll
        for (int ai = 0; ai < 2; ++ai)
#pragma unroll
            for (int m = 0; m < 4; ++m) {
                const bf16_t* hrow = hb + (size_t)(row0 + ai * HALF + m * 16) * DM + col0;
                asm volatile("" : "+v"(hrow) : "v"(dep));
                const float r1 = rv[ai][m];
                float q = 0.f;
#pragma unroll
                for (int bj = 0; bj < 2; ++bj) {
                    const u32x4 hv = *(const u32x4*)(hrow + bj * HALF);
                    const f32x4 h0 = (f32x4){__uint_as_float(hv.x << 16), __uint_as_float(hv.x & 0xffff0000u), __uint_as_float(hv.y << 16), __uint_as_float(hv.y & 0xffff0000u)};
                    const f32x4 h1 = (f32x4){__uint_as_float(hv.z << 16), __uint_as_float(hv.z & 0xffff0000u), __uint_as_float(hv.w << 16), __uint_as_float(hv.w & 0xffff0000u)};
                    const f32x4 gg0 = *(const f32x4*)(gpost + col0 + bj * HALF), gg1 = *(const f32x4*)(gpost + col0 + bj * HALF + 4);
                    f32x4 x0 = h0 + acc[ai][bj][m][0] * r1 * gg0, x1 = h1 + acc[ai][bj][m][1] * r1 * gg1;
                    acc[ai][bj][m][0] = x0; acc[ai][bj][m][1] = x1;
                    q += ((x0[0] * x0[0] + x0[1] * x0[1]) + (x0[2] * x0[2] + x0[3] * x0[3])) + ((x1[0] * x1[0] + x1[1] * x1[1]) + (x1[2] * x1[2] + x1[3] * x1[3]));
                }
                sv[ai][m] = q;
                dep = q;
            }
        if (fout) {
#pragma unroll
            for (int ai = 0; ai < 2; ++ai)
#pragma unroll
                for (int m = 0; m < 4; ++m) { float* orow = fout + (size_t)(row0 + ai * HALF + m * 16) * DM + col0;
#pragma unroll
                    for (int bj = 0; bj < 2; ++bj) { *(f32x4*)(orow + bj * HALF) = acc[ai][bj][m][0]; *(f32x4*)(orow + bj * HALF + 4) = acc[ai][bj][m][1]; } }
            return;
        }
        exchange(1, sv, rv, u, wr, wc, fr, fq, lds, wid, lane);
        float* rs = (float*)(ws + WS_RS);
#pragma unroll
        for (int ai = 0; ai < 2; ++ai)
#pragma unroll
            for (int m = 0; m < 4; ++m) {
                bf16_t* hrow = hb + (size_t)(row0 + ai * HALF + m * 16) * DM + col0;
#pragma unroll
                for (int bj = 0; bj < 2; ++bj) { const f32x4 x0 = acc[ai][bj][m][0], x1 = acc[ai][bj][m][1];
                    u32x4 w; w.x = cvt_pk_bf16(x0[0], x0[1]); w.y = cvt_pk_bf16(x0[2], x0[3]); w.z = cvt_pk_bf16(x1[0], x1[1]); w.w = cvt_pk_bf16(x1[2], x1[3]);
                    *(u32x4*)(hrow + bj * HALF) = w; }
                if (u.pn == 0 && wc == 0 && fq == 0) rs[row0 + ai * HALF + m * 16] = rv[ai][m];
            }
    }
};

template <class Epi>
__device__ __forceinline__ void gemm_phase(LAS unsigned char* lds, const Gemm g, const StaticOrder& S, const Epi& E) {
    int tid = threadIdx.x; LAUNDER(tid);
    const int wid = __builtin_amdgcn_readfirstlane(tid >> 6), lane = tid & 63, wr = wid >> 2, wc = wid & 3, fr = lane & 15, fq = lane >> 4;
    const int K = g.K, nt = K / BK, lda = g.lda;
    unsigned voffA[2], voffB[2];
#pragma unroll
    for (int i = 0; i < 2; ++i) { int R, C; stage_rc(tid * 16 + i * 8192, R, C); const int Rb = Epi::PERM ? ((R & ~31) + perm32(R & 31)) : R;
        voffA[i] = (unsigned)(R * lda + C) * 2u; voffB[i] = (unsigned)(Rb * K + C) * 2u; }
    const size_t kstep = (size_t)(BK * 2);
    const size_t hA = (size_t)HALF * lda * 2, hB = (size_t)HALF * K * 2;
    const size_t tA = 2 * hA, tB = 2 * hB;
    const unsigned ldsw = (unsigned)wid * 1024u;
    const int aoff = lds_byte(wr * 64 + fr, fq * 8), boff = lds_byte(wc * 32 + fr, fq * 8);
#define PG8_SA(b, h) (((b) * 2 + (h)) * HTB)
#define PG8_SB(b, h) ((4 + (b) * 2 + (h)) * HTB)
#define PG8_STAGE(bufoff, gbase, voff) do { _Pragma("unroll") for (int _i = 0; _i < 2; ++_i) \
        __builtin_amdgcn_global_load_lds((const unsigned*)((const char*)(gbase) + (voff)[_i]), (LAS unsigned*)(lds + (bufoff) + ldsw + _i * 8192), 16, 0, 0); } while (0)
#define PG8_LDA(dst, b, h) do { _Pragma("unroll") for (int m = 0; m < 4; ++m) _Pragma("unroll") for (int k = 0; k < 2; ++k) dst[m][k] = *(const LAS bf16x8*)(lds + PG8_SA(b, h) + aoff + m * 2048 + k * 1024); } while (0)
#define PG8_LDB(dst, b, h) do { _Pragma("unroll") for (int n = 0; n < 2; ++n) _Pragma("unroll") for (int k = 0; k < 2; ++k) dst[n][k] = *(const LAS bf16x8*)(lds + PG8_SB(b, h) + boff + n * 2048 + k * 1024); } while (0)
#define PG8_MMA(ai, bj, At, Bt) do { __builtin_amdgcn_s_setprio(1); _Pragma("unroll") for (int m = 0; m < 4; ++m) _Pragma("unroll") for (int n = 0; n < 2; ++n) _Pragma("unroll") for (int k = 0; k < 2; ++k) \
        acc[ai][bj][m][n] = __builtin_amdgcn_mfma_f32_16x16x32_bf16(Bt[n][k], At[m][k], acc[ai][bj][m][n], 0, 0, 0); __builtin_amdgcn_s_setprio(0); } while (0)
#define PG8_WAIT_V(n) asm volatile("s_waitcnt vmcnt(" #n ")" ::: "memory")
#define PG8_WAIT_L(n) asm volatile("s_waitcnt lgkmcnt(" #n ")" ::: "memory")
#define PG8_BAR __builtin_amdgcn_s_barrier()
#define PG8_SCHED __builtin_amdgcn_sched_barrier(0)
    Unit cur, nxt; int ui = 0;
    if (!S.next(0, cur)) return;
    f32x4 acc[2][2][4][2];
#pragma unroll
    for (int a = 0; a < 2; ++a)
#pragma unroll
        for (int b = 0; b < 2; ++b)
#pragma unroll
            for (int m = 0; m < 4; ++m)
#pragma unroll
                for (int n = 0; n < 2; ++n) acc[a][b][m][n] = (f32x4){0.f, 0.f, 0.f, 0.f};
    bf16x8 At[4][2], B0[2][2], B1[2][2];
    const char* cA = (const char*)g.A + (size_t)cur.pm * tA; const char* cB = (const char*)g.Bt + (size_t)cur.pn * tB;
    PG8_STAGE(PG8_SB(0, 0), cB, voffB); PG8_STAGE(PG8_SB(0, 1), cB + hB, voffB); PG8_STAGE(PG8_SA(0, 0), cA, voffA); PG8_STAGE(PG8_SA(0, 1), cA + hA, voffA);
    if (wr == 1) PG8_BAR;
    PG8_WAIT_V(2); PG8_BAR;
    PG8_STAGE(PG8_SB(1, 0), cB + kstep, voffB); PG8_STAGE(PG8_SA(1, 0), cA + kstep, voffA); PG8_STAGE(PG8_SB(1, 1), cB + hB + kstep, voffB);
    PG8_WAIT_V(6); PG8_BAR;
    for (;;) {
        const bool has_next = S.next(ui + 1, nxt);
        const char* nA = has_next ? (const char*)g.A + (size_t)nxt.pm * tA : cA; const char* nB = has_next ? (const char*)g.Bt + (size_t)nxt.pn * tB : cB;
        for (int t = 0; t < nt; t += 2) {
            const bool last = (t == nt - 2);
            const char* a1 = cA + (size_t)(t + 1) * kstep;
            const char* a2 = last ? nA : cA + (size_t)(t + 2) * kstep; const char* b2 = last ? nB : cB + (size_t)(t + 2) * kstep;
            const char* a3 = a2 + kstep; const char* b3 = b2 + kstep;
            PG8_LDB(B0, 0, 0); PG8_LDB(B1, 0, 1); PG8_SCHED; PG8_LDA(At, 0, 0); PG8_STAGE(PG8_SA(1, 1), a1 + hA, voffA);
            PG8_WAIT_V(8); PG8_WAIT_L(0); PG8_BAR; PG8_MMA(0, 0, At, B0); PG8_MMA(0, 1, At, B1); PG8_BAR; PG8_SCHED;
            PG8_LDA(At, 0, 1); PG8_STAGE(PG8_SB(0, 0), b2, voffB); PG8_STAGE(PG8_SB(0, 1), b2 + hB, voffB); PG8_STAGE(PG8_SA(0, 0), a2, voffA);
            PG8_WAIT_V(8); PG8_WAIT_L(0); PG8_BAR; PG8_MMA(1, 0, At, B0); PG8_MMA(1, 1, At, B1); PG8_BAR; PG8_SCHED;
            PG8_LDB(B0, 1, 0); PG8_LDB(B1, 1, 1); PG8_SCHED; PG8_LDA(At, 1, 0); PG8_STAGE(PG8_SA(0, 1), a2 + hA, voffA);
            PG8_WAIT_V(8); PG8_WAIT_L(0); PG8_BAR; PG8_MMA(0, 0, At, B0); PG8_MMA(0, 1, At, B1); PG8_BAR; PG8_SCHED;
            PG8_LDA(At, 1, 1); PG8_STAGE(PG8_SB(1, 0), b3, voffB); PG8_STAGE(PG8_SB(1, 1), b3 + hB, voffB); PG8_STAGE(PG8_SA(1, 0), a3, voffA);
            PG8_WAIT_V(8); PG8_WAIT_L(0); PG8_BAR; PG8_MMA(1, 0, At, B0); PG8_MMA(1, 1, At, B1); PG8_BAR; PG8_SCHED;
        }
        if (wr == 0) PG8_BAR;
        if constexpr (Epi::FUSED) E.fused(acc, cur, wr, wc, fr, fq, lds, wid, lane); else E(acc, cur, wr, wc, fr, fq);
        if (!has_next) break;
#pragma unroll
        for (int a = 0; a < 2; ++a)
#pragma unroll
            for (int b = 0; b < 2; ++b)
#pragma unroll
                for (int m = 0; m < 4; ++m)
#pragma unroll
                    for (int n = 0; n < 2; ++n) acc[a][b][m][n] = (f32x4){0.f, 0.f, 0.f, 0.f};
        cur = nxt; cA = nA; cB = nB; ++ui;
        if (wr == 1) PG8_BAR;
    }
    PG8_WAIT_V(0);
    PG8_BAR;
#undef PG8_SA
#undef PG8_SB
#undef PG8_STAGE
#undef PG8_LDA
#undef PG8_LDB
#undef PG8_MMA
#undef PG8_WAIT_V
#undef PG8_WAIT_L
#undef PG8_BAR
#undef PG8_SCHED
}
}

template <int MAP> __device__ __forceinline__ int src_col(int n) {
    if (MAP == 0) return n;
    if (MAP == 1) { if (n < 1280) return n; if (n < 2304) return n + 24; if (n < 2328) return n - 1024; return -1; }
    const int t = n >> 8, w = n & 255; return (w < 128) ? (128 * t + w) : (DFF + 128 * t + (w - 128));
}
constexpr int TP = 65;
template <int MAP> __device__ __forceinline__ void transpose_item(const float* W, int K, int Nsrc, bf16_t* WT, int nblk, int item, LAS float* scr, int lane, const float* gain = nullptr) {
    const int kb = item / nblk, nb = item % nblk, k0 = 64 * kb, n0 = 64 * nb;
    const int nl = 4 * (lane & 15), kr = lane >> 4;
    const int ns = src_col<MAP>(n0 + nl);
    f32x4 v[16];
#pragma unroll
    for (int i = 0; i < 16; ++i) v[i] = (ns >= 0) ? *(const f32x4*)(W + (size_t)(k0 + kr + 4 * i) * Nsrc + ns) : (f32x4){0.f, 0.f, 0.f, 0.f};
    if (gain) {
#pragma unroll
        for (int i = 0; i < 16; ++i) v[i] = v[i] * gain[k0 + kr + 4 * i];
    }
#pragma unroll
    for (int i = 0; i < 16; ++i) { LAS float* d = scr + (kr + 4 * i) * TP + nl; d[0] = v[i][0]; d[1] = v[i][1]; d[2] = v[i][2]; d[3] = v[i][3]; }
    asm volatile("s_waitcnt lgkmcnt(0)" ::: "memory");
    __builtin_amdgcn_wave_barrier();
    const int c = lane & 7;
#pragma unroll
    for (int j = 0; j < 8; ++j) { const int n = (lane >> 3) + 8 * j; const LAS float* s = scr + (8 * c) * TP + n;
        u32x4 o; o.x = cvt_pk_bf16(s[0 * TP], s[1 * TP]); o.y = cvt_pk_bf16(s[2 * TP], s[3 * TP]); o.z = cvt_pk_bf16(s[4 * TP], s[5 * TP]); o.w = cvt_pk_bf16(s[6 * TP], s[7 * TP]);
        *(u32x4*)(WT + (size_t)(n0 + n) * K + k0 + 8 * c) = o; }
    asm volatile("s_waitcnt lgkmcnt(0)" ::: "memory");
    __builtin_amdgcn_wave_barrier();
}

__device__ __forceinline__ void row_pass(const float* x0, bf16_t* hb, const bf16_t* mix, const float* gpost, float* rs, float* fout, int gw, int NGW, int lane) {
    LAUNDER(lane);
    if (x0) {
        for (int m = gw; m < MT; m += NGW) {
            const f32x4* hr = (const f32x4*)(x0 + (size_t)m * DM) + lane;
            f32x4 h[4]; float s2 = 0.f;
#pragma unroll
            for (int j = 0; j < 4; ++j) { h[j] = hr[64 * j]; s2 += (h[j][0] * h[j][0] + h[j][1] * h[j][1]) + (h[j][2] * h[j][2] + h[j][3] * h[j][3]); }
            const float r2 = 1.0f / sqrtf(wave_sum_fast(s2) * (1.0f / DM) + RMS_EPS);
            u32x2* ao = (u32x2*)(hb + (size_t)m * DM) + lane;
#pragma unroll
            for (int j = 0; j < 4; ++j) { u32x2 w; w.x = cvt_pk_bf16(h[j][0], h[j][1]); w.y = cvt_pk_bf16(h[j][2], h[j][3]); ao[64 * j] = w; }
            if (lane == 0) rs[m] = r2;
        }
        return;
    }
    u32x2 hn[4], mn[4];
    if (gw < MT) {
        const u32x2* hr = (const u32x2*)(hb + (size_t)gw * DM) + lane; const u32x2* mr = (const u32x2*)(mix + (size_t)gw * DM) + lane;
#pragma unroll
        for (int j = 0; j < 4; ++j) { hn[j] = hr[64 * j]; mn[j] = mr[64 * j]; }
    }
    for (int m = gw; m < MT; m += NGW) {
        u32x2 hv[4], mv[4];
#pragma unroll
        for (int j = 0; j < 4; ++j) { hv[j] = hn[j]; mv[j] = mn[j]; }
        const int m2 = m + NGW;
        if (m2 < MT) {
            const u32x2* hr = (const u32x2*)(hb + (size_t)m2 * DM) + lane; const u32x2* mr = (const u32x2*)(mix + (size_t)m2 * DM) + lane;
#pragma unroll
            for (int j = 0; j < 4; ++j) { hn[j] = hr[64 * j]; mn[j] = mr[64 * j]; }
        }
        f32x4 h[4], x[4]; float ss = 0.f;
#pragma unroll
        for (int j = 0; j < 4; ++j) {
            h[j] = (f32x4){__uint_as_float(hv[j].x << 16), __uint_as_float(hv[j].x & 0xffff0000u), __uint_as_float(hv[j].y << 16), __uint_as_float(hv[j].y & 0xffff0000u)};
            x[j] = (f32x4){__uint_as_float(mv[j].x << 16), __uint_as_float(mv[j].x & 0xffff0000u), __uint_as_float(mv[j].y << 16), __uint_as_float(mv[j].y & 0xffff0000u)};
            ss += (x[j][0] * x[j][0] + x[j][1] * x[j][1]) + (x[j][2] * x[j][2] + x[j][3] * x[j][3]);
        }
        const float r1 = 1.0f / sqrtf(wave_sum_fast(ss) * (1.0f / DM) + RMS_EPS);
        float s2 = 0.f;
#pragma unroll
        for (int j = 0; j < 4; ++j) { const f32x4 gp = *((const f32x4*)gpost + lane + 64 * j); h[j] = h[j] + x[j] * r1 * gp; s2 += (h[j][0] * h[j][0] + h[j][1] * h[j][1]) + (h[j][2] * h[j][2] + h[j][3] * h[j][3]); }
        if (fout) {
            f32x4* ho = (f32x4*)(fout + (size_t)m * DM) + lane;
#pragma unroll
            for (int j = 0; j < 4; ++j) ho[64 * j] = h[j];
        } else {
            const float r2 = 1.0f / sqrtf(wave_sum_fast(s2) * (1.0f / DM) + RMS_EPS);
            u32x2* ao = (u32x2*)(hb + (size_t)m * DM) + lane;
#pragma unroll
            for (int j = 0; j < 4; ++j) { u32x2 w; w.x = cvt_pk_bf16(h[j][0], h[j][1]); w.y = cvt_pk_bf16(h[j][2], h[j][3]); ao[64 * j] = w; }
            if (lane == 0) rs[m] = r2;
        }
    }
}

constexpr int ZPITCH = 136;
__device__ __forceinline__ void gmlp_unit(const Params& p, int layer, int chunk, LAS unsigned char* lds, int wave, int lane) {
    LAUNDER(lane);
    const unsigned char* ws = P_ws(p);
    const bf16_t* zu = (const bf16_t*)(ws + WS_R1 + R_ZU); const bf16_t* zv = (const bf16_t*)(ws + WS_R1 + R_ZV);
    bf16_t* mixed = (bf16_t*)(ws + WS_AN);
    const float* ln_g = P_in(p, 13) + layer * 512; const float* ln_b = P_in(p, 14) + layer * 512;
    const float* w_s = P_in(p, 15) + (size_t)layer * 8 * 128 * 128 + (size_t)wave * 128 * 128;
    const float* b_s = P_in(p, 16) + layer * 8 * 128 + wave * 128;
    LAS float* stats = (LAS float*)(lds + 8 * 64 * ZPITCH * 2);
    LAS bf16_t* zt = (LAS bf16_t*)(lds + wave * 64 * ZPITCH * 2);
    const int tok0 = chunk * 128;
    __syncthreads();
    {
        bf16x8 sv[16];
#pragma unroll
        for (int i = 0; i < 16; ++i) sv[i] = *(const bf16x8*)(zv + (size_t)(tok0 + wave * 16 + i) * 512 + lane * 8);
        asm volatile("" ::: "memory");
        float mn[16], rs16[16];
#pragma unroll
        for (int i = 0; i < 16; ++i) {
            float s = 0.f, s2 = 0.f;
#pragma unroll
            for (int e = 0; e < 8; ++e) { const float x = bf2f((bf16_t)sv[i][e]); s += x; s2 += x * x; }
            s = wave_sum_fast(s); s2 = wave_sum_fast(s2);
            const float mean = s * (1.0f / 512.0f); const float var = fmaxf(s2 * (1.0f / 512.0f) - mean * mean, 0.f);
            mn[i] = mean; rs16[i] = 1.0f / sqrtf(var + LN_EPS);
        }
        if (lane == 0) {
#pragma unroll
            for (int i = 0; i < 16; ++i) { stats[2 * (wave * 16 + i)] = mn[i]; stats[2 * (wave * 16 + i) + 1] = rs16[i]; }
        }
    }
    __syncthreads();
    {
        const int dc = lane & 7, d0 = dc * 8;
        const f32x4 g0 = *(const f32x4*)(ln_g + wave * 64 + d0), g1 = *(const f32x4*)(ln_g + wave * 64 + d0 + 4);
        const f32x4 b0 = *(const f32x4*)(ln_b + wave * 64 + d0), b1 = *(const f32x4*)(ln_b + wave * 64 + d0 + 4);
        bf16x8 zq[16];
#pragma unroll
        for (int i = 0; i < 16; ++i) zq[i] = *(const bf16x8*)(zv + (size_t)(tok0 + (lane >> 3) + 8 * i) * 512 + wave * 64 + d0);
#pragma unroll
        for (int i = 0; i < 16; ++i) {
            const int s = (lane >> 3) + 8 * i;
            const float mean = stats[2 * s], rstd = stats[2 * s + 1];
#pragma unroll
            for (int e = 0; e < 8; ++e) {
                const float gg = (e < 4) ? g0[e & 3] : g1[e & 3], bb = (e < 4) ? b0[e & 3] : b1[e & 3];
                const float y = (bf2f((bf16_t)zq[i][e]) - mean) * rstd * gg + bb;
                zt[(d0 + e) * ZPITCH + s] = (bf16_t)(cvt_pk_bf16(y, 0.f) & 0xffff);
            }
        }
    }
    asm volatile("s_waitcnt lgkmcnt(0)" ::: "memory");
    __builtin_amdgcn_wave_barrier();
    const int r = lane & 31, h = lane >> 5;
#pragma unroll
    for (int mt = 0; mt < 4; ++mt) {
        f32x16 acc0, acc1;
#pragma unroll
        for (int i = 0; i < 16; ++i) { acc0[i] = 0.f; acc1[i] = 0.f; }
        const int t = 32 * mt + r;
        const size_t rowoff = (size_t)(tok0 + t) * 512 + wave * 64;
        f32x4 wq[8][2]; u32x2 zz[2][4];
#pragma unroll
        for (int ks = 0; ks < 2 * (mt + 1); ++ks) { wq[ks][0] = *(const f32x4*)(w_s + (size_t)t * 128 + 16 * ks + 8 * h); wq[ks][1] = *(const f32x4*)(w_s + (size_t)t * 128 + 16 * ks + 8 * h + 4); }
#pragma unroll
        for (int dt = 0; dt < 2; ++dt)
#pragma unroll
            for (int i4 = 0; i4 < 4; ++i4) zz[dt][i4] = *(const u32x2*)(zu + rowoff + 32 * dt + 8 * i4 + 4 * h);
        const float bs = b_s[t];
#pragma unroll
        for (int ks = 0; ks < 2 * (mt + 1); ++ks) {
            const int s0 = 16 * ks + 8 * h;
            const f32x4 w0 = wq[ks][0], w1 = wq[ks][1];
            float wv[8] = {w0[0], w0[1], w0[2], w0[3], w1[0], w1[1], w1[2], w1[3]};
#pragma unroll
            for (int e = 0; e < 8; ++e) wv[e] = (s0 + e <= t) ? wv[e] : 0.f;
            u32x4 wb; wb.x = cvt_pk_bf16(wv[0], wv[1]); wb.y = cvt_pk_bf16(wv[2], wv[3]); wb.z = cvt_pk_bf16(wv[4], wv[5]); wb.w = cvt_pk_bf16(wv[6], wv[7]);
            const bf16x8 bfrag = __builtin_bit_cast(bf16x8, wb);
            const bf16x8 a0 = *(const LAS bf16x8*)(zt + (r) * ZPITCH + s0);
            const bf16x8 a1 = *(const LAS bf16x8*)(zt + (32 + r) * ZPITCH + s0);
            acc0 = MFMA32(a0, bfrag, acc0);
            acc1 = MFMA32(a1, bfrag, acc1);
        }
        bf16_t* mrow = mixed + (size_t)(tok0 + t) * 1024 + 512 + wave * 64;
#pragma unroll
        for (int dt = 0; dt < 2; ++dt)
#pragma unroll
            for (int i4 = 0; i4 < 4; ++i4) {
                const int d = 32 * dt + 8 * i4 + 4 * h;
                const u32x2 zv2 = zz[dt][i4];
                const float z0 = __uint_as_float(zv2.x << 16), z1 = __uint_as_float(zv2.x & 0xffff0000u), z2 = __uint_as_float(zv2.y << 16), z3 = __uint_as_float(zv2.y & 0xffff0000u);
                const f32x16& a = dt ? acc1 : acc0;
                u32x2 o; o.x = cvt_pk_bf16(z0 * (a[4 * i4] + bs), z1 * (a[4 * i4 + 1] + bs)); o.y = cvt_pk_bf16(z2 * (a[4 * i4 + 2] + bs), z3 * (a[4 * i4 + 3] + bs));
                *(u32x2*)(mrow + d) = o;
            }
    }
}

__device__ __forceinline__ void cmp_gemm2(const bf16_t* hidden, const bf16_t* w2t, bf16_t* kcmp, bf16_t* vcmpT, int kv, int row0, int lane) {
    LAUNDER(lane);
    const int r = lane & 31, h = lane >> 5;
    f32x16 acc[2];
#pragma unroll
    for (int i = 0; i < 16; ++i) { acc[0][i] = 0.f; acc[1][i] = 0.f; }
#pragma unroll
    for (int ks = 0; ks < 16; ++ks) {
        const bf16x8 hf = *(const bf16x8*)(hidden + (size_t)(row0 + r) * 256 + ks * 16 + h * 8);
#pragma unroll
        for (int dt = 0; dt < 2; ++dt) {
            const bf16x8 wf = *(const bf16x8*)(w2t + (size_t)(dt * 32 + r) * 256 + ks * 16 + h * 8);
            if (kv == 0) acc[dt] = MFMA32(wf, hf, acc[dt]);
            else         acc[dt] = MFMA32(hf, wf, acc[dt]);
        }
    }
#pragma unroll
    for (int dt = 0; dt < 2; ++dt)
#pragma unroll
        for (int i4 = 0; i4 < 4; ++i4) {
            u32x2 o; o.x = cvt_pk_bf16(acc[dt][4 * i4], acc[dt][4 * i4 + 1]); o.y = cvt_pk_bf16(acc[dt][4 * i4 + 2], acc[dt][4 * i4 + 3]);
            if (kv == 0) *(u32x2*)(kcmp + (size_t)(row0 >> 5) * 2048 + (dt * 2 + (i4 >> 1)) * 512 + (i4 & 1) * 256 + r * 8 + 4 * h) = o;
            else         *(u32x2*)(vcmpT + (size_t)(row0 >> 5) * 2048 + dt * 1024 + (i4 >> 1) * 512 + h * 256 + r * 8 + (i4 & 1) * 4) = o;
        }
}

constexpr int NSA_WAVE_LDS = 19456;
constexpr float NEG_INF = -__builtin_inff();

__device__ __forceinline__ void load_k(bf16x8 (&kf)[4], const bf16_t* Kt, int lane) {
    const int r = lane & 31, h = lane >> 5;
#pragma unroll
    for (int ks = 0; ks < 4; ++ks) kf[ks] = *(const bf16x8*)(Kt + ks * 512 + lane * 8);
}
__device__ __forceinline__ void load_v(bf16x8 (&vf)[2][2], const bf16_t* vT, int lane) {
    const int r = lane & 31, h = lane >> 5;
#pragma unroll
    for (int dt = 0; dt < 2; ++dt)
#pragma unroll
        for (int s = 0; s < 2; ++s) vf[dt][s] = *(const bf16x8*)(vT + dt * 1024 + s * 512 + lane * 8);
}
__device__ __forceinline__ f32x16 qk_tile(const bf16x8 (&kf)[4], const bf16x8 (&qf)[4]) {
    f32x16 s;
#pragma unroll
    for (int i = 0; i < 16; ++i) s[i] = 0.f;
#pragma unroll
    for (int ks = 0; ks < 4; ++ks) s = MFMA32(kf[ks], qf[ks], s);
    return s;
}
template <int STRIDE> __device__ __forceinline__ void score_tile(f32x16& s, int dl, int dmax, bool lane_ok, bool fast, float lutfar, const LAS float* lutr) {
    if (fast) {
#pragma unroll
        for (int i = 0; i < 16; ++i) s[i] = lane_ok ? (s[i] + lutfar) : NEG_INF;
    } else {
#pragma unroll
        for (int i = 0; i < 16; ++i) {
            const int d = dl - STRIDE * ((i & 3) + 8 * (i >> 2));
            const bool ok = lane_ok && d >= 0 && d < dmax;
            const int di = min(max(d, 0), 128);
            s[i] = ok ? (s[i] + lutr[di]) : NEG_INF;
        }
    }
}
__device__ __forceinline__ void pv_tile(f32x16& o0, f32x16& o1, const f32x16& pr, const bf16x8 (&vf)[2][2]) {
#pragma unroll
    for (int s = 0; s < 2; ++s) {
        u32x4 pk; pk.x = cvt_pk_bf16(pr[8 * s], pr[8 * s + 1]); pk.y = cvt_pk_bf16(pr[8 * s + 2], pr[8 * s + 3]); pk.z = cvt_pk_bf16(pr[8 * s + 4], pr[8 * s + 5]); pk.w = cvt_pk_bf16(pr[8 * s + 6], pr[8 * s + 7]);
        const bf16x8 pb = __builtin_bit_cast(bf16x8, pk);
        o0 = MFMA32(vf[0][s], pb, o0);
        o1 = MFMA32(vf[1][s], pb, o1);
    }
}
template <bool FAST> __device__ __forceinline__ void online_step(f32x16& s, float bias, bool lane_ok, float& m, float& l, f32x16& o0, f32x16& o1, const bf16x8 (&vf)[2][2]) {
    float mx = fmaxf(fmaxf(fmaxf(s[0], s[1]), fmaxf(s[2], s[3])), fmaxf(fmaxf(s[4], s[5]), fmaxf(s[6], s[7])));
    mx = fmaxf(mx, fmaxf(fmaxf(fmaxf(s[8], s[9]), fmaxf(s[10], s[11])), fmaxf(fmaxf(s[12], s[13]), fmaxf(s[14], s[15]))));
    if (FAST) { mx += bias; mx = lane_ok ? mx : NEG_INF; }
    mx = xhalf_max(mx);
    if (__any(mx > m + 8.0f)) {
        const float mnew = (mx > m + 8.0f) ? mx : m;
        const float alpha = fast_exp2(m - mnew);
        l *= alpha; m = mnew;
#pragma unroll
        for (int i = 0; i < 16; ++i) { o0[i] *= alpha; o1[i] *= alpha; }
    }
    const float c = FAST ? (lane_ok ? (m - bias) : __builtin_inff()) : m;
    float ps = 0.f;
#pragma unroll
    for (int i = 0; i < 16; ++i) { s[i] = fast_exp2(s[i] - c); ps += s[i]; }
    ps = xhalf_sum(ps);
    l += ps;
    pv_tile(o0, o1, s, vf);
}

#define MFMA8(a, b, c) __builtin_amdgcn_mfma_f32_32x32x16_fp8_fp8((a), (b), (c), 0, 0, 0)
__device__ __forceinline__ void load_k8(long (&kf)[4], const unsigned char* Kt, int lane) {
#pragma unroll
    for (int ks = 0; ks < 4; ++ks) kf[ks] = *(const long*)(Kt + ks * 512 + lane * 8);
}
__device__ __forceinline__ void load_v8(long (&vf)[2][2], const unsigned char* vT, int lane) {
#pragma unroll
    for (int dt = 0; dt < 2; ++dt)
#pragma unroll
        for (int s = 0; s < 2; ++s) vf[dt][s] = *(const long*)(vT + dt * 1024 + s * 512 + lane * 8);
}
__device__ __forceinline__ long pack_fp8x8(float a0, float a1, float a2, float a3, float a4, float a5, float a6, float a7) {
    int w0 = __builtin_amdgcn_cvt_pk_fp8_f32(a0, a1, 0, false); w0 = __builtin_amdgcn_cvt_pk_fp8_f32(a2, a3, w0, true);
    int w1 = __builtin_amdgcn_cvt_pk_fp8_f32(a4, a5, 0, false); w1 = __builtin_amdgcn_cvt_pk_fp8_f32(a6, a7, w1, true);
    return (long)(((unsigned long long)(unsigned)w1 << 32) | (unsigned long long)(unsigned)w0);
}
template <bool FAST> __device__ __forceinline__ void online_step8(f32x16& s, float bias, bool lane_ok, float& m, float& l, f32x16& o0, f32x16& o1, const long (&vf)[2][2]) {
    float mx = fmaxf(fmaxf(fmaxf(s[0], s[1]), fmaxf(s[2], s[3])), fmaxf(fmaxf(s[4], s[5]), fmaxf(s[6], s[7])));
    mx = fmaxf(mx, fmaxf(fmaxf(fmaxf(s[8], s[9]), fmaxf(s[10], s[11])), fmaxf(fmaxf(s[12], s[13]), fmaxf(s[14], s[15]))));
    if (FAST) { mx = mx * QSCALE + bias; mx = lane_ok ? mx : NEG_INF; }
    mx = xhalf_max(mx);
    if (__any(mx > m + 2.0f)) {
        const float mnew = (mx > m + 2.0f) ? mx : m;
        const float alpha = fast_exp2(m - mnew);
        l *= alpha; m = mnew;
#pragma unroll
        for (int i = 0; i < 16; ++i) { o0[i] *= alpha; o1[i] *= alpha; }
    }
    float ps = 0.f;
    if (FAST) {
        const float c = lane_ok ? (m - bias - 6.0f) : __builtin_inff();
#pragma unroll
        for (int i = 0; i < 16; ++i) { s[i] = fast_exp2(__builtin_fmaf(s[i], QSCALE, -c)); ps += s[i]; }
    } else {
        const float c = m - 6.0f;
#pragma unroll
        for (int i = 0; i < 16; ++i) { s[i] = fast_exp2(s[i] - c); ps += s[i]; }
    }
    ps = xhalf_sum(ps);
    l += ps;
#pragma unroll
    for (int t = 0; t < 2; ++t) {
        const long pb = pack_fp8x8(s[8 * t], s[8 * t + 1], s[8 * t + 2], s[8 * t + 3], s[8 * t + 4], s[8 * t + 5], s[8 * t + 6], s[8 * t + 7]);
        o0 = MFMA8(vf[0][t], pb, o0);
        o1 = MFMA8(vf[1][t], pb, o1);
    }
}

__device__ __forceinline__ float max16(const f32x16& s) {
    const float a = fmaxf(fmaxf(fmaxf(s[0], s[1]), fmaxf(s[2], s[3])), fmaxf(fmaxf(s[4], s[5]), fmaxf(s[6], s[7])));
    const float b = fmaxf(fmaxf(fmaxf(s[8], s[9]), fmaxf(s[10], s[11])), fmaxf(fmaxf(s[12], s[13]), fmaxf(s[14], s[15])));
    return fmaxf(a, b);
}
template <bool FAST> __device__ __forceinline__ void online_step8x2(f32x16& sa, f32x16& sb, float bias, bool lane_ok, float& m, float& l, f32x16& o0, f32x16& o1, const long (&va)[2][2], const long (&vb)[2][2]) {
    float mx = fmaxf(max16(sa), max16(sb));
    if (FAST) { mx = mx * QSCALE + bias; mx = lane_ok ? mx : NEG_INF; }
    mx = xhalf_max(mx);
    if (__any(mx > m + 2.0f)) {
        const float mnew = (mx > m + 2.0f) ? mx : m;
        const float alpha = fast_exp2(m - mnew);
        l *= alpha; m = mnew;
#pragma unroll
        for (int i = 0; i < 16; ++i) { o0[i] *= alpha; o1[i] *= alpha; }
    }
    float ps = 0.f, ps2 = 0.f;
    if (FAST) {
        const float c = lane_ok ? (m - bias - 6.0f) : __builtin_inff();
#pragma unroll
        for (int i = 0; i < 16; ++i) { sa[i] = fast_exp2(__builtin_fmaf(sa[i], QSCALE, -c)); ps += sa[i]; sb[i] = fast_exp2(__builtin_fmaf(sb[i], QSCALE, -c)); ps2 += sb[i]; }
    } else {
        const float c = m - 6.0f;
#pragma unroll
        for (int i = 0; i < 16; ++i) { sa[i] = fast_exp2(sa[i] - c); ps += sa[i]; sb[i] = fast_exp2(sb[i] - c); ps2 += sb[i]; }
    }
    ps += ps2;
    ps = xhalf_sum(ps);
    l += ps;
    const long pa0 = pack_fp8x8(sa[0], sa[1], sa[2], sa[3], sa[4], sa[5], sa[6], sa[7]);
    const long pb0 = pack_fp8x8(sb[0], sb[1], sb[2], sb[3], sb[4], sb[5], sb[6], sb[7]);
    o0 = MFMA8(va[0][0], pa0, o0); o1 = MFMA8(va[1][0], pa0, o1);
    const long pa1 = pack_fp8x8(sa[8], sa[9], sa[10], sa[11], sa[12], sa[13], sa[14], sa[15]);
    o0 = MFMA8(vb[0][0], pb0, o0); o1 = MFMA8(vb[1][0], pb0, o1);
    const long pb1 = pack_fp8x8(sb[8], sb[9], sb[10], sb[11], sb[12], sb[13], sb[14], sb[15]);
    o0 = MFMA8(va[0][1], pa1, o0); o1 = MFMA8(va[1][1], pa1, o1);
    o0 = MFMA8(vb[0][1], pb1, o0); o1 = MFMA8(vb[1][1], pb1, o1);
}

__device__ __forceinline__ void nsa_unit(const Params& p, int bg, int jq, LAS unsigned char* lds, int wave, int lane, bool build_lut) {
    LAUNDER(lane);
    const unsigned char* ws = P_ws(p);
    const bf16_t* qb = (const bf16_t*)(ws + WS_R1 + R_Q);
    const bf16_t* kcmp = (const bf16_t*)(ws + WS_R1 + R_KCMP) + (size_t)bg * NCMP * 64;
    const bf16_t* vcmpT = (const bf16_t*)(ws + WS_R1 + R_VCMPT) + (size_t)bg * NCMP * 64;
    const unsigned char* ks8 = ws + WS_R1 + R_KS + (size_t)bg * S * 64;
    const unsigned char* vs8 = ws + WS_R1 + R_VST + (size_t)bg * S * 64;
    const bf16_t* kwb = (const bf16_t*)(ws + WS_R1 + R_KW) + (size_t)bg * S * 64;
    const bf16_t* vwT = (const bf16_t*)(ws + WS_R1 + R_VWT) + (size_t)bg * S * 64;
    const float* gates = (const float*)(ws + WS_R1 + R_GATES);
    bf16_t* mixed = (bf16_t*)(ws + WS_AN);
    const float* relb = P_in(p, 1);
    const int b = bg >> 1, g = bg & 1;
    LAS float* imp = (LAS float*)(lds + wave * NSA_WAVE_LDS);
    LAS unsigned* selw = (LAS unsigned*)(lds + wave * NSA_WAVE_LDS + 8192);
    LAS float* lut = (LAS float*)(lds + wave * NSA_WAVE_LDS + 8192 + 256);
    LAS int* list = (LAS int*)(lds + wave * NSA_WAVE_LDS + 8192 + 256 + 2112);
    const int c = lane & 31, h = lane >> 5, ql = c >> 2, r = c & 3;
    const int tq0 = 64 * jq + 8 * wave, tq = tq0 + ql;
    const size_t tok = (size_t)b * S + tq;

    if (build_lut) {
        for (int e = lane; e < 4 * 129; e += 64) {
            const int rr = e / 129, n = e % 129;
            int bk = n;
            if (n >= 16) bk = 16 + (n >= 19) + (n >= 21) + (n >= 24) + (n >= 27) + (n >= 31) + (n >= 35) + (n >= 40) + (n >= 46) + (n >= 52) + (n >= 59) + (n >= 67) + (n >= 77) + (n >= 87) + (n >= 99) + (n >= 113);
            lut[rr * 132 + n] = relb[bk * 8 + g * 4 + rr] * LOG2E;
        }
    }
#pragma unroll
    for (int e = 0; e < 8; ++e) *(LAS f32x4*)(imp + 4 * (lane + 64 * e)) = (f32x4){0.f, 0.f, 0.f, 0.f};
    {
        const int k = lane & 7; unsigned w = 0u;
        if (k == 0) w |= 1u;
        if ((jq >> 5) == k) w |= 1u << (jq & 31);
        if (jq >= 1 && ((jq - 1) >> 5) == k) w |= 1u << ((jq - 1) & 31);
        selw[lane] = w;
    }
    asm volatile("s_waitcnt lgkmcnt(0)" ::: "memory");
    __builtin_amdgcn_wave_barrier();
    const LAS float* lutr = lut + r * 132;
    const float lutfar = lutr[128];

    bf16x8 qf[4];
#pragma unroll
    for (int ks = 0; ks < 4; ++ks) qf[ks] = *(const bf16x8*)(qb + tok * 512 + (g * 4 + r) * 64 + ks * 16 + h * 8);
    const float g0 = gates[tok * 24 + (g * 4 + r) * 3 + 0], g1 = gates[tok * 24 + (g * 4 + r) * 3 + 1], g2 = gates[tok * 24 + (g * 4 + r) * 3 + 2];

    f32x16 oa0, oa1;
    bf16x8 kf[4], kn[4], vf[2][2];
    {
        const int jmaxw = (tq0 + 7 - 31) >> 4;
        const int ntile = (jmaxw >= 0) ? (jmaxw >> 5) + 1 : 0;
        float m = -1e30f, l = 0.f;
        if (ntile > 0) load_k(kn, kcmp, lane);
        for (int T = 0; T < ntile; ++T) {
#pragma unroll
            for (int ks = 0; ks < 4; ++ks) kf[ks] = kn[ks];
            if (T + 1 < ntile) load_k(kn, kcmp + (size_t)(T + 1) * 2048, lane);
            f32x16 s = qk_tile(kf, qf);
            const int base = 512 * T + 31;
            const bool fast = (tq0 - base - 16 * 31) >= 128;
            score_tile<16>(s, tq - base - 64 * h, 1 << 30, true, fast, lutfar, lutr);
            float mx = s[0];
#pragma unroll
            for (int i = 1; i < 16; ++i) mx = fmaxf(mx, s[i]);
            mx = xhalf_max(mx);
            const float mnew = fmaxf(m, mx);
            float ps = 0.f;
#pragma unroll
            for (int i = 0; i < 16; ++i) ps += fast_exp2(s[i] - mnew);
            ps = xhalf_sum(ps);
            l = l * fast_exp2(m - mnew) + ps; m = mnew;
        }
        const float c2 = (l > 0.f) ? (m + __builtin_amdgcn_logf(l)) : __builtin_inff();
        const float c2f = c2 - lutfar;
        f32x16 o0, o1;
#pragma unroll
        for (int i = 0; i < 16; ++i) { o0[i] = 0.f; o1[i] = 0.f; }
        if (ntile > 0) load_k(kn, kcmp, lane);
        for (int T = 0; T < ntile; ++T) {
#pragma unroll
            for (int ks = 0; ks < 4; ++ks) kf[ks] = kn[ks];
            load_v(vf, vcmpT + (size_t)T * 2048, lane);
            if (T + 1 < ntile) load_k(kn, kcmp + (size_t)(T + 1) * 2048, lane);
            f32x16 s = qk_tile(kf, qf);
            const int base = 512 * T + 31;
            const bool fast = (tq0 - base - 16 * 31) >= 128;
            if (fast) {
#pragma unroll
                for (int i = 0; i < 16; ++i) s[i] = fast_exp2(s[i] - c2f);
            } else {
                score_tile<16>(s, tq - base - 64 * h, 1 << 30, true, false, lutfar, lutr);
#pragma unroll
                for (int i = 0; i < 16; ++i) s[i] = fast_exp2(s[i] - c2);
            }
#pragma unroll
            for (int i4 = 0; i4 < 4; ++i4) {
                float a = (s[4 * i4] + s[4 * i4 + 1]) + (s[4 * i4 + 2] + 0.5f * s[4 * i4 + 3]);
                float bb = 0.5f * s[4 * i4 + 3];
                a = quad_sum(a); bb = quad_sum(bb);
                if (r == i4) {
                    const int n = 8 * T + 2 * i4 + h;
                    atomicAdd((float*)(imp + ql * 256 + n), a);
                    if (n + 1 < 256) atomicAdd((float*)(imp + ql * 256 + n + 1), bb);
                }
            }
            pv_tile(o0, o1, s, vf);
        }
        {
            LAS float* park = (LAS float*)(lds + wave * NSA_WAVE_LDS + 11264);
#pragma unroll
            for (int i = 0; i < 16; ++i) { park[i * 64 + lane] = g0 * o0[i]; park[(16 + i) * 64 + lane] = g0 * o1[i]; }
        }
    }
    asm volatile("s_waitcnt lgkmcnt(0)" ::: "memory");
    __builtin_amdgcn_wave_barrier();
    if (jq >= 3) {
        const int tj = lane & 7;
        int val[32];
#pragma unroll
        for (int c4 = 0; c4 < 8; ++c4) {
            const f32x4 iv = *(const LAS f32x4*)(imp + (lane >> 3) * 256 + 32 * tj + 4 * c4);
#pragma unroll
            for (int e = 0; e < 4; ++e) {
                const int n = 32 * tj + 4 * c4 + e;
                const int key = (int)((__float_as_uint(iv[e]) & 0x7fffff00u) | (unsigned)(255 - n));
                val[4 * c4 + e] = (n >= 1 && n <= jq - 2) ? key : -1;
            }
        }
        unsigned myw = 0u;
        for (int round = 0; round < 13; ++round) {
            int lm = val[0];
#pragma unroll
            for (int e = 1; e < 32; ++e) lm = max(lm, val[e]);
            int gm = max(lm, __builtin_amdgcn_mov_dpp(lm, 0xB1, 0xf, 0xf, true));
            gm = max(gm, __builtin_amdgcn_mov_dpp(gm, 0x4E, 0xf, 0xf, true));
            gm = max(gm, __builtin_amdgcn_mov_dpp(gm, 0x141, 0xf, 0xf, true));
            const int n = 255 - (gm & 0xff);
            myw |= (gm >= 0 && (n >> 5) == tj) ? (1u << (n & 31)) : 0u;
#pragma unroll
            for (int e = 0; e < 32; ++e) val[e] = (val[e] == gm) ? -1 : val[e];
        }
        selw[lane] |= myw;
    }
    asm volatile("s_waitcnt lgkmcnt(0)" ::: "memory");
    __builtin_amdgcn_wave_barrier();
    {
        unsigned uwA = 0u, uwB = 0u;
        if (lane < 8) {
#pragma unroll
            for (int qq = 0; qq < 4; ++qq) { uwA |= selw[qq * 8 + lane]; uwB |= selw[(qq + 4) * 8 + lane]; }
        }
        int cntA = 0, cntB = 0;
#pragma unroll
        for (int k = 0; k < 8; ++k) {
            const unsigned ba = (unsigned)__builtin_amdgcn_readlane((int)uwA, k), bb2 = (unsigned)__builtin_amdgcn_readlane((int)uwB, k);
            if (lane < 32) {
                const unsigned below = (1u << lane) - 1u;
                if ((ba >> lane) & 1u) list[cntA + __builtin_popcount(ba & below)] = 32 * k + lane;
                if ((bb2 >> lane) & 1u) list[64 + cntB + __builtin_popcount(bb2 & below)] = 32 * k + lane;
            }
            cntA += __builtin_popcount(ba); cntB += __builtin_popcount(bb2);
        }
        asm volatile("s_waitcnt lgkmcnt(0)" ::: "memory");
        __builtin_amdgcn_wave_barrier();
        LAS float* ostage = imp;
        const int c16 = lane & 15, fq = lane >> 4, q4 = c16 >> 2, r16 = c16 & 3;
        const LAS float* lutr16 = lut + r16 * 132;
        const float lutfar16 = lutr16[128];
        for (int grp = 0; grp < 2; ++grp) {
            const int cnt = grp ? cntB : cntA, lbase = grp * 64;
            const int tqg = tq0 + 4 * grp + q4, tq0g = tq0 + 4 * grp;
            long q8[2];
            bf16x8 qv2[2];
            {
                const bf16_t* qp = qb + ((size_t)b * S + tqg) * 512 + (g * 4 + r16) * 64 + 8 * fq;
                qv2[0] = *(const bf16x8*)(qp); qv2[1] = *(const bf16x8*)(qp + 32);
            }
            float m = -1e30f;
            f32x4 lacc = (f32x4){0.f, 0.f, 0.f, 0.f};
            const long ones8 = 0x3838383838383838L;
            f32x4 o[4];
#pragma unroll
            for (int dt = 0; dt < 4; ++dt) o[dt] = (f32x4){0.f, 0.f, 0.f, 0.f};
            const int npair = (cnt + 1) >> 1;
            if (lane == 0 && (cnt & 1)) list[lbase + cnt] = 0;
            asm volatile("s_waitcnt lgkmcnt(0)" ::: "memory");
            __builtin_amdgcn_wave_barrier();
            long k8[2][8], v8[2][8];
            int n0 = __builtin_amdgcn_readfirstlane(list[lbase]), n1 = __builtin_amdgcn_readfirstlane(list[lbase + 1]);
#pragma unroll
            for (int i = 0; i < 4; ++i) { const l64x2 t0 = *(const l64x2*)(ks8 + (size_t)n0 * 4096 + i * 1024 + lane * 16), t1 = *(const l64x2*)(ks8 + (size_t)n1 * 4096 + i * 1024 + lane * 16);
                k8[0][2 * i] = t0[0]; k8[0][2 * i + 1] = t0[1]; k8[1][2 * i] = t1[0]; k8[1][2 * i + 1] = t1[1]; }
#pragma unroll
            for (int ks = 0; ks < 2; ++ks) {
                float f[8];
#pragma unroll
                for (int e = 0; e < 8; ++e) f[e] = bf2f((bf16_t)qv2[ks][e]) * 4.0f;
                q8[ks] = pack_fp8x8(f[0], f[1], f[2], f[3], f[4], f[5], f[6], f[7]);
            }
            for (int it = 0; it < npair; ++it) {
                const int nb[2] = {n0, n1};
                const bool real1 = (2 * it + 1) < cnt;
#pragma unroll
                for (int u = 0; u < 2; ++u)
#pragma unroll
                    for (int i = 0; i < 4; ++i) { const l64x2 t = *(const l64x2*)(vs8 + (size_t)nb[u] * 4096 + i * 1024 + lane * 16); v8[u][2 * i] = t[0]; v8[u][2 * i + 1] = t[1]; }
                bool ok[2];
                ok[0] = (selw[(grp * 4 + q4) * 8 + (nb[0] >> 5)] >> (nb[0] & 31)) & 1u;
                ok[1] = real1 && ((selw[(grp * 4 + q4) * 8 + (nb[1] >> 5)] >> (nb[1] & 31)) & 1u);
                const int bmax = real1 ? max(nb[0], nb[1]) : nb[0];
                const bool fast = (tq0g - 64 * bmax - 63) >= 128;
                const bool fresh = m < -1e29f;
                const float mref = fresh ? 0.f : m;
                float ini[2];
                ini[0] = fast ? (ok[0] ? -(mref - lutfar16 - 6.0f) : NEG_INF) : 0.f;
                ini[1] = fast ? (ok[1] ? -(mref - lutfar16 - 6.0f) : NEG_INF) : 0.f;
                f32x4 sc[2][4];
#pragma unroll
                for (int u = 0; u < 2; ++u)
#pragma unroll
                    for (int kt = 0; kt < 4; ++kt) {
                        sc[u][kt] = __builtin_amdgcn_mfma_f32_16x16x32_fp8_fp8(k8[u][2 * kt], q8[0], (f32x4){ini[u], ini[u], ini[u], ini[u]}, 0, 0, 0);
                        sc[u][kt] = __builtin_amdgcn_mfma_f32_16x16x32_fp8_fp8(k8[u][2 * kt + 1], q8[1], sc[u][kt], 0, 0, 0);
                    }
                if (it + 1 < npair) {
                    n0 = __builtin_amdgcn_readfirstlane(list[lbase + 2 * it + 2]); n1 = __builtin_amdgcn_readfirstlane(list[lbase + 2 * it + 3]);
#pragma unroll
                    for (int i = 0; i < 4; ++i) { const l64x2 t0 = *(const l64x2*)(ks8 + (size_t)n0 * 4096 + i * 1024 + lane * 16), t1 = *(const l64x2*)(ks8 + (size_t)n1 * 4096 + i * 1024 + lane * 16);
                        k8[0][2 * i] = t0[0]; k8[0][2 * i + 1] = t0[1]; k8[1][2 * i] = t1[0]; k8[1][2 * i + 1] = t1[1]; }
                }
                if (fast) {
                    float t = NEG_INF;
#pragma unroll
                    for (int u = 0; u < 2; ++u) {
                        float tt = fmaxf(fmaxf(fmaxf(sc[u][0][0], sc[u][0][1]), fmaxf(sc[u][0][2], sc[u][0][3])), fmaxf(fmaxf(sc[u][1][0], sc[u][1][1]), fmaxf(sc[u][1][2], sc[u][1][3])));
                        tt = fmaxf(tt, fmaxf(fmaxf(fmaxf(sc[u][2][0], sc[u][2][1]), fmaxf(sc[u][2][2], sc[u][2][3])), fmaxf(fmaxf(sc[u][3][0], sc[u][3][1]), fmaxf(sc[u][3][2], sc[u][3][3]))));
                        t = fmaxf(t, tt);
                    }
                    { auto t1 = __builtin_amdgcn_permlane16_swap(__float_as_uint(t), __float_as_uint(t), false, false); t = fmaxf(__uint_as_float(t1[0]), __uint_as_float(t1[1])); t = xhalf_max(t); }
                    const float mxt = t - 6.0f + mref;
                    const bool need = fresh ? (t > NEG_INF) : (mxt > m + 2.0f);
                    if (__any(need)) {
                        const float mnew = need ? mxt : m;
                        const float delta = need ? (mnew - mref) : 0.f;
                        const float alpha = (need && !fresh) ? fast_exp2(m - mnew) : 1.0f;
                        lacc = lacc * alpha; m = mnew;
#pragma unroll
                        for (int dt = 0; dt < 4; ++dt) o[dt] = o[dt] * alpha;
#pragma unroll
                        for (int u = 0; u < 2; ++u)
#pragma unroll
                            for (int kt = 0; kt < 4; ++kt) sc[u][kt] = sc[u][kt] - delta;
                    }
#pragma unroll
                    for (int u = 0; u < 2; ++u)
#pragma unroll
                        for (int kt = 0; kt < 4; ++kt)
#pragma unroll
                            for (int e = 0; e < 4; ++e) sc[u][kt][e] = fast_exp2(sc[u][kt][e]);
                } else {
                    float mx = NEG_INF;
#pragma unroll
                    for (int u = 0; u < 2; ++u)
#pragma unroll
                        for (int kt = 0; kt < 4; ++kt)
#pragma unroll
                            for (int e = 0; e < 4; ++e) {
                                const int d = tqg - 64 * nb[u] - 16 * kt - 4 * fq - e;
                                const bool okk = ok[u] && d >= 0;
                                const float v = okk ? (sc[u][kt][e] + lutr16[min(max(d, 0), 128)]) : NEG_INF;
                                sc[u][kt][e] = v; mx = fmaxf(mx, v);
                            }
                    { auto t1 = __builtin_amdgcn_permlane16_swap(__float_as_uint(mx), __float_as_uint(mx), false, false); mx = fmaxf(__uint_as_float(t1[0]), __uint_as_float(t1[1])); mx = xhalf_max(mx); }
                    if (__any(mx > m + 2.0f)) {
                        const float mnew = (mx > m + 2.0f) ? mx : m;
                        const float alpha = fast_exp2(m - mnew);
                        lacc = lacc * alpha; m = mnew;
#pragma unroll
                        for (int dt = 0; dt < 4; ++dt) o[dt] = o[dt] * alpha;
                    }
                    const float cexp = m - 6.0f;
#pragma unroll
                    for (int u = 0; u < 2; ++u)
#pragma unroll
                        for (int kt = 0; kt < 4; ++kt)
#pragma unroll
                            for (int e = 0; e < 4; ++e) sc[u][kt][e] = fast_exp2(sc[u][kt][e] - cexp);
                }
#pragma unroll
                for (int u = 0; u < 2; ++u) {
                    const long pb0 = pack_fp8x8(sc[u][0][0], sc[u][0][1], sc[u][0][2], sc[u][0][3], sc[u][1][0], sc[u][1][1], sc[u][1][2], sc[u][1][3]);
                    const long pb1 = pack_fp8x8(sc[u][2][0], sc[u][2][1], sc[u][2][2], sc[u][2][3], sc[u][3][0], sc[u][3][1], sc[u][3][2], sc[u][3][3]);
#pragma unroll
                    for (int dt = 0; dt < 4; ++dt) {
                        o[dt] = __builtin_amdgcn_mfma_f32_16x16x32_fp8_fp8(v8[u][2 * dt], pb0, o[dt], 0, 0, 0);
                        o[dt] = __builtin_amdgcn_mfma_f32_16x16x32_fp8_fp8(v8[u][2 * dt + 1], pb1, o[dt], 0, 0, 0);
                    }
                    lacc = __builtin_amdgcn_mfma_f32_16x16x32_fp8_fp8(ones8, pb0, lacc, 0, 0, 0);
                    lacc = __builtin_amdgcn_mfma_f32_16x16x32_fp8_fp8(ones8, pb1, lacc, 0, 0, 0);
                }
            }
            const float l = lacc[0];
            const float invl = (l > 0.f) ? 1.0f / l : 0.f;
#pragma unroll
            for (int dt = 0; dt < 4; ++dt) *(LAS f32x4*)(ostage + ((grp * 4 + q4) * 4 + r16) * 64 + 16 * dt + 4 * fq) = o[dt] * invl;
        }
        asm volatile("s_waitcnt lgkmcnt(0)" ::: "memory");
        __builtin_amdgcn_wave_barrier();
        {
            const LAS float* park = (const LAS float*)(lds + wave * NSA_WAVE_LDS + 11264);
#pragma unroll
            for (int i = 0; i < 16; ++i) { oa0[i] = park[i * 64 + lane]; oa1[i] = park[(16 + i) * 64 + lane]; }
        }
#pragma unroll
        for (int dt = 0; dt < 2; ++dt)
#pragma unroll
            for (int i4 = 0; i4 < 4; ++i4) {
                const f32x4 v = *(const LAS f32x4*)(ostage + (ql * 4 + r) * 64 + 32 * dt + 8 * i4 + 4 * h);
                if (dt == 0) { oa0[4 * i4] += g1 * v[0]; oa0[4 * i4 + 1] += g1 * v[1]; oa0[4 * i4 + 2] += g1 * v[2]; oa0[4 * i4 + 3] += g1 * v[3]; }
                else         { oa1[4 * i4] += g1 * v[0]; oa1[4 * i4 + 1] += g1 * v[1]; oa1[4 * i4 + 2] += g1 * v[2]; oa1[4 * i4 + 3] += g1 * v[3]; }
            }
        asm volatile("s_waitcnt lgkmcnt(0)" ::: "memory");
        __builtin_amdgcn_wave_barrier();
    }
    {
        {
            const bf16_t* qp = qb + tok * 512 + (g * 4 + r) * 64 + h * 8;
            asm volatile("" : "+v"(qp));
#pragma unroll
            for (int ks = 0; ks < 4; ++ks) qf[ks] = *(const bf16x8*)(qp + ks * 16);
        }
        const int T0 = max(0, (tq0 - 511) >> 5), T1 = (tq0 + 7) >> 5;
        float m = -1e30f, l = 0.f;
        f32x16 o0, o1;
#pragma unroll
        for (int i = 0; i < 16; ++i) { o0[i] = 0.f; o1[i] = 0.f; }
        load_k(kn, kwb + (size_t)(32 * T0) * 64, lane);
        for (int T = T0; T <= T1; ++T) {
#pragma unroll
            for (int ks = 0; ks < 4; ++ks) kf[ks] = kn[ks];
            load_v(vf, vwT + (size_t)T * 2048, lane);
            if (T < T1) load_k(kn, kwb + (size_t)(32 * (T + 1)) * 64, lane);
            const int base = 32 * T;
            f32x16 s = qk_tile(kf, qf);
            if (((tq0 - base - 31) >= 128) && ((tq0 + 7 - base) < 512)) online_step<true>(s, lutfar, true, m, l, o0, o1, vf);
            else { score_tile<1>(s, tq - base - 4 * h, 512, true, false, lutfar, lutr); online_step<false>(s, 0.f, true, m, l, o0, o1, vf); }
        }
        const float sc = (l > 0.f) ? g2 / l : 0.f;
#pragma unroll
        for (int i = 0; i < 16; ++i) { oa0[i] += sc * o0[i]; oa1[i] += sc * o1[i]; }
    }
    bf16_t* orow = mixed + tok * 1024 + (g * 4 + r) * 64;
#pragma unroll
    for (int dt = 0; dt < 2; ++dt)
#pragma unroll
        for (int i4 = 0; i4 < 4; ++i4) {
            const f32x16& a = dt ? oa1 : oa0;
            u32x2 o; o.x = cvt_pk_bf16(a[4 * i4], a[4 * i4 + 1]); o.y = cvt_pk_bf16(a[4 * i4 + 2], a[4 * i4 + 3]);
            *(u32x2*)(orow + 32 * dt + 8 * i4 + 4 * h) = o;
        }
}


#define XB_TMO      128
#define XB_XCNT(j)  (256  + 64 * (j))
#define XB_XSUB(j)  (1280 + 64 * (j))
#define XB_XGEN(j)  (2304 + 64 * (j))
#define XB_TOP      3328
#define XB_TOPGEN   3392
#define XCD_BAR_WORDS 3456
#define XB_SPIN_CAP (1u << 22)
__device__ __forceinline__ unsigned xb_ld(unsigned* p)              { return __hip_atomic_load(p, __ATOMIC_RELAXED, __HIP_MEMORY_SCOPE_AGENT); }
__device__ __forceinline__ unsigned xb_add(unsigned* p, unsigned v) { return __hip_atomic_fetch_add(p, v, __ATOMIC_RELAXED, __HIP_MEMORY_SCOPE_AGENT); }
__device__ __forceinline__ unsigned xb_xcc_id() { return (unsigned)__builtin_amdgcn_s_getreg((3 << 11) | 20) & 0xFu; }
#define XB_SPIN(cond, bar) do { unsigned _sp = 0; while (cond) { __builtin_amdgcn_s_sleep(1); \
    if ((++_sp & 255u) == 0u) { if (xb_ld(&(bar)[XB_TMO])) break; if (_sp > XB_SPIN_CAP) { atomicAdd(&(bar)[XB_TMO], 1u); break; } } } } while (0)
__device__ __forceinline__ void xcd_barrier_complete(unsigned* bar, unsigned x, unsigned& nloc, unsigned& nx) {
    const unsigned G = gridDim.x * gridDim.y * gridDim.z;
    unsigned sum, cnt, mine, sp = 0u;
    for (;;) {
        sum = 0u; cnt = 0u; mine = 0u;
#pragma unroll
        for (unsigned j = 0; j < 16; ++j) { const unsigned c = xb_ld(&bar[XB_XCNT(j)]); sum += c; cnt += (c > 0u) ? 1u : 0u; mine = (j == x) ? c : mine; }
        if (sum == G) break;
        __builtin_amdgcn_s_sleep(1);
        if ((++sp & 255u) == 0u) { if (xb_ld(&bar[XB_TMO])) break; if (sp > XB_SPIN_CAP) { atomicAdd(&bar[XB_TMO], 1u); break; } }
    }
    nloc = mine > 0u ? mine : 1u; nx = cnt > 0u ? cnt : 1u;
}
__device__ __forceinline__ void xcd_barrier(unsigned* bar, volatile LAS unsigned* st) {
    asm volatile("s_waitcnt vmcnt(0)" ::: "memory");
    __syncthreads();
    if (threadIdx.x == 0) {
        const unsigned x = xb_xcc_id();
        __builtin_amdgcn_s_waitcnt(0);
        unsigned nloc = st[0], nx = st[1];
        if (nloc == 0u) { xcd_barrier_complete(bar, x, nloc, nx); st[0] = nloc; st[1] = nx; }
        const unsigned old = xb_add(&bar[XB_XSUB(x)], 1u);
        const unsigned gen = old / nloc;
        if (old + 1u == (gen + 1u) * nloc) {
            __builtin_amdgcn_fence(__ATOMIC_RELEASE, "agent");
            asm volatile("s_waitcnt vmcnt(0)" ::: "memory");
            const unsigned og = xb_add(&bar[XB_TOP], 1u);
            const unsigned tg = og / nx;
            if (og + 1u == (tg + 1u) * nx) xb_add(&bar[XB_TOPGEN], 1u);
            else XB_SPIN(xb_ld(&bar[XB_TOPGEN]) == tg, bar);
            __builtin_amdgcn_fence(__ATOMIC_ACQUIRE, "agent");
            xb_add(&bar[XB_XGEN(x)], 1u);
            asm volatile("s_waitcnt vmcnt(0)" ::: "memory");
        } else {
            XB_SPIN(xb_ld(&bar[XB_XGEN(x)]) == gen, bar);
            __builtin_amdgcn_fence(__ATOMIC_ACQUIRE, "agent");
            asm volatile("s_waitcnt vmcnt(0)" ::: "memory");
        }
    }
    __syncthreads();
}

__global__ void __launch_bounds__(NTHREADS, 2) fwd_megakernel(Params p) {
    extern __shared__ __attribute__((aligned(16))) unsigned char lds_raw[];
    LAS unsigned char* lds = (LAS unsigned char*)lds_raw;
    cg::grid_group grid = cg::this_grid();
#define TID_F ({ int _t = threadIdx.x; LAUNDER(_t); _t; })
#define LANE_F (TID_F & 63)
#define WAVE_F (__builtin_amdgcn_readfirstlane(TID_F >> 6))
    const int G = gridDim.x, bx = blockIdx.x;
    const int NGW = G * NWAVES;
#define GW_F (bx * NWAVES + WAVE_F)
#define FRESH_WS unsigned char* ws = P_ws(p); bf16_t* AN = (bf16_t*)(ws + WS_AN); float* MIX = (float*)(ws + WS_MIX); (void)AN; (void)MIX

    { const int tid = TID_F; if (tid < 16) ((LAS unsigned*)(lds + LDS_BYTES - 64))[tid] = 0u; }
    if (bx == 0) { unsigned* barw = (unsigned*)P_ws(p); for (int i = TID_F; i < XCD_BAR_WORDS; i += NTHREADS) barw[i] = 0u; }
    { const int t = TID_F; if (t < 128) ((unsigned*)(P_ws(p) + WS_XCNT))[bx * 128 + t] = 0u; }
    __syncthreads();
    {
        FRESH_WS;
        const int tid = TID_F, lane = tid & 63, wave = __builtin_amdgcn_readfirstlane(tid >> 6), gw = bx * NWAVES + wave;
        LAS float* scr = (LAS float*)(lds + wave * 17408);
        for (int layer = 0; layer < DEPTH; ++layer) {
            unsigned char* wl = ws + WS_W + (size_t)layer * W_LAYER;
            const int I_IN = 16 * (NINP / 64), I_OUT = 16 * 16, I_GU = 16 * (NGU / 64), I_DN = 44 * 16, I_C1 = 32 * 4, I_C2 = 4 * 1;
            const int NIT = I_IN + I_OUT + I_GU + I_DN + 2 * I_C1 + 2 * I_C2;
            for (int it = gw; it < NIT; it += NGW) {
                int r = it;
                if (r < I_IN) { transpose_item<1>(P_in(p, 6) + (size_t)layer * DM * INW, DM, INW, (bf16_t*)(wl + W_IN), NINP / 64, r, scr, lane, P_in(p, 2) + layer * DM); continue; } r -= I_IN;
                if (r < I_OUT) { transpose_item<0>(P_in(p, 17) + (size_t)layer * DM * DM, DM, DM, (bf16_t*)(wl + W_OUT), 16, r, scr, lane); continue; } r -= I_OUT;
                if (r < I_GU) { transpose_item<2>(P_in(p, 18) + (size_t)layer * DM * NGU, DM, NGU, (bf16_t*)(wl + W_GU), NGU / 64, r, scr, lane, P_in(p, 4) + layer * DM); continue; } r -= I_GU;
                if (r < I_DN) { transpose_item<0>(P_in(p, 19) + (size_t)layer * DFF * DM, DFF, DM, (bf16_t*)(wl + W_DN), 16, r, scr, lane); continue; } r -= I_DN;
                if (r < I_C1) { transpose_item<0>(P_in(p, 8) + (size_t)layer * 2048 * 256, 2048, 256, (bf16_t*)(wl + W_C1K), 4, r, scr, lane); continue; } r -= I_C1;
                if (r < I_C1) { transpose_item<0>(P_in(p, 11) + (size_t)layer * 2048 * 256, 2048, 256, (bf16_t*)(wl + W_C1V), 4, r, scr, lane); continue; } r -= I_C1;
                if (r < I_C2) { transpose_item<0>(P_in(p, 9) + (size_t)layer * 256 * 64, 256, 64, (bf16_t*)(wl + W_C2K), 1, r, scr, lane); continue; } r -= I_C2;
                transpose_item<0>(P_in(p, 12) + (size_t)layer * 256 * 64, 256, 64, (bf16_t*)(wl + W_C2V), 1, r, scr, lane);
            }
        }
        __syncthreads();
        if (bx >= G - 2 * DEPTH) {
            const int id = G - 1 - bx, layer = id >> 1, kv = id & 1;
            const float* pos = P_in(p, kv ? 10 : 7) + (size_t)layer * 2048;
            const float* w1 = P_in(p, kv ? 11 : 8) + (size_t)layer * 2048 * 256;
            LAS float* red = (LAS float*)lds;
            f32x4 acc4 = (f32x4){0.f, 0.f, 0.f, 0.f};
#pragma unroll 8
            for (int i = wave * 256; i < wave * 256 + 256; ++i) { const f32x4 w = *(const f32x4*)(w1 + (size_t)i * 256 + 4 * lane); acc4 = acc4 + w * pos[i]; }
            red[wave * 256 + 4 * lane + 0] = acc4[0]; red[wave * 256 + 4 * lane + 1] = acc4[1]; red[wave * 256 + 4 * lane + 2] = acc4[2]; red[wave * 256 + 4 * lane + 3] = acc4[3];
            __syncthreads();
            if (tid < 256) { float sum = 0.f;
#pragma unroll
                for (int w = 0; w < 8; ++w) sum += red[w * 256 + tid];
                ((float*)(ws + WS_W + (size_t)layer * W_LAYER + (kv ? W_CBV : W_CBK)))[tid] = sum; }
            __syncthreads();
        }
        row_pass(P_in(p, 0), (bf16_t*)(ws + WS_HB), nullptr, nullptr, (float*)(ws + WS_RS), nullptr, gw, NGW, lane);
    }
    grid.sync();
    if (TID_F == 0) (void)xb_add(&((unsigned*)P_ws(p))[XB_XCNT(xb_xcc_id())], 1u);

#pragma unroll 1
    for (int layer = 0; layer < DEPTH; ++layer) {
        const size_t wloff = WS_W + (size_t)layer * W_LAYER;
#ifndef SKIP_PA
        {
            FRESH_WS; unsigned char* wl = ws + wloff;
            pg8::Gemm g{(const bf16_t*)(ws + WS_HB), (const bf16_t*)(wl + W_IN), MT, NINP, DM, DM};
            pg8::StaticOrder so; so.init(MT, NINP, G, bx, REP_PA);
            pg8::EpiIn E{ws + WS_R1, (const float*)(ws + WS_RS)};
            pg8::gemm_phase<pg8::EpiIn>(lds, g, so, E);
        }
#endif
        GSYNC();
#ifndef SKIP_PB
        for (int rep = 0; rep < REP_PB; ++rep) {
            FRESH_WS; unsigned char* wl = ws + wloff;
            for (int kv = 0; kv < 2; ++kv) {
                const int c = kv ? ((bx + (G >> 1)) % G) : bx;
                if (c < 16) {
                    bf16_t* hid = (bf16_t*)(ws + WS_R1 + R_HID) + (size_t)kv * 4096 * 256;
                    pg8::Gemm g{(const bf16_t*)(ws + WS_R1 + (kv ? R_VC : R_KC)), (const bf16_t*)(wl + (kv ? W_C1V : W_C1K)), 4096, 256, 2048, 1024};
                    pg8::StaticOrder so; so.init(4096, 256, G, c);
                    pg8::EpiCmp1 E{hid, (const float*)(wl + (kv ? W_CBV : W_CBK))};
                    pg8::gemm_phase<pg8::EpiCmp1>(lds, g, so, E);
                    pg8::Unit u; so.next(0, u);
                    asm volatile("s_waitcnt vmcnt(0)" ::: "memory");
                    __builtin_amdgcn_fence(__ATOMIC_RELEASE, "agent");
                    __syncthreads();
                    __builtin_amdgcn_fence(__ATOMIC_ACQUIRE, "agent");
                    cmp_gemm2(hid, (const bf16_t*)(wl + (kv ? W_C2V : W_C2K)), (bf16_t*)(ws + WS_R1 + R_KCMP), (bf16_t*)(ws + WS_R1 + R_VCMPT), kv, u.pm * 256 + WAVE_F * 32, LANE_F);
                    __syncthreads();
                }
            }
            if (G == 256) {
                const bool is_cmp = (bx < 16) || (bx >= 128 && bx < 144);
                if (!is_cmp) {
                    const int idx = (bx < 128) ? (bx - 16) : (bx - 32);
                    gmlp_unit(p, layer, idx, lds, WAVE_F, LANE_F);
                    if (idx + 224 < MT / 128) gmlp_unit(p, layer, idx + 224, lds, WAVE_F, LANE_F);
                }
            } else {
                for (int ch = bx; ch < MT / 128; ch += G) gmlp_unit(p, layer, ch, lds, WAVE_F, LANE_F);
            }
        }
#endif
        GSYNC();
        {
#if NSA_ENABLE
            __syncthreads();
            for (int rep = 0; rep < REP_PC; ++rep) {
                if (G == 256) {
                    const int x = bx & 7, y = bx >> 3, bg = x >> 1, j = (x & 1) * 32 + y;
                    for (int i = 0; i < 4; ++i) {
                        const int jq = (i >> 1) * 128 + ((i & 1) ? (127 - j) : j);
                        nsa_unit(p, bg, jq, lds, WAVE_F, LANE_F, i == 0);
                    }
                } else {
                    for (int i = 0; bx + i * G < 1024; ++i) {
                        const int u = bx + i * G;
                        const int bg = u >> 8, x = u & 255;
                        const int jq = (bg & 1) ? (255 - x) : x;
                        nsa_unit(p, bg, jq, lds, WAVE_F, LANE_F, true);
                    }
                }
            }
#else
            FRESH_WS;
            bf16_t* mixed = (bf16_t*)(ws + WS_AN);
            for (int m = GW_F; m < MT; m += NGW) { u32x4* o = (u32x4*)(mixed + (size_t)m * 1024); o[LANE_F] = (u32x4){0u, 0u, 0u, 0u}; }
#endif
        }
        GSYNC();
        {
            FRESH_WS; unsigned char* wl = ws + wloff;
            pg8::Gemm g{AN, (const bf16_t*)(wl + W_OUT), MT, DM, DM, DM};
            pg8::StaticOrder so; so.init(MT, DM, G, bx, 1);
            pg8::EpiNormRes E{ws, P_in(p, 3) + layer * DM, nullptr, 2 * layer};
            pg8::gemm_phase<pg8::EpiNormRes>(lds, g, so, E);
        }
        GSYNC();
#ifndef SKIP_PF
        {
            FRESH_WS; unsigned char* wl = ws + wloff;
            pg8::Gemm g{(const bf16_t*)(ws + WS_HB), (const bf16_t*)(wl + W_GU), MT, NGU, DM, DM};
            pg8::StaticOrder so; so.init(MT, NGU, G, bx, REP_PF);
            pg8::EpiGU E{(bf16_t*)(ws + WS_R1), (const float*)(ws + WS_RS)};
            pg8::gemm_phase<pg8::EpiGU>(lds, g, so, E);
        }
#endif
        GSYNC();
        {
            FRESH_WS; unsigned char* wl = ws + wloff;
            pg8::Gemm g{(const bf16_t*)(ws + WS_R1), (const bf16_t*)(wl + W_DN), MT, DM, DFF, DFF};
            pg8::StaticOrder so; so.init(MT, DM, G, bx, 1);
            pg8::EpiNormRes E{ws, P_in(p, 5) + layer * DM, (layer + 1 < DEPTH) ? nullptr : P_out(p), 2 * layer + 1};
            pg8::gemm_phase<pg8::EpiNormRes>(lds, g, so, E);
        }
        if (layer + 1 < DEPTH) GSYNC();
    }
}

extern "C" void kernel_launch(void* const* d_in, const int* in_sizes, int n_in, void* d_out, int out_size, void* d_ws, size_t ws_size, hipStream_t stream) {
    static int grid = 0;
    if (grid == 0) {
        if (n_in != 20 || out_size != MT * DM || ws_size < WS_END) { fprintf(stderr, "kernel_launch: unexpected shapes (n_in %d out %d ws %zu need %zu)\n", n_in, out_size, ws_size, (size_t)WS_END); grid = -1; return; }
        int dev = 0, cus = 0, per_cu = 0;
        hipGetDevice(&dev);
        hipDeviceGetAttribute(&cus, hipDeviceAttributeMultiprocessorCount, dev);
        if (hipFuncSetAttribute((const void*)fwd_megakernel, hipFuncAttributeMaxDynamicSharedMemorySize, LDS_BYTES) != hipSuccess) { fprintf(stderr, "kernel_launch: hipFuncSetAttribute failed\n"); grid = -1; return; }
        if (hipOccupancyMaxActiveBlocksPerMultiprocessor(&per_cu, (const void*)fwd_megakernel, NTHREADS, LDS_BYTES) != hipSuccess || per_cu < 1) { fprintf(stderr, "kernel_launch: occupancy query says %d\n", per_cu); per_cu = 1; }
        (void)hipGetLastError();
        grid = cus;
        if (grid > 256) grid = 256;
    }
    if (grid < 0) return;
    Params p{};
    for (int i = 0; i < 20; ++i) p.in[i] = (const float*)d_in[i];
    p.out = (float*)d_out; p.ws = (unsigned char*)d_ws;
    void* args[] = {&p};
    hipError_t e = hipLaunchCooperativeKernel((const void*)fwd_megakernel, dim3(grid), dim3(NTHREADS), args, LDS_BYTES, stream);
    if (e != hipSuccess) fprintf(stderr, "cooperative launch failed: %s (grid %d)\n", hipGetErrorString(e), grid);
}
```

```cpp
#include <hip/hip_runtime.h>
#include <hip/hip_cooperative_groups.h>
#include <cstdio>
#include <cstdint>
namespace cg = cooperative_groups;

#define LAS __attribute__((address_space(3)))
typedef unsigned short bf16_t;
typedef short bf16x8 __attribute__((ext_vector_type(8)));
typedef short s16x4 __attribute__((ext_vector_type(4)));
typedef float f32x2 __attribute__((ext_vector_type(2)));
typedef float f32x4 __attribute__((ext_vector_type(4)));
typedef float f32x16 __attribute__((ext_vector_type(16)));
typedef unsigned u32x2 __attribute__((ext_vector_type(2)));
typedef unsigned u32x4 __attribute__((ext_vector_type(4)));
typedef long l64x2 __attribute__((ext_vector_type(2)));

#ifndef REP_PA
#define REP_PA 1
#endif
#ifndef REP_PB
#define REP_PB 1
#endif
#ifndef REP_PC
#define REP_PC 1
#endif
#ifndef REP_PD
#define REP_PD 1
#endif
#ifndef REP_PF
#define REP_PF 1
#endif
#ifndef REP_PG
#define REP_PG 1
#endif
#ifndef SYNC_REP
#define SYNC_REP 1
#endif
#define GSYNC() do { for (int _r = 0; _r < SYNC_REP; ++_r) xcd_barrier((unsigned*)P_ws(p), (volatile LAS unsigned*)(lds + LDS_BYTES - 64)); } while (0)
#ifndef NSA_ENABLE
#define NSA_ENABLE 1
#endif

constexpr int NB = 2, S = 16384, DM = 1024, DEPTH = 4, MT = NB * S;
constexpr int INW = 2328, NINP = 2560, DFF = 2816, NGU = 2 * DFF;
constexpr int NCMP = 1024;
constexpr float RMS_EPS = 1e-6f, LN_EPS = 1e-5f;
constexpr float LOG2E = 1.4426950408889634f;
constexpr float QSCALE = 0.125f * LOG2E;
constexpr int NWAVES = 8, NTHREADS = 512;
constexpr int LDS_BYTES = 156672;

constexpr size_t MiB = 1u << 20;
constexpr size_t WS_W = 1 * MiB, W_LAYER = 26 * MiB;
constexpr size_t W_IN = 0, W_OUT = 5 * MiB, W_GU = 7 * MiB, W_DN = 18 * MiB, W_C1K = 23 * MiB + 512 * 1024, W_C1V = 24 * MiB + 512 * 1024,
                 W_C2K = 25 * MiB + 512 * 1024, W_C2V = W_C2K + 64 * 1024, W_CBK = W_C2V + 64 * 1024, W_CBV = W_CBK + 4096;
constexpr size_t WS_AN = 105 * MiB;
constexpr size_t WS_R1 = 169 * MiB;
constexpr size_t R_Q = 0, R_ZU = 32 * MiB, R_ZV = 64 * MiB, R_KC = 96 * MiB, R_VC = 105 * MiB, R_KS = 114 * MiB, R_VST = 122 * MiB, R_KW = 130 * MiB,
                 R_VWT = 138 * MiB, R_GATES = 146 * MiB, R_HID = 150 * MiB, R_KCMP = 154 * MiB, R_VCMPT = 155 * MiB;
constexpr size_t WS_MIX = 345 * MiB;
constexpr size_t WS_HB = WS_MIX + 64 * MiB;
constexpr size_t WS_RS = 256 * 1024;
constexpr size_t WS_XCNT = 512 * 1024;
constexpr size_t WS_XBUF = WS_MIX;
constexpr size_t WS_END = 473 * MiB;

struct Params {
    const float* in[20];
    float* out;
    unsigned char* ws;
};

typedef const __attribute__((address_space(4))) unsigned char* kargp_t;
__device__ __forceinline__ void* karg_ld(int byte_off) {
    kargp_t k = (kargp_t)__builtin_amdgcn_kernarg_segment_ptr();
    int off = byte_off; asm volatile("" : "+s"(off));
    return *(void* const __attribute__((address_space(4)))*)(k + off);
}
__device__ __forceinline__ const float* P_in(const Params&, int i) { return (const float*)karg_ld(8 * i); }
__device__ __forceinline__ float* P_out(const Params&) { return (float*)karg_ld(160); }
__device__ __forceinline__ unsigned char* P_ws(const Params&) { return (unsigned char*)karg_ld(168); }
__device__ __forceinline__ unsigned cvt_pk_bf16(float lo, float hi) { unsigned r; asm volatile("v_cvt_pk_bf16_f32 %0, %1, %2" : "=v"(r) : "v"(lo), "v"(hi)); return r; }
__device__ __forceinline__ float fast_exp2(float x) { return __builtin_amdgcn_exp2f(x); }
__device__ __forceinline__ float fast_rcp(float x) { return __builtin_amdgcn_rcpf(x); }
__device__ __forceinline__ float gelu_tanh(float x) { const float u = x + 0.044715f * x * x * x; return x * fast_rcp(1.0f + fast_exp2(-2.3022081982f * u)); }
__device__ __forceinline__ float silu_f(float x) { return x * fast_rcp(1.0f + fast_exp2(-LOG2E * x)); }
__device__ __forceinline__ float sigmoid_f(float x) { return fast_rcp(1.0f + fast_exp2(-LOG2E * x)); }
__device__ __forceinline__ float wave_sum(float v) {
#pragma unroll
    for (int o = 1; o < 64; o <<= 1) v += __shfl_xor(v, o);
    return v;
}
__device__ __forceinline__ float wave_max(float v) {
#pragma unroll
    for (int o = 1; o < 64; o <<= 1) v = fmaxf(v, __shfl_xor(v, o));
    return v;
}
template <int CTRL> __device__ __forceinline__ float dpp_f(float x) { return __builtin_bit_cast(float, __builtin_amdgcn_mov_dpp(__builtin_bit_cast(int, x), CTRL, 0xf, 0xf, true)); }
__device__ __forceinline__ float xhalf_max(float x) { auto t = __builtin_amdgcn_permlane32_swap(__float_as_uint(x), __float_as_uint(x), false, false); return fmaxf(__uint_as_float(t[0]), __uint_as_float(t[1])); }
__device__ __forceinline__ float xhalf_sum(float x) { auto t = __builtin_amdgcn_permlane32_swap(__float_as_uint(x), __float_as_uint(x), false, false); return __uint_as_float(t[0]) + __uint_as_float(t[1]); }
__device__ __forceinline__ float quad_sum(float x) { x += dpp_f<0xB1>(x); x += dpp_f<0x4E>(x); return x; }
__device__ __forceinline__ float wave_max_fast(float x) {
    x = fmaxf(x, dpp_f<0xB1>(x)); x = fmaxf(x, dpp_f<0x4E>(x)); x = fmaxf(x, dpp_f<0x141>(x)); x = fmaxf(x, dpp_f<0x128>(x));
    auto s = __builtin_amdgcn_permlane16_swap(__float_as_uint(x), __float_as_uint(x), false, false); x = fmaxf(__uint_as_float(s[0]), __uint_as_float(s[1]));
    return xhalf_max(x);
}
__device__ __forceinline__ float wave_sum_fast(float x) {
    x += dpp_f<0xB1>(x); x += dpp_f<0x4E>(x); x += dpp_f<0x141>(x); x += dpp_f<0x128>(x);
    auto s = __builtin_amdgcn_permlane16_swap(__float_as_uint(x), __float_as_uint(x), false, false); x = __uint_as_float(s[0]) + __uint_as_float(s[1]);
    return xhalf_sum(x);
}
__device__ __forceinline__ float bf2f(bf16_t b) { return __uint_as_float(((unsigned)b) << 16); }
#define LAUNDER(x) asm volatile("" : "+v"(x))
#define MFMA32(a, b, c) __builtin_amdgcn_mfma_f32_32x32x16_bf16((a), (b), (c), 0, 0, 0)

namespace pg8 {
constexpr int BM = 256, BK = 64, HALF = 128, HTB = HALF * BK * 2, STAGE_BYTES = 8 * HTB, NXCD = 8, WGM = 8;
__host__ __device__ __forceinline__ int lds_byte(int r, int c) { const int st = (r >> 4) * 2 + (c >> 5), rr = r & 15, cc = c & 31, ob = rr * 64 + cc * 2; return st * 1024 + (ob ^ (((ob >> 9) & 1) << 5)); }
__host__ __device__ __forceinline__ void stage_rc(int b, int& R, int& C) { const int st = b / 1024, sb = b % 1024, swz = sb ^ (((sb >> 9) & 1) << 5); R = (st >> 1) * 16 + swz / 64; C = (st & 1) * 32 + (swz % 64) / 2; }
__host__ __device__ __forceinline__ int perm32(int rho) { const int n = rho >> 4, i = rho & 15; return 8 * (i >> 2) + 4 * n + (i & 3); }

struct Unit { int pm, pn; };
struct Gemm { const bf16_t* A; const bf16_t* Bt; int M, N, K, lda; };

struct StaticOrder {
    int nM, nN, nwg, G, c, lim;
    __device__ __forceinline__ void init(int M, int N, int G_, int c_, int reps = 1) { nM = M / BM; nN = N / BM; nwg = nM * nN; G = G_; c = c_; const int per = (c < nwg) ? (nwg - c + G - 1) / G : 0; lim = per * reps; }
    __device__ __forceinline__ bool next(int i, Unit& u) const {
        if (i >= lim) return false;
        const int per = (nwg - c + G - 1) / G; const long L = (long)(i % per) * G + c;
        int wgid = (int)L; { const int q = nwg / NXCD, r = nwg % NXCD, xcd = wgid % NXCD, off = wgid / NXCD; wgid = (xcd < r ? xcd * (q + 1) : r * (q + 1) + (xcd - r) * q) + off; }
        const int nig = WGM * nN, gid = wgid / nig, fm = gid * WGM, gsz = (nM - fm) < WGM ? (nM - fm) : WGM;
        u.pm = fm + ((wgid % nig) % gsz); u.pn = (wgid % nig) / gsz; return true;
    }
};

struct EpiF32 {
    static constexpr bool PERM = false, FUSED = false;
    float* C; int ldc;
    __device__ __forceinline__ void operator()(const f32x4 (&acc)[2][2][4][2], const Unit& u, int wr, int wc, int fr, int fq) const {
        const int row0 = u.pm * BM + wr * 64 + fr, col0 = u.pn * BM + wc * 32 + 4 * fq;
#pragma unroll
        for (int ai = 0; ai < 2; ++ai)
#pragma unroll
            for (int m = 0; m < 4; ++m) { float* rowp = C + (size_t)(row0 + ai * HALF + m * 16) * ldc + col0;
#pragma unroll
                for (int bj = 0; bj < 2; ++bj)
#pragma unroll
                    for (int n = 0; n < 2; ++n) *(f32x4*)(rowp + bj * HALF + n * 16) = acc[ai][bj][m][n]; }
    }
};

struct EpiBf16 {
    static constexpr bool PERM = true, FUSED = false;
    bf16_t* C; int ldc;
    __device__ __forceinline__ void operator()(const f32x4 (&acc)[2][2][4][2], const Unit& u, int wr, int wc, int fr, int fq) const {
        const int row0 = u.pm * BM + wr * 64 + fr, col0 = u.pn * BM + wc * 32 + 8 * fq;
#pragma unroll
        for (int ai = 0; ai < 2; ++ai)
#pragma unroll
            for (int m = 0; m < 4; ++m) { bf16_t* rowp = C + (size_t)(row0 + ai * HALF + m * 16) * ldc + col0;
#pragma unroll
                for (int bj = 0; bj < 2; ++bj) { const f32x4 v0 = acc[ai][bj][m][0], v1 = acc[ai][bj][m][1];
                    u32x4 w; w.x = cvt_pk_bf16(v0[0], v0[1]); w.y = cvt_pk_bf16(v0[2], v0[3]); w.z = cvt_pk_bf16(v1[0], v1[1]); w.w = cvt_pk_bf16(v1[2], v1[3]);
                    *(u32x4*)(rowp + bj * HALF) = w; } }
    }
};

struct EpiGU {
    static constexpr bool PERM = true, FUSED = false;
    bf16_t* act; const float* rs;
    __device__ __forceinline__ void operator()(const f32x4 (&acc)[2][2][4][2], const Unit& u, int wr, int wc, int fr, int fq) const {
        const int row0 = u.pm * BM + wr * 64 + fr, col0 = u.pn * HALF + wc * 32 + 8 * fq;
        float rrv[2][4];
#pragma unroll
        for (int ai = 0; ai < 2; ++ai)
#pragma unroll
            for (int m = 0; m < 4; ++m) rrv[ai][m] = rs[row0 + ai * HALF + m * 16];
#pragma unroll
        for (int ai = 0; ai < 2; ++ai)
#pragma unroll
            for (int m = 0; m < 4; ++m) {
                const float rr = rrv[ai][m];
                const f32x4 g0 = acc[ai][0][m][0] * rr, g1 = acc[ai][0][m][1] * rr, u0 = acc[ai][1][m][0] * rr, u1 = acc[ai][1][m][1] * rr;
                u32x4 w;
                w.x = cvt_pk_bf16(silu_f(g0[0]) * u0[0], silu_f(g0[1]) * u0[1]); w.y = cvt_pk_bf16(silu_f(g0[2]) * u0[2], silu_f(g0[3]) * u0[3]);
                w.z = cvt_pk_bf16(silu_f(g1[0]) * u1[0], silu_f(g1[1]) * u1[1]); w.w = cvt_pk_bf16(silu_f(g1[2]) * u1[2], silu_f(g1[3]) * u1[3]);
                *(u32x4*)(act + (size_t)(row0 + ai * HALF + m * 16) * DFF + col0) = w;
            }
    }
};

struct EpiCmp1 {
    static constexpr bool PERM = true, FUSED = false;
    bf16_t* hid; const float* cbias;
    __device__ __forceinline__ void operator()(const f32x4 (&acc)[2][2][4][2], const Unit& u, int wr, int wc, int fr, int fq) const {
        const int row0 = u.pm * BM + wr * 64 + fr;
#pragma unroll
        for (int bj = 0; bj < 2; ++bj) {
            const int col0 = bj * HALF + wc * 32 + 8 * fq;
            const f32x4 b0 = *(const f32x4*)(cbias + col0), b1 = *(const f32x4*)(cbias + col0 + 4);
#pragma unroll
            for (int ai = 0; ai < 2; ++ai)
#pragma unroll
                for (int m = 0; m < 4; ++m) {
                    const f32x4 v0 = acc[ai][bj][m][0] + b0, v1 = acc[ai][bj][m][1] + b1;
                    u32x4 w;
                    w.x = cvt_pk_bf16(gelu_tanh(v0[0]), gelu_tanh(v0[1])); w.y = cvt_pk_bf16(gelu_tanh(v0[2]), gelu_tanh(v0[3]));
                    w.z = cvt_pk_bf16(gelu_tanh(v1[0]), gelu_tanh(v1[1])); w.w = cvt_pk_bf16(gelu_tanh(v1[2]), gelu_tanh(v1[3]));
                    *(u32x4*)(hid + (size_t)(row0 + ai * HALF + m * 16) * 256 + col0) = w;
                }
        }
    }
};

struct EpiIn {
    static constexpr bool PERM = true, FUSED = false;
    unsigned char* r1;
    const float* rs;
    __device__ __forceinline__ void operator()(const f32x4 (&acc)[2][2][4][2], const Unit& u, int wr, int wc, int fr, int fq) const {
        const int pn = u.pn;
        float rrv[2][4];
#pragma unroll
        for (int ai = 0; ai < 2; ++ai)
#pragma unroll
            for (int m = 0; m < 4; ++m) rrv[ai][m] = rs[u.pm * BM + ai * HALF + wr * 64 + m * 16 + fr];
#pragma unroll
        for (int ai = 0; ai < 2; ++ai)
#pragma unroll
            for (int m = 0; m < 4; ++m) {
                const int row = u.pm * BM + ai * HALF + wr * 64 + m * 16 + fr;
                const int b = row >> 14, s = row & (S - 1);
                const float rr = rrv[ai][m];
#pragma unroll
                for (int bj = 0; bj < 2; ++bj) {
                    f32x4 v0 = acc[ai][bj][m][0] * rr, v1 = acc[ai][bj][m][1] * rr;
                    const int cw = bj * HALF + wc * 32 + 8 * fq;
                    if (pn < 2) {
                        v0 = v0 * QSCALE; v1 = v1 * QSCALE;
                        u32x4 w; w.x = cvt_pk_bf16(v0[0], v0[1]); w.y = cvt_pk_bf16(v0[2], v0[3]); w.z = cvt_pk_bf16(v1[0], v1[1]); w.w = cvt_pk_bf16(v1[2], v1[3]);
                        *(u32x4*)((bf16_t*)(r1 + R_Q) + (size_t)row * 512 + pn * 256 + cw) = w;
                    } else if (pn < 5) {
                        const int g = wc >> 1, d = (wc & 1) * 32 + 8 * fq, bg = b * 2 + g;
                        if (pn == 2) {
                            bf16_t* base = (bf16_t*)(r1 + (bj == 0 ? R_KC : R_VC));
                            u32x4 w; w.x = cvt_pk_bf16(v0[0], v0[1]); w.y = cvt_pk_bf16(v0[2], v0[3]); w.z = cvt_pk_bf16(v1[0], v1[1]); w.w = cvt_pk_bf16(v1[2], v1[3]);
                            *(u32x4*)(base + ((size_t)bg * S + s) * 64 + d) = w;
                        } else if (pn == 3) {
                            if (bj == 0) {
                                v0 = v0 * 0.25f; v1 = v1 * 0.25f;
                                int w0 = __builtin_amdgcn_cvt_pk_fp8_f32(v0[0], v0[1], 0, false); w0 = __builtin_amdgcn_cvt_pk_fp8_f32(v0[2], v0[3], w0, true);
                                int w1 = __builtin_amdgcn_cvt_pk_fp8_f32(v1[0], v1[1], 0, false); w1 = __builtin_amdgcn_cvt_pk_fp8_f32(v1[2], v1[3], w1, true);
                                u32x2 w; w.x = (unsigned)w0; w.y = (unsigned)w1;
                                *(u32x2*)(r1 + R_KS + (size_t)bg * S * 64 + (size_t)(s >> 6) * 4096 + ((s >> 4) & 3) * 1024 + (((d >> 3) & 3) * 16 + (s & 15)) * 16 + (d >> 5) * 8) = w;
                            } else {
                                const int kb = s & 63, kp = kb >> 5, k32 = kb & 31, fqv = (k32 >> 2) & 3, jj = ((k32 >> 4) << 2) | (k32 & 3);
                                unsigned char* dst = r1 + R_VST + (size_t)bg * S * 64 + (size_t)(s >> 6) * 4096 + (d >> 4) * 1024 + (fqv * 16 + (d & 15)) * 16 + kp * 8 + jj;
                                const int w0 = __builtin_amdgcn_cvt_pk_fp8_f32(v0[0], v0[1], 0, false), w1 = __builtin_amdgcn_cvt_pk_fp8_f32(v0[2], v0[3], 0, false);
                                const int w2 = __builtin_amdgcn_cvt_pk_fp8_f32(v1[0], v1[1], 0, false), w3 = __builtin_amdgcn_cvt_pk_fp8_f32(v1[2], v1[3], 0, false);
                                dst[0] = (unsigned char)(w0 & 0xff); dst[16] = (unsigned char)((w0 >> 8) & 0xff); dst[32] = (unsigned char)(w1 & 0xff); dst[48] = (unsigned char)((w1 >> 8) & 0xff);
                                dst[64] = (unsigned char)(w2 & 0xff); dst[80] = (unsigned char)((w2 >> 8) & 0xff); dst[96] = (unsigned char)(w3 & 0xff); dst[112] = (unsigned char)((w3 >> 8) & 0xff);
                            }
                        } else if (bj == 0) {
                            bf16_t* base = (bf16_t*)(r1 + R_KW);
                            u32x4 w; w.x = cvt_pk_bf16(v0[0], v0[1]); w.y = cvt_pk_bf16(v0[2], v0[3]); w.z = cvt_pk_bf16(v1[0], v1[1]); w.w = cvt_pk_bf16(v1[2], v1[3]);
                            *(u32x4*)(base + (size_t)bg * S * 64 + (size_t)(s >> 5) * 2048 + (d >> 4) * 512 + ((d >> 3) & 1) * 256 + (s & 31) * 8) = w;
                        } else {
                            const int kk = s & 31;
                            bf16_t* dst = (bf16_t*)(r1 + R_VWT) + (size_t)bg * S * 64 + (size_t)(s >> 5) * 2048 + (d >> 5) * 1024 + (kk >> 4) * 512 + ((kk >> 2) & 1) * 256 + (d & 31) * 8 + ((kk >> 3) & 1) * 4 + (kk & 3);
                            const unsigned w0 = cvt_pk_bf16(v0[0], v0[1]), w1 = cvt_pk_bf16(v0[2], v0[3]), w2 = cvt_pk_bf16(v1[0], v1[1]), w3 = cvt_pk_bf16(v1[2], v1[3]);
                            dst[0] = (bf16_t)(w0 & 0xffff); dst[8] = (bf16_t)(w0 >> 16); dst[16] = (bf16_t)(w1 & 0xffff); dst[24] = (bf16_t)(w1 >> 16);
                            dst[32] = (bf16_t)(w2 & 0xffff); dst[40] = (bf16_t)(w2 >> 16); dst[48] = (bf16_t)(w3 & 0xffff); dst[56] = (bf16_t)(w3 >> 16);
                        }
                    } else if (pn < 9) {
                        bf16_t* base = (bf16_t*)(r1 + ((pn < 7) ? R_ZU : R_ZV)); const int ct = (pn < 7) ? (pn - 5) : (pn - 7);
                        u32x4 w;
                        w.x = cvt_pk_bf16(gelu_tanh(v0[0]), gelu_tanh(v0[1])); w.y = cvt_pk_bf16(gelu_tanh(v0[2]), gelu_tanh(v0[3]));
                        w.z = cvt_pk_bf16(gelu_tanh(v1[0]), gelu_tanh(v1[1])); w.w = cvt_pk_bf16(gelu_tanh(v1[2]), gelu_tanh(v1[3]));
                        *(u32x4*)(base + (size_t)row * 512 + ct * 256 + cw) = w;
                    } else {
                        if (bj == 0 && wc == 0 && fq < 3) {
                            float* gp = (float*)(r1 + R_GATES) + (size_t)row * 24 + 8 * fq;
                            *(f32x4*)gp = (f32x4){sigmoid_f(v0[0]), sigmoid_f(v0[1]), sigmoid_f(v0[2]), sigmoid_f(v0[3])};
                            *(f32x4*)(gp + 4) = (f32x4){sigmoid_f(v1[0]), sigmoid_f(v1[1]), sigmoid_f(v1[2]), sigmoid_f(v1[3])};
                        }
                    }
                }
            }
    }
};

struct EpiNormRes {
    static constexpr bool PERM = true, FUSED = true;
    unsigned char* ws; const float* gpost; float* fout; int inst;
    __device__ __forceinline__ void exchange(int e, float (&sv)[2][4], float (&rv)[2][4], const Unit& u, int wr, int wc, int fr, int fq, LAS unsigned char* lds, int wid, int lane) const {
        LAS float* P = (LAS float*)(lds + 131072);
        LAS float* Sx = P + 1024;
        float* xbuf = (float*)(ws + WS_XBUF) + (size_t)e * MT * 4;
        unsigned* cnt = (unsigned*)(ws + WS_XCNT) + ((size_t)(e * 8 + inst) * 128 + u.pm) * 16;
#pragma unroll
        for (int ai = 0; ai < 2; ++ai)
#pragma unroll
            for (int m = 0; m < 4; ++m) {
                float v = sv[ai][m];
                { auto t1 = __builtin_amdgcn_permlane16_swap(__float_as_uint(v), __float_as_uint(v), false, false); v = __uint_as_float(t1[0]) + __uint_as_float(t1[1]); }
                v = xhalf_sum(v);
                if (fq == 0) P[(ai * HALF + wr * 64 + m * 16 + fr) * 4 + wc] = v;
            }
        asm volatile("s_waitcnt lgkmcnt(0)" ::: "memory"); __builtin_amdgcn_s_barrier(); asm volatile("" ::: "memory");
        const int tid = wid * 64 + lane;
        if (tid < 256) {
            const f32x4 pp = *(const LAS f32x4*)(P + tid * 4);
            __hip_atomic_store(xbuf + ((size_t)u.pm * 256 + tid) * 4 + u.pn, (pp[0] + pp[1]) + (pp[2] + pp[3]), __ATOMIC_RELAXED, __HIP_MEMORY_SCOPE_AGENT);
        }
        asm volatile("s_waitcnt vmcnt(0)" ::: "memory");
        if (wid < 4 && lane == 0) __hip_atomic_fetch_add(cnt, 1u, __ATOMIC_RELAXED, __HIP_MEMORY_SCOPE_AGENT);
        if (wid == 0) {
            unsigned sp = 0;
            while ((unsigned)__builtin_amdgcn_readfirstlane(__hip_atomic_load(cnt, __ATOMIC_RELAXED, __HIP_MEMORY_SCOPE_AGENT)) < 16u) { __builtin_amdgcn_s_sleep(2); if (++sp > (1u << 22)) break; }
            __builtin_amdgcn_fence(__ATOMIC_ACQUIRE, "agent");
        }
        asm volatile("s_waitcnt vmcnt(0) lgkmcnt(0)" ::: "memory"); __builtin_amdgcn_s_barrier(); asm volatile("" ::: "memory");
        if (tid < 256) {
            const float* sl = xbuf + ((size_t)u.pm * 256 + tid) * 4;
            const float t0 = __hip_atomic_load(sl + 0, __ATOMIC_RELAXED, __HIP_MEMORY_SCOPE_AGENT), t1 = __hip_atomic_load(sl + 1, __ATOMIC_RELAXED, __HIP_MEMORY_SCOPE_AGENT);
            const float t2 = __hip_atomic_load(sl + 2, __ATOMIC_RELAXED, __HIP_MEMORY_SCOPE_AGENT), t3 = __hip_atomic_load(sl + 3, __ATOMIC_RELAXED, __HIP_MEMORY_SCOPE_AGENT);
            Sx[tid] = 1.0f / sqrtf(((t0 + t1) + (t2 + t3)) * (1.0f / 1024.0f) + RMS_EPS);
        }
        asm volatile("s_waitcnt vmcnt(0) lgkmcnt(0)" ::: "memory"); __builtin_amdgcn_s_barrier(); asm volatile("" ::: "memory");
#pragma unroll
        for (int ai = 0; ai < 2; ++ai)
#pragma unroll
            for (int m = 0; m < 4; ++m) rv[ai][m] = Sx[ai * HALF + wr * 64 + m * 16 + fr];
    }
    __device__ __forceinline__ void fused(f32x4 (&acc)[2][2][4][2], const Unit& u, int wr, int wc, int fr, int fq, LAS unsigned char* lds, int wid, int lane) const {
        bf16_t* hb = (bf16_t*)(ws + WS_HB);
        const int row0 = u.pm * BM + wr * 64 + fr, col0 = u.pn * BM + wc * 32 + 8 * fq;
        float sv[2][4], rv[2][4];
#pragma unroll
        for (int ai = 0; ai < 2; ++ai)
#pragma unroll
            for (int m = 0; m < 4; ++m) {
                float q = 0.f;
#pragma unroll
                for (int bj = 0; bj < 2; ++bj)
#pragma unroll
                    for (int n = 0; n < 2; ++n) { const f32x4 x = acc[ai][bj][m][n]; q += (x[0] * x[0] + x[1] * x[1]) + (x[2] * x[2] + x[3] * x[3]); }
                sv[ai][m] = q;
            }
        exchange(0, sv, rv, u, wr, wc, fr, fq, lds, wid, lane);
        float dep = 0.f;
#pragma unroll
        for (int ai = 0; ai < 2; ++ai)
#pragma unroll
            for (int m = 0; m < 4; ++m) {
                const bf16_t* hrow = hb + (size_t)(row0 + ai * HALF + m * 16) * DM + col0;
                asm volatile("" : "+v"(hrow) : "v"(dep));
                const float r1 = rv[ai][m];
                float q = 0.f;
#pragma unroll
                for (int bj = 0; bj < 2; ++bj) {
                    const u32x4 hv = *(const u32x4*)(hrow + bj * HALF);
                    const f32x4 h0 = (f32x4){__uint_as_float(hv.x << 16), __uint_as_float(hv.x & 0xffff0000u), __uint_as_float(hv.y << 16), __uint_as_float(hv.y & 0xffff0000u)};
                    const f32x4 h1 = (f32x4){__uint_as_float(hv.z << 16), __uint_as_float(hv.z & 0xffff0000u), __uint_as_float(hv.w << 16), __uint_as_float(hv.w & 0xffff0000u)};
                    const f32x4 gg0 = *(const f32x4*)(gpost + col0 + bj * HALF), gg1 = *(const f32x4*)(gpost + col0 + bj * HALF + 4);
                    f32x4 x0 = h0 + acc[ai][bj][m][0] * r1 * gg0, x1 = h1 + acc[ai][bj][m][1] * r1 * gg1;
                    acc[ai][bj][m][0] = x0; acc[ai][bj][m][1] = x1;
                    q += ((x0[0] * x0[0] + x0[1] * x0[1]) + (x0[2] * x0[2] + x0[3] * x0[3])) + ((x1[0] * x1[0] + x1[1] * x1[1]) + (x1[2] * x1[2] + x1[3] * x1[3]));
                }
                sv[ai][m] = q;
                dep = q;
            }
        if (fout) {
#pragma unroll
            for (int ai = 0; ai < 2; ++ai)
#pragma unroll
                for (int m = 0; m < 4; ++m) { float* orow = fout + (size_t)(row0 + ai * HALF + m * 16) * DM + col0;
#pragma unroll
                    for (int bj = 0; bj < 2; ++bj) { *(f32x4*)(orow + bj * HALF) = acc[ai][bj][m][0]; *(f32x4*)(orow + bj * HALF + 4) = acc[ai][bj][m][1]; } }
            return;
        }
        exchange(1, sv, rv, u, wr, wc, fr, fq, lds, wid, lane);
        float* rs = (float*)(ws + WS_RS);
#pragma unroll
        for (int ai = 0; ai < 2; ++ai)
#pragma unroll
            for (int m = 0; m < 4; ++m) {
                bf16_t* hrow = hb + (size_t)(row0 + ai * HALF + m * 16) * DM + col0;
#pragma unroll
                for (int bj = 0; bj < 2; ++bj) { const f32x4 x0 = acc[ai][bj][m][0], x1 = acc[ai][bj][m][1];
                    u32x4 w; w.x = cvt_pk_bf16(x0[0], x0[1]); w.y = cvt_pk_bf16(x0[2], x0[3]); w.z = cvt_pk_bf16(x1[0], x1[1]); w.w = cvt_pk_bf16(x1[2], x1[3]);
                    *(u32x4*)(hrow + bj * HALF) = w; }
                if (u.pn == 0 && wc == 0 && fq == 0) rs[row0 + ai * HALF + m * 16] = rv[ai][m];
            }
    }
};

template <class Epi>
__device__ __forceinline__ void gemm_phase(LAS unsigned char* lds, const Gemm g, const StaticOrder& S, const Epi& E) {
    int tid = threadIdx.x; LAUNDER(tid);
    const int wid = __builtin_amdgcn_readfirstlane(tid >> 6), lane = tid & 63, wr = wid >> 2, wc = wid & 3, fr = lane & 15, fq = lane >> 4;
    const int K = g.K, nt = K / BK, lda = g.lda;
    unsigned voffA[2], voffB[2];
#pragma unroll
    for (int i = 0; i < 2; ++i) { int R, C; stage_rc(tid * 16 + i * 8192, R, C); const int Rb = Epi::PERM ? ((R & ~31) + perm32(R & 31)) : R;
        voffA[i] = (unsigned)(R * lda + C) * 2u; voffB[i] = (unsigned)(Rb * K + C) * 2u; }
    const size_t kstep = (size_t)(BK * 2);
    const size_t hA = (size_t)HALF * lda * 2, hB = (size_t)HALF * K * 2;
    const size_t tA = 2 * hA, tB = 2 * hB;
    const unsigned ldsw = (unsigned)wid * 1024u;
    const int aoff = lds_byte(wr * 64 + fr, fq * 8), boff = lds_byte(wc * 32 + fr, fq * 8);
#define PG8_SA(b, h) (((b) * 2 + (h)) * HTB)
#define PG8_SB(b, h) ((4 + (b) * 2 + (h)) * HTB)
#define PG8_STAGE(bufoff, gbase, voff) do { _Pragma("unroll") for (int _i = 0; _i < 2; ++_i) \
        __builtin_amdgcn_global_load_lds((const unsigned*)((const char*)(gbase) + (voff)[_i]), (LAS unsigned*)(lds + (bufoff) + ldsw + _i * 8192), 16, 0, 0); } while (0)
#define PG8_LDA(dst, b, h) do { _Pragma("unroll") for (int m = 0; m < 4; ++m) _Pragma("unroll") for (int k = 0; k < 2; ++k) dst[m][k] = *(const LAS bf16x8*)(lds + PG8_SA(b, h) + aoff + m * 2048 + k * 1024); } while (0)
#define PG8_LDB(dst, b, h) do { _Pragma("unroll") for (int n = 0; n < 2; ++n) _Pragma("unroll") for (int k = 0; k < 2; ++k) dst[n][k] = *(const LAS bf16x8*)(lds + PG8_SB(b, h) + boff + n * 2048 + k * 1024); } while (0)
#define PG8_MMA(ai, bj, At, Bt) do { __builtin_amdgcn_s_setprio(1); _Pragma("unroll") for (int m = 0; m < 4; ++m) _Pragma("unroll") for (int n = 0; n < 2; ++n) _Pragma("unroll") for (int k = 0; k < 2; ++k) \
        acc[ai][bj][m][n] = __builtin_amdgcn_mfma_f32_16x16x32_bf16(Bt[n][k], At[m][k], acc[ai][bj][m][n], 0, 0, 0); __builtin_amdgcn_s_setprio(0); } while (0)
#define PG8_WAIT_V(n) asm volatile("s_waitcnt vmcnt(" #n ")" ::: "memory")
#define PG8_WAIT_L(n) asm volatile("s_waitcnt lgkmcnt(" #n ")" ::: "memory")
#define PG8_BAR __builtin_amdgcn_s_barrier()
#define PG8_SCHED __builtin_amdgcn_sched_barrier(0)
    Unit cur, nxt; int ui = 0;
    if (!S.next(0, cur)) return;
    f32x4 acc[2][2][4][2];
#pragma unroll
    for (int a = 0; a < 2; ++a)
#pragma unroll
        for (int b = 0; b < 2; ++b)
#pragma unroll
            for (int m = 0; m < 4; ++m)
#pragma unroll
                for (int n = 0; n < 2; ++n) acc[a][b][m][n] = (f32x4){0.f, 0.f, 0.f, 0.f};
    bf16x8 At[4][2], B0[2][2], B1[2][2];
    const char* cA = (const char*)g.A + (size_t)cur.pm * tA; const char* cB = (const char*)g.Bt + (size_t)cur.pn * tB;
    PG8_STAGE(PG8_SB(0, 0), cB, voffB); PG8_STAGE(PG8_SB(0, 1), cB + hB, voffB); PG8_STAGE(PG8_SA(0, 0), cA, voffA); PG8_STAGE(PG8_SA(0, 1), cA + hA, voffA);
    if (wr == 1) PG8_BAR;
    PG8_WAIT_V(2); PG8_BAR;
    PG8_STAGE(PG8_SB(1, 0), cB + kstep, voffB); PG8_STAGE(PG8_SA(1, 0), cA + kstep, voffA); PG8_STAGE(PG8_SB(1, 1), cB + hB + kstep, voffB);
    PG8_WAIT_V(6); PG8_BAR;
    for (;;) {
        const bool has_next = S.next(ui + 1, nxt);
        const char* nA = has_next ? (const char*)g.A + (size_t)nxt.pm * tA : cA; const char* nB = has_next ? (const char*)g.Bt + (size_t)nxt.pn * tB : cB;
        for (int t = 0; t < nt; t += 2) {
            const bool last = (t == nt - 2);
            const char* a1 = cA + (size_t)(t + 1) * kstep;
            const char* a2 = last ? nA : cA + (size_t)(t + 2) * kstep; const char* b2 = last ? nB : cB + (size_t)(t + 2) * kstep;
            const char* a3 = a2 + kstep; const char* b3 = b2 + kstep;
            PG8_LDB(B0, 0, 0); PG8_LDB(B1, 0, 1); PG8_SCHED; PG8_LDA(At, 0, 0); PG8_STAGE(PG8_SA(1, 1), a1 + hA, voffA);
            PG8_WAIT_V(8); PG8_WAIT_L(0); PG8_BAR; PG8_MMA(0, 0, At, B0); PG8_MMA(0, 1, At, B1); PG8_BAR; PG8_SCHED;
            PG8_LDA(At, 0, 1); PG8_STAGE(PG8_SB(0, 0), b2, voffB); PG8_STAGE(PG8_SB(0, 1), b2 + hB, voffB); PG8_STAGE(PG8_SA(0, 0), a2, voffA);
            PG8_WAIT_V(8); PG8_WAIT_L(0); PG8_BAR; PG8_MMA(1, 0, At, B0); PG8_MMA(1, 1, At, B1); PG8_BAR; PG8_SCHED;
            PG8_LDB(B0, 1, 0); PG8_LDB(B1, 1, 1); PG8_SCHED; PG8_LDA(At, 1, 0); PG8_STAGE(PG8_SA(0, 1), a2 + hA, voffA);
            PG8_WAIT_V(8); PG8_WAIT_L(0); PG8_BAR; PG8_MMA(0, 0, At, B0); PG8_MMA(0, 1, At, B1); PG8_BAR; PG8_SCHED;
            PG8_LDA(At, 1, 1); PG8_STAGE(PG8_SB(1, 0), b3, voffB); PG8_STAGE(PG8_SB(1, 1), b3 + hB, voffB); PG8_STAGE(PG8_SA(1, 0), a3, voffA);
            PG8_WAIT_V(8); PG8_WAIT_L(0); PG8_BAR; PG8_MMA(1, 0, At, B0); PG8_MMA(1, 1, At, B1); PG8_BAR; PG8_SCHED;
        }
        if (wr == 0) PG8_BAR;
        if constexpr (Epi::FUSED) E.fused(acc, cur, wr, wc, fr, fq, lds, wid, lane); else E(acc, cur, wr, wc, fr, fq);
        if (!has_next) break;
#pragma unroll
        for (int a = 0; a < 2; ++a)
#pragma unroll
            for (int b = 0; b < 2; ++b)
#pragma unroll
                for (int m = 0; m < 4; ++m)
#pragma unroll
                    for (int n = 0; n < 2; ++n) acc[a][b][m][n] = (f32x4){0.f, 0.f, 0.f, 0.f};
        cur = nxt; cA = nA; cB = nB; ++ui;
        if (wr == 1) PG8_BAR;
    }
    PG8_WAIT_V(0);
    PG8_BAR;
#undef PG8_SA
#undef PG8_SB
#undef PG8_STAGE
#undef PG8_LDA
#undef PG8_LDB
#undef PG8_MMA
#undef PG8_WAIT_V
#undef PG8_WAIT_L
#undef PG8_BAR
#undef PG8_SCHED
}
}

template <int MAP> __device__ __forceinline__ int src_col(int n) {
    if (MAP == 0) return n;
    if (MAP == 1) { if (n < 1280) return n; if (n < 2304) return n + 24; if (n < 2328) return n - 1024; return -1; }
    const int t = n >> 8, w = n & 255; return (w < 128) ? (128 * t + w) : (DFF + 128 * t + (w - 128));
}
constexpr int TP = 65;
template <int MAP> __device__ __forceinline__ void transpose_item(const float* W, int K, int Nsrc, bf16_t* WT, int nblk, int item, LAS float* scr, int lane, const float* gain = nullptr) {
    const int kb = item / nblk, nb = item % nblk, k0 = 64 * kb, n0 = 64 * nb;
    const int nl = 4 * (lane & 15), kr = lane >> 4;
    const int ns = src_col<MAP>(n0 + nl);
    f32x4 v[16];
#pragma unroll
    for (int i = 0; i < 16; ++i) v[i] = (ns >= 0) ? *(const f32x4*)(W + (size_t)(k0 + kr + 4 * i) * Nsrc + ns) : (f32x4){0.f, 0.f, 0.f, 0.f};
    if (gain) {
#pragma unroll
        for (int i = 0; i < 16; ++i) v[i] = v[i] * gain[k0 + kr + 4 * i];
    }
#pragma unroll
    for (int i = 0; i < 16; ++i) { LAS float* d = scr + (kr + 4 * i) * TP + nl; d[0] = v[i][0]; d[1] = v[i][1]; d[2] = v[i][2]; d[3] = v[i][3]; }
    asm volatile("s_waitcnt lgkmcnt(0)" ::: "memory");
    __builtin_amdgcn_wave_barrier();
    const int c = lane & 7;
#pragma unroll
    for (int j = 0; j < 8; ++j) { const int n = (lane >> 3) + 8 * j; const LAS float* s = scr + (8 * c) * TP + n;
        u32x4 o; o.x = cvt_pk_bf16(s[0 * TP], s[1 * TP]); o.y = cvt_pk_bf16(s[2 * TP], s[3 * TP]); o.z = cvt_pk_bf16(s[4 * TP], s[5 * TP]); o.w = cvt_pk_bf16(s[6 * TP], s[7 * TP]);
        *(u32x4*)(WT + (size_t)(n0 + n) * K + k0 + 8 * c) = o; }
    asm volatile("s_waitcnt lgkmcnt(0)" ::: "memory");
    __builtin_amdgcn_wave_barrier();
}

__device__ __forceinline__ void row_pass(const float* x0, bf16_t* hb, const bf16_t* mix, const float* gpost, float* rs, float* fout, int gw, int NGW, int lane) {
    LAUNDER(lane);
    if (x0) {
        for (int m = gw; m < MT; m += NGW) {
            const f32x4* hr = (const f32x4*)(x0 + (size_t)m * DM) + lane;
            f32x4 h[4]; float s2 = 0.f;
#pragma unroll
            for (int j = 0; j < 4; ++j) { h[j] = hr[64 * j]; s2 += (h[j][0] * h[j][0] + h[j][1] * h[j][1]) + (h[j][2] * h[j][2] + h[j][3] * h[j][3]); }
            const float r2 = 1.0f / sqrtf(wave_sum_fast(s2) * (1.0f / DM) + RMS_EPS);
            u32x2* ao = (u32x2*)(hb + (size_t)m * DM) + lane;
#pragma unroll
            for (int j = 0; j < 4; ++j) { u32x2 w; w.x = cvt_pk_bf16(h[j][0], h[j][1]); w.y = cvt_pk_bf16(h[j][2], h[j][3]); ao[64 * j] = w; }
            if (lane == 0) rs[m] = r2;
        }
        return;
    }
    u32x2 hn[4], mn[4];
    if (gw < MT) {
        const u32x2* hr = (const u32x2*)(hb + (size_t)gw * DM) + lane; const u32x2* mr = (const u32x2*)(mix + (size_t)gw * DM) + lane;
#pragma unroll
        for (int j = 0; j < 4; ++j) { hn[j] = hr[64 * j]; mn[j] = mr[64 * j]; }
    }
    for (int m = gw; m < MT; m += NGW) {
        u32x2 hv[4], mv[4];
#pragma unroll
        for (int j = 0; j < 4; ++j) { hv[j] = hn[j]; mv[j] = mn[j]; }
        const int m2 = m + NGW;
        if (m2 < MT) {
            const u32x2* hr = (const u32x2*)(hb + (size_t)m2 * DM) + lane; const u32x2* mr = (const u32x2*)(mix + (size_t)m2 * DM) + lane;
#pragma unroll
            for (int j = 0; j < 4; ++j) { hn[j] = hr[64 * j]; mn[j] = mr[64 * j]; }
        }
        f32x4 h[4], x[4]; float ss = 0.f;
#pragma unroll
        for (int j = 0; j < 4; ++j) {
            h[j] = (f32x4){__uint_as_float(hv[j].x << 16), __uint_as_float(hv[j].x & 0xffff0000u), __uint_as_float(hv[j].y << 16), __uint_as_float(hv[j].y & 0xffff0000u)};
            x[j] = (f32x4){__uint_as_float(mv[j].x << 16), __uint_as_float(mv[j].x & 0xffff0000u), __uint_as_float(mv[j].y << 16), __uint_as_float(mv[j].y & 0xffff0000u)};
            ss += (x[j][0] * x[j][0] + x[j][1] * x[j][1]) + (x[j][2] * x[j][2] + x[j][3] * x[j][3]);
        }
        const float r1 = 1.0f / sqrtf(wave_sum_fast(ss) * (1.0f / DM) + RMS_EPS);
        float s2 = 0.f;
#pragma unroll
        for (int j = 0; j < 4; ++j) { const f32x4 gp = *((const f32x4*)gpost + lane + 64 * j); h[j] = h[j] + x[j] * r1 * gp; s2 += (h[j][0] * h[j][0] + h[j][1] * h[j][1]) + (h[j][2] * h[j][2] + h[j][3] * h[j][3]); }
        if (fout) {
            f32x4* ho = (f32x4*)(fout + (size_t)m * DM) + lane;
#pragma unroll
            for (int j = 0; j < 4; ++j) ho[64 * j] = h[j];
        } else {
            const float r2 = 1.0f / sqrtf(wave_sum_fast(s2) * (1.0f / DM) + RMS_EPS);
            u32x2* ao = (u32x2*)(hb + (size_t)m * DM) + lane;
#pragma unroll
            for (int j = 0; j < 4; ++j) { u32x2 w; w.x = cvt_pk_bf16(h[j][0], h[j][1]); w.y = cvt_pk_bf16(h[j][2], h[j][3]); ao[64 * j] = w; }
            if (lane == 0) rs[m] = r2;
        }
    }
}

constexpr int ZPITCH = 136;
__device__ __forceinline__ void gmlp_unit(const Params& p, int layer, int chunk, LAS unsigned char* lds, int wave, int lane) {
    LAUNDER(lane);
    const unsigned char* ws = P_ws(p);
    const bf16_t* zu = (const bf16_t*)(ws + WS_R1 + R_ZU); const bf16_t* zv = (const bf16_t*)(ws + WS_R1 + R_ZV);
    bf16_t* mixed = (bf16_t*)(ws + WS_AN);
    const float* ln_g = P_in(p, 13) + layer * 512; const float* ln_b = P_in(p, 14) + layer * 512;
    const float* w_s = P_in(p, 15) + (size_t)layer * 8 * 128 * 128 + (size_t)wave * 128 * 128;
    const float* b_s = P_in(p, 16) + layer * 8 * 128 + wave * 128;
    LAS float* stats = (LAS float*)(lds + 8 * 64 * ZPITCH * 2);
    LAS bf16_t* zt = (LAS bf16_t*)(lds + wave * 64 * ZPITCH * 2);
    const int tok0 = chunk * 128;
    __syncthreads();
    {
        bf16x8 sv[16];
#pragma unroll
        for (int i = 0; i < 16; ++i) sv[i] = *(const bf16x8*)(zv + (size_t)(tok0 + wave * 16 + i) * 512 + lane * 8);
        asm volatile("" ::: "memory");
        float mn[16], rs16[16];
#pragma unroll
        for (int i = 0; i < 16; ++i) {
            float s = 0.f, s2 = 0.f;
#pragma unroll
            for (int e = 0; e < 8; ++e) { const float x = bf2f((bf16_t)sv[i][e]); s += x; s2 += x * x; }
            s = wave_sum_fast(s); s2 = wave_sum_fast(s2);
            const float mean = s * (1.0f / 512.0f); const float var = fmaxf(s2 * (1.0f / 512.0f) - mean * mean, 0.f);
            mn[i] = mean; rs16[i] = 1.0f / sqrtf(var + LN_EPS);
        }
        if (lane == 0) {
#pragma unroll
            for (int i = 0; i < 16; ++i) { stats[2 * (wave * 16 + i)] = mn[i]; stats[2 * (wave * 16 + i) + 1] = rs16[i]; }
        }
    }
    __syncthreads();
    {
        const int dc = lane & 7, d0 = dc * 8;
        const f32x4 g0 = *(const f32x4*)(ln_g + wave * 64 + d0), g1 = *(const f32x4*)(ln_g + wave * 64 + d0 + 4);
        const f32x4 b0 = *(const f32x4*)(ln_b + wave * 64 + d0), b1 = *(const f32x4*)(ln_b + wave * 64 + d0 + 4);
        bf16x8 zq[16];
#pragma unroll
        for (int i = 0; i < 16; ++i) zq[i] = *(const bf16x8*)(zv + (size_t)(tok0 + (lane >> 3) + 8 * i) * 512 + wave * 64 + d0);
#pragma unroll
        for (int i = 0; i < 16; ++i) {
            const int s = (lane >> 3) + 8 * i;
            const float mean = stats[2 * s], rstd = stats[2 * s + 1];
#pragma unroll
            for (int e = 0; e < 8; ++e) {
                const float gg = (e < 4) ? g0[e & 3] : g1[e & 3], bb = (e < 4) ? b0[e & 3] : b1[e & 3];
                const float y = (bf2f((bf16_t)zq[i][e]) - mean) * rstd * gg + bb;
                zt[(d0 + e) * ZPITCH + s] = (bf16_t)(cvt_pk_bf16(y, 0.f) & 0xffff);
            }
        }
    }
    asm volatile("s_waitcnt lgkmcnt(0)" ::: "memory");
    __builtin_amdgcn_wave_barrier();
    const int r = lane & 31, h = lane >> 5;
#pragma unroll
    for (int mt = 0; mt < 4; ++mt) {
        f32x16 acc0, acc1;
#pragma unroll
        for (int i = 0; i < 16; ++i) { acc0[i] = 0.f; acc1[i] = 0.f; }
        const int t = 32 * mt + r;
        const size_t rowoff = (size_t)(tok0 + t) * 512 + wave * 64;
        f32x4 wq[8][2]; u32x2 zz[2][4];
#pragma unroll
        for (int ks = 0; ks < 2 * (mt + 1); ++ks) { wq[ks][0] = *(const f32x4*)(w_s + (size_t)t * 128 + 16 * ks + 8 * h); wq[ks][1] = *(const f32x4*)(w_s + (size_t)t * 128 + 16 * ks + 8 * h + 4); }
#pragma unroll
        for (int dt = 0; dt < 2; ++dt)
#pragma unroll
            for (int i4 = 0; i4 < 4; ++i4) zz[dt][i4] = *(const u32x2*)(zu + rowoff + 32 * dt + 8 * i4 + 4 * h);
        const float bs = b_s[t];
#pragma unroll
        for (int ks = 0; ks < 2 * (mt + 1); ++ks) {
            const int s0 = 16 * ks + 8 * h;
            const f32x4 w0 = wq[ks][0], w1 = wq[ks][1];
            float wv[8] = {w0[0], w0[1], w0[2], w0[3], w1[0], w1[1], w1[2], w1[3]};
#pragma unroll
            for (int e = 0; e < 8; ++e) wv[e] = (s0 + e <= t) ? wv[e] : 0.f;
            u32x4 wb; wb.x = cvt_pk_bf16(wv[0], wv[1]); wb.y = cvt_pk_bf16(wv[2], wv[3]); wb.z = cvt_pk_bf16(wv[4], wv[5]); wb.w = cvt_pk_bf16(wv[6], wv[7]);
            const bf16x8 bfrag = __builtin_bit_cast(bf16x8, wb);
            const bf16x8 a0 = *(const LAS bf16x8*)(zt + (r) * ZPITCH + s0);
            const bf16x8 a1 = *(const LAS bf16x8*)(zt + (32 + r) * ZPITCH + s0);
            acc0 = MFMA32(a0, bfrag, acc0);
            acc1 = MFMA32(a1, bfrag, acc1);
        }
        bf16_t* mrow = mixed + (size_t)(tok0 + t) * 1024 + 512 + wave * 64;
#pragma unroll
        for (int dt = 0; dt < 2; ++dt)
#pragma unroll
            for (int i4 = 0; i4 < 4; ++i4) {
                const int d = 32 * dt + 8 * i4 + 4 * h;
                const u32x2 zv2 = zz[dt][i4];
                const float z0 = __uint_as_float(zv2.x << 16), z1 = __uint_as_float(zv2.x & 0xffff0000u), z2 = __uint_as_float(zv2.y << 16), z3 = __uint_as_float(zv2.y & 0xffff0000u);
                const f32x16& a = dt ? acc1 : acc0;
                u32x2 o; o.x = cvt_pk_bf16(z0 * (a[4 * i4] + bs), z1 * (a[4 * i4 + 1] + bs)); o.y = cvt_pk_bf16(z2 * (a[4 * i4 + 2] + bs), z3 * (a[4 * i4 + 3] + bs));
                *(u32x2*)(mrow + d) = o;
            }
    }
}

__device__ __forceinline__ void cmp_gemm2(const bf16_t* hidden, const bf16_t* w2t, bf16_t* kcmp, bf16_t* vcmpT, int kv, int row0, int lane) {
    LAUNDER(lane);
    const int r = lane & 31, h = lane >> 5;
    f32x16 acc[2];
#pragma unroll
    for (int i = 0; i < 16; ++i) { acc[0][i] = 0.f; acc[1][i] = 0.f; }
#pragma unroll
    for (int ks = 0; ks < 16; ++ks) {
        const bf16x8 hf = *(const bf16x8*)(hidden + (size_t)(row0 + r) * 256 + ks * 16 + h * 8);
#pragma unroll
        for (int dt = 0; dt < 2; ++dt) {
            const bf16x8 wf = *(const bf16x8*)(w2t + (size_t)(dt * 32 + r) * 256 + ks * 16 + h * 8);
            if (kv == 0) acc[dt] = MFMA32(wf, hf, acc[dt]);
            else         acc[dt] = MFMA32(hf, wf, acc[dt]);
        }
    }
#pragma unroll
    for (int dt = 0; dt < 2; ++dt)
#pragma unroll
        for (int i4 = 0; i4 < 4; ++i4) {
            u32x2 o; o.x = cvt_pk_bf16(acc[dt][4 * i4], acc[dt][4 * i4 + 1]); o.y = cvt_pk_bf16(acc[dt][4 * i4 + 2], acc[dt][4 * i4 + 3]);
            if (kv == 0) *(u32x2*)(kcmp + (size_t)(row0 >> 5) * 2048 + (dt * 2 + (i4 >> 1)) * 512 + (i4 & 1) * 256 + r * 8 + 4 * h) = o;
            else         *(u32x2*)(vcmpT + (size_t)(row0 >> 5) * 2048 + dt * 1024 + (i4 >> 1) * 512 + h * 256 + r * 8 + (i4 & 1) * 4) = o;
        }
}

constexpr int NSA_WAVE_LDS = 19456;
constexpr float NEG_INF = -__builtin_inff();

__device__ __forceinline__ void load_k(bf16x8 (&kf)[4], const bf16_t* Kt, int lane) {
    const int r = lane & 31, h = lane >> 5;
#pragma unroll
    for (int ks = 0; ks < 4; ++ks) kf[ks] = *(const bf16x8*)(Kt + ks * 512 + lane * 8);
}
__device__ __forceinline__ void load_v(bf16x8 (&vf)[2][2], const bf16_t* vT, int lane) {
    const int r = lane & 31, h = lane >> 5;
#pragma unroll
    for (int dt = 0; dt < 2; ++dt)
#pragma unroll
        for (int s = 0; s < 2; ++s) vf[dt][s] = *(const bf16x8*)(vT + dt * 1024 + s * 512 + lane * 8);
}
__device__ __forceinline__ f32x16 qk_tile(const bf16x8 (&kf)[4], const bf16x8 (&qf)[4]) {
    f32x16 s;
#pragma unroll
    for (int i = 0; i < 16; ++i) s[i] = 0.f;
#pragma unroll
    for (int ks = 0; ks < 4; ++ks) s = MFMA32(kf[ks], qf[ks], s);
    return s;
}
template <int STRIDE> __device__ __forceinline__ void score_tile(f32x16& s, int dl, int dmax, bool lane_ok, bool fast, float lutfar, const LAS float* lutr) {
    if (fast) {
#pragma unroll
        for (int i = 0; i < 16; ++i) s[i] = lane_ok ? (s[i] + lutfar) : NEG_INF;
    } else {
#pragma unroll
        for (int i = 0; i < 16; ++i) {
            const int d = dl - STRIDE * ((i & 3) + 8 * (i >> 2));
            const bool ok = lane_ok && d >= 0 && d < dmax;
            const int di = min(max(d, 0), 128);
            s[i] = ok ? (s[i] + lutr[di]) : NEG_INF;
        }
    }
}
__device__ __forceinline__ void pv_tile(f32x16& o0, f32x16& o1, const f32x16& pr, const bf16x8 (&vf)[2][2]) {
#pragma unroll
    for (int s = 0; s < 2; ++s) {
        u32x4 pk; pk.x = cvt_pk_bf16(pr[8 * s], pr[8 * s + 1]); pk.y = cvt_pk_bf16(pr[8 * s + 2], pr[8 * s + 3]); pk.z = cvt_pk_bf16(pr[8 * s + 4], pr[8 * s + 5]); pk.w = cvt_pk_bf16(pr[8 * s + 6], pr[8 * s + 7]);
        const bf16x8 pb = __builtin_bit_cast(bf16x8, pk);
        o0 = MFMA32(vf[0][s], pb, o0);
        o1 = MFMA32(vf[1][s], pb, o1);
    }
}
template <bool FAST> __device__ __forceinline__ void online_step(f32x16& s, float bias, bool lane_ok, float& m, float& l, f32x16& o0, f32x16& o1, const bf16x8 (&vf)[2][2]) {
    float mx = fmaxf(fmaxf(fmaxf(s[0], s[1]), fmaxf(s[2], s[3])), fmaxf(fmaxf(s[4], s[5]), fmaxf(s[6], s[7])));
    mx = fmaxf(mx, fmaxf(fmaxf(fmaxf(s[8], s[9]), fmaxf(s[10], s[11])), fmaxf(fmaxf(s[12], s[13]), fmaxf(s[14], s[15]))));
    if (FAST) { mx += bias; mx = lane_ok ? mx : NEG_INF; }
    mx = xhalf_max(mx);
    if (__any(mx > m + 8.0f)) {
        const float mnew = (mx > m + 8.0f) ? mx : m;
        const float alpha = fast_exp2(m - mnew);
        l *= alpha; m = mnew;
#pragma unroll
        for (int i = 0; i < 16; ++i) { o0[i] *= alpha; o1[i] *= alpha; }
    }
    const float c = FAST ? (lane_ok ? (m - bias) : __builtin_inff()) : m;
    float ps = 0.f;
#pragma unroll
    for (int i = 0; i < 16; ++i) { s[i] = fast_exp2(s[i] - c); ps += s[i]; }
    ps = xhalf_sum(ps);
    l += ps;
    pv_tile(o0, o1, s, vf);
}

#define MFMA8(a, b, c) __builtin_amdgcn_mfma_f32_32x32x16_fp8_fp8((a), (b), (c), 0, 0, 0)
__device__ __forceinline__ void load_k8(long (&kf)[4], const unsigned char* Kt, int lane) {
#pragma unroll
    for (int ks = 0; ks < 4; ++ks) kf[ks] = *(const long*)(Kt + ks * 512 + lane * 8);
}
__device__ __forceinline__ void load_v8(long (&vf)[2][2], const unsigned char* vT, int lane) {
#pragma unroll
    for (int dt = 0; dt < 2; ++dt)
#pragma unroll
        for (int s = 0; s < 2; ++s) vf[dt][s] = *(const long*)(vT + dt * 1024 + s * 512 + lane * 8);
}
__device__ __forceinline__ long pack_fp8x8(float a0, float a1, float a2, float a3, float a4, float a5, float a6, float a7) {
    int w0 = __builtin_amdgcn_cvt_pk_fp8_f32(a0, a1, 0, false); w0 = __builtin_amdgcn_cvt_pk_fp8_f32(a2, a3, w0, true);
    int w1 = __builtin_amdgcn_cvt_pk_fp8_f32(a4, a5, 0, false); w1 = __builtin_amdgcn_cvt_pk_fp8_f32(a6, a7, w1, true);
    return (long)(((unsigned long long)(unsigned)w1 << 32) | (unsigned long long)(unsigned)w0);
}
template <bool FAST> __device__ __forceinline__ void online_step8(f32x16& s, float bias, bool lane_ok, float& m, float& l, f32x16& o0, f32x16& o1, const long (&vf)[2][2]) {
    float mx = fmaxf(fmaxf(fmaxf(s[0], s[1]), fmaxf(s[2], s[3])), fmaxf(fmaxf(s[4], s[5]), fmaxf(s[6], s[7])));
    mx = fmaxf(mx, fmaxf(fmaxf(fmaxf(s[8], s[9]), fmaxf(s[10], s[11])), fmaxf(fmaxf(s[12], s[13]), fmaxf(s[14], s[15]))));
    if (FAST) { mx = mx * QSCALE + bias; mx = lane_ok ? mx : NEG_INF; }
    mx = xhalf_max(mx);
    if (__any(mx > m + 2.0f)) {
        const float mnew = (mx > m + 2.0f) ? mx : m;
        const float alpha = fast_exp2(m - mnew);
        l *= alpha; m = mnew;
#pragma unroll
        for (int i = 0; i < 16; ++i) { o0[i] *= alpha; o1[i] *= alpha; }
    }
    float ps = 0.f;
    if (FAST) {
        const float c = lane_ok ? (m - bias - 6.0f) : __builtin_inff();
#pragma unroll
        for (int i = 0; i < 16; ++i) { s[i] = fast_exp2(__builtin_fmaf(s[i], QSCALE, -c)); ps += s[i]; }
    } else {
        const float c = m - 6.0f;
#pragma unroll
        for (int i = 0; i < 16; ++i) { s[i] = fast_exp2(s[i] - c); ps += s[i]; }
    }
    ps = xhalf_sum(ps);
    l += ps;
#pragma unroll
    for (int t = 0; t < 2; ++t) {
        const long pb = pack_fp8x8(s[8 * t], s[8 * t + 1], s[8 * t + 2], s[8 * t + 3], s[8 * t + 4], s[8 * t + 5], s[8 * t + 6], s[8 * t + 7]);
        o0 = MFMA8(vf[0][t], pb, o0);
        o1 = MFMA8(vf[1][t], pb, o1);
    }
}

__device__ __forceinline__ float max16(const f32x16& s) {
    const float a = fmaxf(fmaxf(fmaxf(s[0], s[1]), fmaxf(s[2], s[3])), fmaxf(fmaxf(s[4], s[5]), fmaxf(s[6], s[7])));
    const float b = fmaxf(fmaxf(fmaxf(s[8], s[9]), fmaxf(s[10], s[11])), fmaxf(fmaxf(s[12], s[13]), fmaxf(s[14], s[15])));
    return fmaxf(a, b);
}
template <bool FAST> __device__ __forceinline__ void online_step8x2(f32x16& sa, f32x16& sb, float bias, bool lane_ok, float& m, float& l, f32x16& o0, f32x16& o1, const long (&va)[2][2], const long (&vb)[2][2]) {
    float mx = fmaxf(max16(sa), max16(sb));
    if (FAST) { mx = mx * QSCALE + bias; mx = lane_ok ? mx : NEG_INF; }
    mx = xhalf_max(mx);
    if (__any(mx > m + 2.0f)) {
        const float mnew = (mx > m + 2.0f) ? mx : m;
        const float alpha = fast_exp2(m - mnew);
        l *= alpha; m = mnew;
#pragma unroll
        for (int i = 0; i < 16; ++i) { o0[i] *= alpha; o1[i] *= alpha; }
    }
    float ps = 0.f, ps2 = 0.f;
    if (FAST) {
        const float c = lane_ok ? (m - bias - 6.0f) : __builtin_inff();
#pragma unroll
        for (int i = 0; i < 16; ++i) { sa[i] = fast_exp2(__builtin_fmaf(sa[i], QSCALE, -c)); ps += sa[i]; sb[i] = fast_exp2(__builtin_fmaf(sb[i], QSCALE, -c)); ps2 += sb[i]; }
    } else {
        const float c = m - 6.0f;
#pragma unroll
        for (int i = 0; i < 16; ++i) { sa[i] = fast_exp2(sa[i] - c); ps += sa[i]; sb[i] = fast_exp2(sb[i] - c); ps2 += sb[i]; }
    }
    ps += ps2;
    ps = xhalf_sum(ps);
    l += ps;
    const long pa0 = pack_fp8x8(sa[0], sa[1], sa[2], sa[3], sa[4], sa[5], sa[6], sa[7]);
    const long pb0 = pack_fp8x8(sb[0], sb[1], sb[2], sb[3], sb[4], sb[5], sb[6], sb[7]);
    o0 = MFMA8(va[0][0], pa0, o0); o1 = MFMA8(va[1][0], pa0, o1);
    const long pa1 = pack_fp8x8(sa[8], sa[9], sa[10], sa[11], sa[12], sa[13], sa[14], sa[15]);
    o0 = MFMA8(vb[0][0], pb0, o0); o1 = MFMA8(vb[1][0], pb0, o1);
    const long pb1 = pack_fp8x8(sb[8], sb[9], sb[10], sb[11], sb[12], sb[13], sb[14], sb[15]);
    o0 = MFMA8(va[0][1], pa1, o0); o1 = MFMA8(va[1][1], pa1, o1);
    o0 = MFMA8(vb[0][1], pb1, o0); o1 = MFMA8(vb[1][1], pb1, o1);
}

__device__ __forceinline__ void nsa_unit(const Params& p, int bg, int jq, LAS unsigned char* lds, int wave, int lane, bool build_lut) {
    LAUNDER(lane);
    const unsigned char* ws = P_ws(p);
    const bf16_t* qb = (const bf16_t*)(ws + WS_R1 + R_Q);
    const bf16_t* kcmp = (const bf16_t*)(ws + WS_R1 + R_KCMP) + (size_t)bg * NCMP * 64;
    const bf16_t* vcmpT = (const bf16_t*)(ws + WS_R1 + R_VCMPT) + (size_t)bg * NCMP * 64;
    const unsigned char* ks8 = ws + WS_R1 + R_KS + (size_t)bg * S * 64;
    const unsigned char* vs8 = ws + WS_R1 + R_VST + (size_t)bg * S * 64;
    const bf16_t* kwb = (const bf16_t*)(ws + WS_R1 + R_KW) + (size_t)bg * S * 64;
    const bf16_t* vwT = (const bf16_t*)(ws + WS_R1 + R_VWT) + (size_t)bg * S * 64;
    const float* gates = (const float*)(ws + WS_R1 + R_GATES);
    bf16_t* mixed = (bf16_t*)(ws + WS_AN);
    const float* relb = P_in(p, 1);
    const int b = bg >> 1, g = bg & 1;
    LAS float* imp = (LAS float*)(lds + wave * NSA_WAVE_LDS);
    LAS unsigned* selw = (LAS unsigned*)(lds + wave * NSA_WAVE_LDS + 8192);
    LAS float* lut = (LAS float*)(lds + wave * NSA_WAVE_LDS + 8192 + 256);
    LAS int* list = (LAS int*)(lds + wave * NSA_WAVE_LDS + 8192 + 256 + 2112);
    const int c = lane & 31, h = lane >> 5, ql = c >> 2, r = c & 3;
    const int tq0 = 64 * jq + 8 * wave, tq = tq0 + ql;
    const size_t tok = (size_t)b * S + tq;

    if (build_lut) {
        for (int e = lane; e < 4 * 129; e += 64) {
            const int rr = e / 129, n = e % 129;
            int bk = n;
            if (n >= 16) bk = 16 + (n >= 19) + (n >= 21) + (n >= 24) + (n >= 27) + (n >= 31) + (n >= 35) + (n >= 40) + (n >= 46) + (n >= 52) + (n >= 59) + (n >= 67) + (n >= 77) + (n >= 87) + (n >= 99) + (n >= 113);
            lut[rr * 132 + n] = relb[bk * 8 + g * 4 + rr] * LOG2E;
        }
    }
#pragma unroll
    for (int e = 0; e < 8; ++e) *(LAS f32x4*)(imp + 4 * (lane + 64 * e)) = (f32x4){0.f, 0.f, 0.f, 0.f};
    {
        const int k = lane & 7; unsigned w = 0u;
        if (k == 0) w |= 1u;
        if ((jq >> 5) == k) w |= 1u << (jq & 31);
        if (jq >= 1 && ((jq - 1) >> 5) == k) w |= 1u << ((jq - 1) & 31);
        selw[lane] = w;
    }
    asm volatile("s_waitcnt lgkmcnt(0)" ::: "memory");
    __builtin_amdgcn_wave_barrier();
    const LAS float* lutr = lut + r * 132;
    const float lutfar = lutr[128];

    bf16x8 qf[4];
#pragma unroll
    for (int ks = 0; ks < 4; ++ks) qf[ks] = *(const bf16x8*)(qb + tok * 512 + (g * 4 + r) * 64 + ks * 16 + h * 8);
    const float g0 = gates[tok * 24 + (g * 4 + r) * 3 + 0], g1 = gates[tok * 24 + (g * 4 + r) * 3 + 1], g2 = gates[tok * 24 + (g * 4 + r) * 3 + 2];

    f32x16 oa0, oa1;
    bf16x8 kf[4], kn[4], vf[2][2];
    {
        const int jmaxw = (tq0 + 7 - 31) >> 4;
        const int ntile = (jmaxw >= 0) ? (jmaxw >> 5) + 1 : 0;
        float m = -1e30f, l = 0.f;
        if (ntile > 0) load_k(kn, kcmp, lane);
        for (int T = 0; T < ntile; ++T) {
#pragma unroll
            for (int ks = 0; ks < 4; ++ks) kf[ks] = kn[ks];
            if (T + 1 < ntile) load_k(kn, kcmp + (size_t)(T + 1) * 2048, lane);
            f32x16 s = qk_tile(kf, qf);
            const int base = 512 * T + 31;
            const bool fast = (tq0 - base - 16 * 31) >= 128;
            score_tile<16>(s, tq - base - 64 * h, 1 << 30, true, fast, lutfar, lutr);
            float mx = s[0];
#pragma unroll
            for (int i = 1; i < 16; ++i) mx = fmaxf(mx, s[i]);
            mx = xhalf_max(mx);
            const float mnew = fmaxf(m, mx);
            float ps = 0.f;
#pragma unroll
            for (int i = 0; i < 16; ++i) ps += fast_exp2(s[i] - mnew);
            ps = xhalf_sum(ps);
            l = l * fast_exp2(m - mnew) + ps; m = mnew;
        }
        const float c2 = (l > 0.f) ? (m + __builtin_amdgcn_logf(l)) : __builtin_inff();
        const float c2f = c2 - lutfar;
        f32x16 o0, o1;
#pragma unroll
        for (int i = 0; i < 16; ++i) { o0[i] = 0.f; o1[i] = 0.f; }
        if (ntile > 0) load_k(kn, kcmp, lane);
        for (int T = 0; T < ntile; ++T) {
#pragma unroll
            for (int ks = 0; ks < 4; ++ks) kf[ks] = kn[ks];
            load_v(vf, vcmpT + (size_t)T * 2048, lane);
            if (T + 1 < ntile) load_k(kn, kcmp + (size_t)(T + 1) * 2048, lane);
            f32x16 s = qk_tile(kf, qf);
            const int base = 512 * T + 31;
            const bool fast = (tq0 - base - 16 * 31) >= 128;
            if (fast) {
#pragma unroll
                for (int i = 0; i < 16; ++i) s[i] = fast_exp2(s[i] - c2f);
            } else {
                score_tile<16>(s, tq - base - 64 * h, 1 << 30, true, false, lutfar, lutr);
#pragma unroll
                for (int i = 0; i < 16; ++i) s[i] = fast_exp2(s[i] - c2);
            }
#pragma unroll
            for (int i4 = 0; i4 < 4; ++i4) {
                float a = (s[4 * i4] + s[4 * i4 + 1]) + (s[4 * i4 + 2] + 0.5f * s[4 * i4 + 3]);
                float bb = 0.5f * s[4 * i4 + 3];
                a = quad_sum(a); bb = quad_sum(bb);
                if (r == i4) {
                    const int n = 8 * T + 2 * i4 + h;
                    atomicAdd((float*)(imp + ql * 256 + n), a);
                    if (n + 1 < 256) atomicAdd((float*)(imp + ql * 256 + n + 1), bb);
                }
            }
            pv_tile(o0, o1, s, vf);
        }
        {
            LAS float* park = (LAS float*)(lds + wave * NSA_WAVE_LDS + 11264);
#pragma unroll
            for (int i = 0; i < 16; ++i) { park[i * 64 + lane] = g0 * o0[i]; park[(16 + i) * 64 + lane] = g0 * o1[i]; }
        }
    }
    asm volatile("s_waitcnt lgkmcnt(0)" ::: "memory");
    __builtin_amdgcn_wave_barrier();
    if (jq >= 3) {
        const int tj = lane & 7;
        int val[32];
#pragma unroll
        for (int c4 = 0; c4 < 8; ++c4) {
            const f32x4 iv = *(const LAS f32x4*)(imp + (lane >> 3) * 256 + 32 * tj + 4 * c4);
#pragma unroll
            for (int e = 0; e < 4; ++e) {
                const int n = 32 * tj + 4 * c4 + e;
                const int key = (int)((__float_as_uint(iv[e]) & 0x7fffff00u) | (unsigned)(255 - n));
                val[4 * c4 + e] = (n >= 1 && n <= jq - 2) ? key : -1;
            }
        }
        unsigned myw = 0u;
        for (int round = 0; round < 13; ++round) {
            int lm = val[0];
#pragma unroll
            for (int e = 1; e < 32; ++e) lm = max(lm, val[e]);
            int gm = max(lm, __builtin_amdgcn_mov_dpp(lm, 0xB1, 0xf, 0xf, true));
            gm = max(gm, __builtin_amdgcn_mov_dpp(gm, 0x4E, 0xf, 0xf, true));
            gm = max(gm, __builtin_amdgcn_mov_dpp(gm, 0x141, 0xf, 0xf, true));
            const int n = 255 - (gm & 0xff);
            myw |= (gm >= 0 && (n >> 5) == tj) ? (1u << (n & 31)) : 0u;
#pragma unroll
            for (int e = 0; e < 32; ++e) val[e] = (val[e] == gm) ? -1 : val[e];
        }
        selw[lane] |= myw;
    }
    asm volatile("s_waitcnt lgkmcnt(0)" ::: "memory");
    __builtin_amdgcn_wave_barrier();
    {
        unsigned uwA = 0u, uwB = 0u;
        if (lane < 8) {
#pragma unroll
            for (int qq = 0; qq < 4; ++qq) { uwA |= selw[qq * 8 + lane]; uwB |= selw[(qq + 4) * 8 + lane]; }
        }
        int cntA = 0, cntB = 0;
#pragma unroll
        for (int k = 0; k < 8; ++k) {
            const unsigned ba = (unsigned)__builtin_amdgcn_readlane((int)uwA, k), bb2 = (unsigned)__builtin_amdgcn_readlane((int)uwB, k);
            if (lane < 32) {
                const unsigned below = (1u << lane) - 1u;
                if ((ba >> lane) & 1u) list[cntA + __builtin_popcount(ba & below)] = 32 * k + lane;
                if ((bb2 >> lane) & 1u) list[64 + cntB + __builtin_popcount(bb2 & below)] = 32 * k + lane;
            }
            cntA += __builtin_popcount(ba); cntB += __builtin_popcount(bb2);
        }
        asm volatile("s_waitcnt lgkmcnt(0)" ::: "memory");
        __builtin_amdgcn_wave_barrier();
        LAS float* ostage = imp;
        const int c16 = lane & 15, fq = lane >> 4, q4 = c16 >> 2, r16 = c16 & 3;
        const LAS float* lutr16 = lut + r16 * 132;
        const float lutfar16 = lutr16[128];
        for (int grp = 0; grp < 2; ++grp) {
            const int cnt = grp ? cntB : cntA, lbase = grp * 64;
            const int tqg = tq0 + 4 * grp + q4, tq0g = tq0 + 4 * grp;
            long q8[2];
            bf16x8 qv2[2];
            {
                const bf16_t* qp = qb + ((size_t)b * S + tqg) * 512 + (g * 4 + r16) * 64 + 8 * fq;
                qv2[0] = *(const bf16x8*)(qp); qv2[1] = *(const bf16x8*)(qp + 32);
            }
            float m = -1e30f;
            f32x4 lacc = (f32x4){0.f, 0.f, 0.f, 0.f};
            const long ones8 = 0x3838383838383838L;
            f32x4 o[4];
#pragma unroll
            for (int dt = 0; dt < 4; ++dt) o[dt] = (f32x4){0.f, 0.f, 0.f, 0.f};
            const int npair = (cnt + 1) >> 1;
            if (lane == 0 && (cnt & 1)) list[lbase + cnt] = 0;
            asm volatile("s_waitcnt lgkmcnt(0)" ::: "memory");
            __builtin_amdgcn_wave_barrier();
            long k8[2][8], v8[2][8];
            int n0 = __builtin_amdgcn_readfirstlane(list[lbase]), n1 = __builtin_amdgcn_readfirstlane(list[lbase + 1]);
#pragma unroll
            for (int i = 0; i < 4; ++i) { const l64x2 t0 = *(const l64x2*)(ks8 + (size_t)n0 * 4096 + i * 1024 + lane * 16), t1 = *(const l64x2*)(ks8 + (size_t)n1 * 4096 + i * 1024 + lane * 16);
                k8[0][2 * i] = t0[0]; k8[0][2 * i + 1] = t0[1]; k8[1][2 * i] = t1[0]; k8[1][2 * i + 1] = t1[1]; }
#pragma unroll
            for (int ks = 0; ks < 2; ++ks) {
                float f[8];
#pragma unroll
                for (int e = 0; e < 8; ++e) f[e] = bf2f((bf16_t)qv2[ks][e]) * 4.0f;
                q8[ks] = pack_fp8x8(f[0], f[1], f[2], f[3], f[4], f[5], f[6], f[7]);
            }
            for (int it = 0; it < npair; ++it) {
                const int nb[2] = {n0, n1};
                const bool real1 = (2 * it + 1) < cnt;
#pragma unroll
                for (int u = 0; u < 2; ++u)
#pragma unroll
                    for (int i = 0; i < 4; ++i) { const l64x2 t = *(const l64x2*)(vs8 + (size_t)nb[u] * 4096 + i * 1024 + lane * 16); v8[u][2 * i] = t[0]; v8[u][2 * i + 1] = t[1]; }
                bool ok[2];
                ok[0] = (selw[(grp * 4 + q4) * 8 + (nb[0] >> 5)] >> (nb[0] & 31)) & 1u;
                ok[1] = real1 && ((selw[(grp * 4 + q4) * 8 + (nb[1] >> 5)] >> (nb[1] & 31)) & 1u);
                const int bmax = real1 ? max(nb[0], nb[1]) : nb[0];
                const bool fast = (tq0g - 64 * bmax - 63) >= 128;
                const bool fresh = m < -1e29f;
                const float mref = fresh ? 0.f : m;
                float ini[2];
                ini[0] = fast ? (ok[0] ? -(mref - lutfar16 - 6.0f) : NEG_INF) : 0.f;
                ini[1] = fast ? (ok[1] ? -(mref - lutfar16 - 6.0f) : NEG_INF) : 0.f;
                f32x4 sc[2][4];
#pragma unroll
                for (int u = 0; u < 2; ++u)
#pragma unroll
                    for (int kt = 0; kt < 4; ++kt) {
                        sc[u][kt] = __builtin_amdgcn_mfma_f32_16x16x32_fp8_fp8(k8[u][2 * kt], q8[0], (f32x4){ini[u], ini[u], ini[u], ini[u]}, 0, 0, 0);
                        sc[u][kt] = __builtin_amdgcn_mfma_f32_16x16x32_fp8_fp8(k8[u][2 * kt + 1], q8[1], sc[u][kt], 0, 0, 0);
                    }
                if (it + 1 < npair) {
                    n0 = __builtin_amdgcn_readfirstlane(list[lbase + 2 * it + 2]); n1 = __builtin_amdgcn_readfirstlane(list[lbase + 2 * it + 3]);
#pragma unroll
                    for (int i = 0; i < 4; ++i) { const l64x2 t0 = *(const l64x2*)(ks8 + (size_t)n0 * 4096 + i * 1024 + lane * 16), t1 = *(const l64x2*)(ks8 + (size_t)n1 * 4096 + i * 1024 + lane * 16);
                        k8[0][2 * i] = t0[0]; k8[0][2 * i + 1] = t0[1]; k8[1][2 * i] = t1[0]; k8[1][2 * i + 1] = t1[1]; }
                }
                if (fast) {
                    float t = NEG_INF;
#pragma unroll
                    for (int u = 0; u < 2; ++u) {
                        float tt = fmaxf(fmaxf(fmaxf(sc[u][0][0], sc[u][0][1]), fmaxf(sc[u][0][2], sc[u][0][3])), fmaxf(fmaxf(sc[u][1][0], sc[u][1][1]), fmaxf(sc[u][1][2], sc[u][1][3])));
                        tt = fmaxf(tt, fmaxf(fmaxf(fmaxf(sc[u][2][0], sc[u][2][1]), fmaxf(sc[u][2][2], sc[u][2][3])), fmaxf(fmaxf(sc[u][3][0], sc[u][3][1]), fmaxf(sc[u][3][2], sc[u][3][3]))));
                        t = fmaxf(t, tt);
                    }
                    { auto t1 = __builtin_amdgcn_permlane16_swap(__float_as_uint(t), __float_as_uint(t), false, false); t = fmaxf(__uint_as_float(t1[0]), __uint_as_float(t1[1])); t = xhalf_max(t); }
                    const float mxt = t - 6.0f + mref;
                    const bool need = fresh ? (t > NEG_INF) : (mxt > m + 2.0f);
                    if (__any(need)) {
                        const float mnew = need ? mxt : m;
                        const float delta = need ? (mnew - mref) : 0.f;
                        const float alpha = (need && !fresh) ? fast_exp2(m - mnew) : 1.0f;
                        lacc = lacc * alpha; m = mnew;
#pragma unroll
                        for (int dt = 0; dt < 4; ++dt) o[dt] = o[dt] * alpha;
#pragma unroll
                        for (int u = 0; u < 2; ++u)
#pragma unroll
                            for (int kt = 0; kt < 4; ++kt) sc[u][kt] = sc[u][kt] - delta;
                    }
#pragma unroll
                    for (int u = 0; u < 2; ++u)
#pragma unroll
                        for (int kt = 0; kt < 4; ++kt)
#pragma unroll
                            for (int e = 0; e < 4; ++e) sc[u][kt][e] = fast_exp2(sc[u][kt][e]);
                } else {
                    float mx = NEG_INF;
#pragma unroll
                    for (int u = 0; u < 2; ++u)
#pragma unroll
                        for (int kt = 0; kt < 4; ++kt)
#pragma unroll
                            for (int e = 0; e < 4; ++e) {
                                const int d = tqg - 64 * nb[u] - 16 * kt - 4 * fq - e;
                                const bool okk = ok[u] && d >= 0;
                                const float v = okk ? (sc[u][kt][e] + lutr16[min(max(d, 0), 128)]) : NEG_INF;
                                sc[u][kt][e] = v; mx = fmaxf(mx, v);
                            }
                    { auto t1 = __builtin_amdgcn_permlane16_swap(__float_as_uint(mx), __float_as_uint(mx), false, false); mx = fmaxf(__uint_as_float(t1[0]), __uint_as_float(t1[1])); mx = xhalf_max(mx); }
                    if (__any(mx > m + 2.0f)) {
                        const float mnew = (mx > m + 2.0f) ? mx : m;
                        const float alpha = fast_exp2(m - mnew);
                        lacc = lacc * alpha; m = mnew;
#pragma unroll
                        for (int dt = 0; dt < 4; ++dt) o[dt] = o[dt] * alpha;
                    }
                    const float cexp = m - 6.0f;
#pragma unroll
                    for (int u = 0; u < 2; ++u)
#pragma unroll
                        for (int kt = 0; kt < 4; ++kt)
#pragma unroll
                            for (int e = 0; e < 4; ++e) sc[u][kt][e] = fast_exp2(sc[u][kt][e] - cexp);
                }
#pragma unroll
                for (int u = 0; u < 2; ++u) {
                    const long pb0 = pack_fp8x8(sc[u][0][0], sc[u][0][1], sc[u][0][2], sc[u][0][3], sc[u][1][0], sc[u][1][1], sc[u][1][2], sc[u][1][3]);
                    const long pb1 = pack_fp8x8(sc[u][2][0], sc[u][2][1], sc[u][2][2], sc[u][2][3], sc[u][3][0], sc[u][3][1], sc[u][3][2], sc[u][3][3]);
#pragma unroll
                    for (int dt = 0; dt < 4; ++dt) {
                        o[dt] = __builtin_amdgcn_mfma_f32_16x16x32_fp8_fp8(v8[u][2 * dt], pb0, o[dt], 0, 0, 0);
                        o[dt] = __builtin_amdgcn_mfma_f32_16x16x32_fp8_fp8(v8[u][2 * dt + 1], pb1, o[dt], 0, 0, 0);
                    }
                    lacc = __builtin_amdgcn_mfma_f32_16x16x32_fp8_fp8(ones8, pb0, lacc, 0, 0, 0);
                    lacc = __builtin_amdgcn_mfma_f32_16x16x32_fp8_fp8(ones8, pb1, lacc, 0, 0, 0);
                }
            }
            const float l = lacc[0];
            const float invl = (l > 0.f) ? 1.0f / l : 0.f;
#pragma unroll
            for (int dt = 0; dt < 4; ++dt) *(LAS f32x4*)(ostage + ((grp * 4 + q4) * 4 + r16) * 64 + 16 * dt + 4 * fq) = o[dt] * invl;
        }
        asm volatile("s_waitcnt lgkmcnt(0)" ::: "memory");
        __builtin_amdgcn_wave_barrier();
        {
            const LAS float* park = (const LAS float*)(lds + wave * NSA_WAVE_LDS + 11264);
#pragma unroll
            for (int i = 0; i < 16; ++i) { oa0[i] = park[i * 64 + lane]; oa1[i] = park[(16 + i) * 64 + lane]; }
        }
#pragma unroll
        for (int dt = 0; dt < 2; ++dt)
#pragma unroll
            for (int i4 = 0; i4 < 4; ++i4) {
                const f32x4 v = *(const LAS f32x4*)(ostage + (ql * 4 + r) * 64 + 32 * dt + 8 * i4 + 4 * h);
                if (dt == 0) { oa0[4 * i4] += g1 * v[0]; oa0[4 * i4 + 1] += g1 * v[1]; oa0[4 * i4 + 2] += g1 * v[2]; oa0[4 * i4 + 3] += g1 * v[3]; }
                else         { oa1[4 * i4] += g1 * v[0]; oa1[4 * i4 + 1] += g1 * v[1]; oa1[4 * i4 + 2] += g1 * v[2]; oa1[4 * i4 + 3] += g1 * v[3]; }
            }
        asm volatile("s_waitcnt lgkmcnt(0)" ::: "memory");
        __builtin_amdgcn_wave_barrier();
    }
    {
        {
            const bf16_t* qp = qb + tok * 512 + (g * 4 + r) * 64 + h * 8;
            asm volatile("" : "+v"(qp));
#pragma unroll
            for (int ks = 0; ks < 4; ++ks) qf[ks] = *(const bf16x8*)(qp + ks * 16);
        }
        const int T0 = max(0, (tq0 - 511) >> 5), T1 = (tq0 + 7) >> 5;
        float m = -1e30f, l = 0.f;
        f32x16 o0, o1;
#pragma unroll
        for (int i = 0; i < 16; ++i) { o0[i] = 0.f; o1[i] = 0.f; }
        load_k(kn, kwb + (size_t)(32 * T0) * 64, lane);
        for (int T = T0; T <= T1; ++T) {
#pragma unroll
            for (int ks = 0; ks < 4; ++ks) kf[ks] = kn[ks];
            load_v(vf, vwT + (size_t)T * 2048, lane);
            if (T < T1) load_k(kn, kwb + (size_t)(32 * (T + 1)) * 64, lane);
            const int base = 32 * T;
            f32x16 s = qk_tile(kf, qf);
            if (((tq0 - base - 31) >= 128) && ((tq0 + 7 - base) < 512)) online_step<true>(s, lutfar, true, m, l, o0, o1, vf);
            else { score_tile<1>(s, tq - base - 4 * h, 512, true, false, lutfar, lutr); online_step<false>(s, 0.f, true, m, l, o0, o1, vf); }
        }
        const float sc = (l > 0.f) ? g2 / l : 0.f;
#pragma unroll
        for (int i = 0; i < 16; ++i) { oa0[i] += sc * o0[i]; oa1[i] += sc * o1[i]; }
    }
    bf16_t* orow = mixed + tok * 1024 + (g * 4 + r) * 64;
#pragma unroll
    for (int dt = 0; dt < 2; ++dt)
#pragma unroll
        for (int i4 = 0; i4 < 4; ++i4) {
            const f32x16& a = dt ? oa1 : oa0;
            u32x2 o; o.x = cvt_pk_bf16(a[4 * i4], a[4 * i4 + 1]); o.y = cvt_pk_bf16(a[4 * i4 + 2], a[4 * i4 + 3]);
            *(u32x2*)(orow + 32 * dt + 8 * i4 + 4 * h) = o;
        }
}


#define XB_TMO      128
#define XB_XCNT(j)  (256  + 64 * (j))
#define XB_XSUB(j)  (1280 + 64 * (j))
#define XB_XGEN(j)  (2304 + 64 * (j))
#define XB_TOP      3328
#define XB_TOPGEN   3392
#define XCD_BAR_WORDS 3456
#define XB_SPIN_CAP (1u << 22)
__device__ __forceinline__ unsigned xb_ld(unsigned* p)              { return __hip_atomic_load(p, __ATOMIC_RELAXED, __HIP_MEMORY_SCOPE_AGENT); }
__device__ __forceinline__ unsigned xb_add(unsigned* p, unsigned v) { return __hip_atomic_fetch_add(p, v, __ATOMIC_RELAXED, __HIP_MEMORY_SCOPE_AGENT); }
__device__ __forceinline__ unsigned xb_xcc_id() { return (unsigned)__builtin_amdgcn_s_getreg((3 << 11) | 20) & 0xFu; }
#define XB_SPIN(cond, bar) do { unsigned _sp = 0; while (cond) { __builtin_amdgcn_s_sleep(1); \
    if ((++_sp & 255u) == 0u) { if (xb_ld(&(bar)[XB_TMO])) break; if (_sp > XB_SPIN_CAP) { atomicAdd(&(bar)[XB_TMO], 1u); break; } } } } while (0)
__device__ __forceinline__ void xcd_barrier_complete(unsigned* bar, unsigned x, unsigned& nloc, unsigned& nx) {
    const unsigned G = gridDim.x * gridDim.y * gridDim.z;
    unsigned sum, cnt, mine, sp = 0u;
    for (;;) {
        sum = 0u; cnt = 0u; mine = 0u;
#pragma unroll
        for (unsigned j = 0; j < 16; ++j) { const unsigned c = xb_ld(&bar[XB_XCNT(j)]); sum += c; cnt += (c > 0u) ? 1u : 0u; mine = (j == x) ? c : mine; }
        if (sum == G) break;
        __builtin_amdgcn_s_sleep(1);
        if ((++sp & 255u) == 0u) { if (xb_ld(&bar[XB_TMO])) break; if (sp > XB_SPIN_CAP) { atomicAdd(&bar[XB_TMO], 1u); break; } }
    }
    nloc = mine > 0u ? mine : 1u; nx = cnt > 0u ? cnt : 1u;
}
__device__ __forceinline__ void xcd_barrier(unsigned* bar, volatile LAS unsigned* st) {
    asm volatile("s_waitcnt vmcnt(0)" ::: "memory");
    __syncthreads();
    if (threadIdx.x == 0) {
        const unsigned x = xb_xcc_id();
        __builtin_amdgcn_s_waitcnt(0);
        unsigned nloc = st[0], nx = st[1];
        if (nloc == 0u) { xcd_barrier_complete(bar, x, nloc, nx); st[0] = nloc; st[1] = nx; }
        const unsigned old = xb_add(&bar[XB_XSUB(x)], 1u);
        const unsigned gen = old / nloc;
        if (old + 1u == (gen + 1u) * nloc) {
            __builtin_amdgcn_fence(__ATOMIC_RELEASE, "agent");
            asm volatile("s_waitcnt vmcnt(0)" ::: "memory");
            const unsigned og = xb_add(&bar[XB_TOP], 1u);
            const unsigned tg = og / nx;
            if (og + 1u == (tg + 1u) * nx) xb_add(&bar[XB_TOPGEN], 1u);
            else XB_SPIN(xb_ld(&bar[XB_TOPGEN]) == tg, bar);
            __builtin_amdgcn_fence(__ATOMIC_ACQUIRE, "agent");
            xb_add(&bar[XB_XGEN(x)], 1u);
            asm volatile("s_waitcnt vmcnt(0)" ::: "memory");
        } else {
            XB_SPIN(xb_ld(&bar[XB_XGEN(x)]) == gen, bar);
            __builtin_amdgcn_fence(__ATOMIC_ACQUIRE, "agent");
            asm volatile("s_waitcnt vmcnt(0)" ::: "memory");
        }
    }
    __syncthreads();
}

__global__ void __launch_bounds__(NTHREADS, 2) fwd_megakernel(Params p) {
    extern __shared__ __attribute__((aligned(16))) unsigned char lds_raw[];
    LAS unsigned char* lds = (LAS unsigned char*)lds_raw;
    cg::grid_group grid = cg::this_grid();
#define TID_F ({ int _t = threadIdx.x; LAUNDER(_t); _t; })
#define LANE_F (TID_F & 63)
#define WAVE_F (__builtin_amdgcn_readfirstlane(TID_F >> 6))
    const int G = gridDim.x, bx = blockIdx.x;
    const int NGW = G * NWAVES;
#define GW_F (bx * NWAVES + WAVE_F)
#define FRESH_WS unsigned char* ws = P_ws(p); bf16_t* AN = (bf16_t*)(ws + WS_AN); float* MIX = (float*)(ws + WS_MIX); (void)AN; (void)MIX

    { const int tid = TID_F; if (tid < 16) ((LAS unsigned*)(lds + LDS_BYTES - 64))[tid] = 0u; }
    if (bx == 0) { unsigned* barw = (unsigned*)P_ws(p); for (int i = TID_F; i < XCD_BAR_WORDS; i += NTHREADS) barw[i] = 0u; }
    { const int t = TID_F; if (t < 128) ((unsigned*)(P_ws(p) + WS_XCNT))[bx * 128 + t] = 0u; }
    __syncthreads();
    {
        FRESH_WS;
        const int tid = TID_F, lane = tid & 63, wave = __builtin_amdgcn_readfirstlane(tid >> 6), gw = bx * NWAVES + wave;
        LAS float* scr = (LAS float*)(lds + wave * 17408);
        for (int layer = 0; layer < DEPTH; ++layer) {
            unsigned char* wl = ws + WS_W + (size_t)layer * W_LAYER;
            const int I_IN = 16 * (NINP / 64), I_OUT = 16 * 16, I_GU = 16 * (NGU / 64), I_DN = 44 * 16, I_C1 = 32 * 4, I_C2 = 4 * 1;
            const int NIT = I_IN + I_OUT + I_GU + I_DN + 2 * I_C1 + 2 * I_C2;
            for (int it = gw; it < NIT; it += NGW) {
                int r = it;
                if (r < I_IN) { transpose_item<1>(P_in(p, 6) + (size_t)layer * DM * INW, DM, INW, (bf16_t*)(wl + W_IN), NINP / 64, r, scr, lane, P_in(p, 2) + layer * DM); continue; } r -= I_IN;
                if (r < I_OUT) { transpose_item<0>(P_in(p, 17) + (size_t)layer * DM * DM, DM, DM, (bf16_t*)(wl + W_OUT), 16, r, scr, lane); continue; } r -= I_OUT;
                if (r < I_GU) { transpose_item<2>(P_in(p, 18) + (size_t)layer * DM * NGU, DM, NGU, (bf16_t*)(wl + W_GU), NGU / 64, r, scr, lane, P_in(p, 4) + layer * DM); continue; } r -= I_GU;
                if (r < I_DN) { transpose_item<0>(P_in(p, 19) + (size_t)layer * DFF * DM, DFF, DM, (bf16_t*)(wl + W_DN), 16, r, scr, lane); continue; } r -= I_DN;
                if (r < I_C1) { transpose_item<0>(P_in(p, 8) + (size_t)layer * 2048 * 256, 2048, 256, (bf16_t*)(wl + W_C1K), 4, r, scr, lane); continue; } r -= I_C1;
                if (r < I_C1) { transpose_item<0>(P_in(p, 11) + (size_t)layer * 2048 * 256, 2048, 256, (bf16_t*)(wl + W_C1V), 4, r, scr, lane); continue; } r -= I_C1;
                if (r < I_C2) { transpose_item<0>(P_in(p, 9) + (size_t)layer * 256 * 64, 256, 64, (bf16_t*)(wl + W_C2K), 1, r, scr, lane); continue; } r -= I_C2;
                transpose_item<0>(P_in(p, 12) + (size_t)layer * 256 * 64, 256, 64, (bf16_t*)(wl + W_C2V), 1, r, scr, lane);
            }
        }
        __syncthreads();
        for (int task = bx; task < 256; task += G) {
            const int id = task >> 5, layer = id >> 1, kv = id & 1, c0 = (task & 31) * 8;
            const float* pos = P_in(p, kv ? 10 : 7) + (size_t)layer * 2048;
            const float* w1 = P_in(p, kv ? 11 : 8) + (size_t)layer * 2048 * 256;
            LAS float* red = (LAS float*)lds;
            f32x4 a0 = (f32x4){0.f, 0.f, 0.f, 0.f}, a1 = (f32x4){0.f, 0.f, 0.f, 0.f};
#pragma unroll
            for (int rr = 0; rr < 4; ++rr) {
                const int i = wave * 256 + lane + 64 * rr;
                const float pv = pos[i];
                a0 = a0 + *(const f32x4*)(w1 + (size_t)i * 256 + c0) * pv;
                a1 = a1 + *(const f32x4*)(w1 + (size_t)i * 256 + c0 + 4) * pv;
            }
            float acc8[8] = {a0[0], a0[1], a0[2], a0[3], a1[0], a1[1], a1[2], a1[3]};
#pragma unroll
            for (int e = 0; e < 8; ++e) acc8[e] = wave_sum_fast(acc8[e]);
            if (lane == 0) {
#pragma unroll
                for (int e = 0; e < 8; ++e) red[wave * 8 + e] = acc8[e];
            }
            __syncthreads();
            if (tid < 8) { float sum = 0.f;
#pragma unroll
                for (int w = 0; w < 8; ++w) sum += red[w * 8 + tid];
                ((float*)(ws + WS_W + (size_t)layer * W_LAYER + (kv ? W_CBV : W_CBK)))[c0 + tid] = sum; }
            __syncthreads();
        }
        row_pass(P_in(p, 0), (bf16_t*)(ws + WS_HB), nullptr, nullptr, (float*)(ws + WS_RS), nullptr, gw, NGW, lane);
    }
    grid.sync();
    if (TID_F == 0) (void)xb_add(&((unsigned*)P_ws(p))[XB_XCNT(xb_xcc_id())], 1u);

#pragma unroll 1
    for (int layer = 0; layer < DEPTH; ++layer) {
        const size_t wloff = WS_W + (size_t)layer * W_LAYER;
#ifndef SKIP_PA
        {
            FRESH_WS; unsigned char* wl = ws + wloff;
            pg8::Gemm g{(const bf16_t*)(ws + WS_HB), (const bf16_t*)(wl + W_IN), MT, NINP, DM, DM};
            pg8::StaticOrder so; so.init(MT, NINP, G, bx, REP_PA);
            pg8::EpiIn E{ws + WS_R1, (const float*)(ws + WS_RS)};
            pg8::gemm_phase<pg8::EpiIn>(lds, g, so, E);
        }
#endif
        GSYNC();
#ifndef SKIP_PB
        for (int rep = 0; rep < REP_PB; ++rep) {
            FRESH_WS; unsigned char* wl = ws + wloff;
            for (int kv = 0; kv < 2; ++kv) {
                const int c = kv ? ((bx + (G >> 1)) % G) : bx;
                if (c < 16) {
                    bf16_t* hid = (bf16_t*)(ws + WS_R1 + R_HID) + (size_t)kv * 4096 * 256;
                    pg8::Gemm g{(const bf16_t*)(ws + WS_R1 + (kv ? R_VC : R_KC)), (const bf16_t*)(wl + (kv ? W_C1V : W_C1K)), 4096, 256, 2048, 1024};
                    pg8::StaticOrder so; so.init(4096, 256, G, c);
                    pg8::EpiCmp1 E{hid, (const float*)(wl + (kv ? W_CBV : W_CBK))};
                    pg8::gemm_phase<pg8::EpiCmp1>(lds, g, so, E);
                    pg8::Unit u; so.next(0, u);
                    asm volatile("s_waitcnt vmcnt(0)" ::: "memory");
                    __builtin_amdgcn_fence(__ATOMIC_RELEASE, "agent");
                    __syncthreads();
                    __builtin_amdgcn_fence(__ATOMIC_ACQUIRE, "agent");
                    cmp_gemm2(hid, (const bf16_t*)(wl + (kv ? W_C2V : W_C2K)), (bf16_t*)(ws + WS_R1 + R_KCMP), (bf16_t*)(ws + WS_R1 + R_VCMPT), kv, u.pm * 256 + WAVE_F * 32, LANE_F);
                    __syncthreads();
                }
            }
            if (G == 256) {
                const bool is_cmp = (bx < 16) || (bx >= 128 && bx < 144);
                if (!is_cmp) {
                    const int idx = (bx < 128) ? (bx - 16) : (bx - 32);
                    gmlp_unit(p, layer, idx, lds, WAVE_F, LANE_F);
                    if (idx + 224 < MT / 128) gmlp_unit(p, layer, idx + 224, lds, WAVE_F, LANE_F);
                }
            } else {
                for (int ch = bx; ch < MT / 128; ch += G) gmlp_unit(p, layer, ch, lds, WAVE_F, LANE_F);
            }
        }
#endif
        GSYNC();
        {
#if NSA_ENABLE
            __syncthreads();
            for (int rep = 0; rep < REP_PC; ++rep) {
                if (G == 256) {
                    const int x = bx & 7, y = bx >> 3, bg = x >> 1, j = (x & 1) * 32 + y;
                    for (int i = 0; i < 4; ++i) {
                        const int jq = (i >> 1) * 128 + ((i & 1) ? (127 - j) : j);
                        nsa_unit(p, bg, jq, lds, WAVE_F, LANE_F, i == 0);
                    }
                } else {
                    for (int i = 0; bx + i * G < 1024; ++i) {
                        const int u = bx + i * G;
                        const int bg = u >> 8, x = u & 255;
                        const int jq = (bg & 1) ? (255 - x) : x;
                        nsa_unit(p, bg, jq, lds, WAVE_F, LANE_F, true);
                    }
                }
            }
#else
            FRESH_WS;
            bf16_t* mixed = (bf16_t*)(ws + WS_AN);
            for (int m = GW_F; m < MT; m += NGW) { u32x4* o = (u32x4*)(mixed + (size_t)m * 1024); o[LANE_F] = (u32x4){0u, 0u, 0u, 0u}; }
#endif
        }
        GSYNC();
        {
            FRESH_WS; unsigned char* wl = ws + wloff;
            pg8::Gemm g{AN, (const bf16_t*)(wl + W_OUT), MT, DM, DM, DM};
            pg8::StaticOrder so; so.init(MT, DM, G, bx, 1);
            pg8::EpiNormRes E{ws, P_in(p, 3) + layer * DM, nullptr, 2 * layer};
            pg8::gemm_phase<pg8::EpiNormRes>(lds, g, so, E);
        }
        GSYNC();
#ifndef SKIP_PF
        {
            FRESH_WS; unsigned char* wl = ws + wloff;
            pg8::Gemm g{(const bf16_t*)(ws + WS_HB), (const bf16_t*)(wl + W_GU), MT, NGU, DM, DM};
            pg8::StaticOrder so; so.init(MT, NGU, G, bx, REP_PF);
            pg8::EpiGU E{(bf16_t*)(ws + WS_R1), (const float*)(ws + WS_RS)};
            pg8::gemm_phase<pg8::EpiGU>(lds, g, so, E);
        }
#endif
        GSYNC();
        {
            FRESH_WS; unsigned char* wl = ws + wloff;
            pg8::Gemm g{(const bf16_t*)(ws + WS_R1), (const bf16_t*)(wl + W_DN), MT, DM, DFF, DFF};
            pg8::StaticOrder so; so.init(MT, DM, G, bx, 1);
            pg8::EpiNormRes E{ws, P_in(p, 5) + layer * DM, (layer + 1 < DEPTH) ? nullptr : P_out(p), 2 * layer + 1};
            pg8::gemm_phase<pg8::EpiNormRes>(lds, g, so, E);
        }
        if (layer + 1 < DEPTH) GSYNC();
    }
}

extern "C" void kernel_launch(void* const* d_in, const int* in_sizes, int n_in, void* d_out, int out_size, void* d_ws, size_t ws_size, hipStream_t stream) {
    static int grid = 0;
    if (grid == 0) {
        if (n_in != 20 || out_size != MT * DM || ws_size < WS_END) { fprintf(stderr, "kernel_launch: unexpected shapes (n_in %d out %d ws %zu need %zu)\n", n_in, out_size, ws_size, (size_t)WS_END); grid = -1; return; }
        int dev = 0, cus = 0, per_cu = 0;
        hipGetDevice(&dev);
        hipDeviceGetAttribute(&cus, hipDeviceAttributeMultiprocessorCount, dev);
        if (hipFuncSetAttribute((const void*)fwd_megakernel, hipFuncAttributeMaxDynamicSharedMemorySize, LDS_BYTES) != hipSuccess) { fprintf(stderr, "kernel_launch: hipFuncSetAttribute failed\n"); grid = -1; return; }
        if (hipOccupancyMaxActiveBlocksPerMultiprocessor(&per_cu, (const void*)fwd_megakernel, NTHREADS, LDS_BYTES) != hipSuccess || per_cu < 1) { fprintf(stderr, "kernel_launch: occupancy query says %d\n", per_cu); per_cu = 1; }
        (void)hipGetLastError();
        grid = cus;
        if (grid > 256) grid = 256;
    }
    if (grid < 0) return;
    Params p{};
    for (int i = 0; i < 20; ++i) p.in[i] = (const float*)d_in[i];
    p.out = (float*)d_out; p.ws = (unsigned char*)d_ws;
    void* args[] = {&p};
    hipError_t e = hipLaunchCooperativeKernel((const void*)fwd_megakernel, dim3(grid), dim3(NTHREADS), args, LDS_BYTES, stream);
    if (e != hipSuccess) fprintf(stderr, "cooperative launch failed: %s (grid %d)\n", hipGetErrorString(e), grid);
}
```
